# Optimizing an MI355X kernel written in HIP

```python
import jax, jax.numpy as jnp
from jax import lax
import numpy as np

D_MODEL = 1024
BATCH = 8
SEQ = 4096
DEPTH = 1

MEM_LEN = 256
LRU_WIDTH = 512
LRU_BLOCKS = 8
LRU_BLOCK_DIM = LRU_WIDTH // LRU_BLOCKS
CONV_WIDTH = 4
LRU_C = 8.0
FOX_HEADS = 8
FOX_HEAD_DIM = 64
FOX_WIDTH = FOX_HEADS * FOX_HEAD_DIM
Q_BLOCK = 128
MIX_WIDTH = LRU_WIDTH + FOX_WIDTH
IN_COLS = 2 * LRU_WIDTH + 3 * FOX_WIDTH + FOX_HEADS
MEM_HEADS = 4
MEM_HEAD_DIM = 128
MEM_WIDTH = MEM_HEADS * MEM_HEAD_DIM
N_GROUPS = 4
EXPERTS_PER_GROUP = 8
N_EXPERTS = N_GROUPS * EXPERTS_PER_GROUP
TOP_K = 2
D_EXPERT = 512
MOE_BLOCK = 128
EPS = 1e-6

kernel_name = 'hymba_rglru_fox_hmoe_layer'


def rmsnorm(x, g):
    xf = x.astype(jnp.float32)
    y = xf * lax.rsqrt(jnp.mean(xf * xf, axis=-1, keepdims=True) + EPS)
    return (y * g.astype(jnp.float32)).astype(x.dtype)


def rg_lru_group(u, gate_in, conv_w, conv_b, wa, ba, wx, bx, a_param):
    B, S, _ = u.shape
    up = jnp.pad(u, ((0, 0), (CONV_WIDTH - 1, 0), (0, 0)))
    xc = conv_b
    for tap in range(CONV_WIDTH):
        xc = xc + up[:, tap:tap + S] * conv_w[tap]
    xb = xc.reshape(B, S, LRU_BLOCKS, LRU_BLOCK_DIM)
    r = jax.nn.sigmoid(jnp.einsum('bsni,nij->bsnj', xb, wa).reshape(B, S, LRU_WIDTH) + ba)
    i = jax.nn.sigmoid(jnp.einsum('bsni,nij->bsnj', xb, wx).reshape(B, S, LRU_WIDTH) + bx)
    log_a = -LRU_C * r.astype(jnp.float32) * jax.nn.softplus(-a_param.astype(jnp.float32))
    a = jnp.exp(log_a)
    mult = jnp.sqrt(jnp.maximum(-jnp.expm1(2.0 * log_a), 0.0))
    b = mult * (i * xc).astype(jnp.float32)

    def combine(lhs, rhs):
        a1, b1 = lhs
        a2, b2 = rhs
        return a1 * a2, a2 * b1 + b2

    _, h = lax.associative_scan(combine, (a, b), axis=1)
    return (h * jax.nn.gelu(gate_in.astype(jnp.float32))).astype(u.dtype)


def forgetting_attention(q, k, v, log_f):
    B, S, H, Dh = q.shape
    c = jnp.cumsum(log_f, axis=1).transpose(0, 2, 1)
    scale = Dh ** -0.5
    outs = []
    for blk in range(S // Q_BLOCK):
        q0 = blk * Q_BLOCK
        q1 = q0 + Q_BLOCK
        s = jnp.einsum('bqhd,bkhd->bhqk', q[:, q0:q1], k[:, :q1]).astype(jnp.float32) * scale
        s = s + c[:, :, q0:q1, None] - c[:, :, None, :q1]
        qpos = q0 + jnp.arange(Q_BLOCK)[:, None]
        kpos = jnp.arange(q1)[None, :]
        s = jnp.where(kpos <= qpos, s, -jnp.inf)
        p = jax.nn.softmax(s, axis=-1)
        outs.append(jnp.einsum('bhqk,bkhd->bqhd', p.astype(v.dtype), v[:, :q1]))
    return jnp.concatenate(outs, axis=1)


def memory_cross_attention(xn, memn, wq, wkv, q_g, k_g, wo):
    B, S, _ = xn.shape
    M = memn.shape[1]
    q = (xn @ wq).reshape(B, S, MEM_HEADS, MEM_HEAD_DIM)
    kv = memn @ wkv
    k = kv[..., :MEM_WIDTH].reshape(B, M, MEM_HEADS, MEM_HEAD_DIM)
    v = kv[..., MEM_WIDTH:].reshape(B, M, MEM_HEADS, MEM_HEAD_DIM)
    q = rmsnorm(q, q_g)
    k = rmsnorm(k, k_g)
    s = jnp.einsum('bqhd,bkhd->bhqk', q, k).astype(jnp.float32) * (MEM_HEAD_DIM ** -0.5)
    p = jax.nn.softmax(s, axis=-1)
    o = jnp.einsum('bhqk,bkhd->bqhd', p.astype(v.dtype), v).reshape(B, S, MEM_WIDTH)
    return o @ wo


def hierarchical_moe(xn, wg, bg, we, be, w_gate, w_up, w_down):
    B, S, D = xn.shape
    T = B * S
    xt = xn.reshape(T, D)
    g_logits = (xt @ wg).astype(jnp.float32) + bg
    g_prob = jax.nn.softmax(g_logits, axis=-1)
    g_idx = jnp.argmax(g_logits, axis=-1)
    g_w = jnp.take_along_axis(g_prob, g_idx[:, None], axis=1)[:, 0]
    e_logits = ((xt @ we).astype(jnp.float32) + be).reshape(T, N_GROUPS, EXPERTS_PER_GROUP)
    e_logits = jnp.take_along_axis(e_logits, g_idx[:, None, None], axis=1)[:, 0]
    e_prob = jax.nn.softmax(e_logits, axis=-1)
    top_p, top_i = lax.top_k(e_prob, TOP_K)
    top_p = top_p / jnp.sum(top_p, axis=-1, keepdims=True)
    gate = g_w[:, None] * top_p
    expert = g_idx[:, None] * EXPERTS_PER_GROUP + top_i
    A = T * TOP_K
    e_flat = expert.reshape(A).astype(jnp.int32)
    tok_flat = jnp.repeat(jnp.arange(T, dtype=jnp.int32), TOP_K)
    w_flat = gate.reshape(A)
    order = jnp.argsort(e_flat)
    e_s = e_flat[order]
    tok_s = tok_flat[order]
    w_s = w_flat[order]
    counts = jnp.zeros((N_EXPERTS,), jnp.int32).at[e_flat].add(1)
    starts = jnp.cumsum(counts) - counts
    padded = (counts + MOE_BLOCK - 1) // MOE_BLOCK * MOE_BLOCK
    pstarts = jnp.cumsum(padded) - padded
    pends = pstarts + padded
    dest = pstarts[e_s] + (jnp.arange(A, dtype=jnp.int32) - starts[e_s])
    P = A + N_EXPERTS * MOE_BLOCK
    n_blocks = P // MOE_BLOCK
    tok_buf = jnp.zeros((P,), jnp.int32).at[dest].set(tok_s)
    w_buf = jnp.zeros((P,), jnp.float32).at[dest].set(w_s)
    blk_start = jnp.arange(n_blocks, dtype=jnp.int32) * MOE_BLOCK
    blk_expert = jnp.minimum(jnp.sum(blk_start[:, None] >= pends[None, :], axis=1), N_EXPERTS - 1)
    x_buf = xt[tok_buf].reshape(n_blocks, MOE_BLOCK, D)

    def run_block(args):
        xb, e = args
        hdn = jax.nn.silu(xb @ w_gate[e]) * (xb @ w_up[e])
        return hdn @ w_down[e]

    y_buf = lax.map(run_block, (x_buf, blk_expert)).reshape(P, D)
    y = jax.ops.segment_sum(y_buf * w_buf[:, None].astype(y_buf.dtype), tok_buf, num_segments=T)
    return y.reshape(B, S, D)


def setup_inputs(seed: int = 0) -> dict:
    key = jax.random.key(seed)
    ks = jax.random.split(key, 32)
    f32 = jnp.float32
    L = DEPTH

    def nrm(k, shape, scale):
        return jax.random.normal(k, shape, f32) * scale

    def gain(k, shape):
        return 1.0 + 0.01 * jax.random.normal(k, shape, f32)

    a_c = jax.random.uniform(ks[10], (L, LRU_WIDTH), f32, minval=0.9, maxval=0.999)
    sig = a_c ** (1.0 / LRU_C)
    a_param = jnp.log(sig) - jnp.log1p(-sig)
    return {
        'x': jax.random.normal(ks[0], (BATCH, SEQ, D_MODEL), f32),
        'mem': jax.random.normal(ks[1], (BATCH, MEM_LEN, D_MODEL), f32),
        'norm_mix_g': gain(ks[2], (L, D_MODEL)),
        'w_in': nrm(ks[3], (L, D_MODEL, IN_COLS), D_MODEL ** -0.5),
        'b_forget': jax.random.uniform(ks[4], (L, FOX_HEADS), f32, minval=1.0, maxval=5.0),
        'conv_w': nrm(ks[5], (L, CONV_WIDTH, LRU_WIDTH), CONV_WIDTH ** -0.5),
        'conv_b': nrm(ks[6], (L, LRU_WIDTH), 0.01),
        'lru_wa': nrm(ks[7], (L, LRU_BLOCKS, LRU_BLOCK_DIM, LRU_BLOCK_DIM), LRU_BLOCK_DIM ** -0.5),
        'lru_ba': nrm(ks[8], (L, LRU_WIDTH), 0.01),
        'lru_wx': nrm(ks[9], (L, LRU_BLOCKS, LRU_BLOCK_DIM, LRU_BLOCK_DIM), LRU_BLOCK_DIM ** -0.5),
        'lru_bx': nrm(ks[11], (L, LRU_WIDTH), 0.01),
        'lru_a_param': a_param,
        'fox_q_g': gain(ks[12], (L, FOX_HEAD_DIM)),
        'fox_k_g': gain(ks[13], (L, FOX_HEAD_DIM)),
        'lru_out_g': gain(ks[14], (L, LRU_WIDTH)),
        'fox_out_g': gain(ks[15], (L, FOX_WIDTH)),
        'w_out': nrm(ks[16], (L, MIX_WIDTH, D_MODEL), MIX_WIDTH ** -0.5),
        'norm_mem_x_g': gain(ks[17], (L, D_MODEL)),
        'norm_mem_g': gain(ks[18], (L, D_MODEL)),
        'mem_wq': nrm(ks[19], (L, D_MODEL, MEM_WIDTH), D_MODEL ** -0.5),
        'mem_wkv': nrm(ks[20], (L, D_MODEL, 2 * MEM_WIDTH), D_MODEL ** -0.5),
        'mem_q_g': gain(ks[21], (L, MEM_HEAD_DIM)),
        'mem_k_g': gain(ks[22], (L, MEM_HEAD_DIM)),
        'mem_wo': nrm(ks[23], (L, MEM_WIDTH, D_MODEL), MEM_WIDTH ** -0.5),
        'norm_ffn_g': gain(ks[24], (L, D_MODEL)),
        'router_group_w': nrm(ks[25], (L, D_MODEL, N_GROUPS), D_MODEL ** -0.5),
        'router_group_b': nrm(ks[26], (L, N_GROUPS), 0.01),
        'router_expert_w': nrm(ks[27], (L, D_MODEL, N_EXPERTS), D_MODEL ** -0.5),
        'router_expert_b': nrm(ks[28], (L, N_EXPERTS), 0.01),
        'exp_w_gate': nrm(ks[29], (L, N_EXPERTS, D_MODEL, D_EXPERT), D_MODEL ** -0.5),
        'exp_w_up': nrm(ks[30], (L, N_EXPERTS, D_MODEL, D_EXPERT), D_MODEL ** -0.5),
        'exp_w_down': nrm(ks[31], (L, N_EXPERTS, D_EXPERT, D_MODEL), D_EXPERT ** -0.5),
    }


def reference(x, mem, norm_mix_g, w_in, b_forget, conv_w, conv_b, lru_wa, lru_ba, lru_wx, lru_bx,
              lru_a_param, fox_q_g, fox_k_g, lru_out_g, fox_out_g, w_out, norm_mem_x_g, norm_mem_g,
              mem_wq, mem_wkv, mem_q_g, mem_k_g, mem_wo, norm_ffn_g, router_group_w, router_group_b,
              router_expert_w, router_expert_b, exp_w_gate, exp_w_up, exp_w_down):
    B, S, _ = x.shape
    cuts = [LRU_WIDTH, 2 * LRU_WIDTH, 2 * LRU_WIDTH + FOX_WIDTH,
            2 * LRU_WIDTH + 2 * FOX_WIDTH, 2 * LRU_WIDTH + 3 * FOX_WIDTH]
    for l in range(DEPTH):
        h = rmsnorm(x, norm_mix_g[l])
        proj = h @ w_in[l]
        u_lru, g_lru, q, k, v, f_logit = jnp.split(proj, cuts, axis=-1)
        y_lru = rg_lru_group(u_lru, g_lru, conv_w[l], conv_b[l], lru_wa[l], lru_ba[l],
                             lru_wx[l], lru_bx[l], lru_a_param[l])
        q = rmsnorm(q.reshape(B, S, FOX_HEADS, FOX_HEAD_DIM), fox_q_g[l])
        k = rmsnorm(k.reshape(B, S, FOX_HEADS, FOX_HEAD_DIM), fox_k_g[l])
        v = v.reshape(B, S, FOX_HEADS, FOX_HEAD_DIM)
        log_f = jax.nn.log_sigmoid(f_logit.astype(jnp.float32) + b_forget[l])
        y_fox = forgetting_attention(q, k, v, log_f).reshape(B, S, FOX_WIDTH)
        mixed = jnp.concatenate([rmsnorm(y_lru, lru_out_g[l]), rmsnorm(y_fox, fox_out_g[l])], axis=-1)
        x = x + mixed @ w_out[l]
        memn = rmsnorm(mem, norm_mem_g[l])
        x = x + memory_cross_attention(rmsnorm(x, norm_mem_x_g[l]), memn, mem_wq[l], mem_wkv[l],
                                       mem_q_g[l], mem_k_g[l], mem_wo[l])
        x = x + hierarchical_moe(rmsnorm(x, norm_ffn_g[l]), router_group_w[l], router_group_b[l],
                                 router_expert_w[l], router_expert_b[l], exp_w_gate[l],
                                 exp_w_up[l], exp_w_down[l])
    return x
```

```cpp
#include <hip/hip_runtime.h>
#include <stdint.h>
#include <math.h>
#include <cstdio>

typedef unsigned short bf16_t;
typedef short bf16x8 __attribute__((ext_vector_type(8)));
typedef float f32x4 __attribute__((ext_vector_type(4)));
typedef float f32x16 __attribute__((ext_vector_type(16)));
#define GAS __attribute__((address_space(1)))
#define LAS __attribute__((address_space(3)))

constexpr int BATCH = 8, SEQ = 4096, T = BATCH * SEQ, DM = 1024;
constexpr int MEM_LEN = 256, TM = BATCH * MEM_LEN;
constexpr int LRU_W = 512, FOX_H = 8, FOX_D = 64, FOX_W = 512;
constexpr int IN_COLS = 2568;
constexpr int MEM_H = 4, MEM_D = 128, MEM_W = 512;
constexpr int N_GROUPS = 4, EPG = 8, N_EXP = 32, D_EXP = 512;
constexpr int NA = T * 2;
constexpr int MOE_PAD = 256;
constexpr int P_MAX = NA + N_EXP * MOE_PAD;
constexpr int N_TILES = P_MAX / MOE_PAD;
constexpr float EPS = 1e-6f;
constexpr float LOG2E = 1.4426950408889634f;
constexpr int NTHREADS = 512, NWAVES = 8;
constexpr int ESPLIT = 12;

constexpr size_t MiB = 1u << 20;
constexpr size_t WS_CTL = 0;
constexpr size_t CTL_ZERO_BYTES = 256 * 1024;
constexpr int CW_MOE = 0;
constexpr int CW_BAR = 4096;
constexpr size_t WS_LOGF = 1 * MiB;
constexpr size_t WS_CUM = 2 * MiB;
constexpr size_t WS_MEMN = 3 * MiB;
constexpr size_t WS_KM = 7 * MiB;
constexpr size_t WS_VM = 9 * MiB;
constexpr size_t WS_RE = 11 * MiB;
constexpr size_t WS_RW = 11 * MiB + 512 * 1024;
constexpr size_t WS_ROWTOK = 12 * MiB;
constexpr size_t WS_TILEE = 13 * MiB;
constexpr size_t WS_SUMA = 14 * MiB;
constexpr size_t WS_SUMH = 14 * MiB + 512 * 1024;
constexpr size_t WS_LRUW = 15 * MiB;
constexpr size_t WS_WT_IN = 16 * MiB;
constexpr size_t WS_WT_KV = 21 * MiB;
constexpr size_t WS_WT_OUT = 23 * MiB;
constexpr size_t WS_WT_Q = 25 * MiB;
constexpr size_t WS_WT_O = 26 * MiB;
constexpr size_t WS_WT_GU = 27 * MiB;
constexpr size_t WS_WT_D = 91 * MiB;
constexpr size_t WS_H = 123 * MiB;
constexpr size_t WS_MIXED = 123 * MiB;
constexpr size_t WS_LA = 123 * MiB;
constexpr size_t WS_YL = 187 * MiB;
constexpr size_t WS_YF = 219 * MiB;
constexpr size_t WS_YB = 123 * MiB;
constexpr size_t WS_U = 251 * MiB;
constexpr size_t WS_GATE = 283 * MiB;
constexpr size_t WS_Q = 315 * MiB;
constexpr size_t WS_K = 347 * MiB;
constexpr size_t WS_V = 379 * MiB;
constexpr size_t WS_QM = 251 * MiB;
constexpr size_t WS_OM = 283 * MiB;
constexpr size_t WS_HDN = 315 * MiB;
constexpr size_t WS_LB = 411 * MiB;
constexpr size_t WS_X1B = 123 * MiB;
constexpr size_t WS_X2Q = 360 * MiB;
constexpr size_t WS_X2B = 411 * MiB;
constexpr size_t WS_LIST = 476 * MiB;
constexpr size_t WS_SSL = 480 * MiB;
constexpr size_t WS_SSF = 481 * MiB;
constexpr size_t WS_SS1 = 482 * MiB;
constexpr size_t WS_SS2 = 484 * MiB;
constexpr size_t WS_RSTD2 = 486 * MiB;
constexpr size_t WS_WT_R = 487 * MiB;
constexpr size_t WS_END = 488 * MiB;
static_assert((size_t)P_MAX * 512 * 2 <= 96 * MiB && (size_t)NA * DM * 2 <= 128 * MiB, "ws map");

constexpr int LDS_BYTES = 155648;
constexpr int MISC_OFF = LDS_BYTES - 512;

__device__ __forceinline__ bf16_t f2bf(float f) { unsigned u = __float_as_uint(f); return (bf16_t)((u + 0x7fffu + ((u >> 16) & 1u)) >> 16); }
__device__ __forceinline__ float bf2f(bf16_t h) { return __uint_as_float(((unsigned)h) << 16); }
__device__ __forceinline__ float wave_sum(float v) {
#pragma unroll
    for (int o = 1; o < 64; o <<= 1) v += __shfl_xor(v, o);
    return v;
}
__device__ __forceinline__ int crow(int r, int hi) { return (r & 3) + 8 * (r >> 2) + 4 * hi; }
__device__ __forceinline__ float sigmoidf_(float x) { return 1.f / (1.f + __expf(-x)); }
__device__ __forceinline__ float gelu_tanh(float x) {
    const float k0 = 0.7978845608028654f, k1 = 0.044715f;
    float u = k0 * (x + k1 * x * x * x);
    float t = 1.f - 2.f / (1.f + __expf(2.f * u));
    return 0.5f * x * (1.f + t);
}

#define XB_TMO      128
#define XB_XCNT(j)  (256  + 64 * (j))
#define XB_XSUB(j)  (1280 + 64 * (j))
#define XB_XGEN(j)  (2304 + 64 * (j))
#define XB_TOP      3328
#define XB_TOPGEN   3392
#define XCD_BAR_WORDS 3456
#define XB_SPIN_CAP (1u << 20)
__device__ __forceinline__ unsigned xb_ld(unsigned* p)              { return __hip_atomic_load(p, __ATOMIC_RELAXED, __HIP_MEMORY_SCOPE_AGENT); }
__device__ __forceinline__ unsigned xb_add(unsigned* p, unsigned v) { return __hip_atomic_fetch_add(p, v, __ATOMIC_RELAXED, __HIP_MEMORY_SCOPE_AGENT); }
__device__ __forceinline__ unsigned xb_xcc_id() { return (unsigned)__builtin_amdgcn_s_getreg((3 << 11) | 20) & 0xFu; }
#define XB_SPIN(cond, bar) do { unsigned _sp = 0; while (cond) { __builtin_amdgcn_s_sleep(1); \
    if ((++_sp & 255u) == 0u) { if (xb_ld(&(bar)[XB_TMO])) break; if (_sp > XB_SPIN_CAP) { atomicAdd(&(bar)[XB_TMO], 1u); break; } } } } while (0)
struct XcdBarrier { unsigned* bar; unsigned x; volatile LAS unsigned* st; };
__device__ __forceinline__ XcdBarrier xcd_barrier_post(unsigned* bar, volatile LAS unsigned* st) {
    XcdBarrier b; b.bar = bar; b.x = xb_xcc_id(); b.st = st;
    if (threadIdx.x == 0) (void)xb_add(&bar[XB_XCNT(b.x)], 1u);
    return b;
}
__device__ __forceinline__ void xcd_barrier_complete(unsigned* bar, unsigned x, unsigned& nloc, unsigned& nx) {
    const unsigned G = gridDim.x * gridDim.y * gridDim.z;
    unsigned sum, cnt, mine, sp = 0u;
    for (;;) {
        sum = 0u; cnt = 0u; mine = 0u;
#pragma unroll
        for (unsigned j = 0; j < 16; ++j) { const unsigned c = xb_ld(&bar[XB_XCNT(j)]); sum += c; cnt += (c > 0u) ? 1u : 0u; mine = (j == x) ? c : mine; }
        if (sum == G) break;
        __builtin_amdgcn_s_sleep(1);
        if ((++sp & 255u) == 0u) { if (xb_ld(&bar[XB_TMO])) break; if (sp > XB_SPIN_CAP) { atomicAdd(&bar[XB_TMO], 1u); break; } }
    }
    nloc = mine > 0u ? mine : 1u; nx = cnt > 0u ? cnt : 1u;
}
__device__ __forceinline__ void xcd_barrier(const XcdBarrier& b) {
    asm volatile("s_waitcnt vmcnt(0)" ::: "memory");
    __syncthreads();
    if (threadIdx.x == 0) {
        unsigned* bar = b.bar;
        __builtin_amdgcn_s_waitcnt(0);
        unsigned nloc = b.st[0], nx = b.st[1];
        if (nloc == 0u) { xcd_barrier_complete(bar, b.x, nloc, nx); b.st[0] = nloc; b.st[1] = nx; }
        const unsigned old = xb_add(&bar[XB_XSUB(b.x)], 1u);
        const unsigned gen = old / nloc;
        if (old + 1u == (gen + 1u) * nloc) {
            __builtin_amdgcn_fence(__ATOMIC_RELEASE, "agent");
            asm volatile("s_waitcnt vmcnt(0)" ::: "memory");
            const unsigned og = xb_add(&bar[XB_TOP], 1u);
            const unsigned tg = og / nx;
            if (og + 1u == (tg + 1u) * nx) xb_add(&bar[XB_TOPGEN], 1u);
            else XB_SPIN(xb_ld(&bar[XB_TOPGEN]) == tg, bar);
            __builtin_amdgcn_fence(__ATOMIC_ACQUIRE, "agent");
            xb_add(&bar[XB_XGEN(b.x)], 1u);
            asm volatile("s_waitcnt vmcnt(0)" ::: "memory");
        } else {
            XB_SPIN(xb_ld(&bar[XB_XGEN(b.x)]) == gen, bar);
            __builtin_amdgcn_fence(__ATOMIC_ACQUIRE, "agent");
            asm volatile("s_waitcnt vmcnt(0)" ::: "memory");
        }
    }
    __syncthreads();
}

__device__ __forceinline__ void b_rmsnorm_row(const float* __restrict__ x, const float* __restrict__ g, bf16_t* __restrict__ out, int row, int lane) {
    const f32x4* xr = (const f32x4*)(x + (size_t)row * DM) + lane;
    f32x4 v[4]; float s = 0.f;
#pragma unroll
    for (int j = 0; j < 4; ++j) { v[j] = xr[64 * j]; s += v[j].x * v[j].x + v[j].y * v[j].y + v[j].z * v[j].z + v[j].w * v[j].w; }
    const float rstd = rsqrtf(wave_sum(s) * (1.f / DM) + EPS);
    const f32x4* gr = (const f32x4*)g + lane;
    uint2* o = (uint2*)(out + (size_t)row * DM) + lane;
#pragma unroll
    for (int j = 0; j < 4; ++j) {
        f32x4 gg = gr[64 * j];
        uint2 w;
        w.x = (unsigned)f2bf(v[j].x * rstd * gg.x) | ((unsigned)f2bf(v[j].y * rstd * gg.y) << 16);
        w.y = (unsigned)f2bf(v[j].z * rstd * gg.z) | ((unsigned)f2bf(v[j].w * rstd * gg.w) << 16);
        o[64 * j] = w;
    }
}


__device__ __forceinline__ void b_rmsnorm_row_f(const float* __restrict__ x, const float* __restrict__ g, bf16_t* __restrict__ out, const LAS float* wfT, const float* __restrict__ b_forget,
                                                float* __restrict__ LOGF, int row, int lane) {
    const f32x4* xr = (const f32x4*)(x + (size_t)row * DM) + lane;
    f32x4 v[4]; float s = 0.f;
#pragma unroll
    for (int j = 0; j < 4; ++j) { v[j] = xr[64 * j]; s += v[j].x * v[j].x + v[j].y * v[j].y + v[j].z * v[j].z + v[j].w * v[j].w; }
    const float rstd = rsqrtf(wave_sum(s) * (1.f / DM) + EPS);
    const f32x4* gr = (const f32x4*)g + lane;
    uint2* o = (uint2*)(out + (size_t)row * DM) + lane;
#pragma unroll
    for (int j = 0; j < 4; ++j) {
        const f32x4 gg = gr[64 * j];
        v[j].x *= rstd * gg.x; v[j].y *= rstd * gg.y; v[j].z *= rstd * gg.z; v[j].w *= rstd * gg.w;
        uint2 w;
        w.x = (unsigned)f2bf(v[j].x) | ((unsigned)f2bf(v[j].y) << 16);
        w.y = (unsigned)f2bf(v[j].z) | ((unsigned)f2bf(v[j].w) << 16);
        o[64 * j] = w;
    }
    float fl[8];
#pragma unroll
    for (int h = 0; h < 8; ++h) {
        float a = 0.f;
#pragma unroll
        for (int j = 0; j < 4; ++j) { const f32x4 w = *(const LAS f32x4*)(wfT + h * 1024 + 256 * j + 4 * lane); a += (v[j].x * w.x + v[j].y * w.y) + (v[j].z * w.z + v[j].w * w.w); }
        fl[h] = wave_sum(a);
    }
    if (lane == 0) {
#pragma unroll
        for (int h = 0; h < 8; ++h) { const float z = fl[h] + b_forget[h]; LOGF[(size_t)row * 8 + h] = fminf(z, 0.f) - log1pf(__expf(-fabsf(z))); }
    }
}

typedef bf16_t (*As_t)[40];
typedef bf16_t (*Bs_t)[64][40];
template <int NB>
__device__ __forceinline__ void gemm_core64(const bf16_t* aptr, const float* W0, const float* W1, int ldw,
                                            int n0, int N, int K, f32x4 (&acc)[NB][2][2], As_t As, Bs_t Bs, int vt) {
    const int lane = vt & 63, wid = vt >> 6, wr = wid >> 1, wc = wid & 1;
    for (int k0 = 0; k0 < K; k0 += 32) {
        {
            const int r = vt >> 2, c = vt & 3;
            uint4 v = make_uint4(0, 0, 0, 0);
            if (aptr) v = *(const uint4*)(aptr + k0 + c * 8);
            *(uint4*)&As[r][c * 8] = v;
        }
        {
            const int kk = vt >> 3, nc = (vt & 7) * 8;
#pragma unroll
            for (int b = 0; b < NB; ++b) {
                const float* wp = (b == 0 ? W0 : W1) + (size_t)(k0 + kk) * ldw + n0 + nc;
#pragma unroll
                for (int j = 0; j < 8; ++j) { float v = (n0 + nc + j < N) ? wp[j] : 0.f; Bs[b][nc + j][kk] = f2bf(v); }
            }
        }
        __syncthreads();
        bf16x8 a[2];
#pragma unroll
        for (int i = 0; i < 2; ++i) a[i] = *(const bf16x8*)&As[wr * 32 + i * 16 + (lane & 15)][(lane >> 4) * 8];
#pragma unroll
        for (int b = 0; b < NB; ++b)
#pragma unroll
            for (int j = 0; j < 2; ++j) {
                bf16x8 bb = *(const bf16x8*)&Bs[b][wc * 32 + j * 16 + (lane & 15)][(lane >> 4) * 8];
#pragma unroll
                for (int i = 0; i < 2; ++i) acc[b][i][j] = __builtin_amdgcn_mfma_f32_16x16x32_bf16(a[i], bb, acc[b][i][j], 0, 0, 0);
            }
        __syncthreads();
    }
}

template <class Epi>
__device__ __forceinline__ void b_gemm(const bf16_t* __restrict__ A, int lda, const float* __restrict__ W, int ldw, int N, int K, const Epi& epi,
                                       int vbx, int vby, int vt, unsigned char* sm) {
    As_t As = (As_t)sm; Bs_t Bs = (Bs_t)(sm + 64 * 40 * 2);
    const int lane = vt & 63, wid = vt >> 6, wr = wid >> 1, wc = wid & 1;
    const int m0 = vby * 64, n0 = vbx * 64;
    f32x4 acc[1][2][2];
#pragma unroll
    for (int i = 0; i < 2; ++i)
#pragma unroll
        for (int j = 0; j < 2; ++j) acc[0][i][j] = (f32x4){0.f, 0.f, 0.f, 0.f};
    gemm_core64<1>(A + (size_t)(m0 + (vt >> 2)) * lda, W, W, ldw, n0, N, K, acc, As, Bs, vt);
#pragma unroll
    for (int i = 0; i < 2; ++i)
#pragma unroll
        for (int j = 0; j < 2; ++j)
#pragma unroll
            for (int r = 0; r < 4; ++r) {
                const int row = m0 + wr * 32 + i * 16 + (lane >> 4) * 4 + r, col = n0 + wc * 32 + j * 16 + (lane & 15);
                if (col < N) epi(row, col, acc[0][i][j][r]);
            }
}

struct EpiG1 {
    bf16_t *U, *GATE, *Q, *K, *V; float* LOGF; const float* b_forget;
    __device__ __forceinline__ void operator()(int row, int col, float v) const {
        if (col < 512) U[(size_t)row * 512 + col] = f2bf(v);
        else if (col < 1024) GATE[(size_t)row * 512 + col - 512] = f2bf(v);
        else if (col < 1536) Q[(size_t)row * 512 + col - 1024] = f2bf(v);
        else if (col < 2048) K[(size_t)row * 512 + col - 1536] = f2bf(v);
        else if (col < 2560) V[(size_t)row * 512 + col - 2048] = f2bf(v);
        else { const int h = col - 2560; const float z = v + b_forget[h]; LOGF[(size_t)row * 8 + h] = fminf(z, 0.f) - log1pf(__expf(-fabsf(z))); }
    }
};
struct EpiSplit2 { bf16_t *O0, *O1;
    __device__ __forceinline__ void operator()(int row, int col, float v) const {
        if (col < 512) O0[(size_t)row * 512 + col] = f2bf(v); else O1[(size_t)row * 512 + col - 512] = f2bf(v); } };
struct EpiBf16s { bf16_t* O; int ldo;
    __device__ __forceinline__ void operator()(int row, int col, float v) const { O[(size_t)row * ldo + col] = f2bf(v); } };
struct EpiResF32 { const float* base; float* out;
    __device__ __forceinline__ void operator()(int row, int col, float v) const { out[(size_t)row * DM + col] = base[(size_t)row * DM + col] + v; } };

template <int HD>
__device__ __forceinline__ void b_headnorm(bf16_t* __restrict__ X, const float* __restrict__ g, float scale, int idx) {
    const int nh = 512 / HD;
    bf16_t* p = X + (size_t)(idx / nh) * 512 + (idx % nh) * HD;
    float ss = 0.f;
#pragma unroll 8
    for (int d = 0; d < HD; ++d) { float v = bf2f(p[d]); ss += v * v; }
    const float rstd = rsqrtf(ss * (1.f / HD) + EPS) * scale;
#pragma unroll 8
    for (int d = 0; d < HD; ++d) p[d] = f2bf(bf2f(p[d]) * rstd * g[d]);
}

__device__ __forceinline__ void b_cumsum(const float* __restrict__ LOGF, float* __restrict__ CUM, int bh, int vt, unsigned char* sm, bool store) {
    float* part = (float*)sm;
    const int b = bh / FOX_H, h = bh % FOX_H;
    float v[16]; float s = 0.f;
#pragma unroll
    for (int i = 0; i < 16; ++i) { v[i] = LOGF[((size_t)b * SEQ + vt * 16 + i) * 8 + h]; s += v[i]; }
    part[vt] = s; __syncthreads();
    if (vt == 0) { float run = 0.f; for (int i = 0; i < 256; ++i) { float t = part[i]; part[i] = run; run += t; } }
    __syncthreads();
    float run = part[vt];
    if (store) {
#pragma unroll
        for (int i = 0; i < 16; ++i) { run += v[i]; CUM[(size_t)bh * SEQ + vt * 16 + i] = run * LOG2E; }
    }
    __syncthreads();
}

__device__ __forceinline__ void b_lru_ab(const bf16_t* __restrict__ U, const float* __restrict__ conv_w, const float* __restrict__ conv_b,
                                         const float* __restrict__ wa, const float* __restrict__ ba, const float* __restrict__ wx, const float* __restrict__ bx,
                                         const float* __restrict__ a_param, float* __restrict__ LA, float* __restrict__ LB, int t, int ch, unsigned char* sm) {
    float* xc = (float*)sm;
    const int s = t % SEQ;
    float x = conv_b[ch];
#pragma unroll
    for (int tap = 0; tap < 4; ++tap) { const int ss = s - 3 + tap; if (ss >= 0) x += conv_w[tap * 512 + ch] * bf2f(U[(size_t)(t - 3 + tap) * 512 + ch]); }
    xc[ch] = x; __syncthreads();
    const int blk = ch >> 6, j = ch & 63;
    float r = ba[ch], ii = bx[ch];
    const float* wap = wa + (size_t)blk * 4096 + j; const float* wxp = wx + (size_t)blk * 4096 + j;
#pragma unroll 4
    for (int i = 0; i < 64; ++i) { const float xv = xc[blk * 64 + i]; r += xv * wap[i * 64]; ii += xv * wxp[i * 64]; }
    r = sigmoidf_(r); ii = sigmoidf_(ii);
    const float ap = -a_param[ch];
    const float sp = (ap > 20.f) ? ap : log1pf(__expf(ap));
    const float log_a = -8.f * r * sp;
    const float a = __expf(log_a);
    const float mult = sqrtf(fmaxf(-expm1f(2.f * log_a), 0.f));
    LA[(size_t)t * 512 + ch] = a;
    LB[(size_t)t * 512 + ch] = mult * (ii * x);
    __syncthreads();
}
__device__ __forceinline__ void b_lru_scan(const float* __restrict__ LA, const float* __restrict__ LB, const bf16_t* __restrict__ GATE, bf16_t* __restrict__ YL, int vb, int lane) {
    const int b = vb / 8, ch = (vb % 8) * 64 + lane;
    float h = 0.f;
    size_t off = (size_t)b * SEQ * 512 + ch;
    for (int s = 0; s < SEQ; s += 8) {
        float a[8], bb[8], g[8];
#pragma unroll
        for (int i = 0; i < 8; ++i) { a[i] = LA[off + (size_t)(s + i) * 512]; bb[i] = LB[off + (size_t)(s + i) * 512]; g[i] = bf2f(GATE[off + (size_t)(s + i) * 512]); }
#pragma unroll
        for (int i = 0; i < 8; ++i) { h = a[i] * h + bb[i]; YL[off + (size_t)(s + i) * 512] = f2bf(h * gelu_tanh(g[i])); }
    }
}

template <int D, bool CAUSAL, int VB0>
__device__ __forceinline__ void b_attn(const bf16_t* __restrict__ Q, const bf16_t* __restrict__ K, const bf16_t* __restrict__ V, bf16_t* __restrict__ O,
                                       const float* __restrict__ cum, int H, int Sq, int Skv, int pitch, int b, int h, int q0, int lane) {
    const int r32 = lane & 31, hi = lane >> 5;
    const bf16_t* Qp = Q + ((size_t)b * Sq + q0 + r32) * pitch + h * D;
    constexpr bool QREG = (D <= 64);
    bf16x8 qf[QREG ? D / 16 : 1];
    if (QREG) {
#pragma unroll
        for (int d0 = 0; d0 < D / 16; ++d0) qf[QREG ? d0 : 0] = *(const bf16x8*)(Qp + d0 * 16 + hi * 8);
    }
    f32x16 o[2];
#pragma unroll
    for (int i = 0; i < 2; ++i)
#pragma unroll
        for (int r = 0; r < 16; ++r) o[i][r] = 0.f;
    float m = -1e30f, l = 0.f;
    const int nkv = CAUSAL ? (q0 + 32) : Skv;
    const float* cb = cum ? cum + ((size_t)b * H + h) * Skv : nullptr;
    const float cref = cum ? cb[q0] : 0.f;
    const bf16_t* Kb = K + ((size_t)b * Skv) * pitch + h * D;
    const bf16_t* Vb = V + ((size_t)b * Skv) * pitch + h * D;
#pragma unroll 1
    for (int kv0 = 0; kv0 < nkv; kv0 += 32) {
        f32x16 s;
#pragma unroll
        for (int r = 0; r < 16; ++r) s[r] = 0.f;
        const bf16_t* Kp = Kb + (size_t)(kv0 + r32) * pitch;
#pragma unroll
        for (int d0 = 0; d0 < D / 16; ++d0) { bf16x8 kf = *(const bf16x8*)(Kp + d0 * 16 + hi * 8);
            bf16x8 qq; if (QREG) qq = qf[QREG ? d0 : 0]; else qq = *(const bf16x8*)(Qp + d0 * 16 + hi * 8);
            s = __builtin_amdgcn_mfma_f32_32x32x16_bf16(kf, qq, s, 0, 0, 0); }
        float tmax = -INFINITY;
#pragma unroll
        for (int r = 0; r < 16; ++r) {
            const int kv = kv0 + crow(r, hi);
            float v = s[r];
            if (cum) v += cref - cb[kv];
            if (CAUSAL && kv > q0 + r32) v = -INFINITY;
            s[r] = v; tmax = fmaxf(tmax, v);
        }
        tmax = fmaxf(tmax, __shfl_xor(tmax, 32));
        const float mnew = fmaxf(m, tmax);
        const float alpha = exp2f(m - mnew);
        float ps = 0.f;
#pragma unroll
        for (int r = 0; r < 16; ++r) { s[r] = exp2f(s[r] - mnew); ps += s[r]; }
        l = l * alpha + ps; m = mnew;
#pragma unroll
        for (int i = 0; i < 2; ++i)
#pragma unroll
            for (int r = 0; r < 16; ++r) o[i][r] *= alpha;
        bf16x8 pb[2];
#pragma unroll
        for (int s2 = 0; s2 < 2; ++s2)
#pragma unroll
            for (int j = 0; j < 8; ++j) pb[s2][j] = (short)f2bf(s[8 * s2 + j]);
#pragma unroll
        for (int i = 0; i < 2; ++i)
#pragma unroll
            for (int s2 = 0; s2 < 2; ++s2) {
                bf16x8 vf;
#pragma unroll
                for (int j = 0; j < 8; ++j) vf[j] = (short)Vb[(size_t)(kv0 + 16 * s2 + 8 * (j >> 2) + 4 * hi + (j & 3)) * pitch + (VB0 + i) * 32 + r32];
                o[i] = __builtin_amdgcn_mfma_f32_32x32x16_bf16(vf, pb[s2], o[i], 0, 0, 0);
                asm volatile("" ::: "memory");
            }
    }
    l += __shfl_xor(l, 32);
    const float rl = 1.f / l;
    bf16_t* Op = O + ((size_t)b * Sq + q0 + r32) * pitch + h * D;
#pragma unroll
    for (int i = 0; i < 2; ++i)
#pragma unroll
        for (int r = 0; r < 16; ++r) Op[(VB0 + i) * 32 + crow(r, hi)] = f2bf(o[i][r] * rl);
}

__device__ __forceinline__ void b_mixnorm(const bf16_t* __restrict__ YL, const bf16_t* __restrict__ YF, const float* __restrict__ gl, const float* __restrict__ gf, bf16_t* __restrict__ MIXED, int row, int lane) {
#pragma unroll
    for (int part = 0; part < 2; ++part) {
        const bf16_t* src = (part ? YF : YL) + (size_t)row * 512 + lane * 8;
        const float* g = (part ? gf : gl) + lane * 8;
        float v[8]; float ss = 0.f;
#pragma unroll
        for (int j = 0; j < 8; ++j) { v[j] = bf2f(src[j]); ss += v[j] * v[j]; }
        const float rstd = rsqrtf(wave_sum(ss) * (1.f / 512.f) + EPS);
        bf16_t* dst = MIXED + (size_t)row * DM + part * 512 + lane * 8;
#pragma unroll
        for (int j = 0; j < 8; ++j) dst[j] = f2bf(v[j] * rstd * g[j]);
    }
}

__device__ __forceinline__ void b_router(const bf16_t* __restrict__ XN, const float* __restrict__ wg, const float* __restrict__ bg, const float* __restrict__ we, const float* __restrict__ be,
                                         int* __restrict__ RE, float* __restrict__ RW, int* __restrict__ counts, int t, int lane) {
    float acc[36];
#pragma unroll
    for (int o = 0; o < 36; ++o) acc[o] = 0.f;
    const bf16_t* xr = XN + (size_t)t * DM;
#pragma unroll 1
    for (int i = 0; i < 16; ++i) {
        const int k = i * 64 + lane;
        const float xv = bf2f(xr[k]);
        const f32x4 g4 = *(const f32x4*)(wg + (size_t)k * 4);
        acc[0] += xv * g4.x; acc[1] += xv * g4.y; acc[2] += xv * g4.z; acc[3] += xv * g4.w;
        const f32x4* e4 = (const f32x4*)(we + (size_t)k * 32);
#pragma unroll
        for (int q = 0; q < 8; ++q) { const f32x4 e = e4[q]; acc[4 + 4 * q] += xv * e.x; acc[5 + 4 * q] += xv * e.y; acc[6 + 4 * q] += xv * e.z; acc[7 + 4 * q] += xv * e.w; }
    }
#pragma unroll
    for (int o = 0; o < 36; ++o) acc[o] = wave_sum(acc[o]);
    if (lane == 0) {
        float gl[4]; int gi = 0; float gmax;
#pragma unroll
        for (int j = 0; j < 4; ++j) { gl[j] = acc[j] + bg[j]; }
        gmax = gl[0];
#pragma unroll
        for (int j = 1; j < 4; ++j) if (gl[j] > gmax) { gmax = gl[j]; gi = j; }
        float gs = 0.f;
#pragma unroll
        for (int j = 0; j < 4; ++j) gs += __expf(gl[j] - gmax);
        const float gw = 1.f / gs;
        float el[8];
#pragma unroll
        for (int j = 0; j < 8; ++j) {
            float v = 0.f;
#pragma unroll
            for (int g = 0; g < 4; ++g) if (g == gi) v = acc[4 + g * 8 + j] + be[g * 8 + j];
            el[j] = v;
        }
        int i0 = 0; float v0 = el[0];
#pragma unroll
        for (int j = 1; j < 8; ++j) if (el[j] > v0) { v0 = el[j]; i0 = j; }
        int i1 = -1; float v1 = -INFINITY;
#pragma unroll
        for (int j = 0; j < 8; ++j) if (j != i0 && el[j] > v1) { v1 = el[j]; i1 = j; }
        const float e1 = __expf(v1 - v0);
        const float p0 = 1.f / (1.f + e1), p1 = e1 / (1.f + e1);
        const int ex0 = gi * 8 + i0, ex1 = gi * 8 + i1;
        RE[t * 2 + 0] = ex0; RE[t * 2 + 1] = ex1;
        RW[t * 2 + 0] = gw * p0; RW[t * 2 + 1] = gw * p1;
        atomicAdd(&counts[ex0], 1); atomicAdd(&counts[ex1], 1);
    }
}

__device__ __forceinline__ void b_moe_scan(int* __restrict__ ctl, int* __restrict__ TILEE, int tid, unsigned char* sm) {
    int* pst = (int*)sm;
    if (tid == 0) { int run = 0; for (int e = 0; e < N_EXP; ++e) { pst[e] = run; ctl[64 + e] = run; ctl[32 + e] = 0; run += (ctl[e] + MOE_PAD - 1) / MOE_PAD * MOE_PAD; } pst[32] = run; ctl[96] = run / MOE_PAD; }
    __syncthreads();
    for (int tile = tid; tile < N_TILES; tile += NTHREADS) {
        const int p = tile * MOE_PAD; int e = -1;
        for (int j = 0; j < N_EXP; ++j) if (p >= pst[j] && p < pst[j + 1]) e = j;
        TILEE[tile] = e;
    }
}

__device__ __forceinline__ void b_moe_gemm1(const bf16_t* __restrict__ XN, const float* __restrict__ Wg, const float* __restrict__ Wu, const int* __restrict__ ROWTOK, const int* __restrict__ TILEE, bf16_t* __restrict__ HDN,
                                            int vbx, int vby, int vt, unsigned char* sm) {
    As_t As = (As_t)sm; Bs_t Bs = (Bs_t)(sm + 64 * 40 * 2);
    const int e_raw = TILEE[vby];
    const int e = e_raw < 0 ? 0 : e_raw;
    const int lane = vt & 63, wid = vt >> 6, wr = wid >> 1, wc = wid & 1;
    const int p0 = vby * 64, n0 = vbx * 64;
    const int a = ROWTOK[p0 + (vt >> 2)];
    f32x4 acc[2][2][2];
#pragma unroll
    for (int b = 0; b < 2; ++b)
#pragma unroll
        for (int i = 0; i < 2; ++i)
#pragma unroll
            for (int j = 0; j < 2; ++j) acc[b][i][j] = (f32x4){0.f, 0.f, 0.f, 0.f};
    gemm_core64<2>(a >= 0 ? XN + (size_t)(a >> 1) * DM : nullptr, Wg + (size_t)e * DM * D_EXP, Wu + (size_t)e * DM * D_EXP, D_EXP, n0, D_EXP, DM, acc, As, Bs, vt);
    if (e_raw < 0) return;
#pragma unroll
    for (int i = 0; i < 2; ++i)
#pragma unroll
        for (int j = 0; j < 2; ++j)
#pragma unroll
            for (int r = 0; r < 4; ++r) {
                const int row = p0 + wr * 32 + i * 16 + (lane >> 4) * 4 + r, col = n0 + wc * 32 + j * 16 + (lane & 15);
                const float g = acc[0][i][j][r], u = acc[1][i][j][r];
                HDN[(size_t)row * D_EXP + col] = f2bf(g * sigmoidf_(g) * u);
            }
}
__device__ __forceinline__ void b_moe_gemm2(const bf16_t* __restrict__ HDN, const float* __restrict__ Wd, const int* __restrict__ ROWTOK, const int* __restrict__ TILEE, const float* __restrict__ RW, bf16_t* __restrict__ YB,
                                            int vbx, int vby, int vt, unsigned char* sm) {
    As_t As = (As_t)sm; Bs_t Bs = (Bs_t)(sm + 64 * 40 * 2);
    const int e_raw = TILEE[vby];
    const int e = e_raw < 0 ? 0 : e_raw;
    const int lane = vt & 63, wid = vt >> 6, wr = wid >> 1, wc = wid & 1;
    const int p0 = vby * 64, n0 = vbx * 64;
    f32x4 acc[1][2][2];
#pragma unroll
    for (int i = 0; i < 2; ++i)
#pragma unroll
        for (int j = 0; j < 2; ++j) acc[0][i][j] = (f32x4){0.f, 0.f, 0.f, 0.f};
    const int arow = ROWTOK[p0 + (vt >> 2)];
    gemm_core64<1>((arow >= 0 && e_raw >= 0) ? HDN + (size_t)(p0 + (vt >> 2)) * D_EXP : nullptr, Wd + (size_t)e * D_EXP * DM, nullptr, DM, n0, DM, D_EXP, acc, As, Bs, vt);
    if (e_raw < 0) return;
#pragma unroll
    for (int i = 0; i < 2; ++i)
#pragma unroll
        for (int r = 0; r < 4; ++r) {
            const int row = p0 + wr * 32 + i * 16 + (lane >> 4) * 4 + r;
            const int a = ROWTOK[row];
            if (a < 0) continue;
            const float w = RW[a];
#pragma unroll
            for (int j = 0; j < 2; ++j) { const int col = n0 + wc * 32 + j * 16 + (lane & 15); YB[(size_t)a * DM + col] = f2bf(w * acc[0][i][j][r]); }
        }
}
__device__ __forceinline__ void b_final(float* __restrict__ out, const bf16_t* __restrict__ X2B, const unsigned char* __restrict__ YB, size_t i) {
    const size_t t = i / DM, c = i % DM;
    const uint4 xv = *(const uint4*)(X2B + i); const uint2 y0 = *(const uint2*)(YB + (2 * t) * DM + c), y1 = *(const uint2*)(YB + (2 * t + 1) * DM + c);
    const unsigned xs[4] = {xv.x, xv.y, xv.z, xv.w};
    f32x4 o0, o1;
    o0[0] = __uint_as_float(xs[0] << 16) + 0.0625f * (__builtin_amdgcn_cvt_f32_fp8(y0.x, 0) + __builtin_amdgcn_cvt_f32_fp8(y1.x, 0));
    o0[1] = __uint_as_float(xs[0] & 0xffff0000u) + 0.0625f * (__builtin_amdgcn_cvt_f32_fp8(y0.x, 1) + __builtin_amdgcn_cvt_f32_fp8(y1.x, 1));
    o0[2] = __uint_as_float(xs[1] << 16) + 0.0625f * (__builtin_amdgcn_cvt_f32_fp8(y0.x, 2) + __builtin_amdgcn_cvt_f32_fp8(y1.x, 2));
    o0[3] = __uint_as_float(xs[1] & 0xffff0000u) + 0.0625f * (__builtin_amdgcn_cvt_f32_fp8(y0.x, 3) + __builtin_amdgcn_cvt_f32_fp8(y1.x, 3));
    o1[0] = __uint_as_float(xs[2] << 16) + 0.0625f * (__builtin_amdgcn_cvt_f32_fp8(y0.y, 0) + __builtin_amdgcn_cvt_f32_fp8(y1.y, 0));
    o1[1] = __uint_as_float(xs[2] & 0xffff0000u) + 0.0625f * (__builtin_amdgcn_cvt_f32_fp8(y0.y, 1) + __builtin_amdgcn_cvt_f32_fp8(y1.y, 1));
    o1[2] = __uint_as_float(xs[3] << 16) + 0.0625f * (__builtin_amdgcn_cvt_f32_fp8(y0.y, 2) + __builtin_amdgcn_cvt_f32_fp8(y1.y, 2));
    o1[3] = __uint_as_float(xs[3] & 0xffff0000u) + 0.0625f * (__builtin_amdgcn_cvt_f32_fp8(y0.y, 3) + __builtin_amdgcn_cvt_f32_fp8(y1.y, 3));
    *(f32x4*)(out + i) = o0; *(f32x4*)(out + i + 4) = o1;
}

namespace pg8 {
typedef unsigned u32x4 __attribute__((ext_vector_type(4)));
typedef unsigned u32x2 __attribute__((ext_vector_type(2)));
typedef int v4i_t __attribute__((ext_vector_type(4)));
typedef int v8i_t __attribute__((ext_vector_type(8)));
constexpr int BM = 256, BK = 64, HALF = 128, HTB = HALF * BK * 2, STAGE_BYTES = 8 * HTB, NXCD = 8, WGM = 8;
__host__ __device__ __forceinline__ int lds_byte(int r, int c) { const int st = (r >> 4) * 2 + (c >> 5), rr = r & 15, cc = c & 31, ob = rr * 64 + cc * 2; return st * 1024 + (ob ^ (((ob >> 9) & 1) << 5)); }
__host__ __device__ __forceinline__ void stage_rc(int b, int& R, int& C) { const int st = b / 1024, sb = b % 1024, swz = sb ^ (((sb >> 9) & 1) << 5); R = (st >> 1) * 16 + swz / 64; C = (st & 1) * 32 + (swz % 64) / 2; }
__host__ __device__ __forceinline__ int perm32(int rho) { const int n = rho >> 4, i = rho & 15; return 8 * (i >> 2) + 4 * n + (i & 3); }
struct Unit { int pm, pn, e, r0, cnt; };
struct Gemm { const void* A; const void* Bt; int lda, ldb, K; size_t astride, bstride; int scale_a, scale_b; };
struct StaticOrder {
    static constexpr bool GATHER = false; static constexpr int ESZ = 2;
    int nM, nN, nwg, G, c, i0, i1;
    __device__ void init(int M, int N, int G_, int c_, int i0_ = 0, int i1_ = 1 << 30) { nM = M / BM; nN = N / BM; nwg = nM * nN; G = G_; c = c_; i0 = i0_; i1 = i1_; }
    __device__ bool next(int i, Unit& u) const {
        i += i0; if (i >= i1) return false;
        const long L = (long)i * G + c; if (L >= nwg) return false;
        int wgid = (int)L; { const int q = nwg / NXCD, r = nwg % NXCD, xcd = wgid % NXCD, off = wgid / NXCD; wgid = (xcd < r ? xcd * (q + 1) : r * (q + 1) + (xcd - r) * q) + off; }
        const int nig = WGM * nN, gid = wgid / nig, fm = gid * WGM, gsz = (nM - fm) < WGM ? (nM - fm) : WGM;
        u.pm = fm + ((wgid % nig) % gsz); u.pn = (wgid % nig) / gsz; u.e = 0; return true;
    }
};
__device__ __forceinline__ unsigned cvt_pk_bf16(float lo, float hi) { unsigned r; asm volatile("v_cvt_pk_bf16_f32 %0, %1, %2" : "=v"(r) : "v"(lo), "v"(hi)); return r; }

template <class Epi, class Sched, bool ALIGN_EPI>
__device__ __forceinline__ void gemm_phase(LAS unsigned char* lds, const Gemm g, const Sched& S, const Epi& E) {
    int tid = threadIdx.x; asm volatile("" : "+v"(tid));
    const int wid = __builtin_amdgcn_readfirstlane(tid >> 6), lane = tid & 63, wr = wid >> 2, wc = wid & 3, fr = lane & 15, fq = lane >> 4;
    constexpr int ESZ = Sched::ESZ;
    const int K = g.K, nt = K * ESZ / (BK * 2);
    unsigned voffA[2], voffB[2];
#pragma unroll
    for (int i = 0; i < 2; ++i) { int R, C; stage_rc(tid * 16 + i * 8192, R, C); const int Rb = Epi::PERM ? ((R & ~31) + perm32(R & 31)) : R;
        voffA[i] = (unsigned)(R * g.lda * ESZ + C * 2); voffB[i] = (unsigned)(Rb * g.ldb * ESZ + C * 2); }
    const size_t kstep = (size_t)(BK * 2);
    const size_t hstepA = (size_t)HALF * g.lda * ESZ, tstepA = 2 * hstepA;
    const size_t hstepB = (size_t)HALF * g.ldb * ESZ, tstepB = 2 * hstepB;
    const unsigned ldsw = (unsigned)wid * 1024u;
    const int aoff = lds_byte(wr * 64 + fr, ESZ == 2 ? fq * 8 : fq * 16), boff = lds_byte(wc * 32 + fr, ESZ == 2 ? fq * 8 : fq * 16);
    constexpr int PIECE1 = ESZ == 2 ? 1024 : 16;
    unsigned la_ = (unsigned)(size_t)(lds + aoff), lb_ = (unsigned)(size_t)(lds + 65536 + boff);
    asm volatile("" : "+v"(la_), "+v"(lb_));
    const LAS unsigned char* ldsA = (const LAS unsigned char*)(size_t)la_; const LAS unsigned char* ldsB = (const LAS unsigned char*)(size_t)lb_;
#define PG8_SA(b, h) (((b) * 2 + (h)) * HTB)
#define PG8_SB(b, h) ((4 + (b) * 2 + (h)) * HTB)
#define PG8_STAGE(bufoff, gbase, voff) do { _Pragma("unroll") for (int _i = 0; _i < 2; ++_i) \
        __builtin_amdgcn_global_load_lds((const unsigned*)((const char*)(gbase) + (voff)[_i]), (LAS unsigned*)(lds + (bufoff) + ldsw + _i * 8192), 16, 0, 0); } while (0)
#define PG8_LDA(dst, b, h) do { _Pragma("unroll") for (int m = 0; m < 4; ++m) { dst[m][0] = *(const LAS bf16x8*)(ldsA + PG8_SA(b, h) + m * 2048); dst[m][1] = *(const LAS bf16x8*)(ldsA + PG8_SA(b, h) + m * 2048 + PIECE1); } } while (0)
#define PG8_LDB(dst, b, h) do { _Pragma("unroll") for (int n = 0; n < 2; ++n) { dst[n][0] = *(const LAS bf16x8*)(ldsB + (PG8_SB(b, h) - 65536) + n * 2048); dst[n][1] = *(const LAS bf16x8*)(ldsB + (PG8_SB(b, h) - 65536) + n * 2048 + PIECE1); } } while (0)
#define PG8_V8(x) __builtin_shufflevector(__builtin_bit_cast(v4i_t, (x)[0]), __builtin_bit_cast(v4i_t, (x)[1]), 0, 1, 2, 3, 4, 5, 6, 7)
#define PG8_MMA(ai, bj, At, Bt) do { __builtin_amdgcn_s_setprio(1); _Pragma("unroll") for (int m = 0; m < 4; ++m) _Pragma("unroll") for (int n = 0; n < 2; ++n) { \
        if constexpr (ESZ == 2) { _Pragma("unroll") for (int k = 0; k < 2; ++k) acc[ai][bj][m][n] = __builtin_amdgcn_mfma_f32_16x16x32_bf16(Bt[n][k], At[m][k], acc[ai][bj][m][n], 0, 0, 0); } \
        else { acc[ai][bj][m][n] = __builtin_amdgcn_mfma_scale_f32_16x16x128_f8f6f4(PG8_V8(Bt[n]), PG8_V8(At[m]), acc[ai][bj][m][n], 0, 0, 0, g.scale_b, 0, g.scale_a); \
               asm volatile("" : "+v"(acc[ai][bj][m][n])); } }     \
        __builtin_amdgcn_s_setprio(0); } while (0)
#define PG8_WAIT_V(n) asm volatile("s_waitcnt vmcnt(" #n ")" ::: "memory")
#define PG8_WAIT_L(n) asm volatile("s_waitcnt lgkmcnt(" #n ")" ::: "memory")
#define PG8_BAR __builtin_amdgcn_s_barrier()
#define PG8_SCHED __builtin_amdgcn_sched_barrier(0)
    Unit cur, nxt; int ui = 0;
    if (!S.next(0, cur)) return;
    f32x4 acc[2][2][4][2];
#pragma unroll
    for (int a = 0; a < 2; ++a)
#pragma unroll
        for (int b = 0; b < 2; ++b)
#pragma unroll
            for (int m = 0; m < 4; ++m)
#pragma unroll
                for (int n = 0; n < 2; ++n) acc[a][b][m][n] = (f32x4){0.f, 0.f, 0.f, 0.f};
    bf16x8 At[4][2], B0[2][2], B1[2][2];
    constexpr bool GATHER = Sched::GATHER;
    const size_t hsA = GATHER ? 0 : hstepA;
    unsigned c0[2], c1[2], n0[2], n1[2];
    if constexpr (GATHER) { S.a_offsets(cur, tid, g.lda, c0, c1); n0[0] = c0[0]; n0[1] = c0[1]; n1[0] = c1[0]; n1[1] = c1[1]; }
#define PG8_C0 (GATHER ? c0 : voffA)
#define PG8_C1 (GATHER ? c1 : voffA)
    const char* cA = (const char*)g.A + (GATHER ? (size_t)0 : ((size_t)cur.e * g.astride) * ESZ + (size_t)cur.pm * tstepA); const char* cB = (const char*)g.Bt + ((size_t)cur.e * g.bstride) * ESZ + (size_t)cur.pn * tstepB;
    PG8_STAGE(PG8_SB(0, 0), cB, voffB); PG8_STAGE(PG8_SB(0, 1), cB + hstepB, voffB); PG8_STAGE(PG8_SA(0, 0), cA, PG8_C0); PG8_STAGE(PG8_SA(0, 1), cA + hsA, PG8_C1);
    if (wr == 1) PG8_BAR;
    PG8_WAIT_V(2); PG8_BAR;
    PG8_STAGE(PG8_SB(1, 0), cB + kstep, voffB); PG8_STAGE(PG8_SA(1, 0), cA + kstep, PG8_C0); PG8_STAGE(PG8_SB(1, 1), cB + hstepB + kstep, voffB);
    PG8_WAIT_V(6); PG8_BAR;
    for (;;) {
        const bool has_next = S.next(ui + 1, nxt);
        const char* nA = (has_next && !GATHER) ? (const char*)g.A + ((size_t)nxt.e * g.astride) * ESZ + (size_t)nxt.pm * tstepA : cA; const char* nB = has_next ? (const char*)g.Bt + ((size_t)nxt.e * g.bstride) * ESZ + (size_t)nxt.pn * tstepB : cB;
        if constexpr (GATHER) { if (has_next) S.a_offsets(nxt, tid, g.lda, n0, n1); }
#pragma unroll 1
        for (int t = 0; t < nt; t += 2) {
            const bool last = (t == nt - 2);
            const char* a1 = cA + (size_t)(t + 1) * kstep;
            const char* a2 = last ? nA : cA + (size_t)(t + 2) * kstep; const char* b2 = last ? nB : cB + (size_t)(t + 2) * kstep;
            const char* a3 = a2 + kstep; const char* b3 = b2 + kstep;
            unsigned s0[2], s1[2];
            if constexpr (GATHER) {
#pragma unroll
                for (int i_ = 0; i_ < 2; ++i_) { s0[i_] = last ? n0[i_] : c0[i_]; s1[i_] = last ? n1[i_] : c1[i_]; }
            }
#define PG8_S0 (GATHER ? s0 : voffA)
#define PG8_S1 (GATHER ? s1 : voffA)
            PG8_LDB(B0, 0, 0); PG8_LDB(B1, 0, 1); PG8_SCHED; PG8_LDA(At, 0, 0); PG8_STAGE(PG8_SA(1, 1), a1 + hsA, PG8_C1);
            PG8_WAIT_V(8); PG8_WAIT_L(0); PG8_BAR; PG8_MMA(0, 0, At, B0); PG8_MMA(0, 1, At, B1); PG8_BAR; PG8_SCHED;
            PG8_LDA(At, 0, 1); PG8_STAGE(PG8_SB(0, 0), b2, voffB); PG8_STAGE(PG8_SB(0, 1), b2 + hstepB, voffB); PG8_STAGE(PG8_SA(0, 0), a2, PG8_S0);
            PG8_WAIT_V(8); PG8_WAIT_L(0); PG8_BAR; PG8_MMA(1, 0, At, B0); PG8_MMA(1, 1, At, B1); PG8_BAR; PG8_SCHED;
            PG8_LDB(B0, 1, 0); PG8_LDB(B1, 1, 1); PG8_SCHED; PG8_LDA(At, 1, 0); PG8_STAGE(PG8_SA(0, 1), a2 + hsA, PG8_S1);
            PG8_WAIT_V(8); PG8_WAIT_L(0); PG8_BAR; PG8_MMA(0, 0, At, B0); PG8_MMA(0, 1, At, B1); PG8_BAR; PG8_SCHED;
            PG8_LDA(At, 1, 1); PG8_STAGE(PG8_SB(1, 0), b3, voffB); PG8_STAGE(PG8_SB(1, 1), b3 + hstepB, voffB); PG8_STAGE(PG8_SA(1, 0), a3, PG8_S0);
            PG8_WAIT_V(8); PG8_WAIT_L(0); PG8_BAR; PG8_MMA(1, 0, At, B0); PG8_MMA(1, 1, At, B1); PG8_BAR; PG8_SCHED;
        }
        if constexpr (ALIGN_EPI) { if (wr == 0) PG8_BAR; }
        bool chained = false;
        {
            int te = threadIdx.x; asm volatile("" : "+v"(te));
            const int le = te & 63, fre = le & 15, fqe = le >> 4, we = __builtin_amdgcn_readfirstlane(te >> 6), wre = we >> 2, wce = we & 3;
            if constexpr (Epi::CHAIN) chained = E.chain(acc, cur, wre, wce, fre, fqe);
            if (!chained) E(acc, cur, wre, wce, fre, fqe);
        }
        if (!has_next) break;
        if (!chained) {
#pragma unroll
        for (int a = 0; a < 2; ++a)
#pragma unroll
            for (int b = 0; b < 2; ++b)
#pragma unroll
                for (int m = 0; m < 4; ++m)
#pragma unroll
                    for (int n = 0; n < 2; ++n) acc[a][b][m][n] = (f32x4){0.f, 0.f, 0.f, 0.f};
        }
        cur = nxt; cA = nA; cB = nB; ++ui; if constexpr (GATHER) { c0[0] = n0[0]; c0[1] = n0[1]; c1[0] = n1[0]; c1[1] = n1[1]; }
        if constexpr (ALIGN_EPI) { if (wr == 1) PG8_BAR; }
    }
    PG8_WAIT_V(0);
    if constexpr (!ALIGN_EPI) { if (wr == 0) PG8_BAR; }
    PG8_BAR;
#undef PG8_SA
#undef PG8_SB
#undef PG8_STAGE
#undef PG8_LDA
#undef PG8_LDB
#undef PG8_MMA
#undef PG8_V8
#undef PG8_C0
#undef PG8_C1
#undef PG8_S0
#undef PG8_S1
#undef PG8_WAIT_V
#undef PG8_WAIT_L
#undef PG8_BAR
#undef PG8_SCHED
}

struct EpiInProj {
    static constexpr bool PERM = true, CHAIN = false;
    bf16_t* U; const float *qg, *kg;
    static constexpr size_t SEC_STRIDE = (size_t)16 << 20;
    __device__ __forceinline__ void operator()(const f32x4 (&acc)[2][2][4][2], const Unit& u, int wr, int wc, int fr, int fq) const {
        const int sec = u.pn >> 1, row0 = u.pm * BM + wr * 64 + fr;
        bf16_t* base = U + (size_t)sec * SEC_STRIDE;
        if (sec == 2 || sec == 3) {
            const bool isq = (sec == 2); const float sc = isq ? 0.125f * LOG2E : 1.0f;
            const int head = 4 * (u.pn & 1) + wc;
            const f32x4 q00 = *(const f32x4*)(qg + 8 * fq), q01 = *(const f32x4*)(qg + 8 * fq + 4), q10 = *(const f32x4*)(qg + 32 + 8 * fq), q11 = *(const f32x4*)(qg + 32 + 8 * fq + 4);
            const f32x4 k00 = *(const f32x4*)(kg + 8 * fq), k01 = *(const f32x4*)(kg + 8 * fq + 4), k10 = *(const f32x4*)(kg + 32 + 8 * fq), k11 = *(const f32x4*)(kg + 32 + 8 * fq + 4);
            const f32x4 gv00 = isq ? q00 : k00, gv01 = isq ? q01 : k01, gv10 = isq ? q10 : k10, gv11 = isq ? q11 : k11;
#pragma unroll
            for (int ai = 0; ai < 2; ++ai)
#pragma unroll
                for (int m = 0; m < 4; ++m) {
                    float ss = 0.f;
#pragma unroll
                    for (int bj = 0; bj < 2; ++bj)
#pragma unroll
                        for (int n = 0; n < 2; ++n) { const f32x4 x = acc[ai][bj][m][n]; ss += (x[0] * x[0] + x[1] * x[1]) + (x[2] * x[2] + x[3] * x[3]); }
                    ss += __shfl_xor(ss, 16); ss += __shfl_xor(ss, 32);
                    const float rs = rsqrtf(ss * (1.f / 64.f) + EPS) * sc;
                    bf16_t* rowp = base + (size_t)(row0 + ai * HALF + m * 16) * 512 + head * 64 + 8 * fq;
#pragma unroll
                    for (int bj = 0; bj < 2; ++bj) { const f32x4 v0 = acc[ai][bj][m][0] * rs * (bj ? gv10 : gv00), v1 = acc[ai][bj][m][1] * rs * (bj ? gv11 : gv01);
                        u32x4 w; w.x = cvt_pk_bf16(v0[0], v0[1]); w.y = cvt_pk_bf16(v0[2], v0[3]); w.z = cvt_pk_bf16(v1[0], v1[1]); w.w = cvt_pk_bf16(v1[2], v1[3]);
                        *(u32x4*)(rowp + bj * 32) = w; }
                }
        } else {
            const int col0 = (u.pn & 1) * BM + wc * 32 + 8 * fq;
#pragma unroll
            for (int ai = 0; ai < 2; ++ai)
#pragma unroll
                for (int m = 0; m < 4; ++m) { bf16_t* rowp = base + (size_t)(row0 + ai * HALF + m * 16) * 512 + col0;
#pragma unroll
                    for (int bj = 0; bj < 2; ++bj) { const f32x4 v0 = acc[ai][bj][m][0], v1 = acc[ai][bj][m][1];
                        u32x4 w; w.x = cvt_pk_bf16(v0[0], v0[1]); w.y = cvt_pk_bf16(v0[2], v0[3]); w.z = cvt_pk_bf16(v1[0], v1[1]); w.w = cvt_pk_bf16(v1[2], v1[3]);
                        *(u32x4*)(rowp + bj * HALF) = w; } }
        }
    }
};
struct EpiBf16 {
    static constexpr bool PERM = true, CHAIN = false;
    bf16_t *O0, *O1; int ldo, split;
    __device__ __forceinline__ void operator()(const f32x4 (&acc)[2][2][4][2], const Unit& u, int wr, int wc, int fr, int fq) const {
        int colt = u.pn * BM; bf16_t* base = O0; if (colt >= split) { colt -= split; base = O1; }
        const int row0 = u.pm * BM + wr * 64 + fr, col0 = colt + wc * 32 + 8 * fq;
#pragma unroll
        for (int ai = 0; ai < 2; ++ai)
#pragma unroll
            for (int m = 0; m < 4; ++m) { bf16_t* rowp = base + (size_t)(row0 + ai * HALF + m * 16) * ldo + col0;
#pragma unroll
                for (int bj = 0; bj < 2; ++bj) { const f32x4 v0 = acc[ai][bj][m][0], v1 = acc[ai][bj][m][1];
                    u32x4 w; w.x = cvt_pk_bf16(v0[0], v0[1]); w.y = cvt_pk_bf16(v0[2], v0[3]); w.z = cvt_pk_bf16(v1[0], v1[1]); w.w = cvt_pk_bf16(v1[2], v1[3]);
                    *(u32x4*)(rowp + bj * HALF) = w; } }
    }
};
struct EpiResF32 {
    static constexpr bool PERM = false, CHAIN = false;
    const float* base; float* out;
    __device__ __forceinline__ void operator()(const f32x4 (&acc)[2][2][4][2], const Unit& u, int wr, int wc, int fr, int fq) const {
        const int row0 = u.pm * BM + wr * 64 + fr, col0 = u.pn * BM + wc * 32 + 4 * fq;
#pragma unroll
        for (int ai = 0; ai < 2; ++ai)
#pragma unroll
            for (int m = 0; m < 4; ++m) { const size_t off = (size_t)(row0 + ai * HALF + m * 16) * DM + col0;
#pragma unroll
                for (int bj = 0; bj < 2; ++bj)
#pragma unroll
                    for (int n = 0; n < 2; ++n) *(f32x4*)(out + off + bj * HALF + n * 16) = *(const f32x4*)(base + off + bj * HALF + n * 16) + acc[ai][bj][m][n]; }
    }
};


struct PairOrder {
    static constexpr bool GATHER = false; static constexpr int ESZ = 2;
    StaticOrder so;
    __device__ void init(int M, int N, int G_, int c_) { so.init(M, N, G_, c_); }
    __device__ bool next(int i, Unit& u) const { if (!so.next(i >> 1, u)) return false; u.e = i & 1; return true; }
};
__device__ __forceinline__ float rstd8(const float* p, float inv_n) { const f32x4 a = *(const f32x4*)p, b = *(const f32x4*)(p + 4); return rsqrtf(((a[0] + a[1]) + (a[2] + a[3]) + (b[0] + b[1]) + (b[2] + b[3])) * inv_n + EPS); }
__device__ __forceinline__ float rstd16(const float* p, float inv_n) { float t = 0.f;
#pragma unroll
    for (int i = 0; i < 4; ++i) { const f32x4 a = *(const f32x4*)(p + 4 * i); t += (a[0] + a[1]) + (a[2] + a[3]); } return rsqrtf(t * inv_n + EPS); }
struct EpiOutChain {
    static constexpr bool PERM = false, CHAIN = true;
    const float* x; bf16_t* x1b; const float* SSL; const float* SSF; float* SS1;
    __device__ __forceinline__ bool chain(f32x4 (&acc)[2][2][4][2], const Unit& u, int wr, int wc, int fr, int fq) const {
        if (u.e != 0) return false;
        const int row0 = u.pm * BM + wr * 64 + fr;
        float ratio[8];
#pragma unroll
        for (int i = 0; i < 8; ++i) { const int row = row0 + (i >> 2) * HALF + (i & 3) * 16; ratio[i] = rstd8(SSL + (size_t)row * 8, 1.f / 512.f) / rstd8(SSF + (size_t)row * 8, 1.f / 512.f); }
#pragma unroll
        for (int ai = 0; ai < 2; ++ai)
#pragma unroll
            for (int m = 0; m < 4; ++m)
#pragma unroll
                for (int bj = 0; bj < 2; ++bj)
#pragma unroll
                    for (int n = 0; n < 2; ++n) acc[ai][bj][m][n] *= ratio[ai * 4 + m];
        return true;
    }
    __device__ __forceinline__ void operator()(const f32x4 (&acc)[2][2][4][2], const Unit& u, int wr, int wc, int fr, int fq) const {
        const int row0 = u.pm * BM + wr * 64 + fr, col0 = u.pn * BM + wc * 32 + 4 * fq;
        float rfv[8];
#pragma unroll
        for (int i = 0; i < 8; ++i) rfv[i] = rstd8(SSF + (size_t)(row0 + (i >> 2) * HALF + (i & 3) * 16) * 8, 1.f / 512.f);
#pragma unroll
        for (int pr = 0; pr < 4; ++pr) {
            const int ai = pr >> 1;
            f32x4 xv[2][2][2];
#pragma unroll
            for (int mm = 0; mm < 2; ++mm)
#pragma unroll
                for (int bj = 0; bj < 2; ++bj)
#pragma unroll
                    for (int n = 0; n < 2; ++n) xv[mm][bj][n] = *(const f32x4*)(x + (size_t)(row0 + ai * HALF + (2 * (pr & 1) + mm) * 16) * DM + col0 + bj * HALF + n * 16);
            asm volatile("" ::: "memory");
#pragma unroll
            for (int mm = 0; mm < 2; ++mm) { const int m = 2 * (pr & 1) + mm; const int row = row0 + ai * HALF + m * 16; const size_t off = (size_t)row * DM + col0;
                const float rf = rfv[ai * 4 + m]; float ss = 0.f;
#pragma unroll
                for (int bj = 0; bj < 2; ++bj)
#pragma unroll
                    for (int n = 0; n < 2; ++n) { const f32x4 v = xv[mm][bj][n] + acc[ai][bj][m][n] * rf;
                        ss += (v[0] * v[0] + v[1] * v[1]) + (v[2] * v[2] + v[3] * v[3]);
                        u32x2 w; w.x = cvt_pk_bf16(v[0], v[1]); w.y = cvt_pk_bf16(v[2], v[3]); *(u32x2*)(x1b + off + bj * HALF + n * 16) = w; }
                ss += __shfl_xor(ss, 16); ss += __shfl_xor(ss, 32);
                if (fq == 0) SS1[(size_t)row * 16 + u.pn * 4 + wc] = ss; }
        }
    }
};
struct EpiRowScale {
    static constexpr bool PERM = true, CHAIN = false;
    bf16_t* O; int ldo; const float* SS; float inv_n;
    __device__ __forceinline__ void operator()(const f32x4 (&acc)[2][2][4][2], const Unit& u, int wr, int wc, int fr, int fq) const {
        const int row0 = u.pm * BM + wr * 64 + fr, col0 = u.pn * BM + wc * 32 + 8 * fq;
        float rsv[8];
#pragma unroll
        for (int i = 0; i < 8; ++i) rsv[i] = rstd16(SS + (size_t)(row0 + (i >> 2) * HALF + (i & 3) * 16) * 16, inv_n);
#pragma unroll
        for (int ai = 0; ai < 2; ++ai)
#pragma unroll
            for (int m = 0; m < 4; ++m) { const int row = row0 + ai * HALF + m * 16; const float rs = rsv[ai * 4 + m]; bf16_t* rowp = O + (size_t)row * ldo + col0;
#pragma unroll
                for (int bj = 0; bj < 2; ++bj) { const f32x4 v0 = acc[ai][bj][m][0] * rs, v1 = acc[ai][bj][m][1] * rs;
                    u32x4 w; w.x = cvt_pk_bf16(v0[0], v0[1]); w.y = cvt_pk_bf16(v0[2], v0[3]); w.z = cvt_pk_bf16(v1[0], v1[1]); w.w = cvt_pk_bf16(v1[2], v1[3]);
                    *(u32x4*)(rowp + bj * HALF) = w; } }
    }
};

__device__ __forceinline__ float clamp_fp8(float v) { return __builtin_amdgcn_fmed3f(v, -448.f, 448.f); }
__device__ __forceinline__ unsigned cvt4_fp8(float a, float b, float c, float d) { int w = 0; w = __builtin_amdgcn_cvt_pk_fp8_f32(clamp_fp8(a), clamp_fp8(b), w, false); w = __builtin_amdgcn_cvt_pk_fp8_f32(clamp_fp8(c), clamp_fp8(d), w, true); return (unsigned)w; }
struct EpiX2 {
    static constexpr bool PERM = true, CHAIN = false;
    const bf16_t* x1b; bf16_t* xb; unsigned char* xq; float* SS;
    __device__ __forceinline__ void operator()(const f32x4 (&acc)[2][2][4][2], const Unit& u, int wr, int wc, int fr, int fq) const {
        const int row0 = u.pm * BM + wr * 64 + fr, col0 = u.pn * BM + wc * 32 + 8 * fq;
#pragma unroll
        for (int ai = 0; ai < 2; ++ai) {
            u32x4 xrv[4][2];
#pragma unroll
            for (int m = 0; m < 4; ++m)
#pragma unroll
                for (int bj = 0; bj < 2; ++bj) xrv[m][bj] = *(const u32x4*)(x1b + (size_t)(row0 + ai * HALF + m * 16) * DM + col0 + bj * HALF);
            asm volatile("" ::: "memory");
#pragma unroll
            for (int m = 0; m < 4; ++m) { const int row = row0 + ai * HALF + m * 16; const size_t off = (size_t)row * DM + col0; float ss = 0.f;
#pragma unroll
                for (int bj = 0; bj < 2; ++bj) { const u32x4 xr = xrv[m][bj];
                    f32x4 v0 = acc[ai][bj][m][0], v1 = acc[ai][bj][m][1];
                    v0[0] += __uint_as_float(xr.x << 16); v0[1] += __uint_as_float(xr.x & 0xffff0000u); v0[2] += __uint_as_float(xr.y << 16); v0[3] += __uint_as_float(xr.y & 0xffff0000u);
                    v1[0] += __uint_as_float(xr.z << 16); v1[1] += __uint_as_float(xr.z & 0xffff0000u); v1[2] += __uint_as_float(xr.w << 16); v1[3] += __uint_as_float(xr.w & 0xffff0000u);
                    ss += (v0[0] * v0[0] + v0[1] * v0[1]) + (v0[2] * v0[2] + v0[3] * v0[3]) + (v1[0] * v1[0] + v1[1] * v1[1]) + (v1[2] * v1[2] + v1[3] * v1[3]);
                    u32x4 w; w.x = cvt_pk_bf16(v0[0], v0[1]); w.y = cvt_pk_bf16(v0[2], v0[3]); w.z = cvt_pk_bf16(v1[0], v1[1]); w.w = cvt_pk_bf16(v1[2], v1[3]);
                    *(u32x4*)(xb + off + bj * HALF) = w;
                    u32x2 q; q.x = cvt4_fp8(v0[0], v0[1], v0[2], v0[3]); q.y = cvt4_fp8(v1[0], v1[1], v1[2], v1[3]); *(u32x2*)(xq + off + bj * HALF) = q; }
                ss += __shfl_xor(ss, 16); ss += __shfl_xor(ss, 32);
                if (fq == 0) SS[(size_t)row * 16 + u.pn * 4 + wc] = ss; }
        }
    }
};
template <bool GATHER_>
struct MoeOrder {
    static constexpr bool GATHER = GATHER_; static constexpr int ESZ = 1;
    int nu, G, c; const LAS int* pst  ; const int* LIST;
    __device__ bool next(int i, Unit& u) const {
        const int L = i * G + c; if (L >= nu) return false;
        const int x = L & 7, off = L >> 3, per = nu >> 3, r = nu & 7;
        const int wg = (x < r ? x * (per + 1) : r * (per + 1) + (x - r) * per) + off;
        u.pm = wg >> 2; u.pn = wg & 3;
        const int row = u.pm * BM; const int e = pst[128 + u.pm];
        u.e = e; u.r0 = row - pst[e]; u.cnt = pst[64 + e]; return true;
    }
    __device__ __forceinline__ int assignment(const Unit& u, int r) const { const int rank = u.r0 + r; const bool ok = rank < u.cnt; const int a = LIST[(size_t)u.e * T + (ok ? rank : 0)]; return ok ? a : -1; }
    __device__ __forceinline__ void a_offsets(const Unit& u, int tid, int lda, unsigned (&o0)[2], unsigned (&o1)[2]) const {
#pragma unroll
        for (int i = 0; i < 2; ++i) { int R, C; stage_rc(tid * 16 + i * 8192, R, C);
            const int a0 = assignment(u, R), a1 = assignment(u, HALF + R);
            o0[i] = (unsigned)((a0 < 0 ? 0 : a0 >> 1) * lda * ESZ + C * 2); o1[i] = (unsigned)((a1 < 0 ? 0 : a1 >> 1) * lda * ESZ + C * 2); }
    }
};
struct EpiMoe1 {
    static constexpr bool PERM = true, CHAIN = false;
    unsigned char* HDN; const float* RSTD; MoeOrder<true> S;
    __device__ __forceinline__ void operator()(const f32x4 (&acc)[2][2][4][2], const Unit& u, int wr, int wc, int fr, int fq) const {
        const int r0 = wr * 64 + fr, col0 = u.pn * HALF + wc * 32 + 8 * fq;
        int av[8]; float rsv[8];
#pragma unroll
        for (int i = 0; i < 8; ++i) av[i] = S.assignment(u, r0 + (i >> 2) * HALF + (i & 3) * 16);
#pragma unroll
        for (int i = 0; i < 8; ++i) rsv[i] = RSTD[av[i] < 0 ? 0 : av[i] >> 1];
#pragma unroll
        for (int ai = 0; ai < 2; ++ai)
#pragma unroll
            for (int m = 0; m < 4; ++m) {
                const int r = r0 + ai * HALF + m * 16;
                const float rs = av[ai * 4 + m] < 0 ? 0.f : rsv[ai * 4 + m];
                f32x4 h0, h1;
#pragma unroll
                for (int e = 0; e < 4; ++e) { const float g0 = rs * acc[ai][0][m][0][e], g1 = rs * acc[ai][0][m][1][e];
                    h0[e] = g0 * __builtin_amdgcn_rcpf(1.f + __expf(-g0)) * (rs * acc[ai][1][m][0][e]); h1[e] = g1 * __builtin_amdgcn_rcpf(1.f + __expf(-g1)) * (rs * acc[ai][1][m][1][e]); }
                u32x2 w; w.x = cvt4_fp8(8.f * h0[0], 8.f * h0[1], 8.f * h0[2], 8.f * h0[3]); w.y = cvt4_fp8(8.f * h1[0], 8.f * h1[1], 8.f * h1[2], 8.f * h1[3]);
                *(u32x2*)(HDN + (size_t)(u.pm * BM + r) * D_EXP + col0) = w;
            }
    }
};
struct EpiMoe2 {
    static constexpr bool PERM = true, CHAIN = false;
    unsigned char* YB; const float* RW; MoeOrder<false> S;
    __device__ __forceinline__ void operator()(const f32x4 (&acc)[2][2][4][2], const Unit& u, int wr, int wc, int fr, int fq) const {
        const int r0 = wr * 64 + fr, col0 = u.pn * BM + wc * 32 + 8 * fq;
        int av[8]; float wv[8];
#pragma unroll
        for (int i = 0; i < 8; ++i) av[i] = S.assignment(u, r0 + (i >> 2) * HALF + (i & 3) * 16);
#pragma unroll
        for (int i = 0; i < 8; ++i) wv[i] = RW[av[i] < 0 ? 0 : av[i]];
#pragma unroll
        for (int ai = 0; ai < 2; ++ai)
#pragma unroll
            for (int m = 0; m < 4; ++m) {
                const int a = av[ai * 4 + m];
                const int as = a < 0 ? 0 : a;
                const float w_ = 16.f * wv[ai * 4 + m];
                u32x2 w0, w1;
                { const f32x4 v0 = acc[ai][0][m][0] * w_, v1 = acc[ai][0][m][1] * w_; w0.x = cvt4_fp8(v0[0], v0[1], v0[2], v0[3]); w0.y = cvt4_fp8(v1[0], v1[1], v1[2], v1[3]); }
                { const f32x4 v0 = acc[ai][1][m][0] * w_, v1 = acc[ai][1][m][1] * w_; w1.x = cvt4_fp8(v0[0], v0[1], v0[2], v0[3]); w1.y = cvt4_fp8(v1[0], v1[1], v1[2], v1[3]); }
                unsigned char* rowp = YB + (size_t)as * DM + col0;
                if (a >= 0) { *(u32x2*)rowp = w0; *(u32x2*)(rowp + HALF) = w1; }
                asm volatile("" ::: "memory");
            }
    }
};
}


namespace rtr {
__device__ __forceinline__ void task(int t0, const bf16_t* __restrict__ X2B, const bf16_t* __restrict__ WTR, const float* __restrict__ SS2, const float* __restrict__ bg, const float* __restrict__ be,
                                     float* __restrict__ RW, float* __restrict__ RSTD2, int* __restrict__ cnt, int* __restrict__ LIST, LAS float* lg  , const LAS unsigned char* wr, LAS int* hist  , int lane) {
    int ex0_ = 0, ex1_ = 0, lr0_ = 0, lr1_ = 0;
    const int fr = lane & 15, kq = lane >> 4;
    f32x4 acc[3];
#pragma unroll
    for (int n = 0; n < 3; ++n) acc[n] = (f32x4){0.f, 0.f, 0.f, 0.f};
    const LAS unsigned char* bp0 = wr + fr * 2064 + 16 * kq, *bp1 = wr + (16 + fr) * 2064 + 16 * kq, *bp2 = wr + (32 + (fr & 3)) * 2064 + 16 * kq;
    const bool n2ok = fr < 4;
    LAS unsigned char* xs = (LAS unsigned char*)lg;
#pragma unroll 1
    for (int q = 0; q < 4; ++q) {
#pragma unroll
        for (int i = 0; i < 8; ++i) {
            const int r = 2 * i + (lane >> 5);
            const pg8::u32x4 v = *(const pg8::u32x4*)(X2B + (size_t)(t0 + r) * DM + q * 256 + (lane & 31) * 8);
            *(LAS pg8::u32x4*)(xs + r * 528 + (lane & 31) * 16) = v; }
        asm volatile("s_waitcnt vmcnt(0) lgkmcnt(0)" ::: "memory");
#pragma unroll
        for (int ks = 0; ks < 8; ++ks) {
            const bf16x8 a = *(const LAS bf16x8*)(xs + fr * 528 + ks * 64 + kq * 16);
            const int ko = q * 512 + ks * 64;
            const bf16x8 b0 = *(const LAS bf16x8*)(bp0 + ko), b1 = *(const LAS bf16x8*)(bp1 + ko); bf16x8 b2 = *(const LAS bf16x8*)(bp2 + ko);
            if (!n2ok) b2 = (bf16x8){0, 0, 0, 0, 0, 0, 0, 0};
            acc[0] = __builtin_amdgcn_mfma_f32_16x16x32_bf16(a, b0, acc[0], 0, 0, 0); acc[1] = __builtin_amdgcn_mfma_f32_16x16x32_bf16(a, b1, acc[1], 0, 0, 0); acc[2] = __builtin_amdgcn_mfma_f32_16x16x32_bf16(a, b2, acc[2], 0, 0, 0);
        }
        asm volatile("s_waitcnt lgkmcnt(0)" ::: "memory");
    }
#pragma unroll
    for (int n = 0; n < 3; ++n)
#pragma unroll
        for (int r = 0; r < 4; ++r) lg[(4 * kq + r) * 52 + 16 * n + fr] = acc[n][r];
    asm volatile("s_waitcnt lgkmcnt(0)" ::: "memory");
    if (lane < 16) {
        const int t = t0 + lane;
        const float rs = pg8::rstd16(SS2 + (size_t)t * 16, 1.f / DM);
        float v[36];
#pragma unroll
        for (int q = 0; q < 9; ++q) { const f32x4 x4 = *(const LAS f32x4*)(lg + lane * 52 + 4 * q); v[4 * q] = x4[0] * rs; v[4 * q + 1] = x4[1] * rs; v[4 * q + 2] = x4[2] * rs; v[4 * q + 3] = x4[3] * rs; }
        int gi = 0; float gmax = v[0] + bg[0]; float gl[4];
#pragma unroll
        for (int j = 0; j < 4; ++j) gl[j] = v[j] + bg[j];
#pragma unroll
        for (int j = 1; j < 4; ++j) if (gl[j] > gmax) { gmax = gl[j]; gi = j; }
        float gs = 0.f;
#pragma unroll
        for (int j = 0; j < 4; ++j) gs += __expf(gl[j] - gmax);
        const float gw = 1.f / gs;
        float el[8];
#pragma unroll
        for (int j = 0; j < 8; ++j) { float x = 0.f;
#pragma unroll
            for (int g = 0; g < 4; ++g) if (g == gi) x = v[4 + g * 8 + j] + be[g * 8 + j];
            el[j] = x; }
        int i0 = 0; float v0 = el[0];
#pragma unroll
        for (int j = 1; j < 8; ++j) if (el[j] > v0) { v0 = el[j]; i0 = j; }
        int i1 = -1; float v1 = -INFINITY;
#pragma unroll
        for (int j = 0; j < 8; ++j) if (j != i0 && el[j] > v1) { v1 = el[j]; i1 = j; }
        const float e1 = __expf(v1 - v0);
        const float p0 = 1.f / (1.f + e1), p1 = e1 / (1.f + e1);
        const int ex0 = gi * 8 + i0, ex1 = gi * 8 + i1;
        RW[t * 2 + 0] = gw * p0; RW[t * 2 + 1] = gw * p1; RSTD2[t] = rs;
        ex0_ = ex0; ex1_ = ex1;
        lr0_ = __hip_atomic_fetch_add((int*)hist + ex0, 1, __ATOMIC_RELAXED, __HIP_MEMORY_SCOPE_WORKGROUP); lr1_ = __hip_atomic_fetch_add((int*)hist + ex1, 1, __ATOMIC_RELAXED, __HIP_MEMORY_SCOPE_WORKGROUP);
    }
    asm volatile("s_waitcnt lgkmcnt(0)" ::: "memory");
    __syncthreads();
    if (threadIdx.x < N_EXP) { const int c_ = hist[threadIdx.x]; hist[32 + threadIdx.x] = c_ ? atomicAdd(&cnt[threadIdx.x], c_) : 0; }
    __syncthreads();
    if (lane < 16) { const int t = t0 + lane;
        LIST[(size_t)ex0_ * T + hist[32 + ex0_] + lr0_] = 2 * t; LIST[(size_t)ex1_ * T + hist[32 + ex1_] + lr1_] = 2 * t + 1; }
}
}

template <int ROWMAP>
__device__ __forceinline__ int wt_rowmap(int n) {
    if (ROWMAP == 1) {
        if (n >= 1024 && n < 2048) { const int sec = (n - 1024) >> 9, cc = (n - 1024) & 511, h = cc >> 6, d = cc & 63;
            return 1024 + sec * 512 + (h >> 2) * 256 + 128 * (d >> 5) + 32 * (h & 3) + (d & 31); }
    }
    if (ROWMAP == 2) return 256 * (n >> 7) + (n & 127);
    if (ROWMAP == 3) return 256 * (n >> 7) + 128 + (n & 127);
    return n;
}
template <int ROWMAP, bool GAIN>
__device__ __forceinline__ void p0_transpose_item(const float* __restrict__ W, int ldw, int K, int N, bf16_t* __restrict__ WT, LAS unsigned* scr  , int item, int lane,
                                                  const float* __restrict__ g0, const float* __restrict__ g1, int ksplit) {
    const int nblk = N / 64, kb = item / nblk, nb = item % nblk, k0 = 128 * kb, n0 = 64 * nb;
    const int kp = lane >> 4, nq = lane & 15;
    const float* wp = W + (size_t)(k0 + 2 * kp) * ldw + n0 + 4 * nq;
#pragma unroll 8
    for (int it = 0; it < 16; ++it) {
        f32x4 a = *(const f32x4*)(wp + (size_t)(8 * it) * ldw), b = *(const f32x4*)(wp + (size_t)(8 * it + 1) * ldw);
        if (GAIN) { const int k = k0 + 8 * it + 2 * kp; const float* gp = (k0 < ksplit) ? g0 + k : g1 + (k - ksplit); a *= gp[0]; b *= gp[1]; }
        LAS unsigned* d = scr + (4 * nq) * 68 + 4 * it + kp;
        d[0] = pg8::cvt_pk_bf16(a[0], b[0]); d[68] = pg8::cvt_pk_bf16(a[1], b[1]); d[136] = pg8::cvt_pk_bf16(a[2], b[2]); d[204] = pg8::cvt_pk_bf16(a[3], b[3]);
    }
    asm volatile("s_waitcnt lgkmcnt(0)" ::: "memory");
#pragma unroll 4
    for (int j = 0; j < 16; ++j) { const int n = (lane >> 4) + 4 * j, c = lane & 15;
        const pg8::u32x4 o = *(const LAS pg8::u32x4*)(scr + n * 68 + 4 * c);
        *(pg8::u32x4*)(WT + (size_t)wt_rowmap<ROWMAP>(n0 + n) * K + k0 + 8 * c) = o; }
    asm volatile("s_waitcnt lgkmcnt(0)" ::: "memory");
}


template <int ROWMAP, bool GAIN>
__device__ __forceinline__ void p0_transpose_item_q(const float* __restrict__ W, int ldw, int K, int N, unsigned char* __restrict__ WQ, LAS unsigned char* scr, int item, int lane, const float* __restrict__ g0) {
    const int nblk = N / 64, kb = item / nblk, nb = item % nblk, k0 = 128 * kb, n0 = 64 * nb;
    const int kp = lane >> 4, nq = lane & 15;
    const float* wp = W + (size_t)(k0 + 2 * kp) * ldw + n0 + 4 * nq;
#pragma unroll 8
    for (int it = 0; it < 16; ++it) {
        f32x4 a = *(const f32x4*)(wp + (size_t)(8 * it) * ldw), b = *(const f32x4*)(wp + (size_t)(8 * it + 1) * ldw);
        float ga = 32.f, gb = 32.f;
        if (GAIN) { const int k = k0 + 8 * it + 2 * kp; ga *= g0[k]; gb *= g0[k + 1]; }
        LAS unsigned char* d = scr + (4 * nq) * 144 + 8 * it + 2 * kp;
#pragma unroll
        for (int e = 0; e < 4; ++e) *(LAS unsigned short*)(d + e * 144) = (unsigned short)__builtin_amdgcn_cvt_pk_fp8_f32(__builtin_amdgcn_fmed3f(a[e] * ga, -448.f, 448.f), __builtin_amdgcn_fmed3f(b[e] * gb, -448.f, 448.f), 0, false);
    }
    asm volatile("s_waitcnt lgkmcnt(0)" ::: "memory");
#pragma unroll 4
    for (int j = 0; j < 8; ++j) { const int n = (lane >> 3) + 8 * j, c = lane & 7;
        const pg8::u32x4 o = *(const LAS pg8::u32x4*)(scr + n * 144 + 16 * c);
        *(pg8::u32x4*)(WQ + (size_t)wt_rowmap<ROWMAP>(n0 + n) * K + k0 + 16 * c) = o; }
    asm volatile("s_waitcnt lgkmcnt(0)" ::: "memory");
}

namespace fox {
using bf16 = unsigned short;
using s16x4 = __attribute__((ext_vector_type(4))) short;
using u32x4 = __attribute__((ext_vector_type(4))) unsigned;
constexpr int NHEAD = FOX_H, D = 64, DMP = 512;
constexpr int NW = 8, QBLK = 32, QB = QBLK * NW, KVBLK = 64, NQB = SEQ / QB;
#define SBAR() __builtin_amdgcn_sched_barrier(0)
__device__ __forceinline__ void cmask(f32x16& p0, f32x16& p1, int jb, int qrel, int hi) {
  const float NEG = -INFINITY; int kb = 64 * jb + 4 * hi;
  #pragma unroll
  for (int r = 0; r < 16; ++r) { int kv = kb + (r & 3) + 8 * (r >> 2); if (kv > qrel) p0[r] = NEG; if (kv + 32 > qrel) p1[r] = NEG; }
}
constexpr int NSLOT = 3, SLOTB = 8192;
constexpr int LDS_K = 0, LDS_V = NSLOT * SLOTB, LDS_WS = 2 * NSLOT * SLOTB, LDS_OST = LDS_WS + NW * 64 * 4, LDS_BIAS = LDS_OST + NW * 4096, LDS_BYTES = LDS_BIAS + (SEQ + 64) * 4;
__device__ __forceinline__ void glds16(const void* gsrc, unsigned lds_dst) { unsigned keep;
  asm volatile("s_mov_b32 %0, m0\n\ts_mov_b32 m0, %2\n\ts_nop 0\n\tglobal_load_lds_dwordx4 %1, off\n\ts_mov_b32 m0, %0" : "=&s"(keep) : "v"(gsrc), "s"(lds_dst) : "memory"); }
__device__ __forceinline__ float max3f(float a, float b, float c) { float r; asm("v_max3_f32 %0, %1, %2, %3" : "=v"(r) : "v"(a), "v"(b), "v"(c)); return r; }
__device__ __forceinline__ float max2f(float a, float b) { float r; asm("v_max_f32_e32 %0, %1, %2" : "=v"(r) : "v"(a), "v"(b)); return r; }
__device__ __forceinline__ float fadd_s(float a, float b) { float r; asm("v_add_f32_e32 %0, %1, %2" : "=v"(r) : "v"(a), "v"(b)); return r; }
__device__ __forceinline__ float fsub_s(float a, float b) { float r; asm("v_sub_f32_e32 %0, %1, %2" : "=v"(r) : "v"(a), "v"(b)); return r; }
typedef float f32x2_t __attribute__((ext_vector_type(2))); typedef __bf16 bf16x2_t __attribute__((ext_vector_type(2)));
__device__ __forceinline__ unsigned cvtpk_s(float lo, float hi) { f32x2_t v = {lo, hi}; bf16x2_t b = __builtin_convertvector(v, bf16x2_t); return __builtin_bit_cast(unsigned, b); }
#define WAIT_BAR(N) asm volatile("s_waitcnt vmcnt(" #N ") lgkmcnt(0)\n\ts_barrier" ::: "memory")
typedef __attribute__((address_space(3))) const char* lds_cptr;
typedef short v4i16_t __attribute__((ext_vector_type(4)));
__device__ __forceinline__ void qkt(f32x16& p0, f32x16& p1, const char* Kslot, const bf16x8* qr, int r32, int hi) {
  const char* kb = Kslot + hi * 1024 + r32 * 16;
  #pragma unroll
  for (int d0 = 0; d0 < 4; ++d0) {
    const bf16x8 b0 = *reinterpret_cast<const bf16x8*>(kb + d0 * 2048);
    const bf16x8 b1 = *reinterpret_cast<const bf16x8*>(kb + d0 * 2048 + 512);
    p0 = __builtin_amdgcn_mfma_f32_32x32x16_bf16(b0, qr[d0], p0, 0, 0, 0); p1 = __builtin_amdgcn_mfma_f32_32x32x16_bf16(b1, qr[d0], p1, 0, 0, 0); }
}
__device__ __forceinline__ void kload8(bf16x8* kf, lds_cptr kp) {
  kf[0] = *(const LAS bf16x8*)(kp);        kf[1] = *(const LAS bf16x8*)(kp + 512);
  kf[2] = *(const LAS bf16x8*)(kp + 2048); kf[3] = *(const LAS bf16x8*)(kp + 2560);
  kf[4] = *(const LAS bf16x8*)(kp + 4096); kf[5] = *(const LAS bf16x8*)(kp + 4608);
  kf[6] = *(const LAS bf16x8*)(kp + 6144); kf[7] = *(const LAS bf16x8*)(kp + 6656);
}
__device__ __forceinline__ void kload2(bf16x8* kf, lds_cptr kp, int j) { kf[2 * j] = *(const LAS bf16x8*)(kp + j * 2048); kf[2 * j + 1] = *(const LAS bf16x8*)(kp + j * 2048 + 512); }
__device__ __forceinline__ s16x4 vtr(lds_cptr p) { return __builtin_bit_cast(s16x4, __builtin_amdgcn_ds_read_tr16_b64_v4i16((LAS v4i16_t*)p)); }
__device__ __forceinline__ float rowmax(const f32x16& p0, const f32x16& p1) {
  float a = max3f(p0[0], p0[1], p1[0]), b = max3f(p0[2], p0[3], p1[1]); a = max3f(a, p1[2], p1[3]);
  #pragma unroll
  for (int r = 4; r < 16; r += 4) { a = max3f(a, p0[r], p0[r + 1]); b = max3f(b, p0[r + 2], p0[r + 3]); a = max3f(a, p1[r], p1[r + 1]); b = max3f(b, p1[r + 2], p1[r + 3]); }
  const float m = max2f(a, b);
  auto rr = __builtin_amdgcn_permlane32_swap(__float_as_uint(m), __float_as_uint(m), false, false);
  return max2f(__uint_as_float(rr[0]), __uint_as_float(rr[1]));
}
__device__ __forceinline__ void pv(f32x16* o, int vb, bf16x8 pa0, bf16x8 pa1, bf16x8 pa2, bf16x8 pa3) {
  #pragma unroll
  for (int d0 = 0; d0 < 2; ++d0) { s16x4 lo[4], hi[4];
    #pragma unroll
    for (int ks = 0; ks < 4; ++ks) {
      asm volatile("ds_read_b64_tr_b16 %0,%1 offset:%c2" : "=&v"(lo[ks]) : "v"(vb), "i"(d0 * 4096 + ks * 1024) : "memory");
      asm volatile("ds_read_b64_tr_b16 %0,%1 offset:%c2" : "=&v"(hi[ks]) : "v"(vb), "i"(d0 * 4096 + ks * 1024 + 512) : "memory"); }
    asm volatile("s_waitcnt lgkmcnt(0)" ::: "memory"); SBAR();
    #define PK(k) (bf16x8){lo[k][0], lo[k][1], lo[k][2], lo[k][3], hi[k][0], hi[k][1], hi[k][2], hi[k][3]}
    o[d0] = __builtin_amdgcn_mfma_f32_32x32x16_bf16(pa0, PK(0), o[d0], 0, 0, 0);
    o[d0] = __builtin_amdgcn_mfma_f32_32x32x16_bf16(pa1, PK(1), o[d0], 0, 0, 0);
    o[d0] = __builtin_amdgcn_mfma_f32_32x32x16_bf16(pa2, PK(2), o[d0], 0, 0, 0);
    o[d0] = __builtin_amdgcn_mfma_f32_32x32x16_bf16(pa3, PK(3), o[d0], 0, 0, 0);
    #undef PK
  }
}
#define BLD(X0, X1, bp) do { _Pragma("unroll") for (int g_ = 0; g_ < 4; ++g_) { const f32x4 b0_ = *(const LAS f32x4*)((bp) + 32 * g_), b1_ = *(const LAS f32x4*)((bp) + 128 + 32 * g_); \
    X0[4 * g_] = b0_[0]; X0[4 * g_ + 1] = b0_[1]; X0[4 * g_ + 2] = b0_[2]; X0[4 * g_ + 3] = b0_[3]; X1[4 * g_] = b1_[0]; X1[4 * g_ + 1] = b1_[1]; X1[4 * g_ + 2] = b1_[2]; X1[4 * g_ + 3] = b1_[3]; } } while (0)

template <int THRL> __device__ __forceinline__ void attn_unit(int b, int h, int qb, const bf16* Q, const bf16* __restrict__ K, const bf16* __restrict__ V, bf16* O, const float* __restrict__ CUM, float* __restrict__ SSF, char* shm) {
  int tid = threadIdx.x; asm volatile("" : "+v"(tid));
  const int lane = tid & 63, r32 = lane & 31, hi = lane >> 5; const int wid = __builtin_amdgcn_readfirstlane(tid >> 6);
  const long rowbase = (long)b * SEQ; const int q0 = qb * QB;
  const bf16* Qw = Q + (rowbase + q0 + wid * QBLK) * DMP + h * D;
  const bf16 *Kh = K + rowbase * DMP + h * D, *Vh = V + rowbase * DMP + h * D;
  const unsigned lds0 = (unsigned)(uintptr_t)shm;
  float* wsf = (float*)(shm + LDS_WS) + wid * 64;
  const bf16* ksrc = Kh + (long)lane * DMP + wid * 8;
  const bf16* vsrc = Vh + (long)(16 * (wid & 3) + (lane >> 2)) * DMP + (wid >> 2) * 32 + (lane & 3) * 8;
  const unsigned kdst = lds0 + LDS_K + wid * 1024, vdst = lds0 + LDS_V + wid * 1024;
  #define DMA_K(t, slot) glds16(ksrc + (long)(t) * KVBLK * DMP, (unsigned)__builtin_amdgcn_readfirstlane(kdst + (slot)))
  #define DMA_V(t, slot) glds16(vsrc + (long)(t) * KVBLK * DMP, (unsigned)__builtin_amdgcn_readfirstlane(vdst + (slot)))
  const int vb0 = (int)(lds0 + LDS_V) + ((lane >> 4) & 1) * 32 + (lane & 3) * 8 + (4 * hi + ((lane & 15) >> 2)) * 64;
  const char* Kbase = shm + LDS_K; bf16x8 kf[8];
  const lds_cptr shm3 = (lds_cptr)shm; const lds_cptr kp0 = shm3 + LDS_K + hi * 1024 + r32 * 16; const lds_cptr vp0 = shm3 + LDS_V + ((lane >> 4) & 1) * 32 + (lane & 3) * 8 + (4 * hi + ((lane & 15) >> 2)) * 64;
  const lds_cptr bp0 = shm3 + LDS_BIAS + hi * 16;
  const int NT = (q0 + QB) / KVBLK;
  DMA_K(0, 0); DMA_V(0, 0); DMA_K(1, SLOTB);
  {
    const float* cb = CUM + ((long)b * NHEAD + h) * SEQ; const float cref = cb[q0 + QB - 1];
    LAS float* bl = (LAS float*)(shm3 + LDS_BIAS);
    float cv[SEQ / (NW * 64)];
    #pragma unroll
    for (int i = 0; i < SEQ / (NW * 64); ++i) { const int j = tid + i * NW * 64; cv[i] = cb[j < q0 + QB ? j : 0]; }
    #pragma unroll
    for (int i = 0; i < SEQ / (NW * 64); ++i) { const int j = tid + i * NW * 64; if (j < q0 + QB) bl[j] = cref - cv[i]; }
  }
  bf16x8 qr[4];
  #pragma unroll
  for (int d0 = 0; d0 < 4; ++d0) qr[d0] = *reinterpret_cast<const bf16x8*>(&Qw[(long)r32 * DMP + d0 * 16 + hi * 8]);
  float mhat = 0.f, l_reg = 0.f; f32x16 o[2]; o[0] = f32x16{}; o[1] = f32x16{};
  const int qrel = wid * QBLK + r32;
  #define CMASK(P0, P1, t) do { int jb_ = (t) - (NT - 4); if (jb_ >= 0) cmask(P0, P1, jb_, qrel, hi); } while (0)
  bool resc = false;
  #define START(P0, P1) do { const float rm = rowmax(P0, P1); resc = false; \
    { const float dl = rm; mhat = fadd_s(mhat, dl); \
      _Pragma("unroll") for (int r = 0; r < 16; ++r) { P0[r] = fsub_s(P0[r], dl); P1[r] = fsub_s(P1[r], dl); } } \
    _Pragma("unroll") for (int r = 0; r < 16; ++r) P0[r] = __builtin_amdgcn_exp2f(P0[r]); } while (0)
  #define RESC() do { if (resc) { asm volatile("s_waitcnt lgkmcnt(0)" ::: "memory"); \
      _Pragma("unroll") for (int d_ = 0; d_ < 2; ++d_) _Pragma("unroll") for (int r = 0; r < 16; ++r) o[d_][r] *= wsf[crow(r, hi)]; } } while (0)
  f32x16 pA0, pA1, pB0, pB1;
  int sl_prev = 0, sl_cur = 0, sl_next = SLOTB;
  #define ROT() do { sl_prev = sl_cur; sl_cur = sl_next; sl_next = (sl_next == (NSLOT - 1) * SLOTB) ? 0 : sl_next + SLOTB; } while (0)
  DMA_K(2, 2 * SLOTB);
  WAIT_BAR(3);
  BLD(pA0, pA1, bp0);
  qkt(pA0, pA1, Kbase, qr, r32, hi); asm volatile("s_nop 15\n\ts_nop 7" : "+v"(pA0), "+v"(pA1)); CMASK(pA0, pA1, 0);
  START(pA0, pA1);
  _Pragma("unroll") for (int r = 0; r < 16; ++r) pA1[r] = __builtin_amdgcn_exp2f(pA1[r]);
  BLD(pB0, pB1, bp0 + 256);
  _Pragma("unroll") for (int r = 0; r < 16; ++r) { pB0[r] = fsub_s(pB0[r], mhat); pB1[r] = fsub_s(pB1[r], mhat); }
  WAIT_BAR(0);
  DMA_K(3, 0); DMA_V(1, SLOTB);
  ROT();
  kload8(kf, kp0 + sl_cur);
  WAIT_BAR(2);
  s16x4 vlo[8], vhi[8]; u32x4 pw0, pw1, pw2, pw3;
  #define PKW(P, B) cvtpk_s(P[B], P[B + 1])
  #define PAF(k) __builtin_bit_cast(bf16x8, pw##k)
  #define VFR(i) (bf16x8){vlo[i][0], vlo[i][1], vlo[i][2], vlo[i][3], vhi[i][0], vhi[i][1], vhi[i][2], vhi[i][3]}
  #define PIN(x) asm volatile("" : "+v"(x))
  #define MX3(a, b, c) __builtin_fmaxf(__builtin_fmaxf((a), (b)), (c))
  #define GAPA(MF, A0, A1, A2, A3, W0, W1, PW) do { MF; sacc += A0; sacc += A1; sacc += A2; sacc += A3; PIN(sacc); W0; W1; PIN(PW); SBAR(); } while (0)
  #define EX(v) __builtin_amdgcn_exp2f(v)
  #define GAPB(MF, X, B, N, NB) do { MF; X[B] = EX(X[B]); X[B + 1] = EX(X[B + 1]); X[B + 2] = EX(X[B + 2]); X[B + 3] = EX(X[B + 3]); PIN(X); \
    N[NB] = fsub_s(N[NB], mhat); N[NB + 1] = fsub_s(N[NB + 1], mhat); N[NB + 2] = fsub_s(N[NB + 2], mhat); N[NB + 3] = fsub_s(N[NB + 3], mhat); PIN(N); SBAR(); } while (0)
  #define VRD(i) do { vlo[i] = vtr(vp_ + (((i) >> 2) * 4096 + ((i) & 3) * 1024)); vhi[i] = vtr(vp_ + (((i) >> 2) * 4096 + ((i) & 3) * 1024 + 512)); } while (0)
  #define KRD(G, j) do { if (G) { kload2(kf, kp0 + sl_next, j); SBAR(); } } while (0)
  #define STEP(C0, C1, P0, P1, t, GK, GV, GL) do { SBAR(); \
    const lds_cptr vp_ = vp0 + sl_prev; \
    VRD(0); SBAR(); float sacc = (P0[0] + P0[1]); \
    GAPA(C0 = __builtin_amdgcn_mfma_f32_32x32x16_bf16(kf[0], qr[0], C0, 0, 0, 0), P0[2], P0[3], P0[4], P0[5],     pw0[0] = PKW(P0, 0), pw0[1] = PKW(P0, 2), pw0); \
    VRD(4); SBAR(); GAPA(C1 = __builtin_amdgcn_mfma_f32_32x32x16_bf16(kf[1], qr[0], C1, 0, 0, 0), P0[6], P0[7], P0[8], P0[9],     pw0[2] = PKW(P0, 4), pw0[3] = PKW(P0, 6), pw0); \
    VRD(1); SBAR(); GAPA(C0 = __builtin_amdgcn_mfma_f32_32x32x16_bf16(kf[2], qr[1], C0, 0, 0, 0),   P0[10], P0[11], P0[12], P0[13], pw1[0] = PKW(P0, 8), pw1[1] = PKW(P0, 10), pw1); \
    VRD(5); SBAR(); GAPA(C1 = __builtin_amdgcn_mfma_f32_32x32x16_bf16(kf[3], qr[1], C1, 0, 0, 0),   P0[14], P0[15], P1[0], P1[1],   pw1[2] = PKW(P0, 12), pw1[3] = PKW(P0, 14), pw1); \
    VRD(2); SBAR(); GAPA(C0 = __builtin_amdgcn_mfma_f32_32x32x16_bf16(kf[4], qr[2], C0, 0, 0, 0),   P1[2], P1[3], P1[4], P1[5],     pw2[0] = PKW(P1, 0), pw2[1] = PKW(P1, 2), pw2); \
    VRD(6); SBAR(); GAPA(C1 = __builtin_amdgcn_mfma_f32_32x32x16_bf16(kf[5], qr[2], C1, 0, 0, 0),   P1[6], P1[7], P1[8], P1[9],     pw2[2] = PKW(P1, 4), pw2[3] = PKW(P1, 6), pw2); \
    VRD(3); SBAR(); GAPA(C0 = __builtin_amdgcn_mfma_f32_32x32x16_bf16(kf[6], qr[3], C0, 0, 0, 0),   P1[10], P1[11], P1[12], P1[13], pw3[0] = PKW(P1, 8), pw3[1] = PKW(P1, 10), pw3); \
    VRD(7); SBAR(); GAPA(C1 = __builtin_amdgcn_mfma_f32_32x32x16_bf16(kf[7], qr[3], C1, 0, 0, 0),   P1[14], P1[15], 0.f, 0.f,       pw3[2] = PKW(P1, 12), pw3[3] = PKW(P1, 14), pw3); \
    l_reg += sacc; \
    if (GK) { DMA_K((t) + 3, sl_cur); } if (GV) { DMA_V((t) + 1, sl_next); } \
    CMASK(C0, C1, t); \
    { float a = MX3(C0[0], C0[1], C1[0]), b = MX3(C0[2], C0[3], C1[1]); a = MX3(a, C1[2], C1[3]); \
      _Pragma("unroll") for (int r = 4; r < 16; r += 4) { a = MX3(a, C0[r], C0[r + 1]); b = MX3(b, C0[r + 2], C0[r + 3]); a = MX3(a, C1[r], C1[r + 1]); b = MX3(b, C1[r + 2], C1[r + 3]); } \
      float rm = __builtin_fmaxf(a, b); { auto rr = __builtin_amdgcn_permlane32_swap(__float_as_uint(rm), __float_as_uint(rm), false, false); rm = __builtin_fmaxf(__uint_as_float(rr[0]), __uint_as_float(rr[1])); } \
      resc = false; \
      if (__builtin_expect(__any(rm > (float)THRL), 0)) { const float dl = __builtin_fmaxf(rm, 0.f); mhat += dl; \
        _Pragma("unroll") for (int r = 0; r < 16; ++r) { C0[r] -= dl; C1[r] -= dl; } \
        const float f = __builtin_amdgcn_exp2f(-dl); l_reg *= f; if (hi == 0) wsf[r32] = f; resc = true; } } \
    SBAR(); \
    BLD(P0, P1, bp0 + ((t) + 1) * 256); SBAR(); \
    GAPB(o[0] = __builtin_amdgcn_mfma_f32_32x32x16_bf16(PAF(0), VFR(0), o[0], 0, 0, 0), C0, 0, P0, 0); \
    GAPB(o[1] = __builtin_amdgcn_mfma_f32_32x32x16_bf16(PAF(0), VFR(4), o[1], 0, 0, 0), C0, 4, P0, 4); \
    KRD(GL, 0); GAPB(o[0] = __builtin_amdgcn_mfma_f32_32x32x16_bf16(PAF(1), VFR(1), o[0], 0, 0, 0), C0, 8, P0, 8); \
    KRD(GL, 1); GAPB(o[1] = __builtin_amdgcn_mfma_f32_32x32x16_bf16(PAF(1), VFR(5), o[1], 0, 0, 0), C0, 12, P0, 12); \
    KRD(GL, 2); GAPB(o[0] = __builtin_amdgcn_mfma_f32_32x32x16_bf16(PAF(2), VFR(2), o[0], 0, 0, 0), C1, 0, P1, 0); \
    KRD(GL, 3); GAPB(o[1] = __builtin_amdgcn_mfma_f32_32x32x16_bf16(PAF(2), VFR(6), o[1], 0, 0, 0), C1, 4, P1, 4); \
    GAPB(o[0] = __builtin_amdgcn_mfma_f32_32x32x16_bf16(PAF(3), VFR(3), o[0], 0, 0, 0), C1, 8, P1, 8); \
    GAPB(o[1] = __builtin_amdgcn_mfma_f32_32x32x16_bf16(PAF(3), VFR(7), o[1], 0, 0, 0), C1, 12, P1, 12); \
    } while (0)
  int t = 1;
  #undef CMASK
  #define CMASK(P0, P1, t) do {} while (0)
  for (; t + 5 < NT; t += 2) {
    STEP(pB0, pB1, pA0, pA1, t, true, true, true);     WAIT_BAR(2); RESC(); ROT();
    STEP(pA0, pA1, pB0, pB1, t + 1, true, true, true);   WAIT_BAR(2); RESC(); ROT();
  }
  #undef CMASK
  #define CMASK(P0, P1, t) do { int jb_ = (t) - (NT - 4); if (jb_ >= 0) cmask(P0, P1, jb_, qrel, hi); } while (0)
  #define ENDW(tt) do { if ((tt) + 3 < NT) { WAIT_BAR(2); } else if ((tt) + 2 < NT) { WAIT_BAR(1); } else { WAIT_BAR(0); } } while (0)
  for (; t + 1 < NT; t += 2) {
    STEP(pB0, pB1, pA0, pA1, t, (t + 3 < NT), (t + 1 < NT), (t + 1 < NT));       ENDW(t);   RESC(); ROT();
    STEP(pA0, pA1, pB0, pB1, t + 1, (t + 4 < NT), (t + 2 < NT), (t + 2 < NT));     ENDW(t + 1); RESC(); ROT();
  }
  STEP(pB0, pB1, pA0, pA1, NT - 1, false, false, false); RESC();
  { float sacc = pB0[0] + pB0[1]; _Pragma("unroll") for (int r = 2; r < 16; ++r) sacc += pB0[r]; _Pragma("unroll") for (int r = 0; r < 16; ++r) sacc += pB1[r]; l_reg += sacc;
    pw0 = (u32x4){PKW(pB0, 0), PKW(pB0, 2), PKW(pB0, 4), PKW(pB0, 6)}; pw1 = (u32x4){PKW(pB0, 8), PKW(pB0, 10), PKW(pB0, 12), PKW(pB0, 14)}; pw2 = (u32x4){PKW(pB1, 0), PKW(pB1, 2), PKW(pB1, 4), PKW(pB1, 6)}; pw3 = (u32x4){PKW(pB1, 8), PKW(pB1, 10), PKW(pB1, 12), PKW(pB1, 14)};
    SBAR(); pv(o, vb0 + sl_cur, PAF(0), PAF(1), PAF(2), PAF(3)); }
  #undef PKW
  #undef PAF
  #undef VFR
  #undef PIN
  #undef MX3
  #undef GAPA
  #undef GAPB
  #undef EX
  #undef VRD
  #undef KRD
  #undef STEP
  #undef ENDW
  { auto rr = __builtin_amdgcn_permlane32_swap(__float_as_uint(l_reg), __float_as_uint(l_reg), false, false); l_reg = __uint_as_float(rr[0]) + __uint_as_float(rr[1]); }
  if (hi == 0) wsf[32 + r32] = l_reg; asm volatile("s_waitcnt lgkmcnt(0)" ::: "memory");
  float rli[16];
  #pragma unroll
  for (int r = 0; r < 16; ++r) rli[r] = __builtin_amdgcn_rcpf(wsf[32 + crow(r, hi)]);
  bf16* Ow = O + (rowbase + q0 + wid * QBLK) * DMP + h * D;
  { bf16* stg = (bf16*)(shm + LDS_OST) + wid * 2048;
    #pragma unroll
    for (int r = 0; r < 16; ++r) { const int orow = crow(r, hi);
      #pragma unroll
      for (int d0 = 0; d0 < 2; ++d0) stg[orow * 64 + d0 * 32 + r32] = f2bf(o[d0][r] * rli[r]); }
    asm volatile("s_waitcnt lgkmcnt(0)" ::: "memory");
    #pragma unroll
    for (int i = 0; i < 4; ++i) { const int row = i * 8 + (lane >> 3), ch = lane & 7; const u32x4 v = *(const u32x4*)(stg + row * 64 + ch * 8); *(u32x4*)(Ow + (long)row * DMP + ch * 8) = v;
      float ss = 0.f;
      #pragma unroll
      for (int j = 0; j < 4; ++j) { const float lo = __uint_as_float(v[j] << 16), hi_ = __uint_as_float(v[j] & 0xffff0000u); ss += lo * lo + hi_ * hi_; }
      ss += __shfl_xor(ss, 1); ss += __shfl_xor(ss, 2); ss += __shfl_xor(ss, 4);
      if (ch == 0) SSF[(rowbase + q0 + wid * QBLK + row) * 8 + h] = ss; } }
  asm volatile("s_waitcnt lgkmcnt(0)\n\ts_barrier" ::: "memory");
  #undef DMA_K
  #undef DMA_V
  #undef CMASK
  #undef START
  #undef RESC
  #undef ROT
}
template <int THRL> __device__ __forceinline__ void attn_phase(char* lds, const bf16* Q, const bf16* K, const bf16* V, bf16* O, const float* CUM, float* SSF, int grid, int block) {
  const int vcu = (grid % 8 == 0) ? (block % 8) * (grid / 8) + block / 8 : block;
  for (int u = vcu; u < BATCH * NHEAD * 4; u += grid) {
    const int s = u & 3, bh = u >> 2;
    #pragma unroll 1
    for (int i = 0; i < 4; ++i) { const int qb = (i == 0) ? s : (i == 1) ? 7 - s : (i == 2) ? 8 + s : 15 - s; attn_unit<THRL>(bh / NHEAD, bh % NHEAD, qb, Q, K, V, O, CUM, SSF, lds); }
  }
}
#undef SBAR
#undef WAIT_BAR
#undef BLD
}


namespace lru {
constexpr int CL = 128, NCH = SEQ / CL;
constexpr int WLDS = 16384;
typedef unsigned u32x4 __attribute__((ext_vector_type(4)));
template <bool PASS2>
__device__ __forceinline__ void unit(int b, int chunk, const bf16_t* __restrict__ U, const bf16_t* __restrict__ GATE, const float* __restrict__ conv_w, const float* __restrict__ conv_b,
                                     const bf16_t* __restrict__ LRUW, const float* __restrict__ ba, const float* __restrict__ bx, const float* __restrict__ a_param,
                                     float* __restrict__ SUMA, float* __restrict__ SUMH, bf16_t* __restrict__ YL, float* __restrict__ SSL, LAS unsigned char* ldsw, int w, int lane) {
    const int cl = lane & 31, hi = lane >> 5;
    LAS float* cp = (LAS float*)ldsw;
    LAS bf16_t* stg = (LAS bf16_t*)(ldsw + 2048);
    for (int i = lane; i < 320; i += 64) { const int tap = i >> 6, c = i & 63; cp[i] = (tap < 4) ? conv_w[tap * 512 + 64 * w + c] : conv_b[64 * w + c]; }
    { const int c = 64 * w + lane; cp[320 + lane] = ba[c]; cp[384 + lane] = bx[c];
      const float ap = -a_param[c]; const float sp = (ap > 20.f) ? ap : log1pf(__expf(ap)); cp[448 + lane] = -8.f * sp * LOG2E; }
    const u32x4* wf = (const u32x4*)LRUW + (size_t)w * 16 * 64 + lane;
    bf16x8 Bi[2];
#pragma unroll
    for (int q = 0; q < 2; ++q)
#pragma unroll
        for (int j = 0; j < 8; ++j) Bi[q][j] = (16 * q + 8 * hi + j == cl) ? (short)0x3F80 : (short)0;
    float h[2], atot[2];
#pragma unroll
    for (int n = 0; n < 2; ++n) { h[n] = 0.f; atot[n] = 1.f; }
    if (PASS2) {
#pragma unroll 1
        for (int c0 = 0; c0 < chunk; c0 += 8) {
            float sa[8][2], sh[8][2];
#pragma unroll
            for (int j = 0; j < 8; ++j)
#pragma unroll
                for (int n = 0; n < 2; ++n) { const bool ok = (c0 + j < chunk); const size_t o = ((size_t)(b * NCH + (ok ? c0 + j : 0))) * 512 + 64 * w + 32 * n + cl;
                    const float av = SUMA[o], hv = SUMH[o]; sa[j][n] = ok ? av : 1.f; sh[j][n] = ok ? hv : 0.f; }
#pragma unroll
            for (int j = 0; j < 8; ++j)
#pragma unroll
                for (int n = 0; n < 2; ++n) h[n] = sa[j][n] * h[n] + sh[j][n];
        }
    }
    asm volatile("s_waitcnt lgkmcnt(0)" ::: "memory");
    const int t0 = b * SEQ + chunk * CL;
    LAS unsigned char* ub0 = ldsw + 6144;
    const int dri = lane >> 3, dch = lane & 7;
#define LRU_DMA_U(tb_, buf_) do { _Pragma("unroll") for (int i_ = 0; i_ < 5; ++i_) { const int ri_ = 8 * i_ + dri; int gr_ = (tb_) - 3 + ri_; gr_ = gr_ < 0 ? 0 : (gr_ > T - 1 ? T - 1 : gr_); \
        __builtin_amdgcn_global_load_lds((const unsigned*)((const char*)U + (unsigned)((gr_ * 512 + 64 * w + 8 * (dch ^ (ri_ & 7))) * 2)), (LAS unsigned*)(ub0 + (buf_) * 5120 + i_ * 1024), 16, 0, 0); } } while (0)
#define LRU_DMA_G(tb_) do { _Pragma("unroll") for (int i_ = 0; i_ < 4; ++i_) \
        __builtin_amdgcn_global_load_lds((const unsigned*)((const char*)GATE + (unsigned)((((tb_) + 8 * i_ + dri) * 512 + 64 * w + 8 * dch) * 2)), (LAS unsigned*)(ldsw + 2048 + i_ * 1024), 16, 0, 0); } while (0)
    LRU_DMA_U(t0, 0);
#pragma unroll 1
    for (int mt = 0; mt < CL / 32; ++mt) {
        int tb = t0 + mt * 32; asm volatile("" : "+s"(tb));
        const int srow = chunk * CL + mt * 32 + cl;
        asm volatile("s_waitcnt vmcnt(0)" ::: "memory");
        if (mt + 1 < CL / 32) LRU_DMA_U(tb + 32, (mt + 1) & 1);
        if (PASS2) LRU_DMA_G(tb);
        const LAS unsigned char* ub = ub0 + (mt & 1) * 5120;
        bf16x8 af[4];
#pragma unroll
        for (int s_ = 0; s_ < 4; ++s_) {
            const int cc = 16 * s_ + 8 * hi;
            float xv[8];
            { const f32x4 b0 = *(const LAS f32x4*)(cp + 256 + cc), b1 = *(const LAS f32x4*)(cp + 256 + cc + 4);
              xv[0] = b0[0]; xv[1] = b0[1]; xv[2] = b0[2]; xv[3] = b0[3]; xv[4] = b1[0]; xv[5] = b1[1]; xv[6] = b1[2]; xv[7] = b1[3]; }
#pragma unroll
            for (int tap = 0; tap < 4; ++tap) {
                const bool inseq = (srow - 3 + tap >= 0);
                const int ri = cl + tap;
                u32x4 uu = *(const LAS u32x4*)(ub + ri * 128 + (((2 * s_ + hi) ^ (ri & 7)) << 4));
                if (!inseq) uu = (u32x4){0u, 0u, 0u, 0u};
                const f32x4 w0 = *(const LAS f32x4*)(cp + tap * 64 + cc), w1 = *(const LAS f32x4*)(cp + tap * 64 + cc + 4);
                xv[0] += w0[0] * __uint_as_float(uu[0] << 16); xv[1] += w0[1] * __uint_as_float(uu[0] & 0xffff0000u);
                xv[2] += w0[2] * __uint_as_float(uu[1] << 16); xv[3] += w0[3] * __uint_as_float(uu[1] & 0xffff0000u);
                xv[4] += w1[0] * __uint_as_float(uu[2] << 16); xv[5] += w1[1] * __uint_as_float(uu[2] & 0xffff0000u);
                xv[6] += w1[2] * __uint_as_float(uu[3] << 16); xv[7] += w1[3] * __uint_as_float(uu[3] & 0xffff0000u);
            }
            u32x4 pk; pk[0] = pg8::cvt_pk_bf16(xv[0], xv[1]); pk[1] = pg8::cvt_pk_bf16(xv[2], xv[3]); pk[2] = pg8::cvt_pk_bf16(xv[4], xv[5]); pk[3] = pg8::cvt_pk_bf16(xv[6], xv[7]);
            af[s_] = __builtin_bit_cast(bf16x8, pk);
            asm volatile("" ::: "memory"); __builtin_amdgcn_sched_barrier(0);
        }
#pragma unroll
        for (int n = 0; n < 2; ++n) {
            f32x16 rCn, iCn, xCn;
#pragma unroll
            for (int r = 0; r < 16; ++r) { rCn[r] = cp[320 + 32 * n + cl]; iCn[r] = cp[384 + 32 * n + cl]; xCn[r] = 0.f; }
            const float c1n = cp[448 + 32 * n + cl];
#pragma unroll
            for (int s_ = 0; s_ < 4; ++s_) {
                const bf16x8 fa = __builtin_bit_cast(bf16x8, wf[(n * 4 + s_) * 64]), fx = __builtin_bit_cast(bf16x8, wf[(8 + n * 4 + s_) * 64]);
                rCn = __builtin_amdgcn_mfma_f32_32x32x16_bf16(af[s_], fa, rCn, 0, 0, 0);
                iCn = __builtin_amdgcn_mfma_f32_32x32x16_bf16(af[s_], fx, iCn, 0, 0, 0);
                if ((s_ >> 1) == n) xCn = __builtin_amdgcn_mfma_f32_32x32x16_bf16(af[s_], Bi[s_ & 1], xCn, 0, 0, 0);
            }
#pragma unroll
            for (int r = 0; r < 16; ++r) {
                const float rr = __builtin_amdgcn_rcpf(1.f + __builtin_amdgcn_exp2f(-LOG2E * rCn[r]));
                const float ii = __builtin_amdgcn_rcpf(1.f + __builtin_amdgcn_exp2f(-LOG2E * iCn[r]));
                const float a = __builtin_amdgcn_exp2f(c1n * rr);
                const float mult = __builtin_amdgcn_sqrtf(fmaxf(1.f - a * a, 0.f));
                rCn[r] = a; iCn[r] = mult * (ii * xCn[r]);
                if ((r & 3) == 3) __builtin_amdgcn_sched_barrier(0);
            }
            float Ao[4], Bo[4], Ap[4], Bp[4];
#pragma unroll
            for (int g = 0; g < 4; ++g) { float A = rCn[4 * g], B = iCn[4 * g];
#pragma unroll
                for (int k = 1; k < 4; ++k) { B = rCn[4 * g + k] * B + iCn[4 * g + k]; A *= rCn[4 * g + k]; }
                Ao[g] = A; Bo[g] = B; Ap[g] = __shfl_xor(A, 32); Bp[g] = __shfl_xor(B, 32); }
            float hh = h[n], at = atot[n];
#pragma unroll
            for (int g = 0; g < 4; ++g) {
                const float A1 = hi ? Ap[g] : Ao[g], B1 = hi ? Bp[g] : Bo[g], A2 = hi ? Ao[g] : Ap[g], B2 = hi ? Bo[g] : Bp[g];
                const float h1 = A1 * hh + B1, h2 = A2 * h1 + B2;
                float hr = hi ? h1 : hh;
                at *= A1 * A2; hh = h2;
                if (PASS2) {
#pragma unroll
                    for (int k = 0; k < 4; ++k) { hr = rCn[4 * g + k] * hr + iCn[4 * g + k]; iCn[4 * g + k] = hr; }
                }
            }
            h[n] = hh; atot[n] = at;
            if (PASS2) {
                if (n == 0) asm volatile("s_waitcnt vmcnt(0)" ::: "memory");
#pragma unroll
                for (int r = 0; r < 16; ++r) {
                    const int tok = crow(r, hi);
                    const float gx = bf2f(stg[tok * 64 + 32 * n + cl]);
                    const float uq = 0.7978845608028654f * (gx + 0.044715f * gx * gx * gx);
                    const float th = 1.f - 2.f * __builtin_amdgcn_rcpf(1.f + __builtin_amdgcn_exp2f(2.f * LOG2E * uq));
                    stg[tok * 64 + 32 * n + cl] = f2bf(iCn[r] * (0.5f * gx * (1.f + th)));
                    if ((r & 3) == 3) __builtin_amdgcn_sched_barrier(0);
                }
            }
        }
        if (PASS2) {
            asm volatile("s_waitcnt lgkmcnt(0)" ::: "memory");
#pragma unroll
            for (int i = 0; i < 4; ++i) { const int row = i * 8 + (lane >> 3), ch = lane & 7; const u32x4 v = *(const LAS u32x4*)(stg + row * 64 + ch * 8);
                *(u32x4*)((char*)YL + (unsigned)(((tb + row) * 512 + 64 * w + ch * 8) * 2)) = v;
                float ss = 0.f;
#pragma unroll
                for (int j = 0; j < 4; ++j) { const float lo = __uint_as_float(v[j] << 16), hi_ = __uint_as_float(v[j] & 0xffff0000u); ss += lo * lo + hi_ * hi_; }
                ss += __shfl_xor(ss, 1); ss += __shfl_xor(ss, 2); ss += __shfl_xor(ss, 4);
                if (ch == 0) SSL[(size_t)(tb + row) * 8 + w] = ss; }
            asm volatile("s_waitcnt lgkmcnt(0)" ::: "memory");
        }
    }
    if (!PASS2) {
        if (hi == 0) {
#pragma unroll
            for (int n = 0; n < 2; ++n) { const size_t o = ((size_t)(b * NCH + chunk)) * 512 + 64 * w + 32 * n + cl; SUMA[o] = atot[n]; SUMH[o] = h[n]; }
        }
    }
}
#undef LRU_DMA_U
#undef LRU_DMA_G
}


namespace xat {
constexpr int KS_BYTES = MEM_LEN * 256, VT_STRIDE = 520, VT_BYTES = MEM_D * VT_STRIDE, LDS_NEED = KS_BYTES + VT_BYTES;
typedef unsigned u32x4 __attribute__((ext_vector_type(4)));
typedef unsigned u32x2 __attribute__((ext_vector_type(2)));
__device__ __forceinline__ void item(int b, int h, int qhalf  , const bf16_t* __restrict__ QM, const bf16_t* __restrict__ KM, const bf16_t* __restrict__ VM, bf16_t* __restrict__ OM,
                                     const float* __restrict__ q_g, const float* __restrict__ k_g, LAS unsigned char* lds) {
    int tid = threadIdx.x; asm volatile("" : "+v"(tid));
    const int lane = tid & 63, wid = __builtin_amdgcn_readfirstlane(tid >> 6), r32 = lane & 31, hi = lane >> 5;
    LAS unsigned char* Ks = lds; LAS unsigned char* VT = lds + KS_BYTES;
    {
        const int ch = tid & 15, k0 = tid >> 4;
        const f32x4 g0 = *(const f32x4*)(k_g + 8 * ch), g1 = *(const f32x4*)(k_g + 8 * ch + 4);
#pragma unroll 2
        for (int p = 0; p < 8; ++p) {
            const int key = p * 32 + k0;
            const size_t goff = ((size_t)(b * MEM_LEN + key)) * 512 + h * MEM_D + 8 * ch;
            const u32x4 kk = *(const u32x4*)(KM + goff), vv = *(const u32x4*)(VM + goff);
            float f[8];
#pragma unroll
            for (int j = 0; j < 4; ++j) { f[2 * j] = __uint_as_float(kk[j] << 16); f[2 * j + 1] = __uint_as_float(kk[j] & 0xffff0000u); }
            float ss = 0.f;
#pragma unroll
            for (int j = 0; j < 8; ++j) ss += f[j] * f[j];
            ss += __shfl_xor(ss, 1); ss += __shfl_xor(ss, 2); ss += __shfl_xor(ss, 4); ss += __shfl_xor(ss, 8);
            const float rs = rsqrtf(ss * (1.f / MEM_D) + EPS);
            u32x4 o; o[0] = pg8::cvt_pk_bf16(f[0] * rs * g0[0], f[1] * rs * g0[1]); o[1] = pg8::cvt_pk_bf16(f[2] * rs * g0[2], f[3] * rs * g0[3]);
                     o[2] = pg8::cvt_pk_bf16(f[4] * rs * g1[0], f[5] * rs * g1[1]); o[3] = pg8::cvt_pk_bf16(f[6] * rs * g1[2], f[7] * rs * g1[3]);
            *(LAS u32x4*)(Ks + key * 256 + ((ch ^ (key & 15)) << 4)) = o;
#pragma unroll
            for (int j = 0; j < 4; ++j) { *(LAS bf16_t*)(VT + (8 * ch + 2 * j) * VT_STRIDE + key * 2) = (bf16_t)(vv[j] & 0xffffu); *(LAS bf16_t*)(VT + (8 * ch + 2 * j + 1) * VT_STRIDE + key * 2) = (bf16_t)(vv[j] >> 16); }
        }
    }
    __syncthreads();
#pragma unroll 1
    for (int qi = 0; qi < 2; ++qi) {
        const int q0 = qhalf * 512 + qi * 256 + wid * 32;
        const bf16_t* Qp = QM + ((size_t)(b * SEQ + q0 + r32)) * 512 + h * MEM_D + hi * 8;
        bf16x8 qf[8];
        {
            float ss = 0.f; u32x4 raw[8];
#pragma unroll
            for (int d0 = 0; d0 < 8; ++d0) { raw[d0] = *(const u32x4*)(Qp + d0 * 16);
#pragma unroll
                for (int j = 0; j < 4; ++j) { const float lo = __uint_as_float(raw[d0][j] << 16), hi_ = __uint_as_float(raw[d0][j] & 0xffff0000u); ss += lo * lo + hi_ * hi_; } }
            ss += __shfl_xor(ss, 32);
            const float rs = rsqrtf(ss * (1.f / MEM_D) + EPS) * (0.08838834764831845f * LOG2E);
#pragma unroll
            for (int d0 = 0; d0 < 8; ++d0) { const f32x4 g0 = *(const f32x4*)(q_g + 16 * d0 + 8 * hi), g1 = *(const f32x4*)(q_g + 16 * d0 + 8 * hi + 4);
                u32x4 o;
                o[0] = pg8::cvt_pk_bf16(__uint_as_float(raw[d0][0] << 16) * rs * g0[0], __uint_as_float(raw[d0][0] & 0xffff0000u) * rs * g0[1]);
                o[1] = pg8::cvt_pk_bf16(__uint_as_float(raw[d0][1] << 16) * rs * g0[2], __uint_as_float(raw[d0][1] & 0xffff0000u) * rs * g0[3]);
                o[2] = pg8::cvt_pk_bf16(__uint_as_float(raw[d0][2] << 16) * rs * g1[0], __uint_as_float(raw[d0][2] & 0xffff0000u) * rs * g1[1]);
                o[3] = pg8::cvt_pk_bf16(__uint_as_float(raw[d0][3] << 16) * rs * g1[2], __uint_as_float(raw[d0][3] & 0xffff0000u) * rs * g1[3]);
                qf[d0] = __builtin_bit_cast(bf16x8, o); }
        }
        f32x16 o[4];
#pragma unroll
        for (int i = 0; i < 4; ++i)
#pragma unroll
            for (int r = 0; r < 16; ++r) o[i][r] = 0.f;
        float m = -1e30f, l = 0.f;
#pragma unroll 1
        for (int kv0 = 0; kv0 < MEM_LEN; kv0 += 32) {
            f32x16 sc;
#pragma unroll
            for (int r = 0; r < 16; ++r) sc[r] = 0.f;
            const int key = kv0 + r32;
#pragma unroll
            for (int d0 = 0; d0 < 8; ++d0) { const bf16x8 kf = *(const LAS bf16x8*)(Ks + key * 256 + (((2 * d0 + hi) ^ (key & 15)) << 4)); sc = __builtin_amdgcn_mfma_f32_32x32x16_bf16(kf, qf[d0], sc, 0, 0, 0); }
            float tmax = sc[0];
#pragma unroll
            for (int r = 1; r < 16; ++r) tmax = fmaxf(tmax, sc[r]);
            tmax = fmaxf(tmax, __shfl_xor(tmax, 32));
            const float mnew = fmaxf(m, tmax), alpha = __builtin_amdgcn_exp2f(m - mnew);
            float ps = 0.f;
#pragma unroll
            for (int r = 0; r < 16; ++r) { sc[r] = __builtin_amdgcn_exp2f(sc[r] - mnew); ps += sc[r]; }
            l = l * alpha + ps; m = mnew;
#pragma unroll
            for (int i = 0; i < 4; ++i)
#pragma unroll
                for (int r = 0; r < 16; ++r) o[i][r] *= alpha;
            bf16x8 pb[2];
#pragma unroll
            for (int s2 = 0; s2 < 2; ++s2) { u32x4 w; w[0] = pg8::cvt_pk_bf16(sc[8 * s2], sc[8 * s2 + 1]); w[1] = pg8::cvt_pk_bf16(sc[8 * s2 + 2], sc[8 * s2 + 3]); w[2] = pg8::cvt_pk_bf16(sc[8 * s2 + 4], sc[8 * s2 + 5]); w[3] = pg8::cvt_pk_bf16(sc[8 * s2 + 6], sc[8 * s2 + 7]); pb[s2] = __builtin_bit_cast(bf16x8, w); }
#pragma unroll
            for (int i = 0; i < 4; ++i)
#pragma unroll
                for (int s2 = 0; s2 < 2; ++s2) {
                    const LAS unsigned char* vp = VT + (32 * i + r32) * VT_STRIDE + (kv0 + 16 * s2 + 4 * hi) * 2;
                    const u32x2 v0 = *(const LAS u32x2*)vp, v1 = *(const LAS u32x2*)(vp + 16);
                    const u32x4 vv = (u32x4){v0[0], v0[1], v1[0], v1[1]};
                    o[i] = __builtin_amdgcn_mfma_f32_32x32x16_bf16(__builtin_bit_cast(bf16x8, vv), pb[s2], o[i], 0, 0, 0);
                }
        }
        l += __shfl_xor(l, 32);
        const float rl = __builtin_amdgcn_rcpf(l);
        bf16_t* Op = OM + ((size_t)(b * SEQ + q0 + r32)) * 512 + h * MEM_D;
#pragma unroll
        for (int i = 0; i < 4; ++i)
#pragma unroll
            for (int g = 0; g < 4; ++g) { u32x2 w; w[0] = pg8::cvt_pk_bf16(o[i][4 * g] * rl, o[i][4 * g + 1] * rl); w[1] = pg8::cvt_pk_bf16(o[i][4 * g + 2] * rl, o[i][4 * g + 3] * rl);
                *(u32x2*)(Op + 32 * i + 8 * g + 4 * hi) = w; }
    }
    __syncthreads();
}
}

struct Params { const float* in[32]; float* out; unsigned char* ws; };

__global__ void __launch_bounds__(NTHREADS, 2) mega_fwd(Params p) {
    extern __shared__ __attribute__((aligned(16))) unsigned char lds[];
    const int bid = blockIdx.x, G = gridDim.x;
    const int NGW = G * NWAVES, NGT = G * NTHREADS;
#define PHASE_IDS int tid = threadIdx.x; asm volatile("" : "+v"(tid)); const int lane = tid & 63, wave = __builtin_amdgcn_readfirstlane(tid >> 6), half = tid >> 8, vt = tid & 255; \
    unsigned char* sm = lds + half * 32768; const int gw = bid * NWAVES + wave, gt = bid * NTHREADS + tid; (void)lane; (void)vt; (void)sm; (void)gw; (void)gt;

    const float* x = p.in[0];            const float* mem = p.in[1];
    const float* norm_mix_g = p.in[2];   const float* w_in = p.in[3];
    const float* b_forget = p.in[4];     const float* conv_w = p.in[5];
    const float* conv_b = p.in[6];       const float* lru_wa = p.in[7];
    const float* lru_ba = p.in[8];       const float* lru_wx = p.in[9];
    const float* lru_bx = p.in[10];      const float* lru_a_param = p.in[11];
    const float* fox_q_g = p.in[12];     const float* fox_k_g = p.in[13];
    const float* lru_out_g = p.in[14];   const float* fox_out_g = p.in[15];
    const float* w_out = p.in[16];       const float* norm_mem_x_g = p.in[17];
    const float* norm_mem_g = p.in[18];  const float* mem_wq = p.in[19];
    const float* mem_wkv = p.in[20];     const float* mem_q_g = p.in[21];
    const float* mem_k_g = p.in[22];     const float* mem_wo = p.in[23];
    const float* norm_ffn_g = p.in[24];  const float* r_gw = p.in[25];
    const float* r_gb = p.in[26];        const float* r_ew = p.in[27];
    const float* r_eb = p.in[28];        const float* w_gate = p.in[29];
    const float* w_up = p.in[30];        const float* w_down = p.in[31];
    float* out = p.out;
    unsigned char* ws = p.ws;
    int* ctl = (int*)(ws + WS_CTL) + CW_MOE;
    float* LOGF = (float*)(ws + WS_LOGF); float* CUM = (float*)(ws + WS_CUM);
    bf16_t* MEMN = (bf16_t*)(ws + WS_MEMN); bf16_t* KM = (bf16_t*)(ws + WS_KM); bf16_t* VM = (bf16_t*)(ws + WS_VM);
    int* RE = (int*)(ws + WS_RE); float* RW = (float*)(ws + WS_RW); int* ROWTOK = (int*)(ws + WS_ROWTOK); int* TILEE = (int*)(ws + WS_TILEE);
    bf16_t* H = (bf16_t*)(ws + WS_H); bf16_t* U = (bf16_t*)(ws + WS_U); bf16_t* GATE = (bf16_t*)(ws + WS_GATE);
    bf16_t* Q = (bf16_t*)(ws + WS_Q); bf16_t* K = (bf16_t*)(ws + WS_K); bf16_t* V = (bf16_t*)(ws + WS_V);
    bf16_t* YL = (bf16_t*)(ws + WS_YL); bf16_t* YF = (bf16_t*)(ws + WS_YF); bf16_t* MIXED = (bf16_t*)(ws + WS_MIXED);
    float* X1F = p.out;     float* LA = (float*)(ws + WS_LA); float* LB = (float*)(ws + WS_LB);
    bf16_t* QM = (bf16_t*)(ws + WS_QM); bf16_t* OM = (bf16_t*)(ws + WS_OM); unsigned char* HDN = ws + WS_HDN; unsigned char* YB = ws + WS_YB;

    bf16_t* WT_IN = (bf16_t*)(ws + WS_WT_IN); bf16_t* WT_KV = (bf16_t*)(ws + WS_WT_KV); bf16_t* WT_OUT = (bf16_t*)(ws + WS_WT_OUT);
    bf16_t* WT_Q = (bf16_t*)(ws + WS_WT_Q); bf16_t* WT_O = (bf16_t*)(ws + WS_WT_O); unsigned char* WT_GU = ws + WS_WT_GU; unsigned char* WT_D = ws + WS_WT_D; unsigned char* X2Q = ws + WS_X2Q;
    bf16_t* LRUW = (bf16_t*)(ws + WS_LRUW);
    bf16_t* WT_R = (bf16_t*)(ws + WS_WT_R); float* RSTD2 = (float*)(ws + WS_RSTD2); int* LIST = (int*)(ws + WS_LIST);
    bf16_t* X1B = (bf16_t*)(ws + WS_X1B); bf16_t* X2B = (bf16_t*)(ws + WS_X2B); float* SSL = (float*)(ws + WS_SSL); float* SSF = (float*)(ws + WS_SSF);
    float* SS1 = (float*)(ws + WS_SS1); float* SS2 = (float*)(ws + WS_SS2);
    float* SUMA = (float*)(ws + WS_SUMA); float* SUMH = (float*)(ws + WS_SUMH);
    LAS unsigned char* ldsl = (LAS unsigned char*)lds;
    volatile LAS unsigned* MISC = (volatile LAS unsigned*)((LAS unsigned char*)lds + MISC_OFF);
    if (threadIdx.x < 32) MISC[threadIdx.x] = 0u;
    __syncthreads();
    XcdBarrier bar = xcd_barrier_post((unsigned*)(ws + WS_CTL) + CW_BAR, MISC + 8);
#define GRID_BAR() xcd_barrier(bar)
#define FOR_VB(NB) for (int _vb0 = 2 * bid; _vb0 < (NB); _vb0 += 2 * G) { const int vb = (_vb0 + half < (NB)) ? (_vb0 + half) : ((NB) - 1);
#define END_VB }

    { PHASE_IDS
    {
        LAS unsigned* scr = (LAS unsigned*)(ldsl + wave * 17408);
        constexpr int I_IN = (DM / 128) * (2560 / 64), I_KV = (DM / 128) * (1024 / 64), I_OUT = (DM / 128) * (DM / 64), I_Q = (DM / 128) * (MEM_W / 64), I_O = (MEM_W / 128) * (DM / 64);
        constexpr int NITEMS = I_IN + I_KV + I_OUT + I_Q + I_O;
        for (int it = gw; it < NITEMS; it += NGW) {
            int r = it;
            if (r < I_IN) { p0_transpose_item<1, false>(w_in, IN_COLS, DM, 2560, WT_IN, scr, r, lane, nullptr, nullptr, 0); continue; } r -= I_IN;
            if (r < I_KV) { p0_transpose_item<0, false>(mem_wkv, 2 * MEM_W, DM, 2 * MEM_W, WT_KV, scr, r, lane, nullptr, nullptr, 0); continue; } r -= I_KV;
            if (r < I_OUT) { p0_transpose_item<0, true>(w_out, DM, DM, DM, WT_OUT, scr, r, lane, lru_out_g, fox_out_g, 512); continue; } r -= I_OUT;
            if (r < I_Q) { p0_transpose_item<0, true>(mem_wq, MEM_W, DM, MEM_W, WT_Q, scr, r, lane, norm_mem_x_g, norm_mem_x_g, 1 << 30); continue; } r -= I_Q;
            p0_transpose_item<0, false>(mem_wo, DM, MEM_W, DM, WT_O, scr, r, lane, nullptr, nullptr, 0);
        }
    }
    __syncthreads();
    }
    { PHASE_IDS
    {
        LAS float* wfT = (LAS float*)ldsl;
        for (int i = tid; i < 8 * 1024; i += NTHREADS) { const int k = i >> 3, h = i & 7; wfT[h * 1024 + k] = w_in[(size_t)k * IN_COLS + 2560 + h]; }
        __syncthreads();
        for (int row = gw; row < T; row += NGW) b_rmsnorm_row_f(x, norm_mix_g, H, wfT, b_forget, LOGF, row, lane);
    }
    __syncthreads();
    }
    { PHASE_IDS
    for (int row = gw; row < TM; row += NGW) b_rmsnorm_row(mem, norm_mem_g, MEMN, row, lane);
    if (bid == 0 && tid < 128) ctl[tid] = 0;
    for (int i = gt; i < 48 * DM; i += NGT) {
        const int col = i >> 10, k = i & 1023; float v = 0.f;
        if (col < 4) v = r_gw[(size_t)k * 4 + col]; else if (col < 36) v = r_ew[(size_t)k * 32 + col - 4];
        WT_R[i] = f2bf(v * norm_ffn_g[k]);
    }
    for (int i = gt; i < 8 * 16 * 64 * 8; i += NGT) {
        const int j = i & 7, ln = (i >> 3) & 63, s_ = (i >> 9) & 3, n = (i >> 11) & 1, mat = (i >> 12) & 1, blk = i >> 13;
        const float* W = mat ? lru_wx : lru_wa;
        LRUW[i] = f2bf(W[(size_t)blk * 4096 + (16 * s_ + 8 * (ln >> 5) + j) * 64 + 32 * n + (ln & 31)]);
    }
    }
    GRID_BAR();
    { PHASE_IDS
    { const pg8::Gemm g{H, WT_IN, DM, DM, DM, 0, 0, 0, 0};
      const pg8::EpiInProj E{U, fox_q_g, fox_k_g};
      static_assert(WS_GATE - WS_U == 32 * MiB && WS_Q - WS_GATE == 32 * MiB && WS_K - WS_Q == 32 * MiB && WS_V - WS_K == 32 * MiB, "EpiInProj: section stride");
      const int split = bid % 5;
      if (split > 0) { pg8::StaticOrder S; S.init(T, 2560, G, bid, 0, split); pg8::gemm_phase<pg8::EpiInProj, pg8::StaticOrder, true>(ldsl, g, S, E); }
      { LAS unsigned char* scq = ldsl + wave * 17408;
        for (int it = gw; it < N_EXP * 192; it += NGW) {
            const int e = it / 192, q = it % 192;
            if (q < 64) p0_transpose_item_q<2, true>(w_gate + (size_t)e * DM * D_EXP, D_EXP, DM, D_EXP, WT_GU + (size_t)e * 1024 * 1024, scq, q, lane, norm_ffn_g);
            else if (q < 128) p0_transpose_item_q<3, true>(w_up + (size_t)e * DM * D_EXP, D_EXP, DM, D_EXP, WT_GU + (size_t)e * 1024 * 1024, scq, q - 64, lane, norm_ffn_g);
            else p0_transpose_item_q<0, false>(w_down + (size_t)e * D_EXP * DM, DM, D_EXP, DM, WT_D + (size_t)e * 1024 * 512, scq, q - 128, lane, norm_ffn_g);
        }
        __syncthreads(); }
      { pg8::StaticOrder S; S.init(T, 2560, G, bid, split, 1 << 30); pg8::gemm_phase<pg8::EpiInProj, pg8::StaticOrder, true>(ldsl, g, S, E); } }
    }
    GRID_BAR();
    { PHASE_IDS
    { constexpr int NB = BATCH * FOX_H;
      FOR_VB(NB) b_cumsum(LOGF, CUM, vb, vt, sm, true); END_VB }
    if (bid >= 32) {
      const pg8::Gemm g{MEMN, WT_KV, DM, DM, DM, 0, 0, 0, 0}; pg8::StaticOrder S; S.init(TM, 2 * MEM_W, G, bid - 32);
      const pg8::EpiBf16 E{KM, VM, 512, 512};
      pg8::gemm_phase<pg8::EpiBf16, pg8::StaticOrder, true>(ldsl, g, S, E); }
    __syncthreads();
    for (int u = bid; u < BATCH * lru::NCH; u += G) lru::unit<false>(u / lru::NCH, u % lru::NCH, U, GATE, conv_w, conv_b, LRUW, lru_ba, lru_bx, lru_a_param, SUMA, SUMH, YL, SSL, ldsl + wave * lru::WLDS, wave, lane);
    }
    GRID_BAR();
    { PHASE_IDS
    for (int u = bid; u < BATCH * lru::NCH; u += G) lru::unit<true>(u / lru::NCH, u % lru::NCH, U, GATE, conv_w, conv_b, LRUW, lru_ba, lru_bx, lru_a_param, SUMA, SUMH, YL, SSL, ldsl + wave * lru::WLDS, wave, lane);
    __syncthreads();
    fox::attn_phase<8>((char*)lds, Q, K, V, YF, CUM, SSF, G, bid);
    }
    GRID_BAR();
    { PHASE_IDS
    { const pg8::Gemm g{YL, WT_OUT, 512, DM, 512, (size_t)(WS_YF - WS_YL) / 2, 512, 0, 0}; pg8::PairOrder S; S.init(T, DM, G, bid);
      const pg8::EpiOutChain E{x, X1B, SSL, SSF, SS1};
      pg8::gemm_phase<pg8::EpiOutChain, pg8::PairOrder, true>(ldsl, g, S, E); }
    }
    GRID_BAR();
    { PHASE_IDS
    { const pg8::Gemm g{X1B, WT_Q, DM, DM, DM, 0, 0, 0, 0}; pg8::StaticOrder S; S.init(T, MEM_W, G, bid);
      const pg8::EpiRowScale E{QM, 512, SS1, 1.f / DM};
      pg8::gemm_phase<pg8::EpiRowScale, pg8::StaticOrder, true>(ldsl, g, S, E); }
    }
    GRID_BAR();
    { PHASE_IDS
    static_assert(xat::LDS_NEED <= MISC_OFF, "cross-attention LDS");
    for (int it = bid; it < BATCH * MEM_H * 8; it += G) { const int bh = it >> 3; xat::item(bh / MEM_H, bh % MEM_H, it & 7, QM, KM, VM, OM, mem_q_g, mem_k_g, ldsl); }
    }
    GRID_BAR();
    { PHASE_IDS
    { const pg8::Gemm g{OM, WT_O, MEM_W, MEM_W, MEM_W, 0, 0, 0, 0}; pg8::StaticOrder S; S.init(T, DM, G, bid);
      const pg8::EpiX2 E{X1B, X2B, X2Q, SS2};
      pg8::gemm_phase<pg8::EpiX2, pg8::StaticOrder, true>(ldsl, g, S, E); }
    }
    GRID_BAR();
    { PHASE_IDS
    static_assert(T / 16 == 256 * NWAVES, "router: one 16-token task per wave on a 256-workgroup grid");
    LAS int* hist = (LAS int*)(ldsl + 8 * 8448 + 36 * 2064);
    LAS unsigned char* wr = ldsl + 8 * 8448;
    if (tid < 64) hist[tid] = 0;
    for (int i = tid; i < 36 * 128; i += NTHREADS) { const int row = i >> 7, ch = i & 127; *(LAS pg8::u32x4*)(wr + row * 2064 + ch * 16) = *(const pg8::u32x4*)(WT_R + (size_t)row * DM + ch * 8); }
    __syncthreads();
    for (int tk = gw; tk < T / 16; tk += NGW) rtr::task(tk * 16, X2B, WT_R, SS2, r_gb, r_eb, RW, RSTD2, ctl, LIST, (LAS float*)(ldsl + wave * 8448), wr, hist, lane);
    }
    GRID_BAR();
    { PHASE_IDS
    LAS int* mp = (LAS int*)(ldsl + 131072);
    if (tid == 0) { int run = 0; for (int e = 0; e < N_EXP; ++e) { const int c_ = ctl[e]; mp[e] = run; mp[64 + e] = c_; run += (c_ + 255) & ~255; } mp[32] = run; }
    __syncthreads();
    if (tid < N_TILES) { const int row = tid * 256; int e = 0; for (int j = 1; j < N_EXP; ++j) if (mp[j] <= row) e = j; mp[128 + tid] = e; }
    __syncthreads();
    { const pg8::Gemm g{X2Q, WT_GU, DM, DM, DM, 0, (size_t)1024 * 1024, 0x7f7f7f7f, 0x7a7a7a7a};
      const pg8::MoeOrder<true> S{(mp[32] >> 8) * 4, G, bid, mp, LIST};
      const pg8::EpiMoe1 E{HDN, RSTD2, S};
      pg8::gemm_phase<pg8::EpiMoe1, pg8::MoeOrder<true>, true>(ldsl, g, S, E); }
    }
    GRID_BAR();
    { PHASE_IDS
    LAS int* mp = (LAS int*)(ldsl + 131072);
    { const pg8::Gemm g{HDN, WT_D, D_EXP, D_EXP, D_EXP, 0, (size_t)1024 * 512, 0x7c7c7c7c, 0x7a7a7a7a};
      const pg8::MoeOrder<false> S{(mp[32] >> 8) * 4, G, bid, mp, LIST};
      const pg8::EpiMoe2 E{YB, RW, S};
      pg8::gemm_phase<pg8::EpiMoe2, pg8::MoeOrder<false>, true>(ldsl, g, S, E); }
    }
    GRID_BAR();
    { PHASE_IDS
    for (size_t i = (size_t)gt * 8; i < (size_t)T * DM; i += (size_t)NGT * 8) b_final(out, X2B, YB, i);
    }
}

extern "C" void kernel_launch(void* const* d_in, const int* in_sizes, int n_in, void* d_out, int out_size, void* d_ws, size_t ws_size, hipStream_t stream) {
    static int grid = 0;
    if (grid == 0) {
        int dev = 0, cus = 0;
        if (hipGetDevice(&dev) != hipSuccess || hipDeviceGetAttribute(&cus, hipDeviceAttributeMultiprocessorCount, dev) != hipSuccess) { fprintf(stderr, "kernel_launch: device query failed\n"); grid = -1; return; }
        if (hipFuncSetAttribute((const void*)mega_fwd, hipFuncAttributeMaxDynamicSharedMemorySize, LDS_BYTES) != hipSuccess) { fprintf(stderr, "kernel_launch: hipFuncSetAttribute failed\n"); grid = -1; return; }
        if (n_in != 32 || ws_size < WS_END) { fprintf(stderr, "kernel_launch: unexpected inputs (n_in %d, ws %zu)\n", n_in, ws_size); grid = -1; return; }
        grid = cus;
    }
    if (grid < 0) return;
    (void)hipMemsetAsync((char*)d_ws + WS_CTL, 0, CTL_ZERO_BYTES, stream);
    Params p{};
    for (int i = 0; i < 32; ++i) p.in[i] = (const float*)d_in[i];
    p.out = (float*)d_out; p.ws = (unsigned char*)d_ws;
    hipLaunchKernelGGL(mega_fwd, dim3(grid), dim3(NTHREADS), LDS_BYTES, stream, p);
}
```

```cpp
#include <hip/hip_runtime.h>
#include <stdint.h>
#include <math.h>
#include <cstdio>

typedef unsigned short bf16_t;
typedef short bf16x8 __attribute__((ext_vector_type(8)));
typedef float f32x4 __attribute__((ext_vector_type(4)));
typedef float f32x16 __attribute__((ext_vector_type(16)));
#define GAS __attribute__((address_space(1)))
#define LAS __attribute__((address_space(3)))

constexpr int BATCH = 8, SEQ = 4096, T = BATCH * SEQ, DM = 1024;
constexpr int MEM_LEN = 256, TM = BATCH * MEM_LEN;
constexpr int LRU_W = 512, FOX_H = 8, FOX_D = 64, FOX_W = 512;
constexpr int IN_COLS = 2568;
constexpr int MEM_H = 4, MEM_D = 128, MEM_W = 512;
constexpr int N_GROUPS = 4, EPG = 8, N_EXP = 32, D_EXP = 512;
constexpr int NA = T * 2;
constexpr int MOE_PAD = 256;
constexpr int P_MAX = NA + N_EXP * MOE_PAD;
constexpr int N_TILES = P_MAX / MOE_PAD;
constexpr float EPS = 1e-6f;
constexpr float LOG2E = 1.4426950408889634f;
constexpr int NTHREADS = 512, NWAVES = 8;
constexpr int ESPLIT = 12;

constexpr size_t MiB = 1u << 20;
constexpr size_t WS_CTL = 0;
constexpr size_t CTL_ZERO_BYTES = 256 * 1024;
constexpr int CW_MOE = 0;
constexpr int CW_BAR = 4096;
constexpr size_t WS_LOGF = 1 * MiB;
constexpr size_t WS_CUM = 2 * MiB;
constexpr size_t WS_MEMN = 3 * MiB;
constexpr size_t WS_KM = 7 * MiB;
constexpr size_t WS_VM = 9 * MiB;
constexpr size_t WS_RE = 11 * MiB;
constexpr size_t WS_RW = 11 * MiB + 512 * 1024;
constexpr size_t WS_ROWTOK = 12 * MiB;
constexpr size_t WS_TILEE = 13 * MiB;
constexpr size_t WS_SUMA = 14 * MiB;
constexpr size_t WS_SUMH = 14 * MiB + 512 * 1024;
constexpr size_t WS_LRUW = 15 * MiB;
constexpr size_t WS_WT_IN = 16 * MiB;
constexpr size_t WS_WT_KV = 21 * MiB;
constexpr size_t WS_WT_OUT = 23 * MiB;
constexpr size_t WS_WT_Q = 25 * MiB;
constexpr size_t WS_WT_O = 26 * MiB;
constexpr size_t WS_WT_GU = 27 * MiB;
constexpr size_t WS_WT_D = 91 * MiB;
constexpr size_t WS_H = 123 * MiB;
constexpr size_t WS_MIXED = 123 * MiB;
constexpr size_t WS_LA = 123 * MiB;
constexpr size_t WS_YL = 187 * MiB;
constexpr size_t WS_YF = 219 * MiB;
constexpr size_t WS_YB = 123 * MiB;
constexpr size_t WS_U = 251 * MiB;
constexpr size_t WS_GATE = 283 * MiB;
constexpr size_t WS_Q = 315 * MiB;
constexpr size_t WS_K = 347 * MiB;
constexpr size_t WS_V = 379 * MiB;
constexpr size_t WS_QM = 251 * MiB;
constexpr size_t WS_OM = 283 * MiB;
constexpr size_t WS_HDN = 315 * MiB;
constexpr size_t WS_LB = 411 * MiB;
constexpr size_t WS_X1B = 123 * MiB;
constexpr size_t WS_X2Q = 360 * MiB;
constexpr size_t WS_X2B = 411 * MiB;
constexpr size_t WS_LIST = 476 * MiB;
constexpr size_t WS_SSL = 480 * MiB;
constexpr size_t WS_SSF = 481 * MiB;
constexpr size_t WS_SS1 = 482 * MiB;
constexpr size_t WS_SS2 = 484 * MiB;
constexpr size_t WS_RSTD2 = 486 * MiB;
constexpr size_t WS_WT_R = 487 * MiB;
constexpr size_t WS_END = 488 * MiB;
static_assert((size_t)P_MAX * 512 * 2 <= 96 * MiB && (size_t)NA * DM * 2 <= 128 * MiB, "ws map");

constexpr int LDS_BYTES = 155648;
constexpr int MISC_OFF = LDS_BYTES - 512;

__device__ __forceinline__ bf16_t f2bf(float f) { unsigned u = __float_as_uint(f); return (bf16_t)((u + 0x7fffu + ((u >> 16) & 1u)) >> 16); }
__device__ __forceinline__ float bf2f(bf16_t h) { return __uint_as_float(((unsigned)h) << 16); }
__device__ __forceinline__ float wave_sum(float v) {
#pragma unroll
    for (int o = 1; o < 64; o <<= 1) v += __shfl_xor(v, o);
    return v;
}
__device__ __forceinline__ int crow(int r, int hi) { return (r & 3) + 8 * (r >> 2) + 4 * hi; }
__device__ __forceinline__ float sigmoidf_(float x) { return 1.f / (1.f + __expf(-x)); }
__device__ __forceinline__ float gelu_tanh(float x) {
    const float k0 = 0.7978845608028654f, k1 = 0.044715f;
    float u = k0 * (x + k1 * x * x * x);
    float t = 1.f - 2.f / (1.f + __expf(2.f * u));
    return 0.5f * x * (1.f + t);
}

#define XB_TMO      128
#define XB_XCNT(j)  (256  + 64 * (j))
#define XB_XSUB(j)  (1280 + 64 * (j))
#define XB_XGEN(j)  (2304 + 64 * (j))
#define XB_TOP      3328
#define XB_TOPGEN   3392
#define XCD_BAR_WORDS 3456
#define XB_SPIN_CAP (1u << 20)
__device__ __forceinline__ unsigned xb_ld(unsigned* p)              { return __hip_atomic_load(p, __ATOMIC_RELAXED, __HIP_MEMORY_SCOPE_AGENT); }
__device__ __forceinline__ unsigned xb_add(unsigned* p, unsigned v) { return __hip_atomic_fetch_add(p, v, __ATOMIC_RELAXED, __HIP_MEMORY_SCOPE_AGENT); }
__device__ __forceinline__ unsigned xb_xcc_id() { return (unsigned)__builtin_amdgcn_s_getreg((3 << 11) | 20) & 0xFu; }
#define XB_SPIN(cond, bar) do { unsigned _sp = 0; while (cond) { __builtin_amdgcn_s_sleep(1); \
    if ((++_sp & 255u) == 0u) { if (xb_ld(&(bar)[XB_TMO])) break; if (_sp > XB_SPIN_CAP) { atomicAdd(&(bar)[XB_TMO], 1u); break; } } } } while (0)
struct XcdBarrier { unsigned* bar; unsigned x; volatile LAS unsigned* st; };
__device__ __forceinline__ XcdBarrier xcd_barrier_post(unsigned* bar, volatile LAS unsigned* st) {
    XcdBarrier b; b.bar = bar; b.x = xb_xcc_id(); b.st = st;
    if (threadIdx.x == 0) (void)xb_add(&bar[XB_XCNT(b.x)], 1u);
    return b;
}
__device__ __forceinline__ void xcd_barrier_complete(unsigned* bar, unsigned x, unsigned& nloc, unsigned& nx) {
    const unsigned G = gridDim.x * gridDim.y * gridDim.z;
    unsigned sum, cnt, mine, sp = 0u;
    for (;;) {
        sum = 0u; cnt = 0u; mine = 0u;
#pragma unroll
        for (unsigned j = 0; j < 16; ++j) { const unsigned c = xb_ld(&bar[XB_XCNT(j)]); sum += c; cnt += (c > 0u) ? 1u : 0u; mine = (j == x) ? c : mine; }
        if (sum == G) break;
        __builtin_amdgcn_s_sleep(1);
        if ((++sp & 255u) == 0u) { if (xb_ld(&bar[XB_TMO])) break; if (sp > XB_SPIN_CAP) { atomicAdd(&bar[XB_TMO], 1u); break; } }
    }
    nloc = mine > 0u ? mine : 1u; nx = cnt > 0u ? cnt : 1u;
}
__device__ __forceinline__ void xcd_barrier(const XcdBarrier& b) {
    asm volatile("s_waitcnt vmcnt(0)" ::: "memory");
    __syncthreads();
    if (threadIdx.x == 0) {
        unsigned* bar = b.bar;
        __builtin_amdgcn_s_waitcnt(0);
        unsigned nloc = b.st[0], nx = b.st[1];
        if (nloc == 0u) { xcd_barrier_complete(bar, b.x, nloc, nx); b.st[0] = nloc; b.st[1] = nx; }
        const unsigned old = xb_add(&bar[XB_XSUB(b.x)], 1u);
        const unsigned gen = old / nloc;
        if (old + 1u == (gen + 1u) * nloc) {
            __builtin_amdgcn_fence(__ATOMIC_RELEASE, "agent");
            asm volatile("s_waitcnt vmcnt(0)" ::: "memory");
            const unsigned og = xb_add(&bar[XB_TOP], 1u);
            const unsigned tg = og / nx;
            if (og + 1u == (tg + 1u) * nx) xb_add(&bar[XB_TOPGEN], 1u);
            else XB_SPIN(xb_ld(&bar[XB_TOPGEN]) == tg, bar);
            __builtin_amdgcn_fence(__ATOMIC_ACQUIRE, "agent");
            xb_add(&bar[XB_XGEN(b.x)], 1u);
            asm volatile("s_waitcnt vmcnt(0)" ::: "memory");
        } else {
            XB_SPIN(xb_ld(&bar[XB_XGEN(b.x)]) == gen, bar);
            __builtin_amdgcn_fence(__ATOMIC_ACQUIRE, "agent");
            asm volatile("s_waitcnt vmcnt(0)" ::: "memory");
        }
    }
    __syncthreads();
}

__device__ __forceinline__ void b_rmsnorm_row(const float* __restrict__ x, const float* __restrict__ g, bf16_t* __restrict__ out, int row, int lane) {
    const f32x4* xr = (const f32x4*)(x + (size_t)row * DM) + lane;
    f32x4 v[4]; float s = 0.f;
#pragma unroll
    for (int j = 0; j < 4; ++j) { v[j] = xr[64 * j]; s += v[j].x * v[j].x + v[j].y * v[j].y + v[j].z * v[j].z + v[j].w * v[j].w; }
    const float rstd = rsqrtf(wave_sum(s) * (1.f / DM) + EPS);
    const f32x4* gr = (const f32x4*)g + lane;
    uint2* o = (uint2*)(out + (size_t)row * DM) + lane;
#pragma unroll
    for (int j = 0; j < 4; ++j) {
        f32x4 gg = gr[64 * j];
        uint2 w;
        w.x = (unsigned)f2bf(v[j].x * rstd * gg.x) | ((unsigned)f2bf(v[j].y * rstd * gg.y) << 16);
        w.y = (unsigned)f2bf(v[j].z * rstd * gg.z) | ((unsigned)f2bf(v[j].w * rstd * gg.w) << 16);
        o[64 * j] = w;
    }
}


__device__ __forceinline__ void b_rmsnorm_row_f(const float* __restrict__ x, const float* __restrict__ g, bf16_t* __restrict__ out, const LAS float* wfT, const float* __restrict__ b_forget,
                                                float* __restrict__ LOGF, int row, int lane) {
    const f32x4* xr = (const f32x4*)(x + (size_t)row * DM) + lane;
    f32x4 v[4]; float s = 0.f;
#pragma unroll
    for (int j = 0; j < 4; ++j) { v[j] = xr[64 * j]; s += v[j].x * v[j].x + v[j].y * v[j].y + v[j].z * v[j].z + v[j].w * v[j].w; }
    const float rstd = rsqrtf(wave_sum(s) * (1.f / DM) + EPS);
    const f32x4* gr = (const f32x4*)g + lane;
    uint2* o = (uint2*)(out + (size_t)row * DM) + lane;
#pragma unroll
    for (int j = 0; j < 4; ++j) {
        const f32x4 gg = gr[64 * j];
        v[j].x *= rstd * gg.x; v[j].y *= rstd * gg.y; v[j].z *= rstd * gg.z; v[j].w *= rstd * gg.w;
        uint2 w;
        w.x = (unsigned)f2bf(v[j].x) | ((unsigned)f2bf(v[j].y) << 16);
        w.y = (unsigned)f2bf(v[j].z) | ((unsigned)f2bf(v[j].w) << 16);
        o[64 * j] = w;
    }
    float fl[8];
#pragma unroll
    for (int h = 0; h < 8; ++h) {
        float a = 0.f;
#pragma unroll
        for (int j = 0; j < 4; ++j) { const f32x4 w = *(const LAS f32x4*)(wfT + h * 1024 + 256 * j + 4 * lane); a += (v[j].x * w.x + v[j].y * w.y) + (v[j].z * w.z + v[j].w * w.w); }
        fl[h] = wave_sum(a);
    }
    if (lane == 0) {
#pragma unroll
        for (int h = 0; h < 8; ++h) { const float z = fl[h] + b_forget[h]; LOGF[(size_t)row * 8 + h] = fminf(z, 0.f) - log1pf(__expf(-fabsf(z))); }
    }
}

typedef bf16_t (*As_t)[40];
typedef bf16_t (*Bs_t)[64][40];
template <int NB>
__device__ __forceinline__ void gemm_core64(const bf16_t* aptr, const float* W0, const float* W1, int ldw,
                                            int n0, int N, int K, f32x4 (&acc)[NB][2][2], As_t As, Bs_t Bs, int vt) {
    const int lane = vt & 63, wid = vt >> 6, wr = wid >> 1, wc = wid & 1;
    for (int k0 = 0; k0 < K; k0 += 32) {
        {
            const int r = vt >> 2, c = vt & 3;
            uint4 v = make_uint4(0, 0, 0, 0);
            if (aptr) v = *(const uint4*)(aptr + k0 + c * 8);
            *(uint4*)&As[r][c * 8] = v;
        }
        {
            const int kk = vt >> 3, nc = (vt & 7) * 8;
#pragma unroll
            for (int b = 0; b < NB; ++b) {
                const float* wp = (b == 0 ? W0 : W1) + (size_t)(k0 + kk) * ldw + n0 + nc;
#pragma unroll
                for (int j = 0; j < 8; ++j) { float v = (n0 + nc + j < N) ? wp[j] : 0.f; Bs[b][nc + j][kk] = f2bf(v); }
            }
        }
        __syncthreads();
        bf16x8 a[2];
#pragma unroll
        for (int i = 0; i < 2; ++i) a[i] = *(const bf16x8*)&As[wr * 32 + i * 16 + (lane & 15)][(lane >> 4) * 8];
#pragma unroll
        for (int b = 0; b < NB; ++b)
#pragma unroll
            for (int j = 0; j < 2; ++j) {
                bf16x8 bb = *(const bf16x8*)&Bs[b][wc * 32 + j * 16 + (lane & 15)][(lane >> 4) * 8];
#pragma unroll
                for (int i = 0; i < 2; ++i) acc[b][i][j] = __builtin_amdgcn_mfma_f32_16x16x32_bf16(a[i], bb, acc[b][i][j], 0, 0, 0);
            }
        __syncthreads();
    }
}

template <class Epi>
__device__ __forceinline__ void b_gemm(const bf16_t* __restrict__ A, int lda, const float* __restrict__ W, int ldw, int N, int K, const Epi& epi,
                                       int vbx, int vby, int vt, unsigned char* sm) {
    As_t As = (As_t)sm; Bs_t Bs = (Bs_t)(sm + 64 * 40 * 2);
    const int lane = vt & 63, wid = vt >> 6, wr = wid >> 1, wc = wid & 1;
    const int m0 = vby * 64, n0 = vbx * 64;
    f32x4 acc[1][2][2];
#pragma unroll
    for (int i = 0; i < 2; ++i)
#pragma unroll
        for (int j = 0; j < 2; ++j) acc[0][i][j] = (f32x4){0.f, 0.f, 0.f, 0.f};
    gemm_core64<1>(A + (size_t)(m0 + (vt >> 2)) * lda, W, W, ldw, n0, N, K, acc, As, Bs, vt);
#pragma unroll
    for (int i = 0; i < 2; ++i)
#pragma unroll
        for (int j = 0; j < 2; ++j)
#pragma unroll
            for (int r = 0; r < 4; ++r) {
                const int row = m0 + wr * 32 + i * 16 + (lane >> 4) * 4 + r, col = n0 + wc * 32 + j * 16 + (lane & 15);
                if (col < N) epi(row, col, acc[0][i][j][r]);
            }
}

struct EpiG1 {
    bf16_t *U, *GATE, *Q, *K, *V; float* LOGF; const float* b_forget;
    __device__ __forceinline__ void operator()(int row, int col, float v) const {
        if (col < 512) U[(size_t)row * 512 + col] = f2bf(v);
        else if (col < 1024) GATE[(size_t)row * 512 + col - 512] = f2bf(v);
        else if (col < 1536) Q[(size_t)row * 512 + col - 1024] = f2bf(v);
        else if (col < 2048) K[(size_t)row * 512 + col - 1536] = f2bf(v);
        else if (col < 2560) V[(size_t)row * 512 + col - 2048] = f2bf(v);
        else { const int h = col - 2560; const float z = v + b_forget[h]; LOGF[(size_t)row * 8 + h] = fminf(z, 0.f) - log1pf(__expf(-fabsf(z))); }
    }
};
struct EpiSplit2 { bf16_t *O0, *O1;
    __device__ __forceinline__ void operator()(int row, int col, float v) const {
        if (col < 512) O0[(size_t)row * 512 + col] = f2bf(v); else O1[(size_t)row * 512 + col - 512] = f2bf(v); } };
struct EpiBf16s { bf16_t* O; int ldo;
    __device__ __forceinline__ void operator()(int row, int col, float v) const { O[(size_t)row * ldo + col] = f2bf(v); } };
struct EpiResF32 { const float* base; float* out;
    __device__ __forceinline__ void operator()(int row, int col, float v) const { out[(size_t)row * DM + col] = base[(size_t)row * DM + col] + v; } };

template <int HD>
__device__ __forceinline__ void b_headnorm(bf16_t* __restrict__ X, const float* __restrict__ g, float scale, int idx) {
    const int nh = 512 / HD;
    bf16_t* p = X + (size_t)(idx / nh) * 512 + (idx % nh) * HD;
    float ss = 0.f;
#pragma unroll 8
    for (int d = 0; d < HD; ++d) { float v = bf2f(p[d]); ss += v * v; }
    const float rstd = rsqrtf(ss * (1.f / HD) + EPS) * scale;
#pragma unroll 8
    for (int d = 0; d < HD; ++d) p[d] = f2bf(bf2f(p[d]) * rstd * g[d]);
}

__device__ __forceinline__ void b_cumsum(const float* __restrict__ LOGF, float* __restrict__ CUM, int bh, int vt, unsigned char* sm, bool store) {
    float* part = (float*)sm;
    const int b = bh / FOX_H, h = bh % FOX_H;
    float v[16]; float s = 0.f;
#pragma unroll
    for (int i = 0; i < 16; ++i) { v[i] = LOGF[((size_t)b * SEQ + vt * 16 + i) * 8 + h]; s += v[i]; }
    part[vt] = s; __syncthreads();
    if (vt == 0) { float run = 0.f; for (int i = 0; i < 256; ++i) { float t = part[i]; part[i] = run; run += t; } }
    __syncthreads();
    float run = part[vt];
    if (store) {
#pragma unroll
        for (int i = 0; i < 16; ++i) { run += v[i]; CUM[(size_t)bh * SEQ + vt * 16 + i] = run * LOG2E; }
    }
    __syncthreads();
}

__device__ __forceinline__ void b_lru_ab(const bf16_t* __restrict__ U, const float* __restrict__ conv_w, const float* __restrict__ conv_b,
                                         const float* __restrict__ wa, const float* __restrict__ ba, const float* __restrict__ wx, const float* __restrict__ bx,
                                         const float* __restrict__ a_param, float* __restrict__ LA, float* __restrict__ LB, int t, int ch, unsigned char* sm) {
    float* xc = (float*)sm;
    const int s = t % SEQ;
    float x = conv_b[ch];
#pragma unroll
    for (int tap = 0; tap < 4; ++tap) { const int ss = s - 3 + tap; if (ss >= 0) x += conv_w[tap * 512 + ch] * bf2f(U[(size_t)(t - 3 + tap) * 512 + ch]); }
    xc[ch] = x; __syncthreads();
    const int blk = ch >> 6, j = ch & 63;
    float r = ba[ch], ii = bx[ch];
    const float* wap = wa + (size_t)blk * 4096 + j; const float* wxp = wx + (size_t)blk * 4096 + j;
#pragma unroll 4
    for (int i = 0; i < 64; ++i) { const float xv = xc[blk * 64 + i]; r += xv * wap[i * 64]; ii += xv * wxp[i * 64]; }
    r = sigmoidf_(r); ii = sigmoidf_(ii);
    const float ap = -a_param[ch];
    const float sp = (ap > 20.f) ? ap : log1pf(__expf(ap));
    const float log_a = -8.f * r * sp;
    const float a = __expf(log_a);
    const float mult = sqrtf(fmaxf(-expm1f(2.f * log_a), 0.f));
    LA[(size_t)t * 512 + ch] = a;
    LB[(size_t)t * 512 + ch] = mult * (ii * x);
    __syncthreads();
}
__device__ __forceinline__ void b_lru_scan(const float* __restrict__ LA, const float* __restrict__ LB, const bf16_t* __restrict__ GATE, bf16_t* __restrict__ YL, int vb, int lane) {
    const int b = vb / 8, ch = (vb % 8) * 64 + lane;
    float h = 0.f;
    size_t off = (size_t)b * SEQ * 512 + ch;
    for (int s = 0; s < SEQ; s += 8) {
        float a[8], bb[8], g[8];
#pragma unroll
        for (int i = 0; i < 8; ++i) { a[i] = LA[off + (size_t)(s + i) * 512]; bb[i] = LB[off + (size_t)(s + i) * 512]; g[i] = bf2f(GATE[off + (size_t)(s + i) * 512]); }
#pragma unroll
        for (int i = 0; i < 8; ++i) { h = a[i] * h + bb[i]; YL[off + (size_t)(s + i) * 512] = f2bf(h * gelu_tanh(g[i])); }
    }
}

template <int D, bool CAUSAL, int VB0>
__device__ __forceinline__ void b_attn(const bf16_t* __restrict__ Q, const bf16_t* __restrict__ K, const bf16_t* __restrict__ V, bf16_t* __restrict__ O,
                                       const float* __restrict__ cum, int H, int Sq, int Skv, int pitch, int b, int h, int q0, int lane) {
    const int r32 = lane & 31, hi = lane >> 5;
    const bf16_t* Qp = Q + ((size_t)b * Sq + q0 + r32) * pitch + h * D;
    constexpr bool QREG = (D <= 64);
    bf16x8 qf[QREG ? D / 16 : 1];
    if (QREG) {
#pragma unroll
        for (int d0 = 0; d0 < D / 16; ++d0) qf[QREG ? d0 : 0] = *(const bf16x8*)(Qp + d0 * 16 + hi * 8);
    }
    f32x16 o[2];
#pragma unroll
    for (int i = 0; i < 2; ++i)
#pragma unroll
        for (int r = 0; r < 16; ++r) o[i][r] = 0.f;
    float m = -1e30f, l = 0.f;
    const int nkv = CAUSAL ? (q0 + 32) : Skv;
    const float* cb = cum ? cum + ((size_t)b * H + h) * Skv : nullptr;
    const float cref = cum ? cb[q0] : 0.f;
    const bf16_t* Kb = K + ((size_t)b * Skv) * pitch + h * D;
    const bf16_t* Vb = V + ((size_t)b * Skv) * pitch + h * D;
#pragma unroll 1
    for (int kv0 = 0; kv0 < nkv; kv0 += 32) {
        f32x16 s;
#pragma unroll
        for (int r = 0; r < 16; ++r) s[r] = 0.f;
        const bf16_t* Kp = Kb + (size_t)(kv0 + r32) * pitch;
#pragma unroll
        for (int d0 = 0; d0 < D / 16; ++d0) { bf16x8 kf = *(const bf16x8*)(Kp + d0 * 16 + hi * 8);
            bf16x8 qq; if (QREG) qq = qf[QREG ? d0 : 0]; else qq = *(const bf16x8*)(Qp + d0 * 16 + hi * 8);
            s = __builtin_amdgcn_mfma_f32_32x32x16_bf16(kf, qq, s, 0, 0, 0); }
        float tmax = -INFINITY;
#pragma unroll
        for (int r = 0; r < 16; ++r) {
            const int kv = kv0 + crow(r, hi);
            float v = s[r];
            if (cum) v += cref - cb[kv];
            if (CAUSAL && kv > q0 + r32) v = -INFINITY;
            s[r] = v; tmax = fmaxf(tmax, v);
        }
        tmax = fmaxf(tmax, __shfl_xor(tmax, 32));
        const float mnew = fmaxf(m, tmax);
        const float alpha = exp2f(m - mnew);
        float ps = 0.f;
#pragma unroll
        for (int r = 0; r < 16; ++r) { s[r] = exp2f(s[r] - mnew); ps += s[r]; }
        l = l * alpha + ps; m = mnew;
#pragma unroll
        for (int i = 0; i < 2; ++i)
#pragma unroll
            for (int r = 0; r < 16; ++r) o[i][r] *= alpha;
        bf16x8 pb[2];
#pragma unroll
        for (int s2 = 0; s2 < 2; ++s2)
#pragma unroll
            for (int j = 0; j < 8; ++j) pb[s2][j] = (short)f2bf(s[8 * s2 + j]);
#pragma unroll
        for (int i = 0; i < 2; ++i)
#pragma unroll
            for (int s2 = 0; s2 < 2; ++s2) {
                bf16x8 vf;
#pragma unroll
                for (int j = 0; j < 8; ++j) vf[j] = (short)Vb[(size_t)(kv0 + 16 * s2 + 8 * (j >> 2) + 4 * hi + (j & 3)) * pitch + (VB0 + i) * 32 + r32];
                o[i] = __builtin_amdgcn_mfma_f32_32x32x16_bf16(vf, pb[s2], o[i], 0, 0, 0);
                asm volatile("" ::: "memory");
            }
    }
    l += __shfl_xor(l, 32);
    const float rl = 1.f / l;
    bf16_t* Op = O + ((size_t)b * Sq + q0 + r32) * pitch + h * D;
#pragma unroll
    for (int i = 0; i < 2; ++i)
#pragma unroll
        for (int r = 0; r < 16; ++r) Op[(VB0 + i) * 32 + crow(r, hi)] = f2bf(o[i][r] * rl);
}

__device__ __forceinline__ void b_mixnorm(const bf16_t* __restrict__ YL, const bf16_t* __restrict__ YF, const float* __restrict__ gl, const float* __restrict__ gf, bf16_t* __restrict__ MIXED, int row, int lane) {
#pragma unroll
    for (int part = 0; part < 2; ++part) {
        const bf16_t* src = (part ? YF : YL) + (size_t)row * 512 + lane * 8;
        const float* g = (part ? gf : gl) + lane * 8;
        float v[8]; float ss = 0.f;
#pragma unroll
        for (int j = 0; j < 8; ++j) { v[j] = bf2f(src[j]); ss += v[j] * v[j]; }
        const float rstd = rsqrtf(wave_sum(ss) * (1.f / 512.f) + EPS);
        bf16_t* dst = MIXED + (size_t)row * DM + part * 512 + lane * 8;
#pragma unroll
        for (int j = 0; j < 8; ++j) dst[j] = f2bf(v[j] * rstd * g[j]);
    }
}

__device__ __forceinline__ void b_router(const bf16_t* __restrict__ XN, const float* __restrict__ wg, const float* __restrict__ bg, const float* __restrict__ we, const float* __restrict__ be,
                                         int* __restrict__ RE, float* __restrict__ RW, int* __restrict__ counts, int t, int lane) {
    float acc[36];
#pragma unroll
    for (int o = 0; o < 36; ++o) acc[o] = 0.f;
    const bf16_t* xr = XN + (size_t)t * DM;
#pragma unroll 1
    for (int i = 0; i < 16; ++i) {
        const int k = i * 64 + lane;
        const float xv = bf2f(xr[k]);
        const f32x4 g4 = *(const f32x4*)(wg + (size_t)k * 4);
        acc[0] += xv * g4.x; acc[1] += xv * g4.y; acc[2] += xv * g4.z; acc[3] += xv * g4.w;
        const f32x4* e4 = (const f32x4*)(we + (size_t)k * 32);
#pragma unroll
        for (int q = 0; q < 8; ++q) { const f32x4 e = e4[q]; acc[4 + 4 * q] += xv * e.x; acc[5 + 4 * q] += xv * e.y; acc[6 + 4 * q] += xv * e.z; acc[7 + 4 * q] += xv * e.w; }
    }
#pragma unroll
    for (int o = 0; o < 36; ++o) acc[o] = wave_sum(acc[o]);
    if (lane == 0) {
        float gl[4]; int gi = 0; float gmax;
#pragma unroll
        for (int j = 0; j < 4; ++j) { gl[j] = acc[j] + bg[j]; }
        gmax = gl[0];
#pragma unroll
        for (int j = 1; j < 4; ++j) if (gl[j] > gmax) { gmax = gl[j]; gi = j; }
        float gs = 0.f;
#pragma unroll
        for (int j = 0; j < 4; ++j) gs += __expf(gl[j] - gmax);
        const float gw = 1.f / gs;
        float el[8];
#pragma unroll
        for (int j = 0; j < 8; ++j) {
            float v = 0.f;
#pragma unroll
            for (int g = 0; g < 4; ++g) if (g == gi) v = acc[4 + g * 8 + j] + be[g * 8 + j];
            el[j] = v;
        }
        int i0 = 0; float v0 = el[0];
#pragma unroll
        for (int j = 1; j < 8; ++j) if (el[j] > v0) { v0 = el[j]; i0 = j; }
        int i1 = -1; float v1 = -INFINITY;
#pragma unroll
        for (int j = 0; j < 8; ++j) if (j != i0 && el[j] > v1) { v1 = el[j]; i1 = j; }
        const float e1 = __expf(v1 - v0);
        const float p0 = 1.f / (1.f + e1), p1 = e1 / (1.f + e1);
        const int ex0 = gi * 8 + i0, ex1 = gi * 8 + i1;
        RE[t * 2 + 0] = ex0; RE[t * 2 + 1] = ex1;
        RW[t * 2 + 0] = gw * p0; RW[t * 2 + 1] = gw * p1;
        atomicAdd(&counts[ex0], 1); atomicAdd(&counts[ex1], 1);
    }
}

__device__ __forceinline__ void b_moe_scan(int* __restrict__ ctl, int* __restrict__ TILEE, int tid, unsigned char* sm) {
    int* pst = (int*)sm;
    if (tid == 0) { int run = 0; for (int e = 0; e < N_EXP; ++e) { pst[e] = run; ctl[64 + e] = run; ctl[32 + e] = 0; run += (ctl[e] + MOE_PAD - 1) / MOE_PAD * MOE_PAD; } pst[32] = run; ctl[96] = run / MOE_PAD; }
    __syncthreads();
    for (int tile = tid; tile < N_TILES; tile += NTHREADS) {
        const int p = tile * MOE_PAD; int e = -1;
        for (int j = 0; j < N_EXP; ++j) if (p >= pst[j] && p < pst[j + 1]) e = j;
        TILEE[tile] = e;
    }
}

__device__ __forceinline__ void b_moe_gemm1(const bf16_t* __restrict__ XN, const float* __restrict__ Wg, const float* __restrict__ Wu, const int* __restrict__ ROWTOK, const int* __restrict__ TILEE, bf16_t* __restrict__ HDN,
                                            int vbx, int vby, int vt, unsigned char* sm) {
    As_t As = (As_t)sm; Bs_t Bs = (Bs_t)(sm + 64 * 40 * 2);
    const int e_raw = TILEE[vby];
    const int e = e_raw < 0 ? 0 : e_raw;
    const int lane = vt & 63, wid = vt >> 6, wr = wid >> 1, wc = wid & 1;
    const int p0 = vby * 64, n0 = vbx * 64;
    const int a = ROWTOK[p0 + (vt >> 2)];
    f32x4 acc[2][2][2];
#pragma unroll
    for (int b = 0; b < 2; ++b)
#pragma unroll
        for (int i = 0; i < 2; ++i)
#pragma unroll
            for (int j = 0; j < 2; ++j) acc[b][i][j] = (f32x4){0.f, 0.f, 0.f, 0.f};
    gemm_core64<2>(a >= 0 ? XN + (size_t)(a >> 1) * DM : nullptr, Wg + (size_t)e * DM * D_EXP, Wu + (size_t)e * DM * D_EXP, D_EXP, n0, D_EXP, DM, acc, As, Bs, vt);
    if (e_raw < 0) return;
#pragma unroll
    for (int i = 0; i < 2; ++i)
#pragma unroll
        for (int j = 0; j < 2; ++j)
#pragma unroll
            for (int r = 0; r < 4; ++r) {
                const int row = p0 + wr * 32 + i * 16 + (lane >> 4) * 4 + r, col = n0 + wc * 32 + j * 16 + (lane & 15);
                const float g = acc[0][i][j][r], u = acc[1][i][j][r];
                HDN[(size_t)row * D_EXP + col] = f2bf(g * sigmoidf_(g) * u);
            }
}
__device__ __forceinline__ void b_moe_gemm2(const bf16_t* __restrict__ HDN, const float* __restrict__ Wd, const int* __restrict__ ROWTOK, const int* __restrict__ TILEE, const float* __restrict__ RW, bf16_t* __restrict__ YB,
                                            int vbx, int vby, int vt, unsigned char* sm) {
    As_t As = (As_t)sm; Bs_t Bs = (Bs_t)(sm + 64 * 40 * 2);
    const int e_raw = TILEE[vby];
    const int e = e_raw < 0 ? 0 : e_raw;
    const int lane = vt & 63, wid = vt >> 6, wr = wid >> 1, wc = wid & 1;
    const int p0 = vby * 64, n0 = vbx * 64;
    f32x4 acc[1][2][2];
#pragma unroll
    for (int i = 0; i < 2; ++i)
#pragma unroll
        for (int j = 0; j < 2; ++j) acc[0][i][j] = (f32x4){0.f, 0.f, 0.f, 0.f};
    const int arow = ROWTOK[p0 + (vt >> 2)];
    gemm_core64<1>((arow >= 0 && e_raw >= 0) ? HDN + (size_t)(p0 + (vt >> 2)) * D_EXP : nullptr, Wd + (size_t)e * D_EXP * DM, nullptr, DM, n0, DM, D_EXP, acc, As, Bs, vt);
    if (e_raw < 0) return;
#pragma unroll
    for (int i = 0; i < 2; ++i)
#pragma unroll
        for (int r = 0; r < 4; ++r) {
            const int row = p0 + wr * 32 + i * 16 + (lane >> 4) * 4 + r;
            const int a = ROWTOK[row];
            if (a < 0) continue;
            const float w = RW[a];
#pragma unroll
            for (int j = 0; j < 2; ++j) { const int col = n0 + wc * 32 + j * 16 + (lane & 15); YB[(size_t)a * DM + col] = f2bf(w * acc[0][i][j][r]); }
        }
}
__device__ __forceinline__ void b_final(float* __restrict__ out, const bf16_t* __restrict__ X2B, const unsigned char* __restrict__ YB, size_t i) {
    const size_t t = i / DM, c = i % DM;
    const uint4 xv = *(const uint4*)(X2B + i); const uint2 y0 = *(const uint2*)(YB + (2 * t) * DM + c), y1 = *(const uint2*)(YB + (2 * t + 1) * DM + c);
    const unsigned xs[4] = {xv.x, xv.y, xv.z, xv.w};
    f32x4 o0, o1;
    o0[0] = __uint_as_float(xs[0] << 16) + 0.0625f * (__builtin_amdgcn_cvt_f32_fp8(y0.x, 0) + __builtin_amdgcn_cvt_f32_fp8(y1.x, 0));
    o0[1] = __uint_as_float(xs[0] & 0xffff0000u) + 0.0625f * (__builtin_amdgcn_cvt_f32_fp8(y0.x, 1) + __builtin_amdgcn_cvt_f32_fp8(y1.x, 1));
    o0[2] = __uint_as_float(xs[1] << 16) + 0.0625f * (__builtin_amdgcn_cvt_f32_fp8(y0.x, 2) + __builtin_amdgcn_cvt_f32_fp8(y1.x, 2));
    o0[3] = __uint_as_float(xs[1] & 0xffff0000u) + 0.0625f * (__builtin_amdgcn_cvt_f32_fp8(y0.x, 3) + __builtin_amdgcn_cvt_f32_fp8(y1.x, 3));
    o1[0] = __uint_as_float(xs[2] << 16) + 0.0625f * (__builtin_amdgcn_cvt_f32_fp8(y0.y, 0) + __builtin_amdgcn_cvt_f32_fp8(y1.y, 0));
    o1[1] = __uint_as_float(xs[2] & 0xffff0000u) + 0.0625f * (__builtin_amdgcn_cvt_f32_fp8(y0.y, 1) + __builtin_amdgcn_cvt_f32_fp8(y1.y, 1));
    o1[2] = __uint_as_float(xs[3] << 16) + 0.0625f * (__builtin_amdgcn_cvt_f32_fp8(y0.y, 2) + __builtin_amdgcn_cvt_f32_fp8(y1.y, 2));
    o1[3] = __uint_as_float(xs[3] & 0xffff0000u) + 0.0625f * (__builtin_amdgcn_cvt_f32_fp8(y0.y, 3) + __builtin_amdgcn_cvt_f32_fp8(y1.y, 3));
    *(f32x4*)(out + i) = o0; *(f32x4*)(out + i + 4) = o1;
}

namespace pg8 {
typedef unsigned u32x4 __attribute__((ext_vector_type(4)));
typedef unsigned u32x2 __attribute__((ext_vector_type(2)));
typedef int v4i_t __attribute__((ext_vector_type(4)));
typedef int v8i_t __attribute__((ext_vector_type(8)));
constexpr int BM = 256, BK = 64, HALF = 128, HTB = HALF * BK * 2, STAGE_BYTES = 8 * HTB, NXCD = 8, WGM = 8;
__host__ __device__ __forceinline__ int lds_byte(int r, int c) { const int st = (r >> 4) * 2 + (c >> 5), rr = r & 15, cc = c & 31, ob = rr * 64 + cc * 2; return st * 1024 + (ob ^ (((ob >> 9) & 1) << 5)); }
__host__ __device__ __forceinline__ void stage_rc(int b, int& R, int& C) { const int st = b / 1024, sb = b % 1024, swz = sb ^ (((sb >> 9) & 1) << 5); R = (st >> 1) * 16 + swz / 64; C = (st & 1) * 32 + (swz % 64) / 2; }
__host__ __device__ __forceinline__ int perm32(int rho) { const int n = rho >> 4, i = rho & 15; return 8 * (i >> 2) + 4 * n + (i & 3); }
struct Unit { int pm, pn, e, r0, cnt; };
struct Gemm { const void* A; const void* Bt; int lda, ldb, K; size_t astride, bstride; int scale_a, scale_b; };
struct StaticOrder {
    static constexpr bool GATHER = false; static constexpr int ESZ = 2;
    int nM, nN, nwg, G, c, i0, i1;
    __device__ void init(int M, int N, int G_, int c_, int i0_ = 0, int i1_ = 1 << 30) { nM = M / BM; nN = N / BM; nwg = nM * nN; G = G_; c = c_; i0 = i0_; i1 = i1_; }
    __device__ bool next(int i, Unit& u) const {
        i += i0; if (i >= i1) return false;
        const long L = (long)i * G + c; if (L >= nwg) return false;
        int wgid = (int)L; { const int q = nwg / NXCD, r = nwg % NXCD, xcd = wgid % NXCD, off = wgid / NXCD; wgid = (xcd < r ? xcd * (q + 1) : r * (q + 1) + (xcd - r) * q) + off; }
        const int nig = WGM * nN, gid = wgid / nig, fm = gid * WGM, gsz = (nM - fm) < WGM ? (nM - fm) : WGM;
        u.pm = fm + ((wgid % nig) % gsz); u.pn = (wgid % nig) / gsz; u.e = 0; return true;
    }
};
__device__ __forceinline__ unsigned cvt_pk_bf16(float lo, float hi) { unsigned r; asm volatile("v_cvt_pk_bf16_f32 %0, %1, %2" : "=v"(r) : "v"(lo), "v"(hi)); return r; }

template <class Epi, class Sched, bool ALIGN_EPI>
__device__ __forceinline__ void gemm_phase(LAS unsigned char* lds, const Gemm g, const Sched& S, const Epi& E) {
    int tid = threadIdx.x; asm volatile("" : "+v"(tid));
    const int wid = __builtin_amdgcn_readfirstlane(tid >> 6), lane = tid & 63, wr = wid >> 2, wc = wid & 3, fr = lane & 15, fq = lane >> 4;
    constexpr int ESZ = Sched::ESZ;
    const int K = g.K, nt = K * ESZ / (BK * 2);
    unsigned voffA[2], voffB[2];
#pragma unroll
    for (int i = 0; i < 2; ++i) { int R, C; stage_rc(tid * 16 + i * 8192, R, C); const int Rb = Epi::PERM ? ((R & ~31) + perm32(R & 31)) : R;
        voffA[i] = (unsigned)(R * g.lda * ESZ + C * 2); voffB[i] = (unsigned)(Rb * g.ldb * ESZ + C * 2); }
    const size_t kstep = (size_t)(BK * 2);
    const size_t hstepA = (size_t)HALF * g.lda * ESZ, tstepA = 2 * hstepA;
    const size_t hstepB = (size_t)HALF * g.ldb * ESZ, tstepB = 2 * hstepB;
    const unsigned ldsw = (unsigned)wid * 1024u;
    const int aoff = lds_byte(wr * 64 + fr, ESZ == 2 ? fq * 8 : fq * 16), boff = lds_byte(wc * 32 + fr, ESZ == 2 ? fq * 8 : fq * 16);
    constexpr int PIECE1 = ESZ == 2 ? 1024 : 16;
    unsigned la_ = (unsigned)(size_t)(lds + aoff), lb_ = (unsigned)(size_t)(lds + 65536 + boff);
    asm volatile("" : "+v"(la_), "+v"(lb_));
    const LAS unsigned char* ldsA = (const LAS unsigned char*)(size_t)la_; const LAS unsigned char* ldsB = (const LAS unsigned char*)(size_t)lb_;
#define PG8_SA(b, h) (((b) * 2 + (h)) * HTB)
#define PG8_SB(b, h) ((4 + (b) * 2 + (h)) * HTB)
#define PG8_STAGE(bufoff, gbase, voff) do { _Pragma("unroll") for (int _i = 0; _i < 2; ++_i) \
        __builtin_amdgcn_global_load_lds((const unsigned*)((const char*)(gbase) + (voff)[_i]), (LAS unsigned*)(lds + (bufoff) + ldsw + _i * 8192), 16, 0, 0); } while (0)
#define PG8_LDA(dst, b, h) do { _Pragma("unroll") for (int m = 0; m < 4; ++m) { dst[m][0] = *(const LAS bf16x8*)(ldsA + PG8_SA(b, h) + m * 2048); dst[m][1] = *(const LAS bf16x8*)(ldsA + PG8_SA(b, h) + m * 2048 + PIECE1); } } while (0)
#define PG8_LDB(dst, b, h) do { _Pragma("unroll") for (int n = 0; n < 2; ++n) { dst[n][0] = *(const LAS bf16x8*)(ldsB + (PG8_SB(b, h) - 65536) + n * 2048); dst[n][1] = *(const LAS bf16x8*)(ldsB + (PG8_SB(b, h) - 65536) + n * 2048 + PIECE1); } } while (0)
#define PG8_V8(x) __builtin_shufflevector(__builtin_bit_cast(v4i_t, (x)[0]), __builtin_bit_cast(v4i_t, (x)[1]), 0, 1, 2, 3, 4, 5, 6, 7)
#define PG8_MMA(ai, bj, At, Bt) do { __builtin_amdgcn_s_setprio(1); _Pragma("unroll") for (int m = 0; m < 4; ++m) _Pragma("unroll") for (int n = 0; n < 2; ++n) { \
        if constexpr (ESZ == 2) { _Pragma("unroll") for (int k = 0; k < 2; ++k) acc[ai][bj][m][n] = __builtin_amdgcn_mfma_f32_16x16x32_bf16(Bt[n][k], At[m][k], acc[ai][bj][m][n], 0, 0, 0); } \
        else { acc[ai][bj][m][n] = __builtin_amdgcn_mfma_scale_f32_16x16x128_f8f6f4(PG8_V8(Bt[n]), PG8_V8(At[m]), acc[ai][bj][m][n], 0, 0, 0, g.scale_b, 0, g.scale_a); \
               asm volatile("" : "+v"(acc[ai][bj][m][n])); } }     \
        __builtin_amdgcn_s_setprio(0); } while (0)
#define PG8_WAIT_V(n) asm volatile("s_waitcnt vmcnt(" #n ")" ::: "memory")
#define PG8_WAIT_L(n) asm volatile("s_waitcnt lgkmcnt(" #n ")" ::: "memory")
#define PG8_BAR __builtin_amdgcn_s_barrier()
#define PG8_SCHED __builtin_amdgcn_sched_barrier(0)
    Unit cur, nxt; int ui = 0;
    if (!S.next(0, cur)) return;
    f32x4 acc[2][2][4][2];
#pragma unroll
    for (int a = 0; a < 2; ++a)
#pragma unroll
        for (int b = 0; b < 2; ++b)
#pragma unroll
            for (int m = 0; m < 4; ++m)
#pragma unroll
                for (int n = 0; n < 2; ++n) acc[a][b][m][n] = (f32x4){0.f, 0.f, 0.f, 0.f};
    bf16x8 At[4][2], B0[2][2], B1[2][2];
    constexpr bool GATHER = Sched::GATHER;
    const size_t hsA = GATHER ? 0 : hstepA;
    unsigned c0[2], c1[2], n0[2], n1[2];
    if constexpr (GATHER) { S.a_offsets(cur, tid, g.lda, c0, c1); n0[0] = c0[0]; n0[1] = c0[1]; n1[0] = c1[0]; n1[1] = c1[1]; }
#define PG8_C0 (GATHER ? c0 : voffA)
#define PG8_C1 (GATHER ? c1 : voffA)
    const char* cA = (const char*)g.A + (GATHER ? (size_t)0 : ((size_t)cur.e * g.astride) * ESZ + (size_t)cur.pm * tstepA); const char* cB = (const char*)g.Bt + ((size_t)cur.e * g.bstride) * ESZ + (size_t)cur.pn * tstepB;
    PG8_STAGE(PG8_SB(0, 0), cB, voffB); PG8_STAGE(PG8_SB(0, 1), cB + hstepB, voffB); PG8_STAGE(PG8_SA(0, 0), cA, PG8_C0); PG8_STAGE(PG8_SA(0, 1), cA + hsA, PG8_C1);
    if (wr == 1) PG8_BAR;
    PG8_WAIT_V(2); PG8_BAR;
    PG8_STAGE(PG8_SB(1, 0), cB + kstep, voffB); PG8_STAGE(PG8_SA(1, 0), cA + kstep, PG8_C0); PG8_STAGE(PG8_SB(1, 1), cB + hstepB + kstep, voffB);
    PG8_WAIT_V(6); PG8_BAR;
    for (;;) {
        const bool has_next = S.next(ui + 1, nxt);
        const char* nA = (has_next && !GATHER) ? (const char*)g.A + ((size_t)nxt.e * g.astride) * ESZ + (size_t)nxt.pm * tstepA : cA; const char* nB = has_next ? (const char*)g.Bt + ((size_t)nxt.e * g.bstride) * ESZ + (size_t)nxt.pn * tstepB : cB;
        if constexpr (GATHER) { if (has_next) S.a_offsets(nxt, tid, g.lda, n0, n1); }
#pragma unroll 1
        for (int t = 0; t < nt; t += 2) {
            const bool last = (t == nt - 2);
            const char* a1 = cA + (size_t)(t + 1) * kstep;
            const char* a2 = last ? nA : cA + (size_t)(t + 2) * kstep; const char* b2 = last ? nB : cB + (size_t)(t + 2) * kstep;
            const char* a3 = a2 + kstep; const char* b3 = b2 + kstep;
            unsigned s0[2], s1[2];
            if constexpr (GATHER) {
#pragma unroll
                for (int i_ = 0; i_ < 2; ++i_) { s0[i_] = last ? n0[i_] : c0[i_]; s1[i_] = last ? n1[i_] : c1[i_]; }
            }
#define PG8_S0 (GATHER ? s0 : voffA)
#define PG8_S1 (GATHER ? s1 : voffA)
            PG8_LDB(B0, 0, 0); PG8_LDB(B1, 0, 1); PG8_SCHED; PG8_LDA(At, 0, 0); PG8_STAGE(PG8_SA(1, 1), a1 + hsA, PG8_C1);
            PG8_WAIT_V(8); PG8_WAIT_L(0); PG8_BAR; PG8_MMA(0, 0, At, B0); PG8_MMA(0, 1, At, B1); PG8_BAR; PG8_SCHED;
            PG8_LDA(At, 0, 1); PG8_STAGE(PG8_SB(0, 0), b2, voffB); PG8_STAGE(PG8_SB(0, 1), b2 + hstepB, voffB); PG8_STAGE(PG8_SA(0, 0), a2, PG8_S0);
            PG8_WAIT_V(8); PG8_WAIT_L(0); PG8_BAR; PG8_MMA(1, 0, At, B0); PG8_MMA(1, 1, At, B1); PG8_BAR; PG8_SCHED;
            PG8_LDB(B0, 1, 0); PG8_LDB(B1, 1, 1); PG8_SCHED; PG8_LDA(At, 1, 0); PG8_STAGE(PG8_SA(0, 1), a2 + hsA, PG8_S1);
            PG8_WAIT_V(8); PG8_WAIT_L(0); PG8_BAR; PG8_MMA(0, 0, At, B0); PG8_MMA(0, 1, At, B1); PG8_BAR; PG8_SCHED;
            PG8_LDA(At, 1, 1); PG8_STAGE(PG8_SB(1, 0), b3, voffB); PG8_STAGE(PG8_SB(1, 1), b3 + hstepB, voffB); PG8_STAGE(PG8_SA(1, 0), a3, PG8_S0);
            PG8_WAIT_V(8); PG8_WAIT_L(0); PG8_BAR; PG8_MMA(1, 0, At, B0); PG8_MMA(1, 1, At, B1); PG8_BAR; PG8_SCHED;
        }
        if constexpr (ALIGN_EPI) { if (wr == 0) PG8_BAR; }
        bool chained = false;
        {
            int te = threadIdx.x; asm volatile("" : "+v"(te));
            const int le = te & 63, fre = le & 15, fqe = le >> 4, we = __builtin_amdgcn_readfirstlane(te >> 6), wre = we >> 2, wce = we & 3;
            if constexpr (Epi::CHAIN) chained = E.chain(acc, cur, wre, wce, fre, fqe);
            if (!chained) E(acc, cur, wre, wce, fre, fqe);
        }
        if (!has_next) break;
        if (!chained) {
#pragma unroll
        for (int a = 0; a < 2; ++a)
#pragma unroll
            for (int b = 0; b < 2; ++b)
#pragma unroll
                for (int m = 0; m < 4; ++m)
#pragma unroll
                    for (int n = 0; n < 2; ++n) acc[a][b][m][n] = (f32x4){0.f, 0.f, 0.f, 0.f};
        }
        cur = nxt; cA = nA; cB = nB; ++ui; if constexpr (GATHER) { c0[0] = n0[0]; c0[1] = n0[1]; c1[0] = n1[0]; c1[1] = n1[1]; }
        if constexpr (ALIGN_EPI) { if (wr == 1) PG8_BAR; }
    }
    PG8_WAIT_V(0);
    if constexpr (!ALIGN_EPI) { if (wr == 0) PG8_BAR; }
    PG8_BAR;
#undef PG8_SA
#undef PG8_SB
#undef PG8_STAGE
#undef PG8_LDA
#undef PG8_LDB
#undef PG8_MMA
#undef PG8_V8
#undef PG8_C0
#undef PG8_C1
#undef PG8_S0
#undef PG8_S1
#undef PG8_WAIT_V
#undef PG8_WAIT_L
#undef PG8_BAR
#undef PG8_SCHED
}

struct EpiInProj {
    static constexpr bool PERM = true, CHAIN = false;
    bf16_t* U; const float *qg, *kg;
    static constexpr size_t SEC_STRIDE = (size_t)16 << 20;
    __device__ __forceinline__ void operator()(const f32x4 (&acc)[2][2][4][2], const Unit& u, int wr, int wc, int fr, int fq) const {
        const int sec = u.pn >> 1, row0 = u.pm * BM + wr * 64 + fr;
        bf16_t* base = U + (size_t)sec * SEC_STRIDE;
        if (sec == 2 || sec == 3) {
            const bool isq = (sec == 2); const float sc = isq ? 0.125f * LOG2E : 1.0f;
            const int head = 4 * (u.pn & 1) + wc;
            const f32x4 q00 = *(const f32x4*)(qg + 8 * fq), q01 = *(const f32x4*)(qg + 8 * fq + 4), q10 = *(const f32x4*)(qg + 32 + 8 * fq), q11 = *(const f32x4*)(qg + 32 + 8 * fq + 4);
            const f32x4 k00 = *(const f32x4*)(kg + 8 * fq), k01 = *(const f32x4*)(kg + 8 * fq + 4), k10 = *(const f32x4*)(kg + 32 + 8 * fq), k11 = *(const f32x4*)(kg + 32 + 8 * fq + 4);
            const f32x4 gv00 = isq ? q00 : k00, gv01 = isq ? q01 : k01, gv10 = isq ? q10 : k10, gv11 = isq ? q11 : k11;
#pragma unroll
            for (int ai = 0; ai < 2; ++ai)
#pragma unroll
                for (int m = 0; m < 4; ++m) {
                    float ss = 0.f;
#pragma unroll
                    for (int bj = 0; bj < 2; ++bj)
#pragma unroll
                        for (int n = 0; n < 2; ++n) { const f32x4 x = acc[ai][bj][m][n]; ss += (x[0] * x[0] + x[1] * x[1]) + (x[2] * x[2] + x[3] * x[3]); }
                    ss += __shfl_xor(ss, 16); ss += __shfl_xor(ss, 32);
                    const float rs = rsqrtf(ss * (1.f / 64.f) + EPS) * sc;
                    bf16_t* rowp = base + (size_t)(row0 + ai * HALF + m * 16) * 512 + head * 64 + 8 * fq;
#pragma unroll
                    for (int bj = 0; bj < 2; ++bj) { const f32x4 v0 = acc[ai][bj][m][0] * rs * (bj ? gv10 : gv00), v1 = acc[ai][bj][m][1] * rs * (bj ? gv11 : gv01);
                        u32x4 w; w.x = cvt_pk_bf16(v0[0], v0[1]); w.y = cvt_pk_bf16(v0[2], v0[3]); w.z = cvt_pk_bf16(v1[0], v1[1]); w.w = cvt_pk_bf16(v1[2], v1[3]);
                        *(u32x4*)(rowp + bj * 32) = w; }
                }
        } else {
            const int col0 = (u.pn & 1) * BM + wc * 32 + 8 * fq;
#pragma unroll
            for (int ai = 0; ai < 2; ++ai)
#pragma unroll
                for (int m = 0; m < 4; ++m) { bf16_t* rowp = base + (size_t)(row0 + ai * HALF + m * 16) * 512 + col0;
#pragma unroll
                    for (int bj = 0; bj < 2; ++bj) { const f32x4 v0 = acc[ai][bj][m][0], v1 = acc[ai][bj][m][1];
                        u32x4 w; w.x = cvt_pk_bf16(v0[0], v0[1]); w.y = cvt_pk_bf16(v0[2], v0[3]); w.z = cvt_pk_bf16(v1[0], v1[1]); w.w = cvt_pk_bf16(v1[2], v1[3]);
                        *(u32x4*)(rowp + bj * HALF) = w; } }
        }
    }
};
struct EpiBf16 {
    static constexpr bool PERM = true, CHAIN = false;
    bf16_t *O0, *O1; int ldo, split;
    __device__ __forceinline__ void operator()(const f32x4 (&acc)[2][2][4][2], const Unit& u, int wr, int wc, int fr, int fq) const {
        int colt = u.pn * BM; bf16_t* base = O0; if (colt >= split) { colt -= split; base = O1; }
        const int row0 = u.pm * BM + wr * 64 + fr, col0 = colt + wc * 32 + 8 * fq;
#pragma unroll
        for (int ai = 0; ai < 2; ++ai)
#pragma unroll
            for (int m = 0; m < 4; ++m) { bf16_t* rowp = base + (size_t)(row0 + ai * HALF + m * 16) * ldo + col0;
#pragma unroll
                for (int bj = 0; bj < 2; ++bj) { const f32x4 v0 = acc[ai][bj][m][0], v1 = acc[ai][bj][m][1];
                    u32x4 w; w.x = cvt_pk_bf16(v0[0], v0[1]); w.y = cvt_pk_bf16(v0[2], v0[3]); w.z = cvt_pk_bf16(v1[0], v1[1]); w.w = cvt_pk_bf16(v1[2], v1[3]);
                    *(u32x4*)(rowp + bj * HALF) = w; } }
    }
};
struct EpiResF32 {
    static constexpr bool PERM = false, CHAIN = false;
    const float* base; float* out;
    __device__ __forceinline__ void operator()(const f32x4 (&acc)[2][2][4][2], const Unit& u, int wr, int wc, int fr, int fq) const {
        const int row0 = u.pm * BM + wr * 64 + fr, col0 = u.pn * BM + wc * 32 + 4 * fq;
#pragma unroll
        for (int ai = 0; ai < 2; ++ai)
#pragma unroll
            for (int m = 0; m < 4; ++m) { const size_t off = (size_t)(row0 + ai * HALF + m * 16) * DM + col0;
#pragma unroll
                for (int bj = 0; bj < 2; ++bj)
#pragma unroll
                    for (int n = 0; n < 2; ++n) *(f32x4*)(out + off + bj * HALF + n * 16) = *(const f32x4*)(base + off + bj * HALF + n * 16) + acc[ai][bj][m][n]; }
    }
};


struct PairOrder {
    static constexpr bool GATHER = false; static constexpr int ESZ = 2;
    StaticOrder so;
    __device__ void init(int M, int N, int G_, int c_) { so.init(M, N, G_, c_); }
    __device__ bool next(int i, Unit& u) const { if (!so.next(i >> 1, u)) return false; u.e = i & 1; return true; }
};
__device__ __forceinline__ float rstd8(const float* p, float inv_n) { const f32x4 a = *(const f32x4*)p, b = *(const f32x4*)(p + 4); return rsqrtf(((a[0] + a[1]) + (a[2] + a[3]) + (b[0] + b[1]) + (b[2] + b[3])) * inv_n + EPS); }
__device__ __forceinline__ float rstd16(const float* p, float inv_n) { float t = 0.f;
#pragma unroll
    for (int i = 0; i < 4; ++i) { const f32x4 a = *(const f32x4*)(p + 4 * i); t += (a[0] + a[1]) + (a[2] + a[3]); } return rsqrtf(t * inv_n + EPS); }
struct EpiOutChain {
    static constexpr bool PERM = false, CHAIN = true;
    const float* x; bf16_t* x1b; const float* SSL; const float* SSF; float* SS1;
    __device__ __forceinline__ bool chain(f32x4 (&acc)[2][2][4][2], const Unit& u, int wr, int wc, int fr, int fq) const {
        if (u.e != 0) return false;
        const int row0 = u.pm * BM + wr * 64 + fr;
        float ratio[8];
#pragma unroll
        for (int i = 0; i < 8; ++i) { const int row = row0 + (i >> 2) * HALF + (i & 3) * 16; ratio[i] = rstd8(SSL + (size_t)row * 8, 1.f / 512.f) / rstd8(SSF + (size_t)row * 8, 1.f / 512.f); }
#pragma unroll
        for (int ai = 0; ai < 2; ++ai)
#pragma unroll
            for (int m = 0; m < 4; ++m)
#pragma unroll
                for (int bj = 0; bj < 2; ++bj)
#pragma unroll
                    for (int n = 0; n < 2; ++n) acc[ai][bj][m][n] *= ratio[ai * 4 + m];
        return true;
    }
    __device__ __forceinline__ void operator()(const f32x4 (&acc)[2][2][4][2], const Unit& u, int wr, int wc, int fr, int fq) const {
        const int row0 = u.pm * BM + wr * 64 + fr, col0 = u.pn * BM + wc * 32 + 4 * fq;
        float rfv[8];
#pragma unroll
        for (int i = 0; i < 8; ++i) rfv[i] = rstd8(SSF + (size_t)(row0 + (i >> 2) * HALF + (i & 3) * 16) * 8, 1.f / 512.f);
#pragma unroll
        for (int pr = 0; pr < 4; ++pr) {
            const int ai = pr >> 1;
            f32x4 xv[2][2][2];
#pragma unroll
            for (int mm = 0; mm < 2; ++mm)
#pragma unroll
                for (int bj = 0; bj < 2; ++bj)
#pragma unroll
                    for (int n = 0; n < 2; ++n) xv[mm][bj][n] = *(const f32x4*)(x + (size_t)(row0 + ai * HALF + (2 * (pr & 1) + mm) * 16) * DM + col0 + bj * HALF + n * 16);
            asm volatile("" ::: "memory");
#pragma unroll
            for (int mm = 0; mm < 2; ++mm) { const int m = 2 * (pr & 1) + mm; const int row = row0 + ai * HALF + m * 16; const size_t off = (size_t)row * DM + col0;
                const float rf = rfv[ai * 4 + m]; float ss = 0.f;
#pragma unroll
                for (int bj = 0; bj < 2; ++bj)
#pragma unroll
                    for (int n = 0; n < 2; ++n) { const f32x4 v = xv[mm][bj][n] + acc[ai][bj][m][n] * rf;
                        ss += (v[0] * v[0] + v[1] * v[1]) + (v[2] * v[2] + v[3] * v[3]);
                        u32x2 w; w.x = cvt_pk_bf16(v[0], v[1]); w.y = cvt_pk_bf16(v[2], v[3]); *(u32x2*)(x1b + off + bj * HALF + n * 16) = w; }
                ss += __shfl_xor(ss, 16); ss += __shfl_xor(ss, 32);
                if (fq == 0) SS1[(size_t)row * 16 + u.pn * 4 + wc] = ss; }
        }
    }
};
struct EpiRowScale {
    static constexpr bool PERM = true, CHAIN = false;
    bf16_t* O; int ldo; const float* SS; float inv_n;
    __device__ __forceinline__ void operator()(const f32x4 (&acc)[2][2][4][2], const Unit& u, int wr, int wc, int fr, int fq) const {
        const int row0 = u.pm * BM + wr * 64 + fr, col0 = u.pn * BM + wc * 32 + 8 * fq;
        float rsv[8];
#pragma unroll
        for (int i = 0; i < 8; ++i) rsv[i] = rstd16(SS + (size_t)(row0 + (i >> 2) * HALF + (i & 3) * 16) * 16, inv_n);
#pragma unroll
        for (int ai = 0; ai < 2; ++ai)
#pragma unroll
            for (int m = 0; m < 4; ++m) { const int row = row0 + ai * HALF + m * 16; const float rs = rsv[ai * 4 + m]; bf16_t* rowp = O + (size_t)row * ldo + col0;
#pragma unroll
                for (int bj = 0; bj < 2; ++bj) { const f32x4 v0 = acc[ai][bj][m][0] * rs, v1 = acc[ai][bj][m][1] * rs;
                    u32x4 w; w.x = cvt_pk_bf16(v0[0], v0[1]); w.y = cvt_pk_bf16(v0[2], v0[3]); w.z = cvt_pk_bf16(v1[0], v1[1]); w.w = cvt_pk_bf16(v1[2], v1[3]);
                    *(u32x4*)(rowp + bj * HALF) = w; } }
    }
};

__device__ __forceinline__ float clamp_fp8(float v) { return __builtin_amdgcn_fmed3f(v, -448.f, 448.f); }
__device__ __forceinline__ unsigned cvt4_fp8(float a, float b, float c, float d) { int w = 0; w = __builtin_amdgcn_cvt_pk_fp8_f32(clamp_fp8(a), clamp_fp8(b), w, false); w = __builtin_amdgcn_cvt_pk_fp8_f32(clamp_fp8(c), clamp_fp8(d), w, true); return (unsigned)w; }
struct EpiX2 {
    static constexpr bool PERM = true, CHAIN = false;
    const bf16_t* x1b; bf16_t* xb; unsigned char* xq; float* SS;
    __device__ __forceinline__ void operator()(const f32x4 (&acc)[2][2][4][2], const Unit& u, int wr, int wc, int fr, int fq) const {
        const int row0 = u.pm * BM + wr * 64 + fr, col0 = u.pn * BM + wc * 32 + 8 * fq;
#pragma unroll
        for (int ai = 0; ai < 2; ++ai) {
            u32x4 xrv[4][2];
#pragma unroll
            for (int m = 0; m < 4; ++m)
#pragma unroll
                for (int bj = 0; bj < 2; ++bj) xrv[m][bj] = *(const u32x4*)(x1b + (size_t)(row0 + ai * HALF + m * 16) * DM + col0 + bj * HALF);
            asm volatile("" ::: "memory");
#pragma unroll
            for (int m = 0; m < 4; ++m) { const int row = row0 + ai * HALF + m * 16; const size_t off = (size_t)row * DM + col0; float ss = 0.f;
#pragma unroll
                for (int bj = 0; bj < 2; ++bj) { const u32x4 xr = xrv[m][bj];
                    f32x4 v0 = acc[ai][bj][m][0], v1 = acc[ai][bj][m][1];
                    v0[0] += __uint_as_float(xr.x << 16); v0[1] += __uint_as_float(xr.x & 0xffff0000u); v0[2] += __uint_as_float(xr.y << 16); v0[3] += __uint_as_float(xr.y & 0xffff0000u);
                    v1[0] += __uint_as_float(xr.z << 16); v1[1] += __uint_as_float(xr.z & 0xffff0000u); v1[2] += __uint_as_float(xr.w << 16); v1[3] += __uint_as_float(xr.w & 0xffff0000u);
                    ss += (v0[0] * v0[0] + v0[1] * v0[1]) + (v0[2] * v0[2] + v0[3] * v0[3]) + (v1[0] * v1[0] + v1[1] * v1[1]) + (v1[2] * v1[2] + v1[3] * v1[3]);
                    u32x4 w; w.x = cvt_pk_bf16(v0[0], v0[1]); w.y = cvt_pk_bf16(v0[2], v0[3]); w.z = cvt_pk_bf16(v1[0], v1[1]); w.w = cvt_pk_bf16(v1[2], v1[3]);
                    *(u32x4*)(xb + off + bj * HALF) = w;
                    u32x2 q; q.x = cvt4_fp8(v0[0], v0[1], v0[2], v0[3]); q.y = cvt4_fp8(v1[0], v1[1], v1[2], v1[3]); *(u32x2*)(xq + off + bj * HALF) = q; }
                ss += __shfl_xor(ss, 16); ss += __shfl_xor(ss, 32);
                if (fq == 0) SS[(size_t)row * 16 + u.pn * 4 + wc] = ss; }
        }
    }
};
template <bool GATHER_>
struct MoeOrder {
    static constexpr bool GATHER = GATHER_; static constexpr int ESZ = 1;
    int nu, G, c; const LAS int* pst  ; const int* LIST;
    __device__ bool next(int i, Unit& u) const {
        const int L = i * G + c; if (L >= nu) return false;
        const int x = L & 7, off = L >> 3, per = nu >> 3, r = nu & 7;
        const int wg = (x < r ? x * (per + 1) : r * (per + 1) + (x - r) * per) + off;
        u.pm = wg >> 2; u.pn = wg & 3;
        const int row = u.pm * BM; const int e = pst[128 + u.pm];
        u.e = e; u.r0 = row - pst[e]; u.cnt = pst[64 + e]; return true;
    }
    __device__ __forceinline__ int assignment(const Unit& u, int r) const { const int rank = u.r0 + r; const bool ok = rank < u.cnt; const int a = LIST[(size_t)u.e * T + (ok ? rank : 0)]; return ok ? a : -1; }
    __device__ __forceinline__ void a_offsets(const Unit& u, int tid, int lda, unsigned (&o0)[2], unsigned (&o1)[2]) const {
#pragma unroll
        for (int i = 0; i < 2; ++i) { int R, C; stage_rc(tid * 16 + i * 8192, R, C);
            const int a0 = assignment(u, R), a1 = assignment(u, HALF + R);
            o0[i] = (unsigned)((a0 < 0 ? 0 : a0 >> 1) * lda * ESZ + C * 2); o1[i] = (unsigned)((a1 < 0 ? 0 : a1 >> 1) * lda * ESZ + C * 2); }
    }
};
struct EpiMoe1 {
    static constexpr bool PERM = true, CHAIN = false;
    unsigned char* HDN; const float* RSTD; MoeOrder<true> S;
    __device__ __forceinline__ void operator()(const f32x4 (&acc)[2][2][4][2], const Unit& u, int wr, int wc, int fr, int fq) const {
        const int r0 = wr * 64 + fr, col0 = u.pn * HALF + wc * 32 + 8 * fq;
        int av[8]; float rsv[8];
#pragma unroll
        for (int i = 0; i < 8; ++i) av[i] = S.assignment(u, r0 + (i >> 2) * HALF + (i & 3) * 16);
#pragma unroll
        for (int i = 0; i < 8; ++i) rsv[i] = RSTD[av[i] < 0 ? 0 : av[i] >> 1];
#pragma unroll
        for (int ai = 0; ai < 2; ++ai)
#pragma unroll
            for (int m = 0; m < 4; ++m) {
                const int r = r0 + ai * HALF + m * 16;
                const float rs = av[ai * 4 + m] < 0 ? 0.f : rsv[ai * 4 + m];
                f32x4 h0, h1;
#pragma unroll
                for (int e = 0; e < 4; ++e) { const float g0 = rs * acc[ai][0][m][0][e], g1 = rs * acc[ai][0][m][1][e];
                    h0[e] = g0 * __builtin_amdgcn_rcpf(1.f + __expf(-g0)) * (rs * acc[ai][1][m][0][e]); h1[e] = g1 * __builtin_amdgcn_rcpf(1.f + __expf(-g1)) * (rs * acc[ai][1][m][1][e]); }
                u32x2 w; w.x = cvt4_fp8(8.f * h0[0], 8.f * h0[1], 8.f * h0[2], 8.f * h0[3]); w.y = cvt4_fp8(8.f * h1[0], 8.f * h1[1], 8.f * h1[2], 8.f * h1[3]);
                *(u32x2*)(HDN + (size_t)(u.pm * BM + r) * D_EXP + col0) = w;
            }
    }
};
struct EpiMoe2 {
    static constexpr bool PERM = true, CHAIN = false;
    unsigned char* YB; const float* RW; MoeOrder<false> S;
    __device__ __forceinline__ void operator()(const f32x4 (&acc)[2][2][4][2], const Unit& u, int wr, int wc, int fr, int fq) const {
        const int r0 = wr * 64 + fr, col0 = u.pn * BM + wc * 32 + 8 * fq;
        int av[8]; float wv[8];
#pragma unroll
        for (int i = 0; i < 8; ++i) av[i] = S.assignment(u, r0 + (i >> 2) * HALF + (i & 3) * 16);
#pragma unroll
        for (int i = 0; i < 8; ++i) wv[i] = RW[av[i] < 0 ? 0 : av[i]];
#pragma unroll
        for (int ai = 0; ai < 2; ++ai)
#pragma unroll
            for (int m = 0; m < 4; ++m) {
                const int a = av[ai * 4 + m];
                const int as = a < 0 ? 0 : a;
                const float w_ = 16.f * wv[ai * 4 + m];
                u32x2 w0, w1;
                { const f32x4 v0 = acc[ai][0][m][0] * w_, v1 = acc[ai][0][m][1] * w_; w0.x = cvt4_fp8(v0[0], v0[1], v0[2], v0[3]); w0.y = cvt4_fp8(v1[0], v1[1], v1[2], v1[3]); }
                { const f32x4 v0 = acc[ai][1][m][0] * w_, v1 = acc[ai][1][m][1] * w_; w1.x = cvt4_fp8(v0[0], v0[1], v0[2], v0[3]); w1.y = cvt4_fp8(v1[0], v1[1], v1[2], v1[3]); }
                unsigned char* rowp = YB + (size_t)as * DM + col0;
                if (a >= 0) { *(u32x2*)rowp = w0; *(u32x2*)(rowp + HALF) = w1; }
                asm volatile("" ::: "memory");
            }
    }
};
}


namespace rtr {
__device__ __forceinline__ void task(int t0, const bf16_t* __restrict__ X2B, const bf16_t* __restrict__ WTR, const float* __restrict__ SS2, const float* __restrict__ bg, const float* __restrict__ be,
                                     float* __restrict__ RW, float* __restrict__ RSTD2, int* __restrict__ cnt, int* __restrict__ LIST, LAS float* lg  , const LAS unsigned char* wr, LAS int* hist  , int lane) {
    int ex0_ = 0, ex1_ = 0, lr0_ = 0, lr1_ = 0;
    const int fr = lane & 15, kq = lane >> 4;
    f32x4 acc[3];
#pragma unroll
    for (int n = 0; n < 3; ++n) acc[n] = (f32x4){0.f, 0.f, 0.f, 0.f};
    const LAS unsigned char* bp0 = wr + fr * 2064 + 16 * kq, *bp1 = wr + (16 + fr) * 2064 + 16 * kq, *bp2 = wr + (32 + (fr & 3)) * 2064 + 16 * kq;
    const bool n2ok = fr < 4;
    LAS unsigned char* xs = (LAS unsigned char*)lg;
#pragma unroll 1
    for (int q = 0; q < 4; ++q) {
#pragma unroll
        for (int i = 0; i < 8; ++i) {
            const int r = 2 * i + (lane >> 5);
            const pg8::u32x4 v = *(const pg8::u32x4*)(X2B + (size_t)(t0 + r) * DM + q * 256 + (lane & 31) * 8);
            *(LAS pg8::u32x4*)(xs + r * 528 + (lane & 31) * 16) = v; }
        asm volatile("s_waitcnt vmcnt(0) lgkmcnt(0)" ::: "memory");
#pragma unroll
        for (int ks = 0; ks < 8; ++ks) {
            const bf16x8 a = *(const LAS bf16x8*)(xs + fr * 528 + ks * 64 + kq * 16);
            const int ko = q * 512 + ks * 64;
            const bf16x8 b0 = *(const LAS bf16x8*)(bp0 + ko), b1 = *(const LAS bf16x8*)(bp1 + ko); bf16x8 b2 = *(const LAS bf16x8*)(bp2 + ko);
            if (!n2ok) b2 = (bf16x8){0, 0, 0, 0, 0, 0, 0, 0};
            acc[0] = __builtin_amdgcn_mfma_f32_16x16x32_bf16(a, b0, acc[0], 0, 0, 0); acc[1] = __builtin_amdgcn_mfma_f32_16x16x32_bf16(a, b1, acc[1], 0, 0, 0); acc[2] = __builtin_amdgcn_mfma_f32_16x16x32_bf16(a, b2, acc[2], 0, 0, 0);
        }
        asm volatile("s_waitcnt lgkmcnt(0)" ::: "memory");
    }
#pragma unroll
    for (int n = 0; n < 3; ++n)
#pragma unroll
        for (int r = 0; r < 4; ++r) lg[(4 * kq + r) * 52 + 16 * n + fr] = acc[n][r];
    asm volatile("s_waitcnt lgkmcnt(0)" ::: "memory");
    if (lane < 16) {
        const int t = t0 + lane;
        const float rs = pg8::rstd16(SS2 + (size_t)t * 16, 1.f / DM);
        float v[36];
#pragma unroll
        for (int q = 0; q < 9; ++q) { const f32x4 x4 = *(const LAS f32x4*)(lg + lane * 52 + 4 * q); v[4 * q] = x4[0] * rs; v[4 * q + 1] = x4[1] * rs; v[4 * q + 2] = x4[2] * rs; v[4 * q + 3] = x4[3] * rs; }
        int gi = 0; float gmax = v[0] + bg[0]; float gl[4];
#pragma unroll
        for (int j = 0; j < 4; ++j) gl[j] = v[j] + bg[j];
#pragma unroll
        for (int j = 1; j < 4; ++j) if (gl[j] > gmax) { gmax = gl[j]; gi = j; }
        float gs = 0.f;
#pragma unroll
        for (int j = 0; j < 4; ++j) gs += __expf(gl[j] - gmax);
        const float gw = 1.f / gs;
        float el[8];
#pragma unroll
        for (int j = 0; j < 8; ++j) { float x = 0.f;
#pragma unroll
            for (int g = 0; g < 4; ++g) if (g == gi) x = v[4 + g * 8 + j] + be[g * 8 + j];
            el[j] = x; }
        int i0 = 0; float v0 = el[0];
#pragma unroll
        for (int j = 1; j < 8; ++j) if (el[j] > v0) { v0 = el[j]; i0 = j; }
        int i1 = -1; float v1 = -INFINITY;
#pragma unroll
        for (int j = 0; j < 8; ++j) if (j != i0 && el[j] > v1) { v1 = el[j]; i1 = j; }
        const float e1 = __expf(v1 - v0);
        const float p0 = 1.f / (1.f + e1), p1 = e1 / (1.f + e1);
        const int ex0 = gi * 8 + i0, ex1 = gi * 8 + i1;
        RW[t * 2 + 0] = gw * p0; RW[t * 2 + 1] = gw * p1; RSTD2[t] = rs;
        ex0_ = ex0; ex1_ = ex1;
        lr0_ = __hip_atomic_fetch_add((int*)hist + ex0, 1, __ATOMIC_RELAXED, __HIP_MEMORY_SCOPE_WORKGROUP); lr1_ = __hip_atomic_fetch_add((int*)hist + ex1, 1, __ATOMIC_RELAXED, __HIP_MEMORY_SCOPE_WORKGROUP);
    }
    asm volatile("s_waitcnt lgkmcnt(0)" ::: "memory");
    __syncthreads();
    if (threadIdx.x < N_EXP) { const int c_ = hist[threadIdx.x]; hist[32 + threadIdx.x] = c_ ? atomicAdd(&cnt[threadIdx.x], c_) : 0; }
    __syncthreads();
    if (lane < 16) { const int t = t0 + lane;
        LIST[(size_t)ex0_ * T + hist[32 + ex0_] + lr0_] = 2 * t; LIST[(size_t)ex1_ * T + hist[32 + ex1_] + lr1_] = 2 * t + 1; }
}
}

template <int ROWMAP>
__device__ __forceinline__ int wt_rowmap(int n) {
    if (ROWMAP == 1) {
        if (n >= 1024 && n < 2048) { const int sec = (n - 1024) >> 9, cc = (n - 1024) & 511, h = cc >> 6, d = cc & 63;
            return 1024 + sec * 512 + (h >> 2) * 256 + 128 * (d >> 5) + 32 * (h & 3) + (d & 31); }
    }
    if (ROWMAP == 2) return 256 * (n >> 7) + (n & 127);
    if (ROWMAP == 3) return 256 * (n >> 7) + 128 + (n & 127);
    return n;
}
template <int ROWMAP, bool GAIN>
__device__ __forceinline__ void p0_transpose_item(const float* __restrict__ W, int ldw, int K, int N, bf16_t* __restrict__ WT, LAS unsigned* scr  , int item, int lane,
                                                  const float* __restrict__ g0, const float* __restrict__ g1, int ksplit) {
    const int nblk = N / 64, kb = item / nblk, nb = item % nblk, k0 = 128 * kb, n0 = 64 * nb;
    const int kp = lane >> 4, nq = lane & 15;
    const float* wp = W + (size_t)(k0 + 2 * kp) * ldw + n0 + 4 * nq;
#pragma unroll 8
    for (int it = 0; it < 16; ++it) {
        f32x4 a = *(const f32x4*)(wp + (size_t)(8 * it) * ldw), b = *(const f32x4*)(wp + (size_t)(8 * it + 1) * ldw);
        if (GAIN) { const int k = k0 + 8 * it + 2 * kp; const float* gp = (k0 < ksplit) ? g0 + k : g1 + (k - ksplit); a *= gp[0]; b *= gp[1]; }
        LAS unsigned* d = scr + (4 * nq) * 68 + 4 * it + kp;
        d[0] = pg8::cvt_pk_bf16(a[0], b[0]); d[68] = pg8::cvt_pk_bf16(a[1], b[1]); d[136] = pg8::cvt_pk_bf16(a[2], b[2]); d[204] = pg8::cvt_pk_bf16(a[3], b[3]);
    }
    asm volatile("s_waitcnt lgkmcnt(0)" ::: "memory");
#pragma unroll 4
    for (int j = 0; j < 16; ++j) { const int n = (lane >> 4) + 4 * j, c = lane & 15;
        const pg8::u32x4 o = *(const LAS pg8::u32x4*)(scr + n * 68 + 4 * c);
        *(pg8::u32x4*)(WT + (size_t)wt_rowmap<ROWMAP>(n0 + n) * K + k0 + 8 * c) = o; }
    asm volatile("s_waitcnt lgkmcnt(0)" ::: "memory");
}


template <int ROWMAP, bool GAIN>
__device__ __forceinline__ void p0_transpose_item_q(const float* __restrict__ W, int ldw, int K, int N, unsigned char* __restrict__ WQ, LAS unsigned char* scr, int item, int lane, const float* __restrict__ g0) {
    const int nblk = N / 64, kb = item / nblk, nb = item % nblk, k0 = 128 * kb, n0 = 64 * nb;
    const int kp = lane >> 4, nq = lane & 15;
    const float* wp = W + (size_t)(k0 + 2 * kp) * ldw + n0 + 4 * nq;
#pragma unroll 8
    for (int it = 0; it < 16; ++it) {
        f32x4 a = *(const f32x4*)(wp + (size_t)(8 * it) * ldw), b = *(const f32x4*)(wp + (size_t)(8 * it + 1) * ldw);
        float ga = 32.f, gb = 32.f;
        if (GAIN) { const int k = k0 + 8 * it + 2 * kp; ga *= g0[k]; gb *= g0[k + 1]; }
        LAS unsigned char* d = scr + (4 * nq) * 144 + 8 * it + 2 * kp;
#pragma unroll
        for (int e = 0; e < 4; ++e) *(LAS unsigned short*)(d + e * 144) = (unsigned short)__builtin_amdgcn_cvt_pk_fp8_f32(__builtin_amdgcn_fmed3f(a[e] * ga, -448.f, 448.f), __builtin_amdgcn_fmed3f(b[e] * gb, -448.f, 448.f), 0, false);
    }
    asm volatile("s_waitcnt lgkmcnt(0)" ::: "memory");
#pragma unroll 4
    for (int j = 0; j < 8; ++j) { const int n = (lane >> 3) + 8 * j, c = lane & 7;
        const pg8::u32x4 o = *(const LAS pg8::u32x4*)(scr + n * 144 + 16 * c);
        *(pg8::u32x4*)(WQ + (size_t)wt_rowmap<ROWMAP>(n0 + n) * K + k0 + 16 * c) = o; }
    asm volatile("s_waitcnt lgkmcnt(0)" ::: "memory");
}

namespace fox {
using bf16 = unsigned short;
using s16x4 = __attribute__((ext_vector_type(4))) short;
using u32x4 = __attribute__((ext_vector_type(4))) unsigned;
constexpr int NHEAD = FOX_H, D = 64, DMP = 512;
constexpr int NW = 8, QBLK = 32, QB = QBLK * NW, KVBLK = 64, NQB = SEQ / QB;
#define SBAR() __builtin_amdgcn_sched_barrier(0)
__device__ __forceinline__ void cmask(f32x16& p0, f32x16& p1, int jb, int qrel, int hi) {
  const float NEG = -INFINITY; int kb = 64 * jb + 4 * hi;
  #pragma unroll
  for (int r = 0; r < 16; ++r) { int kv = kb + (r & 3) + 8 * (r >> 2); if (kv > qrel) p0[r] = NEG; if (kv + 32 > qrel) p1[r] = NEG; }
}
constexpr int NSLOT = 3, SLOTB = 8192;
constexpr int LDS_K = 0, LDS_V = NSLOT * SLOTB, LDS_WS = 2 * NSLOT * SLOTB, LDS_OST = LDS_WS + NW * 64 * 4, LDS_BIAS = LDS_OST + NW * 4096, LDS_BYTES = LDS_BIAS + (SEQ + 64) * 4;
__device__ __forceinline__ void glds16(const void* gsrc, unsigned lds_dst) { unsigned keep;
  asm volatile("s_mov_b32 %0, m0\n\ts_mov_b32 m0, %2\n\ts_nop 0\n\tglobal_load_lds_dwordx4 %1, off\n\ts_mov_b32 m0, %0" : "=&s"(keep) : "v"(gsrc), "s"(lds_dst) : "memory"); }
__device__ __forceinline__ float max3f(float a, float b, float c) { float r; asm("v_max3_f32 %0, %1, %2, %3" : "=v"(r) : "v"(a), "v"(b), "v"(c)); return r; }
__device__ __forceinline__ float max2f(float a, float b) { float r; asm("v_max_f32_e32 %0, %1, %2" : "=v"(r) : "v"(a), "v"(b)); return r; }
__device__ __forceinline__ float fadd_s(float a, float b) { float r; asm("v_add_f32_e32 %0, %1, %2" : "=v"(r) : "v"(a), "v"(b)); return r; }
__device__ __forceinline__ float fsub_s(float a, float b) { float r; asm("v_sub_f32_e32 %0, %1, %2" : "=v"(r) : "v"(a), "v"(b)); return r; }
typedef float f32x2_t __attribute__((ext_vector_type(2))); typedef __bf16 bf16x2_t __attribute__((ext_vector_type(2)));
__device__ __forceinline__ unsigned cvtpk_s(float lo, float hi) { f32x2_t v = {lo, hi}; bf16x2_t b = __builtin_convertvector(v, bf16x2_t); return __builtin_bit_cast(unsigned, b); }
#define WAIT_BAR(N) asm volatile("s_waitcnt vmcnt(" #N ") lgkmcnt(0)\n\ts_barrier" ::: "memory")
typedef __attribute__((address_space(3))) const char* lds_cptr;
typedef short v4i16_t __attribute__((ext_vector_type(4)));
__device__ __forceinline__ void qkt(f32x16& p0, f32x16& p1, const char* Kslot, const bf16x8* qr, int r32, int hi) {
  const char* kb = Kslot + hi * 1024 + r32 * 16;
  #pragma unroll
  for (int d0 = 0; d0 < 4; ++d0) {
    const bf16x8 b0 = *reinterpret_cast<const bf16x8*>(kb + d0 * 2048);
    const bf16x8 b1 = *reinterpret_cast<const bf16x8*>(kb + d0 * 2048 + 512);
    p0 = __builtin_amdgcn_mfma_f32_32x32x16_bf16(b0, qr[d0], p0, 0, 0, 0); p1 = __builtin_amdgcn_mfma_f32_32x32x16_bf16(b1, qr[d0], p1, 0, 0, 0); }
}
__device__ __forceinline__ void kload8(bf16x8* kf, lds_cptr kp) {
  kf[0] = *(const LAS bf16x8*)(kp);        kf[1] = *(const LAS bf16x8*)(kp + 512);
  kf[2] = *(const LAS bf16x8*)(kp + 2048); kf[3] = *(const LAS bf16x8*)(kp + 2560);
  kf[4] = *(const LAS bf16x8*)(kp + 4096); kf[5] = *(const LAS bf16x8*)(kp + 4608);
  kf[6] = *(const LAS bf16x8*)(kp + 6144); kf[7] = *(const LAS bf16x8*)(kp + 6656);
}
__device__ __forceinline__ void kload2(bf16x8* kf, lds_cptr kp, int j) { kf[2 * j] = *(const LAS bf16x8*)(kp + j * 2048); kf[2 * j + 1] = *(const LAS bf16x8*)(kp + j * 2048 + 512); }
__device__ __forceinline__ s16x4 vtr(lds_cptr p) { return __builtin_bit_cast(s16x4, __builtin_amdgcn_ds_read_tr16_b64_v4i16((LAS v4i16_t*)p)); }
__device__ __forceinline__ float rowmax(const f32x16& p0, const f32x16& p1) {
  float a = max3f(p0[0], p0[1], p1[0]), b = max3f(p0[2], p0[3], p1[1]); a = max3f(a, p1[2], p1[3]);
  #pragma unroll
  for (int r = 4; r < 16; r += 4) { a = max3f(a, p0[r], p0[r + 1]); b = max3f(b, p0[r + 2], p0[r + 3]); a = max3f(a, p1[r], p1[r + 1]); b = max3f(b, p1[r + 2], p1[r + 3]); }
  const float m = max2f(a, b);
  auto rr = __builtin_amdgcn_permlane32_swap(__float_as_uint(m), __float_as_uint(m), false, false);
  return max2f(__uint_as_float(rr[0]), __uint_as_float(rr[1]));
}
__device__ __forceinline__ void pv(f32x16* o, int vb, bf16x8 pa0, bf16x8 pa1, bf16x8 pa2, bf16x8 pa3) {
  #pragma unroll
  for (int d0 = 0; d0 < 2; ++d0) { s16x4 lo[4], hi[4];
    #pragma unroll
    for (int ks = 0; ks < 4; ++ks) {
      asm volatile("ds_read_b64_tr_b16 %0,%1 offset:%c2" : "=&v"(lo[ks]) : "v"(vb), "i"(d0 * 4096 + ks * 1024) : "memory");
      asm volatile("ds_read_b64_tr_b16 %0,%1 offset:%c2" : "=&v"(hi[ks]) : "v"(vb), "i"(d0 * 4096 + ks * 1024 + 512) : "memory"); }
    asm volatile("s_waitcnt lgkmcnt(0)" ::: "memory"); SBAR();
    #define PK(k) (bf16x8){lo[k][0], lo[k][1], lo[k][2], lo[k][3], hi[k][0], hi[k][1], hi[k][2], hi[k][3]}
    o[d0] = __builtin_amdgcn_mfma_f32_32x32x16_bf16(pa0, PK(0), o[d0], 0, 0, 0);
    o[d0] = __builtin_amdgcn_mfma_f32_32x32x16_bf16(pa1, PK(1), o[d0], 0, 0, 0);
    o[d0] = __builtin_amdgcn_mfma_f32_32x32x16_bf16(pa2, PK(2), o[d0], 0, 0, 0);
    o[d0] = __builtin_amdgcn_mfma_f32_32x32x16_bf16(pa3, PK(3), o[d0], 0, 0, 0);
    #undef PK
  }
}
#define BLD(X0, X1, bp) do { _Pragma("unroll") for (int g_ = 0; g_ < 4; ++g_) { const f32x4 b0_ = *(const LAS f32x4*)((bp) + 32 * g_), b1_ = *(const LAS f32x4*)((bp) + 128 + 32 * g_); \
    X0[4 * g_] = b0_[0]; X0[4 * g_ + 1] = b0_[1]; X0[4 * g_ + 2] = b0_[2]; X0[4 * g_ + 3] = b0_[3]; X1[4 * g_] = b1_[0]; X1[4 * g_ + 1] = b1_[1]; X1[4 * g_ + 2] = b1_[2]; X1[4 * g_ + 3] = b1_[3]; } } while (0)

template <int THRL> __device__ __forceinline__ void attn_unit(int b, int h, int qb, const bf16* Q, const bf16* __restrict__ K, const bf16* __restrict__ V, bf16* O, const float* __restrict__ CUM, float* __restrict__ SSF, char* shm) {
  int tid = threadIdx.x; asm volatile("" : "+v"(tid));
  const int lane = tid & 63, r32 = lane & 31, hi = lane >> 5; const int wid = __builtin_amdgcn_readfirstlane(tid >> 6);
  const long rowbase = (long)b * SEQ; const int q0 = qb * QB;
  const bf16* Qw = Q + (rowbase + q0 + wid * QBLK) * DMP + h * D;
  const float* cbs = CUM + ((long)b * NHEAD + h) * SEQ;
  int t_start = 0;
  { const int ntile = (q0 + QB) / KVBLK; const float cq = cbs[q0]; const float ce = cbs[(lane < ntile ? lane : ntile - 1) * KVBLK + KVBLK - 1];
    const unsigned long long keep = __ballot(lane < ntile && (cq - ce >= -64.0f));
    t_start = keep ? (int)__builtin_ctzll(keep) : 0; t_start &= ~1; if (t_start > ntile - 4) t_start = ntile - 4;
    t_start = __builtin_amdgcn_readfirstlane(t_start); }
  const int skip_rows = t_start * KVBLK;
  const bf16 *Kh = K + (rowbase + skip_rows) * DMP + h * D, *Vh = V + (rowbase + skip_rows) * DMP + h * D;
  const unsigned lds0 = (unsigned)(uintptr_t)shm;
  float* wsf = (float*)(shm + LDS_WS) + wid * 64;
  const bf16* ksrc = Kh + (long)lane * DMP + wid * 8;
  const bf16* vsrc = Vh + (long)(16 * (wid & 3) + (lane >> 2)) * DMP + (wid >> 2) * 32 + (lane & 3) * 8;
  const unsigned kdst = lds0 + LDS_K + wid * 1024, vdst = lds0 + LDS_V + wid * 1024;
  #define DMA_K(t, slot) glds16(ksrc + (long)(t) * KVBLK * DMP, (unsigned)__builtin_amdgcn_readfirstlane(kdst + (slot)))
  #define DMA_V(t, slot) glds16(vsrc + (long)(t) * KVBLK * DMP, (unsigned)__builtin_amdgcn_readfirstlane(vdst + (slot)))
  const int vb0 = (int)(lds0 + LDS_V) + ((lane >> 4) & 1) * 32 + (lane & 3) * 8 + (4 * hi + ((lane & 15) >> 2)) * 64;
  const char* Kbase = shm + LDS_K; bf16x8 kf[8];
  const lds_cptr shm3 = (lds_cptr)shm; const lds_cptr kp0 = shm3 + LDS_K + hi * 1024 + r32 * 16; const lds_cptr vp0 = shm3 + LDS_V + ((lane >> 4) & 1) * 32 + (lane & 3) * 8 + (4 * hi + ((lane & 15) >> 2)) * 64;
  const lds_cptr bp0 = shm3 + LDS_BIAS + hi * 16;
  const int NT = (q0 + QB) / KVBLK - t_start;
  DMA_K(0, 0); DMA_V(0, 0); DMA_K(1, SLOTB);
  {
    const float* cb = cbs + skip_rows; const float cref = cbs[q0 + QB - 1]; const int nkeys = q0 + QB - skip_rows;
    LAS float* bl = (LAS float*)(shm3 + LDS_BIAS);
    float cv[SEQ / (NW * 64)];
    #pragma unroll
    for (int i = 0; i < SEQ / (NW * 64); ++i) { const int j = tid + i * NW * 64; cv[i] = cb[j < nkeys ? j : 0]; }
    #pragma unroll
    for (int i = 0; i < SEQ / (NW * 64); ++i) { const int j = tid + i * NW * 64; if (j < nkeys) bl[j] = cref - cv[i]; }
  }
  bf16x8 qr[4];
  #pragma unroll
  for (int d0 = 0; d0 < 4; ++d0) qr[d0] = *reinterpret_cast<const bf16x8*>(&Qw[(long)r32 * DMP + d0 * 16 + hi * 8]);
  float mhat = 0.f, l_reg = 0.f; f32x16 o[2]; o[0] = f32x16{}; o[1] = f32x16{};
  const int qrel = wid * QBLK + r32;
  #define CMASK(P0, P1, t) do { int jb_ = (t) - (NT - 4); if (jb_ >= 0) cmask(P0, P1, jb_, qrel, hi); } while (0)
  bool resc = false;
  #define START(P0, P1) do { const float rm = rowmax(P0, P1); resc = false; \
    { const float dl = rm; mhat = fadd_s(mhat, dl); \
      _Pragma("unroll") for (int r = 0; r < 16; ++r) { P0[r] = fsub_s(P0[r], dl); P1[r] = fsub_s(P1[r], dl); } } \
    _Pragma("unroll") for (int r = 0; r < 16; ++r) P0[r] = __builtin_amdgcn_exp2f(P0[r]); } while (0)
  #define RESC() do { if (resc) { asm volatile("s_waitcnt lgkmcnt(0)" ::: "memory"); \
      _Pragma("unroll") for (int d_ = 0; d_ < 2; ++d_) _Pragma("unroll") for (int r = 0; r < 16; ++r) o[d_][r] *= wsf[crow(r, hi)]; } } while (0)
  f32x16 pA0, pA1, pB0, pB1;
  int sl_prev = 0, sl_cur = 0, sl_next = SLOTB;
  #define ROT() do { sl_prev = sl_cur; sl_cur = sl_next; sl_next = (sl_next == (NSLOT - 1) * SLOTB) ? 0 : sl_next + SLOTB; } while (0)
  DMA_K(2, 2 * SLOTB);
  WAIT_BAR(3);
  BLD(pA0, pA1, bp0);
  qkt(pA0, pA1, Kbase, qr, r32, hi); asm volatile("s_nop 15\n\ts_nop 7" : "+v"(pA0), "+v"(pA1)); CMASK(pA0, pA1, 0);
  START(pA0, pA1);
  _Pragma("unroll") for (int r = 0; r < 16; ++r) pA1[r] = __builtin_amdgcn_exp2f(pA1[r]);
  BLD(pB0, pB1, bp0 + 256);
  _Pragma("unroll") for (int r = 0; r < 16; ++r) { pB0[r] = fsub_s(pB0[r], mhat); pB1[r] = fsub_s(pB1[r], mhat); }
  WAIT_BAR(0);
  DMA_K(3, 0); DMA_V(1, SLOTB);
  ROT();
  kload8(kf, kp0 + sl_cur);
  WAIT_BAR(2);
  s16x4 vlo[8], vhi[8]; u32x4 pw0, pw1, pw2, pw3;
  #define PKW(P, B) cvtpk_s(P[B], P[B + 1])
  #define PAF(k) __builtin_bit_cast(bf16x8, pw##k)
  #define VFR(i) (bf16x8){vlo[i][0], vlo[i][1], vlo[i][2], vlo[i][3], vhi[i][0], vhi[i][1], vhi[i][2], vhi[i][3]}
  #define PIN(x) asm volatile("" : "+v"(x))
  #define MX3(a, b, c) __builtin_fmaxf(__builtin_fmaxf((a), (b)), (c))
  #define GAPA(MF, A0, A1, A2, A3, W0, W1, PW) do { MF; sacc += A0; sacc += A1; sacc += A2; sacc += A3; PIN(sacc); W0; W1; PIN(PW); SBAR(); } while (0)
  #define EX(v) __builtin_amdgcn_exp2f(v)
  #define GAPB(MF, X, B, N, NB) do { MF; X[B] = EX(X[B]); X[B + 1] = EX(X[B + 1]); X[B + 2] = EX(X[B + 2]); X[B + 3] = EX(X[B + 3]); PIN(X); \
    N[NB] = fsub_s(N[NB], mhat); N[NB + 1] = fsub_s(N[NB + 1], mhat); N[NB + 2] = fsub_s(N[NB + 2], mhat); N[NB + 3] = fsub_s(N[NB + 3], mhat); PIN(N); SBAR(); } while (0)
  #define VRD(i) do { vlo[i] = vtr(vp_ + (((i) >> 2) * 4096 + ((i) & 3) * 1024)); vhi[i] = vtr(vp_ + (((i) >> 2) * 4096 + ((i) & 3) * 1024 + 512)); } while (0)
  #define KRD(G, j) do { if (G) { kload2(kf, kp0 + sl_next, j); SBAR(); } } while (0)
  #define STEP(C0, C1, P0, P1, t, GK, GV, GL) do { SBAR(); \
    const lds_cptr vp_ = vp0 + sl_prev; \
    VRD(0); SBAR(); float sacc = (P0[0] + P0[1]); \
    GAPA(C0 = __builtin_amdgcn_mfma_f32_32x32x16_bf16(kf[0], qr[0], C0, 0, 0, 0), P0[2], P0[3], P0[4], P0[5],     pw0[0] = PKW(P0, 0), pw0[1] = PKW(P0, 2), pw0); \
    VRD(4); SBAR(); GAPA(C1 = __builtin_amdgcn_mfma_f32_32x32x16_bf16(kf[1], qr[0], C1, 0, 0, 0), P0[6], P0[7], P0[8], P0[9],     pw0[2] = PKW(P0, 4), pw0[3] = PKW(P0, 6), pw0); \
    VRD(1); SBAR(); GAPA(C0 = __builtin_amdgcn_mfma_f32_32x32x16_bf16(kf[2], qr[1], C0, 0, 0, 0),   P0[10], P0[11], P0[12], P0[13], pw1[0] = PKW(P0, 8), pw1[1] = PKW(P0, 10), pw1); \
    VRD(5); SBAR(); GAPA(C1 = __builtin_amdgcn_mfma_f32_32x32x16_bf16(kf[3], qr[1], C1, 0, 0, 0),   P0[14], P0[15], P1[0], P1[1],   pw1[2] = PKW(P0, 12), pw1[3] = PKW(P0, 14), pw1); \
    VRD(2); SBAR(); GAPA(C0 = __builtin_amdgcn_mfma_f32_32x32x16_bf16(kf[4], qr[2], C0, 0, 0, 0),   P1[2], P1[3], P1[4], P1[5],     pw2[0] = PKW(P1, 0), pw2[1] = PKW(P1, 2), pw2); \
    VRD(6); SBAR(); GAPA(C1 = __builtin_amdgcn_mfma_f32_32x32x16_bf16(kf[5], qr[2], C1, 0, 0, 0),   P1[6], P1[7], P1[8], P1[9],     pw2[2] = PKW(P1, 4), pw2[3] = PKW(P1, 6), pw2); \
    VRD(3); SBAR(); GAPA(C0 = __builtin_amdgcn_mfma_f32_32x32x16_bf16(kf[6], qr[3], C0, 0, 0, 0),   P1[10], P1[11], P1[12], P1[13], pw3[0] = PKW(P1, 8), pw3[1] = PKW(P1, 10), pw3); \
    VRD(7); SBAR(); GAPA(C1 = __builtin_amdgcn_mfma_f32_32x32x16_bf16(kf[7], qr[3], C1, 0, 0, 0),   P1[14], P1[15], 0.f, 0.f,       pw3[2] = PKW(P1, 12), pw3[3] = PKW(P1, 14), pw3); \
    l_reg += sacc; \
    if (GK) { DMA_K((t) + 3, sl_cur); } if (GV) { DMA_V((t) + 1, sl_next); } \
    CMASK(C0, C1, t); \
    { float a = MX3(C0[0], C0[1], C1[0]), b = MX3(C0[2], C0[3], C1[1]); a = MX3(a, C1[2], C1[3]); \
      _Pragma("unroll") for (int r = 4; r < 16; r += 4) { a = MX3(a, C0[r], C0[r + 1]); b = MX3(b, C0[r + 2], C0[r + 3]); a = MX3(a, C1[r], C1[r + 1]); b = MX3(b, C1[r + 2], C1[r + 3]); } \
      float rm = __builtin_fmaxf(a, b); { auto rr = __builtin_amdgcn_permlane32_swap(__float_as_uint(rm), __float_as_uint(rm), false, false); rm = __builtin_fmaxf(__uint_as_float(rr[0]), __uint_as_float(rr[1])); } \
      resc = false; \
      if (__builtin_expect(__any(rm > (float)THRL), 0)) { const float dl = __builtin_fmaxf(rm, 0.f); mhat += dl; \
        _Pragma("unroll") for (int r = 0; r < 16; ++r) { C0[r] -= dl; C1[r] -= dl; } \
        const float f = __builtin_amdgcn_exp2f(-dl); l_reg *= f; if (hi == 0) wsf[r32] = f; resc = true; } } \
    SBAR(); \
    BLD(P0, P1, bp0 + ((t) + 1) * 256); SBAR(); \
    GAPB(o[0] = __builtin_amdgcn_mfma_f32_32x32x16_bf16(PAF(0), VFR(0), o[0], 0, 0, 0), C0, 0, P0, 0); \
    GAPB(o[1] = __builtin_amdgcn_mfma_f32_32x32x16_bf16(PAF(0), VFR(4), o[1], 0, 0, 0), C0, 4, P0, 4); \
    KRD(GL, 0); GAPB(o[0] = __builtin_amdgcn_mfma_f32_32x32x16_bf16(PAF(1), VFR(1), o[0], 0, 0, 0), C0, 8, P0, 8); \
    KRD(GL, 1); GAPB(o[1] = __builtin_amdgcn_mfma_f32_32x32x16_bf16(PAF(1), VFR(5), o[1], 0, 0, 0), C0, 12, P0, 12); \
    KRD(GL, 2); GAPB(o[0] = __builtin_amdgcn_mfma_f32_32x32x16_bf16(PAF(2), VFR(2), o[0], 0, 0, 0), C1, 0, P1, 0); \
    KRD(GL, 3); GAPB(o[1] = __builtin_amdgcn_mfma_f32_32x32x16_bf16(PAF(2), VFR(6), o[1], 0, 0, 0), C1, 4, P1, 4); \
    GAPB(o[0] = __builtin_amdgcn_mfma_f32_32x32x16_bf16(PAF(3), VFR(3), o[0], 0, 0, 0), C1, 8, P1, 8); \
    GAPB(o[1] = __builtin_amdgcn_mfma_f32_32x32x16_bf16(PAF(3), VFR(7), o[1], 0, 0, 0), C1, 12, P1, 12); \
    } while (0)
  int t = 1;
  #undef CMASK
  #define CMASK(P0, P1, t) do {} while (0)
  for (; t + 5 < NT; t += 2) {
    STEP(pB0, pB1, pA0, pA1, t, true, true, true);     WAIT_BAR(2); RESC(); ROT();
    STEP(pA0, pA1, pB0, pB1, t + 1, true, true, true);   WAIT_BAR(2); RESC(); ROT();
  }
  #undef CMASK
  #define CMASK(P0, P1, t) do { int jb_ = (t) - (NT - 4); if (jb_ >= 0) cmask(P0, P1, jb_, qrel, hi); } while (0)
  #define ENDW(tt) do { if ((tt) + 3 < NT) { WAIT_BAR(2); } else if ((tt) + 2 < NT) { WAIT_BAR(1); } else { WAIT_BAR(0); } } while (0)
  for (; t + 1 < NT; t += 2) {
    STEP(pB0, pB1, pA0, pA1, t, (t + 3 < NT), (t + 1 < NT), (t + 1 < NT));       ENDW(t);   RESC(); ROT();
    STEP(pA0, pA1, pB0, pB1, t + 1, (t + 4 < NT), (t + 2 < NT), (t + 2 < NT));     ENDW(t + 1); RESC(); ROT();
  }
  STEP(pB0, pB1, pA0, pA1, NT - 1, false, false, false); RESC();
  { float sacc = pB0[0] + pB0[1]; _Pragma("unroll") for (int r = 2; r < 16; ++r) sacc += pB0[r]; _Pragma("unroll") for (int r = 0; r < 16; ++r) sacc += pB1[r]; l_reg += sacc;
    pw0 = (u32x4){PKW(pB0, 0), PKW(pB0, 2), PKW(pB0, 4), PKW(pB0, 6)}; pw1 = (u32x4){PKW(pB0, 8), PKW(pB0, 10), PKW(pB0, 12), PKW(pB0, 14)}; pw2 = (u32x4){PKW(pB1, 0), PKW(pB1, 2), PKW(pB1, 4), PKW(pB1, 6)}; pw3 = (u32x4){PKW(pB1, 8), PKW(pB1, 10), PKW(pB1, 12), PKW(pB1, 14)};
    SBAR(); pv(o, vb0 + sl_cur, PAF(0), PAF(1), PAF(2), PAF(3)); }
  #undef PKW
  #undef PAF
  #undef VFR
  #undef PIN
  #undef MX3
  #undef GAPA
  #undef GAPB
  #undef EX
  #undef VRD
  #undef KRD
  #undef STEP
  #undef ENDW
  { auto rr = __builtin_amdgcn_permlane32_swap(__float_as_uint(l_reg), __float_as_uint(l_reg), false, false); l_reg = __uint_as_float(rr[0]) + __uint_as_float(rr[1]); }
  if (hi == 0) wsf[32 + r32] = l_reg; asm volatile("s_waitcnt lgkmcnt(0)" ::: "memory");
  float rli[16];
  #pragma unroll
  for (int r = 0; r < 16; ++r) rli[r] = __builtin_amdgcn_rcpf(wsf[32 + crow(r, hi)]);
  bf16* Ow = O + (rowbase + q0 + wid * QBLK) * DMP + h * D;
  { bf16* stg = (bf16*)(shm + LDS_OST) + wid * 2048;
    #pragma unroll
    for (int r = 0; r < 16; ++r) { const int orow = crow(r, hi);
      #pragma unroll
      for (int d0 = 0; d0 < 2; ++d0) stg[orow * 64 + d0 * 32 + r32] = f2bf(o[d0][r] * rli[r]); }
    asm volatile("s_waitcnt lgkmcnt(0)" ::: "memory");
    #pragma unroll
    for (int i = 0; i < 4; ++i) { const int row = i * 8 + (lane >> 3), ch = lane & 7; const u32x4 v = *(const u32x4*)(stg + row * 64 + ch * 8); *(u32x4*)(Ow + (long)row * DMP + ch * 8) = v;
      float ss = 0.f;
      #pragma unroll
      for (int j = 0; j < 4; ++j) { const float lo = __uint_as_float(v[j] << 16), hi_ = __uint_as_float(v[j] & 0xffff0000u); ss += lo * lo + hi_ * hi_; }
      ss += __shfl_xor(ss, 1); ss += __shfl_xor(ss, 2); ss += __shfl_xor(ss, 4);
      if (ch == 0) SSF[(rowbase + q0 + wid * QBLK + row) * 8 + h] = ss; } }
  asm volatile("s_waitcnt lgkmcnt(0)\n\ts_barrier" ::: "memory");
  #undef DMA_K
  #undef DMA_V
  #undef CMASK
  #undef START
  #undef RESC
  #undef ROT
}
template <int THRL> __device__ __forceinline__ void attn_phase(char* lds, const bf16* Q, const bf16* K, const bf16* V, bf16* O, const float* CUM, float* SSF, int* counter) {
  LAS int* slot = (LAS int*)((LAS char*)lds + LDS_BYTES);
  int nxt = 0;
  if (threadIdx.x == 0) nxt = atomicAdd(counter, 1);
  for (;;) {
    if (threadIdx.x == 0) *slot = nxt;
    __syncthreads();
    const int u = *slot;
    __syncthreads();
    if (u >= BATCH * NHEAD * NQB) break;
    if (threadIdx.x == 0) nxt = atomicAdd(counter, 1);
    const int qb = NQB - 1 - (u >> 6), bh = u & 63;
    attn_unit<THRL>(bh / NHEAD, bh % NHEAD, qb, Q, K, V, O, CUM, SSF, lds);
  }
}
#undef SBAR
#undef WAIT_BAR
#undef BLD
}


namespace lru {
constexpr int CL = 128, NCH = SEQ / CL;
constexpr int WLDS = 16384;
typedef unsigned u32x4 __attribute__((ext_vector_type(4)));
template <bool PASS2>
__device__ __forceinline__ void unit(int b, int chunk, const bf16_t* __restrict__ U, const bf16_t* __restrict__ GATE, const float* __restrict__ conv_w, const float* __restrict__ conv_b,
                                     const bf16_t* __restrict__ LRUW, const float* __restrict__ ba, const float* __restrict__ bx, const float* __restrict__ a_param,
                                     float* __restrict__ SUMA, float* __restrict__ SUMH, bf16_t* __restrict__ YL, float* __restrict__ SSL, LAS unsigned char* ldsw, int w, int lane) {
    const int cl = lane & 31, hi = lane >> 5;
    LAS float* cp = (LAS float*)ldsw;
    LAS bf16_t* stg = (LAS bf16_t*)(ldsw + 2048);
    for (int i = lane; i < 320; i += 64) { const int tap = i >> 6, c = i & 63; cp[i] = (tap < 4) ? conv_w[tap * 512 + 64 * w + c] : conv_b[64 * w + c]; }
    { const int c = 64 * w + lane; cp[320 + lane] = ba[c]; cp[384 + lane] = bx[c];
      const float ap = -a_param[c]; const float sp = (ap > 20.f) ? ap : log1pf(__expf(ap)); cp[448 + lane] = -8.f * sp * LOG2E; }
    const u32x4* wf = (const u32x4*)LRUW + (size_t)w * 16 * 64 + lane;
    bf16x8 Bi[2];
#pragma unroll
    for (int q = 0; q < 2; ++q)
#pragma unroll
        for (int j = 0; j < 8; ++j) Bi[q][j] = (16 * q + 8 * hi + j == cl) ? (short)0x3F80 : (short)0;
    float h[2], atot[2];
#pragma unroll
    for (int n = 0; n < 2; ++n) { h[n] = 0.f; atot[n] = 1.f; }
    if (PASS2) {
#pragma unroll 1
        for (int c0 = 0; c0 < chunk; c0 += 8) {
            float sa[8][2], sh[8][2];
#pragma unroll
            for (int j = 0; j < 8; ++j)
#pragma unroll
                for (int n = 0; n < 2; ++n) { const bool ok = (c0 + j < chunk); const size_t o = ((size_t)(b * NCH + (ok ? c0 + j : 0))) * 512 + 64 * w + 32 * n + cl;
                    const float av = SUMA[o], hv = SUMH[o]; sa[j][n] = ok ? av : 1.f; sh[j][n] = ok ? hv : 0.f; }
#pragma unroll
            for (int j = 0; j < 8; ++j)
#pragma unroll
                for (int n = 0; n < 2; ++n) h[n] = sa[j][n] * h[n] + sh[j][n];
        }
    }
    asm volatile("s_waitcnt lgkmcnt(0)" ::: "memory");
    const int t0 = b * SEQ + chunk * CL;
    LAS unsigned char* ub0 = ldsw + 6144;
    const int dri = lane >> 3, dch = lane & 7;
#define LRU_DMA_U(tb_, buf_) do { _Pragma("unroll") for (int i_ = 0; i_ < 5; ++i_) { const int ri_ = 8 * i_ + dri; int gr_ = (tb_) - 3 + ri_; gr_ = gr_ < 0 ? 0 : (gr_ > T - 1 ? T - 1 : gr_); \
        __builtin_amdgcn_global_load_lds((const unsigned*)((const char*)U + (unsigned)((gr_ * 512 + 64 * w + 8 * (dch ^ (ri_ & 7))) * 2)), (LAS unsigned*)(ub0 + (buf_) * 5120 + i_ * 1024), 16, 0, 0); } } while (0)
#define LRU_DMA_G(tb_) do { _Pragma("unroll") for (int i_ = 0; i_ < 4; ++i_) \
        __builtin_amdgcn_global_load_lds((const unsigned*)((const char*)GATE + (unsigned)((((tb_) + 8 * i_ + dri) * 512 + 64 * w + 8 * dch) * 2)), (LAS unsigned*)(ldsw + 2048 + i_ * 1024), 16, 0, 0); } while (0)
    LRU_DMA_U(t0, 0);
#pragma unroll 1
    for (int mt = 0; mt < CL / 32; ++mt) {
        int tb = t0 + mt * 32; asm volatile("" : "+s"(tb));
        const int srow = chunk * CL + mt * 32 + cl;
        asm volatile("s_waitcnt vmcnt(0)" ::: "memory");
        if (mt + 1 < CL / 32) LRU_DMA_U(tb + 32, (mt + 1) & 1);
        if (PASS2) LRU_DMA_G(tb);
        const LAS unsigned char* ub = ub0 + (mt & 1) * 5120;
        bf16x8 af[4];
#pragma unroll
        for (int s_ = 0; s_ < 4; ++s_) {
            const int cc = 16 * s_ + 8 * hi;
            float xv[8];
            { const f32x4 b0 = *(const LAS f32x4*)(cp + 256 + cc), b1 = *(const LAS f32x4*)(cp + 256 + cc + 4);
              xv[0] = b0[0]; xv[1] = b0[1]; xv[2] = b0[2]; xv[3] = b0[3]; xv[4] = b1[0]; xv[5] = b1[1]; xv[6] = b1[2]; xv[7] = b1[3]; }
#pragma unroll
            for (int tap = 0; tap < 4; ++tap) {
                const bool inseq = (srow - 3 + tap >= 0);
                const int ri = cl + tap;
                u32x4 uu = *(const LAS u32x4*)(ub + ri * 128 + (((2 * s_ + hi) ^ (ri & 7)) << 4));
                if (!inseq) uu = (u32x4){0u, 0u, 0u, 0u};
                const f32x4 w0 = *(const LAS f32x4*)(cp + tap * 64 + cc), w1 = *(const LAS f32x4*)(cp + tap * 64 + cc + 4);
                xv[0] += w0[0] * __uint_as_float(uu[0] << 16); xv[1] += w0[1] * __uint_as_float(uu[0] & 0xffff0000u);
                xv[2] += w0[2] * __uint_as_float(uu[1] << 16); xv[3] += w0[3] * __uint_as_float(uu[1] & 0xffff0000u);
                xv[4] += w1[0] * __uint_as_float(uu[2] << 16); xv[5] += w1[1] * __uint_as_float(uu[2] & 0xffff0000u);
                xv[6] += w1[2] * __uint_as_float(uu[3] << 16); xv[7] += w1[3] * __uint_as_float(uu[3] & 0xffff0000u);
            }
            u32x4 pk; pk[0] = pg8::cvt_pk_bf16(xv[0], xv[1]); pk[1] = pg8::cvt_pk_bf16(xv[2], xv[3]); pk[2] = pg8::cvt_pk_bf16(xv[4], xv[5]); pk[3] = pg8::cvt_pk_bf16(xv[6], xv[7]);
            af[s_] = __builtin_bit_cast(bf16x8, pk);
            asm volatile("" ::: "memory"); __builtin_amdgcn_sched_barrier(0);
        }
#pragma unroll
        for (int n = 0; n < 2; ++n) {
            f32x16 rCn, iCn, xCn;
#pragma unroll
            for (int r = 0; r < 16; ++r) { rCn[r] = cp[320 + 32 * n + cl]; iCn[r] = cp[384 + 32 * n + cl]; xCn[r] = 0.f; }
            const float c1n = cp[448 + 32 * n + cl];
#pragma unroll
            for (int s_ = 0; s_ < 4; ++s_) {
                const bf16x8 fa = __builtin_bit_cast(bf16x8, wf[(n * 4 + s_) * 64]), fx = __builtin_bit_cast(bf16x8, wf[(8 + n * 4 + s_) * 64]);
                rCn = __builtin_amdgcn_mfma_f32_32x32x16_bf16(af[s_], fa, rCn, 0, 0, 0);
                iCn = __builtin_amdgcn_mfma_f32_32x32x16_bf16(af[s_], fx, iCn, 0, 0, 0);
                if ((s_ >> 1) == n) xCn = __builtin_amdgcn_mfma_f32_32x32x16_bf16(af[s_], Bi[s_ & 1], xCn, 0, 0, 0);
            }
#pragma unroll
            for (int r = 0; r < 16; ++r) {
                const float rr = __builtin_amdgcn_rcpf(1.f + __builtin_amdgcn_exp2f(-LOG2E * rCn[r]));
                const float ii = __builtin_amdgcn_rcpf(1.f + __builtin_amdgcn_exp2f(-LOG2E * iCn[r]));
                const float a = __builtin_amdgcn_exp2f(c1n * rr);
                const float mult = __builtin_amdgcn_sqrtf(fmaxf(1.f - a * a, 0.f));
                rCn[r] = a; iCn[r] = mult * (ii * xCn[r]);
                if ((r & 3) == 3) __builtin_amdgcn_sched_barrier(0);
            }
            float Ao[4], Bo[4], Ap[4], Bp[4];
#pragma unroll
            for (int g = 0; g < 4; ++g) { float A = rCn[4 * g], B = iCn[4 * g];
#pragma unroll
                for (int k = 1; k < 4; ++k) { B = rCn[4 * g + k] * B + iCn[4 * g + k]; A *= rCn[4 * g + k]; }
                Ao[g] = A; Bo[g] = B; Ap[g] = __shfl_xor(A, 32); Bp[g] = __shfl_xor(B, 32); }
            float hh = h[n], at = atot[n];
#pragma unroll
            for (int g = 0; g < 4; ++g) {
                const float A1 = hi ? Ap[g] : Ao[g], B1 = hi ? Bp[g] : Bo[g], A2 = hi ? Ao[g] : Ap[g], B2 = hi ? Bo[g] : Bp[g];
                const float h1 = A1 * hh + B1, h2 = A2 * h1 + B2;
                float hr = hi ? h1 : hh;
                at *= A1 * A2; hh = h2;
                if (PASS2) {
#pragma unroll
                    for (int k = 0; k < 4; ++k) { hr = rCn[4 * g + k] * hr + iCn[4 * g + k]; iCn[4 * g + k] = hr; }
                }
            }
            h[n] = hh; atot[n] = at;
            if (PASS2) {
                if (n == 0) asm volatile("s_waitcnt vmcnt(0)" ::: "memory");
#pragma unroll
                for (int r = 0; r < 16; ++r) {
                    const int tok = crow(r, hi);
                    const float gx = bf2f(stg[tok * 64 + 32 * n + cl]);
                    const float uq = 0.7978845608028654f * (gx + 0.044715f * gx * gx * gx);
                    const float th = 1.f - 2.f * __builtin_amdgcn_rcpf(1.f + __builtin_amdgcn_exp2f(2.f * LOG2E * uq));
                    stg[tok * 64 + 32 * n + cl] = f2bf(iCn[r] * (0.5f * gx * (1.f + th)));
                    if ((r & 3) == 3) __builtin_amdgcn_sched_barrier(0);
                }
            }
        }
        if (PASS2) {
            asm volatile("s_waitcnt lgkmcnt(0)" ::: "memory");
#pragma unroll
            for (int i = 0; i < 4; ++i) { const int row = i * 8 + (lane >> 3), ch = lane & 7; const u32x4 v = *(const LAS u32x4*)(stg + row * 64 + ch * 8);
                *(u32x4*)((char*)YL + (unsigned)(((tb + row) * 512 + 64 * w + ch * 8) * 2)) = v;
                float ss = 0.f;
#pragma unroll
                for (int j = 0; j < 4; ++j) { const float lo = __uint_as_float(v[j] << 16), hi_ = __uint_as_float(v[j] & 0xffff0000u); ss += lo * lo + hi_ * hi_; }
                ss += __shfl_xor(ss, 1); ss += __shfl_xor(ss, 2); ss += __shfl_xor(ss, 4);
                if (ch == 0) SSL[(size_t)(tb + row) * 8 + w] = ss; }
            asm volatile("s_waitcnt lgkmcnt(0)" ::: "memory");
        }
    }
    if (!PASS2) {
        if (hi == 0) {
#pragma unroll
            for (int n = 0; n < 2; ++n) { const size_t o = ((size_t)(b * NCH + chunk)) * 512 + 64 * w + 32 * n + cl; SUMA[o] = atot[n]; SUMH[o] = h[n]; }
        }
    }
}
#undef LRU_DMA_U
#undef LRU_DMA_G
}


namespace xat {
constexpr int KS_BYTES = MEM_LEN * 256, VT_STRIDE = 520, VT_BYTES = MEM_D * VT_STRIDE, LDS_NEED = KS_BYTES + VT_BYTES;
typedef unsigned u32x4 __attribute__((ext_vector_type(4)));
typedef unsigned u32x2 __attribute__((ext_vector_type(2)));
__device__ __forceinline__ void item(int b, int h, int qhalf  , const bf16_t* __restrict__ QM, const bf16_t* __restrict__ KM, const bf16_t* __restrict__ VM, bf16_t* __restrict__ OM,
                                     const float* __restrict__ q_g, const float* __restrict__ k_g, LAS unsigned char* lds) {
    int tid = threadIdx.x; asm volatile("" : "+v"(tid));
    const int lane = tid & 63, wid = __builtin_amdgcn_readfirstlane(tid >> 6), r32 = lane & 31, hi = lane >> 5;
    LAS unsigned char* Ks = lds; LAS unsigned char* VT = lds + KS_BYTES;
    {
        const int ch = tid & 15, k0 = tid >> 4;
        const f32x4 g0 = *(const f32x4*)(k_g + 8 * ch), g1 = *(const f32x4*)(k_g + 8 * ch + 4);
#pragma unroll 2
        for (int p = 0; p < 8; ++p) {
            const int key = p * 32 + k0;
            const size_t goff = ((size_t)(b * MEM_LEN + key)) * 512 + h * MEM_D + 8 * ch;
            const u32x4 kk = *(const u32x4*)(KM + goff), vv = *(const u32x4*)(VM + goff);
            float f[8];
#pragma unroll
            for (int j = 0; j < 4; ++j) { f[2 * j] = __uint_as_float(kk[j] << 16); f[2 * j + 1] = __uint_as_float(kk[j] & 0xffff0000u); }
            float ss = 0.f;
#pragma unroll
            for (int j = 0; j < 8; ++j) ss += f[j] * f[j];
            ss += __shfl_xor(ss, 1); ss += __shfl_xor(ss, 2); ss += __shfl_xor(ss, 4); ss += __shfl_xor(ss, 8);
            const float rs = rsqrtf(ss * (1.f / MEM_D) + EPS);
            u32x4 o; o[0] = pg8::cvt_pk_bf16(f[0] * rs * g0[0], f[1] * rs * g0[1]); o[1] = pg8::cvt_pk_bf16(f[2] * rs * g0[2], f[3] * rs * g0[3]);
                     o[2] = pg8::cvt_pk_bf16(f[4] * rs * g1[0], f[5] * rs * g1[1]); o[3] = pg8::cvt_pk_bf16(f[6] * rs * g1[2], f[7] * rs * g1[3]);
            *(LAS u32x4*)(Ks + key * 256 + ((ch ^ (key & 15)) << 4)) = o;
#pragma unroll
            for (int j = 0; j < 4; ++j) { *(LAS bf16_t*)(VT + (8 * ch + 2 * j) * VT_STRIDE + key * 2) = (bf16_t)(vv[j] & 0xffffu); *(LAS bf16_t*)(VT + (8 * ch + 2 * j + 1) * VT_STRIDE + key * 2) = (bf16_t)(vv[j] >> 16); }
        }
    }
    __syncthreads();
#pragma unroll 1
    for (int qi = 0; qi < 2; ++qi) {
        const int q0 = qhalf * 512 + qi * 256 + wid * 32;
        const bf16_t* Qp = QM + ((size_t)(b * SEQ + q0 + r32)) * 512 + h * MEM_D + hi * 8;
        bf16x8 qf[8];
        {
            float ss = 0.f; u32x4 raw[8];
#pragma unroll
            for (int d0 = 0; d0 < 8; ++d0) { raw[d0] = *(const u32x4*)(Qp + d0 * 16);
#pragma unroll
                for (int j = 0; j < 4; ++j) { const float lo = __uint_as_float(raw[d0][j] << 16), hi_ = __uint_as_float(raw[d0][j] & 0xffff0000u); ss += lo * lo + hi_ * hi_; } }
            ss += __shfl_xor(ss, 32);
            const float rs = rsqrtf(ss * (1.f / MEM_D) + EPS) * (0.08838834764831845f * LOG2E);
#pragma unroll
            for (int d0 = 0; d0 < 8; ++d0) { const f32x4 g0 = *(const f32x4*)(q_g + 16 * d0 + 8 * hi), g1 = *(const f32x4*)(q_g + 16 * d0 + 8 * hi + 4);
                u32x4 o;
                o[0] = pg8::cvt_pk_bf16(__uint_as_float(raw[d0][0] << 16) * rs * g0[0], __uint_as_float(raw[d0][0] & 0xffff0000u) * rs * g0[1]);
                o[1] = pg8::cvt_pk_bf16(__uint_as_float(raw[d0][1] << 16) * rs * g0[2], __uint_as_float(raw[d0][1] & 0xffff0000u) * rs * g0[3]);
                o[2] = pg8::cvt_pk_bf16(__uint_as_float(raw[d0][2] << 16) * rs * g1[0], __uint_as_float(raw[d0][2] & 0xffff0000u) * rs * g1[1]);
                o[3] = pg8::cvt_pk_bf16(__uint_as_float(raw[d0][3] << 16) * rs * g1[2], __uint_as_float(raw[d0][3] & 0xffff0000u) * rs * g1[3]);
                qf[d0] = __builtin_bit_cast(bf16x8, o); }
        }
        f32x16 o[4];
#pragma unroll
        for (int i = 0; i < 4; ++i)
#pragma unroll
            for (int r = 0; r < 16; ++r) o[i][r] = 0.f;
        float m = -1e30f, l = 0.f;
#pragma unroll 1
        for (int kv0 = 0; kv0 < MEM_LEN; kv0 += 32) {
            f32x16 sc;
#pragma unroll
            for (int r = 0; r < 16; ++r) sc[r] = 0.f;
            const int key = kv0 + r32;
#pragma unroll
            for (int d0 = 0; d0 < 8; ++d0) { const bf16x8 kf = *(const LAS bf16x8*)(Ks + key * 256 + (((2 * d0 + hi) ^ (key & 15)) << 4)); sc = __builtin_amdgcn_mfma_f32_32x32x16_bf16(kf, qf[d0], sc, 0, 0, 0); }
            float tmax = sc[0];
#pragma unroll
            for (int r = 1; r < 16; ++r) tmax = fmaxf(tmax, sc[r]);
            tmax = fmaxf(tmax, __shfl_xor(tmax, 32));
            const float mnew = fmaxf(m, tmax), alpha = __builtin_amdgcn_exp2f(m - mnew);
            float ps = 0.f;
#pragma unroll
            for (int r = 0; r < 16; ++r) { sc[r] = __builtin_amdgcn_exp2f(sc[r] - mnew); ps += sc[r]; }
            l = l * alpha + ps; m = mnew;
#pragma unroll
            for (int i = 0; i < 4; ++i)
#pragma unroll
                for (int r = 0; r < 16; ++r) o[i][r] *= alpha;
            bf16x8 pb[2];
#pragma unroll
            for (int s2 = 0; s2 < 2; ++s2) { u32x4 w; w[0] = pg8::cvt_pk_bf16(sc[8 * s2], sc[8 * s2 + 1]); w[1] = pg8::cvt_pk_bf16(sc[8 * s2 + 2], sc[8 * s2 + 3]); w[2] = pg8::cvt_pk_bf16(sc[8 * s2 + 4], sc[8 * s2 + 5]); w[3] = pg8::cvt_pk_bf16(sc[8 * s2 + 6], sc[8 * s2 + 7]); pb[s2] = __builtin_bit_cast(bf16x8, w); }
#pragma unroll
            for (int i = 0; i < 4; ++i)
#pragma unroll
                for (int s2 = 0; s2 < 2; ++s2) {
                    const LAS unsigned char* vp = VT + (32 * i + r32) * VT_STRIDE + (kv0 + 16 * s2 + 4 * hi) * 2;
                    const u32x2 v0 = *(const LAS u32x2*)vp, v1 = *(const LAS u32x2*)(vp + 16);
                    const u32x4 vv = (u32x4){v0[0], v0[1], v1[0], v1[1]};
                    o[i] = __builtin_amdgcn_mfma_f32_32x32x16_bf16(__builtin_bit_cast(bf16x8, vv), pb[s2], o[i], 0, 0, 0);
                }
        }
        l += __shfl_xor(l, 32);
        const float rl = __builtin_amdgcn_rcpf(l);
        bf16_t* Op = OM + ((size_t)(b * SEQ + q0 + r32)) * 512 + h * MEM_D;
#pragma unroll
        for (int i = 0; i < 4; ++i)
#pragma unroll
            for (int g = 0; g < 4; ++g) { u32x2 w; w[0] = pg8::cvt_pk_bf16(o[i][4 * g] * rl, o[i][4 * g + 1] * rl); w[1] = pg8::cvt_pk_bf16(o[i][4 * g + 2] * rl, o[i][4 * g + 3] * rl);
                *(u32x2*)(Op + 32 * i + 8 * g + 4 * hi) = w; }
    }
    __syncthreads();
}
}

struct Params { const float* in[32]; float* out; unsigned char* ws; };

__global__ void __launch_bounds__(NTHREADS, 2) mega_fwd(Params p) {
    extern __shared__ __attribute__((aligned(16))) unsigned char lds[];
    const int bid = blockIdx.x, G = gridDim.x;
    const int NGW = G * NWAVES, NGT = G * NTHREADS;
#define PHASE_IDS int tid = threadIdx.x; asm volatile("" : "+v"(tid)); const int lane = tid & 63, wave = __builtin_amdgcn_readfirstlane(tid >> 6), half = tid >> 8, vt = tid & 255; \
    unsigned char* sm = lds + half * 32768; const int gw = bid * NWAVES + wave, gt = bid * NTHREADS + tid; (void)lane; (void)vt; (void)sm; (void)gw; (void)gt;

    const float* x = p.in[0];            const float* mem = p.in[1];
    const float* norm_mix_g = p.in[2];   const float* w_in = p.in[3];
    const float* b_forget = p.in[4];     const float* conv_w = p.in[5];
    const float* conv_b = p.in[6];       const float* lru_wa = p.in[7];
    const float* lru_ba = p.in[8];       const float* lru_wx = p.in[9];
    const float* lru_bx = p.in[10];      const float* lru_a_param = p.in[11];
    const float* fox_q_g = p.in[12];     const float* fox_k_g = p.in[13];
    const float* lru_out_g = p.in[14];   const float* fox_out_g = p.in[15];
    const float* w_out = p.in[16];       const float* norm_mem_x_g = p.in[17];
    const float* norm_mem_g = p.in[18];  const float* mem_wq = p.in[19];
    const float* mem_wkv = p.in[20];     const float* mem_q_g = p.in[21];
    const float* mem_k_g = p.in[22];     const float* mem_wo = p.in[23];
    const float* norm_ffn_g = p.in[24];  const float* r_gw = p.in[25];
    const float* r_gb = p.in[26];        const float* r_ew = p.in[27];
    const float* r_eb = p.in[28];        const float* w_gate = p.in[29];
    const float* w_up = p.in[30];        const float* w_down = p.in[31];
    float* out = p.out;
    unsigned char* ws = p.ws;
    int* ctl = (int*)(ws + WS_CTL) + CW_MOE;
    float* LOGF = (float*)(ws + WS_LOGF); float* CUM = (float*)(ws + WS_CUM);
    bf16_t* MEMN = (bf16_t*)(ws + WS_MEMN); bf16_t* KM = (bf16_t*)(ws + WS_KM); bf16_t* VM = (bf16_t*)(ws + WS_VM);
    int* RE = (int*)(ws + WS_RE); float* RW = (float*)(ws + WS_RW); int* ROWTOK = (int*)(ws + WS_ROWTOK); int* TILEE = (int*)(ws + WS_TILEE);
    bf16_t* H = (bf16_t*)(ws + WS_H); bf16_t* U = (bf16_t*)(ws + WS_U); bf16_t* GATE = (bf16_t*)(ws + WS_GATE);
    bf16_t* Q = (bf16_t*)(ws + WS_Q); bf16_t* K = (bf16_t*)(ws + WS_K); bf16_t* V = (bf16_t*)(ws + WS_V);
    bf16_t* YL = (bf16_t*)(ws + WS_YL); bf16_t* YF = (bf16_t*)(ws + WS_YF); bf16_t* MIXED = (bf16_t*)(ws + WS_MIXED);
    float* X1F = p.out;     float* LA = (float*)(ws + WS_LA); float* LB = (float*)(ws + WS_LB);
    bf16_t* QM = (bf16_t*)(ws + WS_QM); bf16_t* OM = (bf16_t*)(ws + WS_OM); unsigned char* HDN = ws + WS_HDN; unsigned char* YB = ws + WS_YB;

    bf16_t* WT_IN = (bf16_t*)(ws + WS_WT_IN); bf16_t* WT_KV = (bf16_t*)(ws + WS_WT_KV); bf16_t* WT_OUT = (bf16_t*)(ws + WS_WT_OUT);
    bf16_t* WT_Q = (bf16_t*)(ws + WS_WT_Q); bf16_t* WT_O = (bf16_t*)(ws + WS_WT_O); unsigned char* WT_GU = ws + WS_WT_GU; unsigned char* WT_D = ws + WS_WT_D; unsigned char* X2Q = ws + WS_X2Q;
    bf16_t* LRUW = (bf16_t*)(ws + WS_LRUW);
    bf16_t* WT_R = (bf16_t*)(ws + WS_WT_R); float* RSTD2 = (float*)(ws + WS_RSTD2); int* LIST = (int*)(ws + WS_LIST);
    bf16_t* X1B = (bf16_t*)(ws + WS_X1B); bf16_t* X2B = (bf16_t*)(ws + WS_X2B); float* SSL = (float*)(ws + WS_SSL); float* SSF = (float*)(ws + WS_SSF);
    float* SS1 = (float*)(ws + WS_SS1); float* SS2 = (float*)(ws + WS_SS2);
    float* SUMA = (float*)(ws + WS_SUMA); float* SUMH = (float*)(ws + WS_SUMH);
    LAS unsigned char* ldsl = (LAS unsigned char*)lds;
    volatile LAS unsigned* MISC = (volatile LAS unsigned*)((LAS unsigned char*)lds + MISC_OFF);
    if (threadIdx.x < 32) MISC[threadIdx.x] = 0u;
    __syncthreads();
    XcdBarrier bar = xcd_barrier_post((unsigned*)(ws + WS_CTL) + CW_BAR, MISC + 8);
#define GRID_BAR() xcd_barrier(bar)
#define FOR_VB(NB) for (int _vb0 = 2 * bid; _vb0 < (NB); _vb0 += 2 * G) { const int vb = (_vb0 + half < (NB)) ? (_vb0 + half) : ((NB) - 1);
#define END_VB }

    { PHASE_IDS
    {
        LAS unsigned* scr = (LAS unsigned*)(ldsl + wave * 17408);
        constexpr int I_IN = (DM / 128) * (2560 / 64), I_KV = (DM / 128) * (1024 / 64), I_OUT = (DM / 128) * (DM / 64), I_Q = (DM / 128) * (MEM_W / 64), I_O = (MEM_W / 128) * (DM / 64);
        constexpr int NITEMS = I_IN + I_KV + I_OUT + I_Q + I_O;
        for (int it = gw; it < NITEMS; it += NGW) {
            int r = it;
            if (r < I_IN) { p0_transpose_item<1, false>(w_in, IN_COLS, DM, 2560, WT_IN, scr, r, lane, nullptr, nullptr, 0); continue; } r -= I_IN;
            if (r < I_KV) { p0_transpose_item<0, false>(mem_wkv, 2 * MEM_W, DM, 2 * MEM_W, WT_KV, scr, r, lane, nullptr, nullptr, 0); continue; } r -= I_KV;
            if (r < I_OUT) { p0_transpose_item<0, true>(w_out, DM, DM, DM, WT_OUT, scr, r, lane, lru_out_g, fox_out_g, 512); continue; } r -= I_OUT;
            if (r < I_Q) { p0_transpose_item<0, true>(mem_wq, MEM_W, DM, MEM_W, WT_Q, scr, r, lane, norm_mem_x_g, norm_mem_x_g, 1 << 30); continue; } r -= I_Q;
            p0_transpose_item<0, false>(mem_wo, DM, MEM_W, DM, WT_O, scr, r, lane, nullptr, nullptr, 0);
        }
    }
    __syncthreads();
    }
    { PHASE_IDS
    {
        LAS float* wfT = (LAS float*)ldsl;
        for (int i = tid; i < 8 * 1024; i += NTHREADS) { const int k = i >> 3, h = i & 7; wfT[h * 1024 + k] = w_in[(size_t)k * IN_COLS + 2560 + h]; }
        __syncthreads();
        for (int row = gw; row < T; row += NGW) b_rmsnorm_row_f(x, norm_mix_g, H, wfT, b_forget, LOGF, row, lane);
    }
    __syncthreads();
    }
    { PHASE_IDS
    for (int row = gw; row < TM; row += NGW) b_rmsnorm_row(mem, norm_mem_g, MEMN, row, lane);
    if (bid == 0 && tid < 128) ctl[tid] = 0;
    for (int i = gt; i < 48 * DM; i += NGT) {
        const int col = i >> 10, k = i & 1023; float v = 0.f;
        if (col < 4) v = r_gw[(size_t)k * 4 + col]; else if (col < 36) v = r_ew[(size_t)k * 32 + col - 4];
        WT_R[i] = f2bf(v * norm_ffn_g[k]);
    }
    for (int i = gt; i < 8 * 16 * 64 * 8; i += NGT) {
        const int j = i & 7, ln = (i >> 3) & 63, s_ = (i >> 9) & 3, n = (i >> 11) & 1, mat = (i >> 12) & 1, blk = i >> 13;
        const float* W = mat ? lru_wx : lru_wa;
        LRUW[i] = f2bf(W[(size_t)blk * 4096 + (16 * s_ + 8 * (ln >> 5) + j) * 64 + 32 * n + (ln & 31)]);
    }
    }
    GRID_BAR();
    { PHASE_IDS
    { const pg8::Gemm g{H, WT_IN, DM, DM, DM, 0, 0, 0, 0};
      const pg8::EpiInProj E{U, fox_q_g, fox_k_g};
      static_assert(WS_GATE - WS_U == 32 * MiB && WS_Q - WS_GATE == 32 * MiB && WS_K - WS_Q == 32 * MiB && WS_V - WS_K == 32 * MiB, "EpiInProj: section stride");
      const int split = bid % 5;
      if (split > 0) { pg8::StaticOrder S; S.init(T, 2560, G, bid, 0, split); pg8::gemm_phase<pg8::EpiInProj, pg8::StaticOrder, true>(ldsl, g, S, E); }
      { LAS unsigned char* scq = ldsl + wave * 17408;
        for (int it = gw; it < N_EXP * 192; it += NGW) {
            const int e = it / 192, q = it % 192;
            if (q < 64) p0_transpose_item_q<2, true>(w_gate + (size_t)e * DM * D_EXP, D_EXP, DM, D_EXP, WT_GU + (size_t)e * 1024 * 1024, scq, q, lane, norm_ffn_g);
            else if (q < 128) p0_transpose_item_q<3, true>(w_up + (size_t)e * DM * D_EXP, D_EXP, DM, D_EXP, WT_GU + (size_t)e * 1024 * 1024, scq, q - 64, lane, norm_ffn_g);
            else p0_transpose_item_q<0, false>(w_down + (size_t)e * D_EXP * DM, DM, D_EXP, DM, WT_D + (size_t)e * 1024 * 512, scq, q - 128, lane, norm_ffn_g);
        }
        __syncthreads(); }
      { pg8::StaticOrder S; S.init(T, 2560, G, bid, split, 1 << 30); pg8::gemm_phase<pg8::EpiInProj, pg8::StaticOrder, true>(ldsl, g, S, E); } }
    }
    GRID_BAR();
    { PHASE_IDS
    { constexpr int NB = BATCH * FOX_H;
      FOR_VB(NB) b_cumsum(LOGF, CUM, vb, vt, sm, true); END_VB }
    if (bid >= 32) {
      const pg8::Gemm g{MEMN, WT_KV, DM, DM, DM, 0, 0, 0, 0}; pg8::StaticOrder S; S.init(TM, 2 * MEM_W, G, bid - 32);
      const pg8::EpiBf16 E{KM, VM, 512, 512};
      pg8::gemm_phase<pg8::EpiBf16, pg8::StaticOrder, true>(ldsl, g, S, E); }
    __syncthreads();
    for (int u = bid; u < BATCH * lru::NCH; u += G) lru::unit<false>(u / lru::NCH, u % lru::NCH, U, GATE, conv_w, conv_b, LRUW, lru_ba, lru_bx, lru_a_param, SUMA, SUMH, YL, SSL, ldsl + wave * lru::WLDS, wave, lane);
    }
    GRID_BAR();
    { PHASE_IDS
    for (int u = bid; u < BATCH * lru::NCH; u += G) lru::unit<true>(u / lru::NCH, u % lru::NCH, U, GATE, conv_w, conv_b, LRUW, lru_ba, lru_bx, lru_a_param, SUMA, SUMH, YL, SSL, ldsl + wave * lru::WLDS, wave, lane);
    __syncthreads();
    fox::attn_phase<8>((char*)lds, Q, K, V, YF, CUM, SSF, ctl + 100);
    }
    GRID_BAR();
    { PHASE_IDS
    { const pg8::Gemm g{YL, WT_OUT, 512, DM, 512, (size_t)(WS_YF - WS_YL) / 2, 512, 0, 0}; pg8::PairOrder S; S.init(T, DM, G, bid);
      const pg8::EpiOutChain E{x, X1B, SSL, SSF, SS1};
      pg8::gemm_phase<pg8::EpiOutChain, pg8::PairOrder, true>(ldsl, g, S, E); }
    }
    GRID_BAR();
    { PHASE_IDS
    { const pg8::Gemm g{X1B, WT_Q, DM, DM, DM, 0, 0, 0, 0}; pg8::StaticOrder S; S.init(T, MEM_W, G, bid);
      const pg8::EpiRowScale E{QM, 512, SS1, 1.f / DM};
      pg8::gemm_phase<pg8::EpiRowScale, pg8::StaticOrder, true>(ldsl, g, S, E); }
    }
    GRID_BAR();
    { PHASE_IDS
    static_assert(xat::LDS_NEED <= MISC_OFF, "cross-attention LDS");
    for (int it = bid; it < BATCH * MEM_H * 8; it += G) { const int bh = it >> 3; xat::item(bh / MEM_H, bh % MEM_H, it & 7, QM, KM, VM, OM, mem_q_g, mem_k_g, ldsl); }
    }
    GRID_BAR();
    { PHASE_IDS
    { const pg8::Gemm g{OM, WT_O, MEM_W, MEM_W, MEM_W, 0, 0, 0, 0}; pg8::StaticOrder S; S.init(T, DM, G, bid);
      const pg8::EpiX2 E{X1B, X2B, X2Q, SS2};
      pg8::gemm_phase<pg8::EpiX2, pg8::StaticOrder, true>(ldsl, g, S, E); }
    }
    GRID_BAR();
    { PHASE_IDS
    static_assert(T / 16 == 256 * NWAVES, "router: one 16-token task per wave on a 256-workgroup grid");
    LAS int* hist = (LAS int*)(ldsl + 8 * 8448 + 36 * 2064);
    LAS unsigned char* wr = ldsl + 8 * 8448;
    if (tid < 64) hist[tid] = 0;
    for (int i = tid; i < 36 * 128; i += NTHREADS) { const int row = i >> 7, ch = i & 127; *(LAS pg8::u32x4*)(wr + row * 2064 + ch * 16) = *(const pg8::u32x4*)(WT_R + (size_t)row * DM + ch * 8); }
    __syncthreads();
    for (int tk = gw; tk < T / 16; tk += NGW) rtr::task(tk * 16, X2B, WT_R, SS2, r_gb, r_eb, RW, RSTD2, ctl, LIST, (LAS float*)(ldsl + wave * 8448), wr, hist, lane);
    }
    GRID_BAR();
    { PHASE_IDS
    LAS int* mp = (LAS int*)(ldsl + 131072);
    if (tid == 0) { int run = 0; for (int e = 0; e < N_EXP; ++e) { const int c_ = ctl[e]; mp[e] = run; mp[64 + e] = c_; run += (c_ + 255) & ~255; } mp[32] = run; }
    __syncthreads();
    if (tid < N_TILES) { const int row = tid * 256; int e = 0; for (int j = 1; j < N_EXP; ++j) if (mp[j] <= row) e = j; mp[128 + tid] = e; }
    __syncthreads();
    { const pg8::Gemm g{X2Q, WT_GU, DM, DM, DM, 0, (size_t)1024 * 1024, 0x7f7f7f7f, 0x7a7a7a7a};
      const pg8::MoeOrder<true> S{(mp[32] >> 8) * 4, G, bid, mp, LIST};
      const pg8::EpiMoe1 E{HDN, RSTD2, S};
      pg8::gemm_phase<pg8::EpiMoe1, pg8::MoeOrder<true>, true>(ldsl, g, S, E); }
    }
    GRID_BAR();
    { PHASE_IDS
    LAS int* mp = (LAS int*)(ldsl + 131072);
    { const pg8::Gemm g{HDN, WT_D, D_EXP, D_EXP, D_EXP, 0, (size_t)1024 * 512, 0x7c7c7c7c, 0x7a7a7a7a};
      const pg8::MoeOrder<false> S{(mp[32] >> 8) * 4, G, bid, mp, LIST};
      const pg8::EpiMoe2 E{YB, RW, S};
      pg8::gemm_phase<pg8::EpiMoe2, pg8::MoeOrder<false>, true>(ldsl, g, S, E); }
    }
    GRID_BAR();
    { PHASE_IDS
    for (size_t i = (size_t)gt * 8; i < (size_t)T * DM; i += (size_t)NGT * 8) b_final(out, X2B, YB, i);
    }
}

extern "C" void kernel_launch(void* const* d_in, const int* in_sizes, int n_in, void* d_out, int out_size, void* d_ws, size_t ws_size, hipStream_t stream) {
    static int grid = 0;
    if (grid == 0) {
        int dev = 0, cus = 0;
        if (hipGetDevice(&dev) != hipSuccess || hipDeviceGetAttribute(&cus, hipDeviceAttributeMultiprocessorCount, dev) != hipSuccess) { fprintf(stderr, "kernel_launch: device query failed\n"); grid = -1; return; }
        if (hipFuncSetAttribute((const void*)mega_fwd, hipFuncAttributeMaxDynamicSharedMemorySize, LDS_BYTES) != hipSuccess) { fprintf(stderr, "kernel_launch: hipFuncSetAttribute failed\n"); grid = -1; return; }
        if (n_in != 32 || ws_size < WS_END) { fprintf(stderr, "kernel_launch: unexpected inputs (n_in %d, ws %zu)\n", n_in, ws_size); grid = -1; return; }
        grid = cus;
    }
    if (grid < 0) return;
    (void)hipMemsetAsync((char*)d_ws + WS_CTL, 0, CTL_ZERO_BYTES, stream);
    Params p{};
    for (int i = 0; i < 32; ++i) p.in[i] = (const float*)d_in[i];
    p.out = (float*)d_out; p.ws = (unsigned char*)d_ws;
    hipLaunchKernelGGL(mega_fwd, dim3(grid), dim3(NTHREADS), LDS_BYTES, stream, p);
}
```

```cpp
#include <hip/hip_runtime.h>
#include <stdint.h>
#include <math.h>
#include <cstdio>

typedef unsigned short bf16_t;
typedef short bf16x8 __attribute__((ext_vector_type(8)));
typedef float f32x4 __attribute__((ext_vector_type(4)));
typedef float f32x16 __attribute__((ext_vector_type(16)));
#define GAS __attribute__((address_space(1)))
#define LAS __attribute__((address_space(3)))

constexpr int BATCH = 8, SEQ = 4096, T = BATCH * SEQ, DM = 1024;
constexpr int MEM_LEN = 256, TM = BATCH * MEM_LEN;
constexpr int LRU_W = 512, FOX_H = 8, FOX_D = 64, FOX_W = 512;
constexpr int IN_COLS = 2568;
constexpr int MEM_H = 4, MEM_D = 128, MEM_W = 512;
constexpr int N_GROUPS = 4, EPG = 8, N_EXP = 32, D_EXP = 512;
constexpr int NA = T * 2;
constexpr int MOE_PAD = 256;
constexpr int P_MAX = NA + N_EXP * MOE_PAD;
constexpr int N_TILES = P_MAX / MOE_PAD;
constexpr float EPS = 1e-6f;
constexpr float LOG2E = 1.4426950408889634f;
constexpr int NTHREADS = 512, NWAVES = 8;
constexpr int ESPLIT = 12;

constexpr size_t MiB = 1u << 20;
constexpr size_t WS_CTL = 0;
constexpr size_t CTL_ZERO_BYTES = 256 * 1024;
constexpr int CW_MOE = 0;
constexpr int CW_BAR = 4096;
constexpr size_t WS_LOGF = 1 * MiB;
constexpr size_t WS_CUM = 2 * MiB;
constexpr size_t WS_MEMN = 3 * MiB;
constexpr size_t WS_KM = 7 * MiB;
constexpr size_t WS_VM = 9 * MiB;
constexpr size_t WS_RE = 11 * MiB;
constexpr size_t WS_RW = 11 * MiB + 512 * 1024;
constexpr size_t WS_ROWTOK = 12 * MiB;
constexpr size_t WS_TILEE = 13 * MiB;
constexpr size_t WS_SUMA = 14 * MiB;
constexpr size_t WS_SUMH = 14 * MiB + 512 * 1024;
constexpr size_t WS_LRUW = 15 * MiB;
constexpr size_t WS_WT_IN = 16 * MiB;
constexpr size_t WS_WT_KV = 21 * MiB;
constexpr size_t WS_WT_OUT = 23 * MiB;
constexpr size_t WS_WT_Q = 25 * MiB;
constexpr size_t WS_WT_O = 26 * MiB;
constexpr size_t WS_WT_GU = 27 * MiB;
constexpr size_t WS_WT_D = 91 * MiB;
constexpr size_t WS_H = 123 * MiB;
constexpr size_t WS_MIXED = 123 * MiB;
constexpr size_t WS_LA = 123 * MiB;
constexpr size_t WS_YL = 187 * MiB;
constexpr size_t WS_YF = 219 * MiB;
constexpr size_t WS_YB = 123 * MiB;
constexpr size_t WS_U = 251 * MiB;
constexpr size_t WS_GATE = 283 * MiB;
constexpr size_t WS_Q = 315 * MiB;
constexpr size_t WS_K = 347 * MiB;
constexpr size_t WS_V = 379 * MiB;
constexpr size_t WS_QM = 251 * MiB;
constexpr size_t WS_OM = 283 * MiB;
constexpr size_t WS_HDN = 315 * MiB;
constexpr size_t WS_LB = 411 * MiB;
constexpr size_t WS_X1B = 123 * MiB;
constexpr size_t WS_X2Q = 360 * MiB;
constexpr size_t WS_X2B = 411 * MiB;
constexpr size_t WS_LIST = 476 * MiB;
constexpr size_t WS_SSL = 480 * MiB;
constexpr size_t WS_SSF = 481 * MiB;
constexpr size_t WS_SS1 = 482 * MiB;
constexpr size_t WS_SS2 = 484 * MiB;
constexpr size_t WS_RSTD2 = 486 * MiB;
constexpr size_t WS_WT_R = 487 * MiB;
constexpr size_t WS_END = 488 * MiB;
static_assert((size_t)P_MAX * 512 * 2 <= 96 * MiB && (size_t)NA * DM * 2 <= 128 * MiB, "ws map");

constexpr int LDS_BYTES = 155648;
constexpr int MISC_OFF = LDS_BYTES - 512;

__device__ __forceinline__ bf16_t f2bf(float f) { unsigned u = __float_as_uint(f); return (bf16_t)((u + 0x7fffu + ((u >> 16) & 1u)) >> 16); }
__device__ __forceinline__ float bf2f(bf16_t h) { return __uint_as_float(((unsigned)h) << 16); }
__device__ __forceinline__ float wave_sum(float v) {
#pragma unroll
    for (int o = 1; o < 64; o <<= 1) v += __shfl_xor(v, o);
    return v;
}
__device__ __forceinline__ int crow(int r, int hi) { return (r & 3) + 8 * (r >> 2) + 4 * hi; }
__device__ __forceinline__ float sigmoidf_(float x) { return 1.f / (1.f + __expf(-x)); }
__device__ __forceinline__ float gelu_tanh(float x) {
    const float k0 = 0.7978845608028654f, k1 = 0.044715f;
    float u = k0 * (x + k1 * x * x * x);
    float t = 1.f - 2.f / (1.f + __expf(2.f * u));
    return 0.5f * x * (1.f + t);
}

#define XB_TMO      128
#define XB_XCNT(j)  (256  + 64 * (j))
#define XB_XSUB(j)  (1280 + 64 * (j))
#define XB_XGEN(j)  (2304 + 64 * (j))
#define XB_TOP      3328
#define XB_TOPGEN   3392
#define XCD_BAR_WORDS 3456
#define XB_SPIN_CAP (1u << 20)
__device__ __forceinline__ unsigned xb_ld(unsigned* p)              { return __hip_atomic_load(p, __ATOMIC_RELAXED, __HIP_MEMORY_SCOPE_AGENT); }
__device__ __forceinline__ unsigned xb_add(unsigned* p, unsigned v) { return __hip_atomic_fetch_add(p, v, __ATOMIC_RELAXED, __HIP_MEMORY_SCOPE_AGENT); }
__device__ __forceinline__ unsigned xb_xcc_id() { return (unsigned)__builtin_amdgcn_s_getreg((3 << 11) | 20) & 0xFu; }
#define XB_SPIN(cond, bar) do { unsigned _sp = 0; while (cond) { __builtin_amdgcn_s_sleep(1); \
    if ((++_sp & 255u) == 0u) { if (xb_ld(&(bar)[XB_TMO])) break; if (_sp > XB_SPIN_CAP) { atomicAdd(&(bar)[XB_TMO], 1u); break; } } } } while (0)
struct XcdBarrier { unsigned* bar; unsigned x; volatile LAS unsigned* st; };
__device__ __forceinline__ XcdBarrier xcd_barrier_post(unsigned* bar, volatile LAS unsigned* st) {
    XcdBarrier b; b.bar = bar; b.x = xb_xcc_id(); b.st = st;
    if (threadIdx.x == 0) (void)xb_add(&bar[XB_XCNT(b.x)], 1u);
    return b;
}
__device__ __forceinline__ void xcd_barrier_complete(unsigned* bar, unsigned x, unsigned& nloc, unsigned& nx) {
    const unsigned G = gridDim.x * gridDim.y * gridDim.z;
    unsigned sum, cnt, mine, sp = 0u;
    for (;;) {
        sum = 0u; cnt = 0u; mine = 0u;
#pragma unroll
        for (unsigned j = 0; j < 16; ++j) { const unsigned c = xb_ld(&bar[XB_XCNT(j)]); sum += c; cnt += (c > 0u) ? 1u : 0u; mine = (j == x) ? c : mine; }
        if (sum == G) break;
        __builtin_amdgcn_s_sleep(1);
        if ((++sp & 255u) == 0u) { if (xb_ld(&bar[XB_TMO])) break; if (sp > XB_SPIN_CAP) { atomicAdd(&bar[XB_TMO], 1u); break; } }
    }
    nloc = mine > 0u ? mine : 1u; nx = cnt > 0u ? cnt : 1u;
}
__device__ __forceinline__ void xcd_barrier(const XcdBarrier& b) {
    asm volatile("s_waitcnt vmcnt(0)" ::: "memory");
    __syncthreads();
    if (threadIdx.x == 0) {
        unsigned* bar = b.bar;
        __builtin_amdgcn_s_waitcnt(0);
        unsigned nloc = b.st[0], nx = b.st[1];
        if (nloc == 0u) { xcd_barrier_complete(bar, b.x, nloc, nx); b.st[0] = nloc; b.st[1] = nx; }
        const unsigned old = xb_add(&bar[XB_XSUB(b.x)], 1u);
        const unsigned gen = old / nloc;
        if (old + 1u == (gen + 1u) * nloc) {
            __builtin_amdgcn_fence(__ATOMIC_RELEASE, "agent");
            asm volatile("s_waitcnt vmcnt(0)" ::: "memory");
            const unsigned og = xb_add(&bar[XB_TOP], 1u);
            const unsigned tg = og / nx;
            if (og + 1u == (tg + 1u) * nx) xb_add(&bar[XB_TOPGEN], 1u);
            else XB_SPIN(xb_ld(&bar[XB_TOPGEN]) == tg, bar);
            __builtin_amdgcn_fence(__ATOMIC_ACQUIRE, "agent");
            xb_add(&bar[XB_XGEN(b.x)], 1u);
            asm volatile("s_waitcnt vmcnt(0)" ::: "memory");
        } else {
            XB_SPIN(xb_ld(&bar[XB_XGEN(b.x)]) == gen, bar);
            __builtin_amdgcn_fence(__ATOMIC_ACQUIRE, "agent");
            asm volatile("s_waitcnt vmcnt(0)" ::: "memory");
        }
    }
    __syncthreads();
}

__device__ __forceinline__ void b_rmsnorm_row(const float* __restrict__ x, const float* __restrict__ g, bf16_t* __restrict__ out, int row, int lane) {
    const f32x4* xr = (const f32x4*)(x + (size_t)row * DM) + lane;
    f32x4 v[4]; float s = 0.f;
#pragma unroll
    for (int j = 0; j < 4; ++j) { v[j] = xr[64 * j]; s += v[j].x * v[j].x + v[j].y * v[j].y + v[j].z * v[j].z + v[j].w * v[j].w; }
    const float rstd = rsqrtf(wave_sum(s) * (1.f / DM) + EPS);
    const f32x4* gr = (const f32x4*)g + lane;
    uint2* o = (uint2*)(out + (size_t)row * DM) + lane;
#pragma unroll
    for (int j = 0; j < 4; ++j) {
        f32x4 gg = gr[64 * j];
        uint2 w;
        w.x = (unsigned)f2bf(v[j].x * rstd * gg.x) | ((unsigned)f2bf(v[j].y * rstd * gg.y) << 16);
        w.y = (unsigned)f2bf(v[j].z * rstd * gg.z) | ((unsigned)f2bf(v[j].w * rstd * gg.w) << 16);
        o[64 * j] = w;
    }
}


__device__ __forceinline__ void b_rmsnorm_row_f(const float* __restrict__ x, const float* __restrict__ g, bf16_t* __restrict__ out, const LAS float* wfT, const float* __restrict__ b_forget,
                                                float* __restrict__ LOGF, int row, int lane) {
    const f32x4* xr = (const f32x4*)(x + (size_t)row * DM) + lane;
    f32x4 v[4]; float s = 0.f;
#pragma unroll
    for (int j = 0; j < 4; ++j) { v[j] = xr[64 * j]; s += v[j].x * v[j].x + v[j].y * v[j].y + v[j].z * v[j].z + v[j].w * v[j].w; }
    const float rstd = rsqrtf(wave_sum(s) * (1.f / DM) + EPS);
    const f32x4* gr = (const f32x4*)g + lane;
    uint2* o = (uint2*)(out + (size_t)row * DM) + lane;
#pragma unroll
    for (int j = 0; j < 4; ++j) {
        const f32x4 gg = gr[64 * j];
        v[j].x *= rstd * gg.x; v[j].y *= rstd * gg.y; v[j].z *= rstd * gg.z; v[j].w *= rstd * gg.w;
        uint2 w;
        w.x = (unsigned)f2bf(v[j].x) | ((unsigned)f2bf(v[j].y) << 16);
        w.y = (unsigned)f2bf(v[j].z) | ((unsigned)f2bf(v[j].w) << 16);
        o[64 * j] = w;
    }
    float fl[8];
#pragma unroll
    for (int h = 0; h < 8; ++h) {
        float a = 0.f;
#pragma unroll
        for (int j = 0; j < 4; ++j) { const f32x4 w = *(const LAS f32x4*)(wfT + h * 1024 + 256 * j + 4 * lane); a += (v[j].x * w.x + v[j].y * w.y) + (v[j].z * w.z + v[j].w * w.w); }
        fl[h] = wave_sum(a);
    }
    if (lane == 0) {
#pragma unroll
        for (int h = 0; h < 8; ++h) { const float z = fl[h] + b_forget[h]; LOGF[(size_t)row * 8 + h] = fminf(z, 0.f) - log1pf(__expf(-fabsf(z))); }
    }
}

typedef bf16_t (*As_t)[40];
typedef bf16_t (*Bs_t)[64][40];
template <int NB>
__device__ __forceinline__ void gemm_core64(const bf16_t* aptr, const float* W0, const float* W1, int ldw,
                                            int n0, int N, int K, f32x4 (&acc)[NB][2][2], As_t As, Bs_t Bs, int vt) {
    const int lane = vt & 63, wid = vt >> 6, wr = wid >> 1, wc = wid & 1;
    for (int k0 = 0; k0 < K; k0 += 32) {
        {
            const int r = vt >> 2, c = vt & 3;
            uint4 v = make_uint4(0, 0, 0, 0);
            if (aptr) v = *(const uint4*)(aptr + k0 + c * 8);
            *(uint4*)&As[r][c * 8] = v;
        }
        {
            const int kk = vt >> 3, nc = (vt & 7) * 8;
#pragma unroll
            for (int b = 0; b < NB; ++b) {
                const float* wp = (b == 0 ? W0 : W1) + (size_t)(k0 + kk) * ldw + n0 + nc;
#pragma unroll
                for (int j = 0; j < 8; ++j) { float v = (n0 + nc + j < N) ? wp[j] : 0.f; Bs[b][nc + j][kk] = f2bf(v); }
            }
        }
        __syncthreads();
        bf16x8 a[2];
#pragma unroll
        for (int i = 0; i < 2; ++i) a[i] = *(const bf16x8*)&As[wr * 32 + i * 16 + (lane & 15)][(lane >> 4) * 8];
#pragma unroll
        for (int b = 0; b < NB; ++b)
#pragma unroll
            for (int j = 0; j < 2; ++j) {
                bf16x8 bb = *(const bf16x8*)&Bs[b][wc * 32 + j * 16 + (lane & 15)][(lane >> 4) * 8];
#pragma unroll
                for (int i = 0; i < 2; ++i) acc[b][i][j] = __builtin_amdgcn_mfma_f32_16x16x32_bf16(a[i], bb, acc[b][i][j], 0, 0, 0);
            }
        __syncthreads();
    }
}

template <class Epi>
__device__ __forceinline__ void b_gemm(const bf16_t* __restrict__ A, int lda, const float* __restrict__ W, int ldw, int N, int K, const Epi& epi,
                                       int vbx, int vby, int vt, unsigned char* sm) {
    As_t As = (As_t)sm; Bs_t Bs = (Bs_t)(sm + 64 * 40 * 2);
    const int lane = vt & 63, wid = vt >> 6, wr = wid >> 1, wc = wid & 1;
    const int m0 = vby * 64, n0 = vbx * 64;
    f32x4 acc[1][2][2];
#pragma unroll
    for (int i = 0; i < 2; ++i)
#pragma unroll
        for (int j = 0; j < 2; ++j) acc[0][i][j] = (f32x4){0.f, 0.f, 0.f, 0.f};
    gemm_core64<1>(A + (size_t)(m0 + (vt >> 2)) * lda, W, W, ldw, n0, N, K, acc, As, Bs, vt);
#pragma unroll
    for (int i = 0; i < 2; ++i)
#pragma unroll
        for (int j = 0; j < 2; ++j)
#pragma unroll
            for (int r = 0; r < 4; ++r) {
                const int row = m0 + wr * 32 + i * 16 + (lane >> 4) * 4 + r, col = n0 + wc * 32 + j * 16 + (lane & 15);
                if (col < N) epi(row, col, acc[0][i][j][r]);
            }
}

struct EpiG1 {
    bf16_t *U, *GATE, *Q, *K, *V; float* LOGF; const float* b_forget;
    __device__ __forceinline__ void operator()(int row, int col, float v) const {
        if (col < 512) U[(size_t)row * 512 + col] = f2bf(v);
        else if (col < 1024) GATE[(size_t)row * 512 + col - 512] = f2bf(v);
        else if (col < 1536) Q[(size_t)row * 512 + col - 1024] = f2bf(v);
        else if (col < 2048) K[(size_t)row * 512 + col - 1536] = f2bf(v);
        else if (col < 2560) V[(size_t)row * 512 + col - 2048] = f2bf(v);
        else { const int h = col - 2560; const float z = v + b_forget[h]; LOGF[(size_t)row * 8 + h] = fminf(z, 0.f) - log1pf(__expf(-fabsf(z))); }
    }
};
struct EpiSplit2 { bf16_t *O0, *O1;
    __device__ __forceinline__ void operator()(int row, int col, float v) const {
        if (col < 512) O0[(size_t)row * 512 + col] = f2bf(v); else O1[(size_t)row * 512 + col - 512] = f2bf(v); } };
struct EpiBf16s { bf16_t* O; int ldo;
    __device__ __forceinline__ void operator()(int row, int col, float v) const { O[(size_t)row * ldo + col] = f2bf(v); } };
struct EpiResF32 { const float* base; float* out;
    __device__ __forceinline__ void operator()(int row, int col, float v) const { out[(size_t)row * DM + col] = base[(size_t)row * DM + col] + v; } };

template <int HD>
__device__ __forceinline__ void b_headnorm(bf16_t* __restrict__ X, const float* __restrict__ g, float scale, int idx) {
    const int nh = 512 / HD;
    bf16_t* p = X + (size_t)(idx / nh) * 512 + (idx % nh) * HD;
    float ss = 0.f;
#pragma unroll 8
    for (int d = 0; d < HD; ++d) { float v = bf2f(p[d]); ss += v * v; }
    const float rstd = rsqrtf(ss * (1.f / HD) + EPS) * scale;
#pragma unroll 8
    for (int d = 0; d < HD; ++d) p[d] = f2bf(bf2f(p[d]) * rstd * g[d]);
}

__device__ __forceinline__ void b_cumsum(const float* __restrict__ LOGF, float* __restrict__ CUM, int bh, int vt, unsigned char* sm, bool store) {
    float* part = (float*)sm;
    const int b = bh / FOX_H, h = bh % FOX_H;
    float v[16]; float s = 0.f;
#pragma unroll
    for (int i = 0; i < 16; ++i) { v[i] = LOGF[((size_t)b * SEQ + vt * 16 + i) * 8 + h]; s += v[i]; }
    part[vt] = s; __syncthreads();
    if (vt == 0) { float run = 0.f; for (int i = 0; i < 256; ++i) { float t = part[i]; part[i] = run; run += t; } }
    __syncthreads();
    float run = part[vt];
    if (store) {
#pragma unroll
        for (int i = 0; i < 16; ++i) { run += v[i]; CUM[(size_t)bh * SEQ + vt * 16 + i] = run * LOG2E; }
    }
    __syncthreads();
}

__device__ __forceinline__ void b_lru_ab(const bf16_t* __restrict__ U, const float* __restrict__ conv_w, const float* __restrict__ conv_b,
                                         const float* __restrict__ wa, const float* __restrict__ ba, const float* __restrict__ wx, const float* __restrict__ bx,
                                         const float* __restrict__ a_param, float* __restrict__ LA, float* __restrict__ LB, int t, int ch, unsigned char* sm) {
    float* xc = (float*)sm;
    const int s = t % SEQ;
    float x = conv_b[ch];
#pragma unroll
    for (int tap = 0; tap < 4; ++tap) { const int ss = s - 3 + tap; if (ss >= 0) x += conv_w[tap * 512 + ch] * bf2f(U[(size_t)(t - 3 + tap) * 512 + ch]); }
    xc[ch] = x; __syncthreads();
    const int blk = ch >> 6, j = ch & 63;
    float r = ba[ch], ii = bx[ch];
    const float* wap = wa + (size_t)blk * 4096 + j; const float* wxp = wx + (size_t)blk * 4096 + j;
#pragma unroll 4
    for (int i = 0; i < 64; ++i) { const float xv = xc[blk * 64 + i]; r += xv * wap[i * 64]; ii += xv * wxp[i * 64]; }
    r = sigmoidf_(r); ii = sigmoidf_(ii);
    const float ap = -a_param[ch];
    const float sp = (ap > 20.f) ? ap : log1pf(__expf(ap));
    const float log_a = -8.f * r * sp;
    const float a = __expf(log_a);
    const float mult = sqrtf(fmaxf(-expm1f(2.f * log_a), 0.f));
    LA[(size_t)t * 512 + ch] = a;
    LB[(size_t)t * 512 + ch] = mult * (ii * x);
    __syncthreads();
}
__device__ __forceinline__ void b_lru_scan(const float* __restrict__ LA, const float* __restrict__ LB, const bf16_t* __restrict__ GATE, bf16_t* __restrict__ YL, int vb, int lane) {
    const int b = vb / 8, ch = (vb % 8) * 64 + lane;
    float h = 0.f;
    size_t off = (size_t)b * SEQ * 512 + ch;
    for (int s = 0; s < SEQ; s += 8) {
        float a[8], bb[8], g[8];
#pragma unroll
        for (int i = 0; i < 8; ++i) { a[i] = LA[off + (size_t)(s + i) * 512]; bb[i] = LB[off + (size_t)(s + i) * 512]; g[i] = bf2f(GATE[off + (size_t)(s + i) * 512]); }
#pragma unroll
        for (int i = 0; i < 8; ++i) { h = a[i] * h + bb[i]; YL[off + (size_t)(s + i) * 512] = f2bf(h * gelu_tanh(g[i])); }
    }
}

template <int D, bool CAUSAL, int VB0>
__device__ __forceinline__ void b_attn(const bf16_t* __restrict__ Q, const bf16_t* __restrict__ K, const bf16_t* __restrict__ V, bf16_t* __restrict__ O,
                                       const float* __restrict__ cum, int H, int Sq, int Skv, int pitch, int b, int h, int q0, int lane) {
    const int r32 = lane & 31, hi = lane >> 5;
    const bf16_t* Qp = Q + ((size_t)b * Sq + q0 + r32) * pitch + h * D;
    constexpr bool QREG = (D <= 64);
    bf16x8 qf[QREG ? D / 16 : 1];
    if (QREG) {
#pragma unroll
        for (int d0 = 0; d0 < D / 16; ++d0) qf[QREG ? d0 : 0] = *(const bf16x8*)(Qp + d0 * 16 + hi * 8);
    }
    f32x16 o[2];
#pragma unroll
    for (int i = 0; i < 2; ++i)
#pragma unroll
        for (int r = 0; r < 16; ++r) o[i][r] = 0.f;
    float m = -1e30f, l = 0.f;
    const int nkv = CAUSAL ? (q0 + 32) : Skv;
    const float* cb = cum ? cum + ((size_t)b * H + h) * Skv : nullptr;
    const float cref = cum ? cb[q0] : 0.f;
    const bf16_t* Kb = K + ((size_t)b * Skv) * pitch + h * D;
    const bf16_t* Vb = V + ((size_t)b * Skv) * pitch + h * D;
#pragma unroll 1
    for (int kv0 = 0; kv0 < nkv; kv0 += 32) {
        f32x16 s;
#pragma unroll
        for (int r = 0; r < 16; ++r) s[r] = 0.f;
        const bf16_t* Kp = Kb + (size_t)(kv0 + r32) * pitch;
#pragma unroll
        for (int d0 = 0; d0 < D / 16; ++d0) { bf16x8 kf = *(const bf16x8*)(Kp + d0 * 16 + hi * 8);
            bf16x8 qq; if (QREG) qq = qf[QREG ? d0 : 0]; else qq = *(const bf16x8*)(Qp + d0 * 16 + hi * 8);
            s = __builtin_amdgcn_mfma_f32_32x32x16_bf16(kf, qq, s, 0, 0, 0); }
        float tmax = -INFINITY;
#pragma unroll
        for (int r = 0; r < 16; ++r) {
            const int kv = kv0 + crow(r, hi);
            float v = s[r];
            if (cum) v += cref - cb[kv];
            if (CAUSAL && kv > q0 + r32) v = -INFINITY;
            s[r] = v; tmax = fmaxf(tmax, v);
        }
        tmax = fmaxf(tmax, __shfl_xor(tmax, 32));
        const float mnew = fmaxf(m, tmax);
        const float alpha = exp2f(m - mnew);
        float ps = 0.f;
#pragma unroll
        for (int r = 0; r < 16; ++r) { s[r] = exp2f(s[r] - mnew); ps += s[r]; }
        l = l * alpha + ps; m = mnew;
#pragma unroll
        for (int i = 0; i < 2; ++i)
#pragma unroll
            for (int r = 0; r < 16; ++r) o[i][r] *= alpha;
        bf16x8 pb[2];
#pragma unroll
        for (int s2 = 0; s2 < 2; ++s2)
#pragma unroll
            for (int j = 0; j < 8; ++j) pb[s2][j] = (short)f2bf(s[8 * s2 + j]);
#pragma unroll
        for (int i = 0; i < 2; ++i)
#pragma unroll
            for (int s2 = 0; s2 < 2; ++s2) {
                bf16x8 vf;
#pragma unroll
                for (int j = 0; j < 8; ++j) vf[j] = (short)Vb[(size_t)(kv0 + 16 * s2 + 8 * (j >> 2) + 4 * hi + (j & 3)) * pitch + (VB0 + i) * 32 + r32];
                o[i] = __builtin_amdgcn_mfma_f32_32x32x16_bf16(vf, pb[s2], o[i], 0, 0, 0);
                asm volatile("" ::: "memory");
            }
    }
    l += __shfl_xor(l, 32);
    const float rl = 1.f / l;
    bf16_t* Op = O + ((size_t)b * Sq + q0 + r32) * pitch + h * D;
#pragma unroll
    for (int i = 0; i < 2; ++i)
#pragma unroll
        for (int r = 0; r < 16; ++r) Op[(VB0 + i) * 32 + crow(r, hi)] = f2bf(o[i][r] * rl);
}

__device__ __forceinline__ void b_mixnorm(const bf16_t* __restrict__ YL, const bf16_t* __restrict__ YF, const float* __restrict__ gl, const float* __restrict__ gf, bf16_t* __restrict__ MIXED, int row, int lane) {
#pragma unroll
    for (int part = 0; part < 2; ++part) {
        const bf16_t* src = (part ? YF : YL) + (size_t)row * 512 + lane * 8;
        const float* g = (part ? gf : gl) + lane * 8;
        float v[8]; float ss = 0.f;
#pragma unroll
        for (int j = 0; j < 8; ++j) { v[j] = bf2f(src[j]); ss += v[j] * v[j]; }
        const float rstd = rsqrtf(wave_sum(ss) * (1.f / 512.f) + EPS);
        bf16_t* dst = MIXED + (size_t)row * DM + part * 512 + lane * 8;
#pragma unroll
        for (int j = 0; j < 8; ++j) dst[j] = f2bf(v[j] * rstd * g[j]);
    }
}

__device__ __forceinline__ void b_router(const bf16_t* __restrict__ XN, const float* __restrict__ wg, const float* __restrict__ bg, const float* __restrict__ we, const float* __restrict__ be,
                                         int* __restrict__ RE, float* __restrict__ RW, int* __restrict__ counts, int t, int lane) {
    float acc[36];
#pragma unroll
    for (int o = 0; o < 36; ++o) acc[o] = 0.f;
    const bf16_t* xr = XN + (size_t)t * DM;
#pragma unroll 1
    for (int i = 0; i < 16; ++i) {
        const int k = i * 64 + lane;
        const float xv = bf2f(xr[k]);
        const f32x4 g4 = *(const f32x4*)(wg + (size_t)k * 4);
        acc[0] += xv * g4.x; acc[1] += xv * g4.y; acc[2] += xv * g4.z; acc[3] += xv * g4.w;
        const f32x4* e4 = (const f32x4*)(we + (size_t)k * 32);
#pragma unroll
        for (int q = 0; q < 8; ++q) { const f32x4 e = e4[q]; acc[4 + 4 * q] += xv * e.x; acc[5 + 4 * q] += xv * e.y; acc[6 + 4 * q] += xv * e.z; acc[7 + 4 * q] += xv * e.w; }
    }
#pragma unroll
    for (int o = 0; o < 36; ++o) acc[o] = wave_sum(acc[o]);
    if (lane == 0) {
        float gl[4]; int gi = 0; float gmax;
#pragma unroll
        for (int j = 0; j < 4; ++j) { gl[j] = acc[j] + bg[j]; }
        gmax = gl[0];
#pragma unroll
        for (int j = 1; j < 4; ++j) if (gl[j] > gmax) { gmax = gl[j]; gi = j; }
        float gs = 0.f;
#pragma unroll
        for (int j = 0; j < 4; ++j) gs += __expf(gl[j] - gmax);
        const float gw = 1.f / gs;
        float el[8];
#pragma unroll
        for (int j = 0; j < 8; ++j) {
            float v = 0.f;
#pragma unroll
            for (int g = 0; g < 4; ++g) if (g == gi) v = acc[4 + g * 8 + j] + be[g * 8 + j];
            el[j] = v;
        }
        int i0 = 0; float v0 = el[0];
#pragma unroll
        for (int j = 1; j < 8; ++j) if (el[j] > v0) { v0 = el[j]; i0 = j; }
        int i1 = -1; float v1 = -INFINITY;
#pragma unroll
        for (int j = 0; j < 8; ++j) if (j != i0 && el[j] > v1) { v1 = el[j]; i1 = j; }
        const float e1 = __expf(v1 - v0);
        const float p0 = 1.f / (1.f + e1), p1 = e1 / (1.f + e1);
        const int ex0 = gi * 8 + i0, ex1 = gi * 8 + i1;
        RE[t * 2 + 0] = ex0; RE[t * 2 + 1] = ex1;
        RW[t * 2 + 0] = gw * p0; RW[t * 2 + 1] = gw * p1;
        atomicAdd(&counts[ex0], 1); atomicAdd(&counts[ex1], 1);
    }
}

__device__ __forceinline__ void b_moe_scan(int* __restrict__ ctl, int* __restrict__ TILEE, int tid, unsigned char* sm) {
    int* pst = (int*)sm;
    if (tid == 0) { int run = 0; for (int e = 0; e < N_EXP; ++e) { pst[e] = run; ctl[64 + e] = run; ctl[32 + e] = 0; run += (ctl[e] + MOE_PAD - 1) / MOE_PAD * MOE_PAD; } pst[32] = run; ctl[96] = run / MOE_PAD; }
    __syncthreads();
    for (int tile = tid; tile < N_TILES; tile += NTHREADS) {
        const int p = tile * MOE_PAD; int e = -1;
        for (int j = 0; j < N_EXP; ++j) if (p >= pst[j] && p < pst[j + 1]) e = j;
        TILEE[tile] = e;
    }
}

__device__ __forceinline__ void b_moe_gemm1(const bf16_t* __restrict__ XN, const float* __restrict__ Wg, const float* __restrict__ Wu, const int* __restrict__ ROWTOK, const int* __restrict__ TILEE, bf16_t* __restrict__ HDN,
                                            int vbx, int vby, int vt, unsigned char* sm) {
    As_t As = (As_t)sm; Bs_t Bs = (Bs_t)(sm + 64 * 40 * 2);
    const int e_raw = TILEE[vby];
    const int e = e_raw < 0 ? 0 : e_raw;
    const int lane = vt & 63, wid = vt >> 6, wr = wid >> 1, wc = wid & 1;
    const int p0 = vby * 64, n0 = vbx * 64;
    const int a = ROWTOK[p0 + (vt >> 2)];
    f32x4 acc[2][2][2];
#pragma unroll
    for (int b = 0; b < 2; ++b)
#pragma unroll
        for (int i = 0; i < 2; ++i)
#pragma unroll
            for (int j = 0; j < 2; ++j) acc[b][i][j] = (f32x4){0.f, 0.f, 0.f, 0.f};
    gemm_core64<2>(a >= 0 ? XN + (size_t)(a >> 1) * DM : nullptr, Wg + (size_t)e * DM * D_EXP, Wu + (size_t)e * DM * D_EXP, D_EXP, n0, D_EXP, DM, acc, As, Bs, vt);
    if (e_raw < 0) return;
#pragma unroll
    for (int i = 0; i < 2; ++i)
#pragma unroll
        for (int j = 0; j < 2; ++j)
#pragma unroll
            for (int r = 0; r < 4; ++r) {
                const int row = p0 + wr * 32 + i * 16 + (lane >> 4) * 4 + r, col = n0 + wc * 32 + j * 16 + (lane & 15);
                const float g = acc[0][i][j][r], u = acc[1][i][j][r];
                HDN[(size_t)row * D_EXP + col] = f2bf(g * sigmoidf_(g) * u);
            }
}
__device__ __forceinline__ void b_moe_gemm2(const bf16_t* __restrict__ HDN, const float* __restrict__ Wd, const int* __restrict__ ROWTOK, const int* __restrict__ TILEE, const float* __restrict__ RW, bf16_t* __restrict__ YB,
                                            int vbx, int vby, int vt, unsigned char* sm) {
    As_t As = (As_t)sm; Bs_t Bs = (Bs_t)(sm + 64 * 40 * 2);
    const int e_raw = TILEE[vby];
    const int e = e_raw < 0 ? 0 : e_raw;
    const int lane = vt & 63, wid = vt >> 6, wr = wid >> 1, wc = wid & 1;
    const int p0 = vby * 64, n0 = vbx * 64;
    f32x4 acc[1][2][2];
#pragma unroll
    for (int i = 0; i < 2; ++i)
#pragma unroll
        for (int j = 0; j < 2; ++j) acc[0][i][j] = (f32x4){0.f, 0.f, 0.f, 0.f};
    const int arow = ROWTOK[p0 + (vt >> 2)];
    gemm_core64<1>((arow >= 0 && e_raw >= 0) ? HDN + (size_t)(p0 + (vt >> 2)) * D_EXP : nullptr, Wd + (size_t)e * D_EXP * DM, nullptr, DM, n0, DM, D_EXP, acc, As, Bs, vt);
    if (e_raw < 0) return;
#pragma unroll
    for (int i = 0; i < 2; ++i)
#pragma unroll
        for (int r = 0; r < 4; ++r) {
            const int row = p0 + wr * 32 + i * 16 + (lane >> 4) * 4 + r;
            const int a = ROWTOK[row];
            if (a < 0) continue;
            const float w = RW[a];
#pragma unroll
            for (int j = 0; j < 2; ++j) { const int col = n0 + wc * 32 + j * 16 + (lane & 15); YB[(size_t)a * DM + col] = f2bf(w * acc[0][i][j][r]); }
        }
}
__device__ __forceinline__ void b_final(float* __restrict__ out, const bf16_t* __restrict__ X2B, const unsigned char* __restrict__ YB, size_t i) {
    const size_t t = i / DM, c = i % DM;
    const uint4 xv = *(const uint4*)(X2B + i); const uint2 y0 = *(const uint2*)(YB + (2 * t) * DM + c), y1 = *(const uint2*)(YB + (2 * t + 1) * DM + c);
    const unsigned xs[4] = {xv.x, xv.y, xv.z, xv.w};
    f32x4 o0, o1;
    o0[0] = __uint_as_float(xs[0] << 16) + 0.0625f * (__builtin_amdgcn_cvt_f32_fp8(y0.x, 0) + __builtin_amdgcn_cvt_f32_fp8(y1.x, 0));
    o0[1] = __uint_as_float(xs[0] & 0xffff0000u) + 0.0625f * (__builtin_amdgcn_cvt_f32_fp8(y0.x, 1) + __builtin_amdgcn_cvt_f32_fp8(y1.x, 1));
    o0[2] = __uint_as_float(xs[1] << 16) + 0.0625f * (__builtin_amdgcn_cvt_f32_fp8(y0.x, 2) + __builtin_amdgcn_cvt_f32_fp8(y1.x, 2));
    o0[3] = __uint_as_float(xs[1] & 0xffff0000u) + 0.0625f * (__builtin_amdgcn_cvt_f32_fp8(y0.x, 3) + __builtin_amdgcn_cvt_f32_fp8(y1.x, 3));
    o1[0] = __uint_as_float(xs[2] << 16) + 0.0625f * (__builtin_amdgcn_cvt_f32_fp8(y0.y, 0) + __builtin_amdgcn_cvt_f32_fp8(y1.y, 0));
    o1[1] = __uint_as_float(xs[2] & 0xffff0000u) + 0.0625f * (__builtin_amdgcn_cvt_f32_fp8(y0.y, 1) + __builtin_amdgcn_cvt_f32_fp8(y1.y, 1));
    o1[2] = __uint_as_float(xs[3] << 16) + 0.0625f * (__builtin_amdgcn_cvt_f32_fp8(y0.y, 2) + __builtin_amdgcn_cvt_f32_fp8(y1.y, 2));
    o1[3] = __uint_as_float(xs[3] & 0xffff0000u) + 0.0625f * (__builtin_amdgcn_cvt_f32_fp8(y0.y, 3) + __builtin_amdgcn_cvt_f32_fp8(y1.y, 3));
    *(f32x4*)(out + i) = o0; *(f32x4*)(out + i + 4) = o1;
}

namespace pg8 {
typedef unsigned u32x4 __attribute__((ext_vector_type(4)));
typedef unsigned u32x2 __attribute__((ext_vector_type(2)));
typedef int v4i_t __attribute__((ext_vector_type(4)));
typedef int v8i_t __attribute__((ext_vector_type(8)));
constexpr int BM = 256, BK = 64, HALF = 128, HTB = HALF * BK * 2, STAGE_BYTES = 8 * HTB, NXCD = 8, WGM = 8;
__host__ __device__ __forceinline__ int lds_byte(int r, int c) { const int st = (r >> 4) * 2 + (c >> 5), rr = r & 15, cc = c & 31, ob = rr * 64 + cc * 2; return st * 1024 + (ob ^ (((ob >> 9) & 1) << 5)); }
__host__ __device__ __forceinline__ void stage_rc(int b, int& R, int& C) { const int st = b / 1024, sb = b % 1024, swz = sb ^ (((sb >> 9) & 1) << 5); R = (st >> 1) * 16 + swz / 64; C = (st & 1) * 32 + (swz % 64) / 2; }
__host__ __device__ __forceinline__ int perm32(int rho) { const int n = rho >> 4, i = rho & 15; return 8 * (i >> 2) + 4 * n + (i & 3); }
struct Unit { int pm, pn, e, r0, cnt; };
struct Gemm { const void* A; const void* Bt; int lda, ldb, K; size_t astride, bstride; int scale_a, scale_b; };
struct StaticOrder {
    static constexpr bool GATHER = false; static constexpr int ESZ = 2;
    int nM, nN, nwg, G, c, i0, i1;
    __device__ void init(int M, int N, int G_, int c_, int i0_ = 0, int i1_ = 1 << 30) { nM = M / BM; nN = N / BM; nwg = nM * nN; G = G_; c = c_; i0 = i0_; i1 = i1_; }
    __device__ bool next(int i, Unit& u) const {
        i += i0; if (i >= i1) return false;
        const long L = (long)i * G + c; if (L >= nwg) return false;
        int wgid = (int)L; { const int q = nwg / NXCD, r = nwg % NXCD, xcd = wgid % NXCD, off = wgid / NXCD; wgid = (xcd < r ? xcd * (q + 1) : r * (q + 1) + (xcd - r) * q) + off; }
        const int nig = WGM * nN, gid = wgid / nig, fm = gid * WGM, gsz = (nM - fm) < WGM ? (nM - fm) : WGM;
        u.pm = fm + ((wgid % nig) % gsz); u.pn = (wgid % nig) / gsz; u.e = 0; return true;
    }
};
__device__ __forceinline__ unsigned cvt_pk_bf16(float lo, float hi) { unsigned r; asm volatile("v_cvt_pk_bf16_f32 %0, %1, %2" : "=v"(r) : "v"(lo), "v"(hi)); return r; }

template <class Epi, class Sched, bool ALIGN_EPI>
__device__ __forceinline__ void gemm_phase(LAS unsigned char* lds, const Gemm g, const Sched& S, const Epi& E) {
    int tid = threadIdx.x; asm volatile("" : "+v"(tid));
    const int wid = __builtin_amdgcn_readfirstlane(tid >> 6), lane = tid & 63, wr = wid >> 2, wc = wid & 3, fr = lane & 15, fq = lane >> 4;
    constexpr int ESZ = Sched::ESZ;
    const int K = g.K, nt = K * ESZ / (BK * 2);
    unsigned voffA[2], voffB[2];
#pragma unroll
    for (int i = 0; i < 2; ++i) { int R, C; stage_rc(tid * 16 + i * 8192, R, C); const int Rb = Epi::PERM ? ((R & ~31) + perm32(R & 31)) : R;
        voffA[i] = (unsigned)(R * g.lda * ESZ + C * 2); voffB[i] = (unsigned)(Rb * g.ldb * ESZ + C * 2); }
    const size_t kstep = (size_t)(BK * 2);
    const size_t hstepA = (size_t)HALF * g.lda * ESZ, tstepA = 2 * hstepA;
    const size_t hstepB = (size_t)HALF * g.ldb * ESZ, tstepB = 2 * hstepB;
    const unsigned ldsw = (unsigned)wid * 1024u;
    const int aoff = lds_byte(wr * 64 + fr, ESZ == 2 ? fq * 8 : fq * 16), boff = lds_byte(wc * 32 + fr, ESZ == 2 ? fq * 8 : fq * 16);
    constexpr int PIECE1 = ESZ == 2 ? 1024 : 16;
    unsigned la_ = (unsigned)(size_t)(lds + aoff), lb_ = (unsigned)(size_t)(lds + 65536 + boff);
    asm volatile("" : "+v"(la_), "+v"(lb_));
    const LAS unsigned char* ldsA = (const LAS unsigned char*)(size_t)la_; const LAS unsigned char* ldsB = (const LAS unsigned char*)(size_t)lb_;
#define PG8_SA(b, h) (((b) * 2 + (h)) * HTB)
#define PG8_SB(b, h) ((4 + (b) * 2 + (h)) * HTB)
#define PG8_STAGE(bufoff, gbase, voff) do { _Pragma("unroll") for (int _i = 0; _i < 2; ++_i) \
        __builtin_amdgcn_global_load_lds((const unsigned*)((const char*)(gbase) + (voff)[_i]), (LAS unsigned*)(lds + (bufoff) + ldsw + _i * 8192), 16, 0, 0); } while (0)
#define PG8_LDA(dst, b, h) do { _Pragma("unroll") for (int m = 0; m < 4; ++m) { dst[m][0] = *(const LAS bf16x8*)(ldsA + PG8_SA(b, h) + m * 2048); dst[m][1] = *(const LAS bf16x8*)(ldsA + PG8_SA(b, h) + m * 2048 + PIECE1); } } while (0)
#define PG8_LDB(dst, b, h) do { _Pragma("unroll") for (int n = 0; n < 2; ++n) { dst[n][0] = *(const LAS bf16x8*)(ldsB + (PG8_SB(b, h) - 65536) + n * 2048); dst[n][1] = *(const LAS bf16x8*)(ldsB + (PG8_SB(b, h) - 65536) + n * 2048 + PIECE1); } } while (0)
#define PG8_V8(x) __builtin_shufflevector(__builtin_bit_cast(v4i_t, (x)[0]), __builtin_bit_cast(v4i_t, (x)[1]), 0, 1, 2, 3, 4, 5, 6, 7)
#define PG8_MMA(ai, bj, At, Bt) do { __builtin_amdgcn_s_setprio(1); _Pragma("unroll") for (int m = 0; m < 4; ++m) _Pragma("unroll") for (int n = 0; n < 2; ++n) { \
        if constexpr (ESZ == 2) { _Pragma("unroll") for (int k = 0; k < 2; ++k) acc[ai][bj][m][n] = __builtin_amdgcn_mfma_f32_16x16x32_bf16(Bt[n][k], At[m][k], acc[ai][bj][m][n], 0, 0, 0); } \
        else { acc[ai][bj][m][n] = __builtin_amdgcn_mfma_scale_f32_16x16x128_f8f6f4(PG8_V8(Bt[n]), PG8_V8(At[m]), acc[ai][bj][m][n], 0, 0, 0, g.scale_b, 0, g.scale_a); \
               asm volatile("" : "+v"(acc[ai][bj][m][n])); } }     \
        __builtin_amdgcn_s_setprio(0); } while (0)
#define PG8_WAIT_V(n) asm volatile("s_waitcnt vmcnt(" #n ")" ::: "memory")
#define PG8_WAIT_L(n) asm volatile("s_waitcnt lgkmcnt(" #n ")" ::: "memory")
#define PG8_BAR __builtin_amdgcn_s_barrier()
#define PG8_SCHED __builtin_amdgcn_sched_barrier(0)
    Unit cur, nxt; int ui = 0;
    if (!S.next(0, cur)) return;
    f32x4 acc[2][2][4][2];
#pragma unroll
    for (int a = 0; a < 2; ++a)
#pragma unroll
        for (int b = 0; b < 2; ++b)
#pragma unroll
            for (int m = 0; m < 4; ++m)
#pragma unroll
                for (int n = 0; n < 2; ++n) acc[a][b][m][n] = (f32x4){0.f, 0.f, 0.f, 0.f};
    bf16x8 At[4][2], B0[2][2], B1[2][2];
    constexpr bool GATHER = Sched::GATHER;
    const size_t hsA = GATHER ? 0 : hstepA;
    unsigned c0[2], c1[2], n0[2], n1[2];
    if constexpr (GATHER) { S.a_offsets(cur, tid, g.lda, c0, c1); n0[0] = c0[0]; n0[1] = c0[1]; n1[0] = c1[0]; n1[1] = c1[1]; }
#define PG8_C0 (GATHER ? c0 : voffA)
#define PG8_C1 (GATHER ? c1 : voffA)
    const char* cA = (const char*)g.A + (GATHER ? (size_t)0 : ((size_t)cur.e * g.astride) * ESZ + (size_t)cur.pm * tstepA); const char* cB = (const char*)g.Bt + ((size_t)cur.e * g.bstride) * ESZ + (size_t)cur.pn * tstepB;
    PG8_STAGE(PG8_SB(0, 0), cB, voffB); PG8_STAGE(PG8_SB(0, 1), cB + hstepB, voffB); PG8_STAGE(PG8_SA(0, 0), cA, PG8_C0); PG8_STAGE(PG8_SA(0, 1), cA + hsA, PG8_C1);
    if (wr == 1) PG8_BAR;
    PG8_WAIT_V(2); PG8_BAR;
    PG8_STAGE(PG8_SB(1, 0), cB + kstep, voffB); PG8_STAGE(PG8_SA(1, 0), cA + kstep, PG8_C0); PG8_STAGE(PG8_SB(1, 1), cB + hstepB + kstep, voffB);
    PG8_WAIT_V(6); PG8_BAR;
    for (;;) {
        const bool has_next = S.next(ui + 1, nxt);
        const char* nA = (has_next && !GATHER) ? (const char*)g.A + ((size_t)nxt.e * g.astride) * ESZ + (size_t)nxt.pm * tstepA : cA; const char* nB = has_next ? (const char*)g.Bt + ((size_t)nxt.e * g.bstride) * ESZ + (size_t)nxt.pn * tstepB : cB;
        if constexpr (GATHER) { if (has_next) S.a_offsets(nxt, tid, g.lda, n0, n1); }
#pragma unroll 1
        for (int t = 0; t < nt; t += 2) {
            const bool last = (t == nt - 2);
            const char* a1 = cA + (size_t)(t + 1) * kstep;
            const char* a2 = last ? nA : cA + (size_t)(t + 2) * kstep; const char* b2 = last ? nB : cB + (size_t)(t + 2) * kstep;
            const char* a3 = a2 + kstep; const char* b3 = b2 + kstep;
            unsigned s0[2], s1[2];
            if constexpr (GATHER) {
#pragma unroll
                for (int i_ = 0; i_ < 2; ++i_) { s0[i_] = last ? n0[i_] : c0[i_]; s1[i_] = last ? n1[i_] : c1[i_]; }
            }
#define PG8_S0 (GATHER ? s0 : voffA)
#define PG8_S1 (GATHER ? s1 : voffA)
            PG8_LDB(B0, 0, 0); PG8_LDB(B1, 0, 1); PG8_SCHED; PG8_LDA(At, 0, 0); PG8_STAGE(PG8_SA(1, 1), a1 + hsA, PG8_C1);
            PG8_WAIT_V(8); PG8_WAIT_L(0); PG8_BAR; PG8_MMA(0, 0, At, B0); PG8_MMA(0, 1, At, B1); PG8_BAR; PG8_SCHED;
            PG8_LDA(At, 0, 1); PG8_STAGE(PG8_SB(0, 0), b2, voffB); PG8_STAGE(PG8_SB(0, 1), b2 + hstepB, voffB); PG8_STAGE(PG8_SA(0, 0), a2, PG8_S0);
            PG8_WAIT_V(8); PG8_WAIT_L(0); PG8_BAR; PG8_MMA(1, 0, At, B0); PG8_MMA(1, 1, At, B1); PG8_BAR; PG8_SCHED;
            PG8_LDB(B0, 1, 0); PG8_LDB(B1, 1, 1); PG8_SCHED; PG8_LDA(At, 1, 0); PG8_STAGE(PG8_SA(0, 1), a2 + hsA, PG8_S1);
            PG8_WAIT_V(8); PG8_WAIT_L(0); PG8_BAR; PG8_MMA(0, 0, At, B0); PG8_MMA(0, 1, At, B1); PG8_BAR; PG8_SCHED;
            PG8_LDA(At, 1, 1); PG8_STAGE(PG8_SB(1, 0), b3, voffB); PG8_STAGE(PG8_SB(1, 1), b3 + hstepB, voffB); PG8_STAGE(PG8_SA(1, 0), a3, PG8_S0);
            PG8_WAIT_V(8); PG8_WAIT_L(0); PG8_BAR; PG8_MMA(1, 0, At, B0); PG8_MMA(1, 1, At, B1); PG8_BAR; PG8_SCHED;
        }
        if constexpr (ALIGN_EPI) { if (wr == 0) PG8_BAR; }
        bool chained = false;
        {
            int te = threadIdx.x; asm volatile("" : "+v"(te));
            const int le = te & 63, fre = le & 15, fqe = le >> 4, we = __builtin_amdgcn_readfirstlane(te >> 6), wre = we >> 2, wce = we & 3;
            if constexpr (Epi::CHAIN) chained = E.chain(acc, cur, wre, wce, fre, fqe);
            if (!chained) E(acc, cur, wre, wce, fre, fqe);
        }
        if (!has_next) break;
        if (!chained) {
#pragma unroll
        for (int a = 0; a < 2; ++a)
#pragma unroll
            for (int b = 0; b < 2; ++b)
#pragma unroll
                for (int m = 0; m < 4; ++m)
#pragma unroll
                    for (int n = 0; n < 2; ++n) acc[a][b][m][n] = (f32x4){0.f, 0.f, 0.f, 0.f};
        }
        cur = nxt; cA = nA; cB = nB; ++ui; if constexpr (GATHER) { c0[0] = n0[0]; c0[1] = n0[1]; c1[0] = n1[0]; c1[1] = n1[1]; }
        if constexpr (ALIGN_EPI) { if (wr == 1) PG8_BAR; }
    }
    PG8_WAIT_V(0);
    if constexpr (!ALIGN_EPI) { if (wr == 0) PG8_BAR; }
    PG8_BAR;
#undef PG8_SA
#undef PG8_SB
#undef PG8_STAGE
#undef PG8_LDA
#undef PG8_LDB
#undef PG8_MMA
#undef PG8_V8
#undef PG8_C0
#undef PG8_C1
#undef PG8_S0
#undef PG8_S1
#undef PG8_WAIT_V
#undef PG8_WAIT_L
#undef PG8_BAR
#undef PG8_SCHED
}

struct EpiInProj {
    static constexpr bool PERM = true, CHAIN = false;
    bf16_t* U; const float *qg, *kg;
    static constexpr size_t SEC_STRIDE = (size_t)16 << 20;
    __device__ __forceinline__ void operator()(const f32x4 (&acc)[2][2][4][2], const Unit& u, int wr, int wc, int fr, int fq) const {
        const int sec = u.pn >> 1, row0 = u.pm * BM + wr * 64 + fr;
        bf16_t* base = U + (size_t)sec * SEC_STRIDE;
        if (sec == 2 || sec == 3) {
            const bool isq = (sec == 2); const float sc = isq ? 0.125f * LOG2E : 1.0f;
            const int head = 4 * (u.pn & 1) + wc;
            const f32x4 q00 = *(const f32x4*)(qg + 8 * fq), q01 = *(const f32x4*)(qg + 8 * fq + 4), q10 = *(const f32x4*)(qg + 32 + 8 * fq), q11 = *(const f32x4*)(qg + 32 + 8 * fq + 4);
            const f32x4 k00 = *(const f32x4*)(kg + 8 * fq), k01 = *(const f32x4*)(kg + 8 * fq + 4), k10 = *(const f32x4*)(kg + 32 + 8 * fq), k11 = *(const f32x4*)(kg + 32 + 8 * fq + 4);
            const f32x4 gv00 = isq ? q00 : k00, gv01 = isq ? q01 : k01, gv10 = isq ? q10 : k10, gv11 = isq ? q11 : k11;
#pragma unroll
            for (int ai = 0; ai < 2; ++ai)
#pragma unroll
                for (int m = 0; m < 4; ++m) {
                    float ss = 0.f;
#pragma unroll
                    for (int bj = 0; bj < 2; ++bj)
#pragma unroll
                        for (int n = 0; n < 2; ++n) { const f32x4 x = acc[ai][bj][m][n]; ss += (x[0] * x[0] + x[1] * x[1]) + (x[2] * x[2] + x[3] * x[3]); }
                    ss += __shfl_xor(ss, 16); ss += __shfl_xor(ss, 32);
                    const float rs = rsqrtf(ss * (1.f / 64.f) + EPS) * sc;
                    bf16_t* rowp = base + (size_t)(row0 + ai * HALF + m * 16) * 512 + head * 64 + 8 * fq;
#pragma unroll
                    for (int bj = 0; bj < 2; ++bj) { const f32x4 v0 = acc[ai][bj][m][0] * rs * (bj ? gv10 : gv00), v1 = acc[ai][bj][m][1] * rs * (bj ? gv11 : gv01);
                        u32x4 w; w.x = cvt_pk_bf16(v0[0], v0[1]); w.y = cvt_pk_bf16(v0[2], v0[3]); w.z = cvt_pk_bf16(v1[0], v1[1]); w.w = cvt_pk_bf16(v1[2], v1[3]);
                        *(u32x4*)(rowp + bj * 32) = w; }
                }
        } else {
            const int col0 = (u.pn & 1) * BM + wc * 32 + 8 * fq;
#pragma unroll
            for (int ai = 0; ai < 2; ++ai)
#pragma unroll
                for (int m = 0; m < 4; ++m) { bf16_t* rowp = base + (size_t)(row0 + ai * HALF + m * 16) * 512 + col0;
#pragma unroll
                    for (int bj = 0; bj < 2; ++bj) { const f32x4 v0 = acc[ai][bj][m][0], v1 = acc[ai][bj][m][1];
                        u32x4 w; w.x = cvt_pk_bf16(v0[0], v0[1]); w.y = cvt_pk_bf16(v0[2], v0[3]); w.z = cvt_pk_bf16(v1[0], v1[1]); w.w = cvt_pk_bf16(v1[2], v1[3]);
                        *(u32x4*)(rowp + bj * HALF) = w; } }
        }
    }
};
struct EpiBf16 {
    static constexpr bool PERM = true, CHAIN = false;
    bf16_t *O0, *O1; int ldo, split;
    __device__ __forceinline__ void operator()(const f32x4 (&acc)[2][2][4][2], const Unit& u, int wr, int wc, int fr, int fq) const {
        int colt = u.pn * BM; bf16_t* base = O0; if (colt >= split) { colt -= split; base = O1; }
        const int row0 = u.pm * BM + wr * 64 + fr, col0 = colt + wc * 32 + 8 * fq;
#pragma unroll
        for (int ai = 0; ai < 2; ++ai)
#pragma unroll
            for (int m = 0; m < 4; ++m) { bf16_t* rowp = base + (size_t)(row0 + ai * HALF + m * 16) * ldo + col0;
#pragma unroll
                for (int bj = 0; bj < 2; ++bj) { const f32x4 v0 = acc[ai][bj][m][0], v1 = acc[ai][bj][m][1];
                    u32x4 w; w.x = cvt_pk_bf16(v0[0], v0[1]); w.y = cvt_pk_bf16(v0[2], v0[3]); w.z = cvt_pk_bf16(v1[0], v1[1]); w.w = cvt_pk_bf16(v1[2], v1[3]);
                    *(u32x4*)(rowp + bj * HALF) = w; } }
    }
};
struct EpiResF32 {
    static constexpr bool PERM = false, CHAIN = false;
    const float* base; float* out;
    __device__ __forceinline__ void operator()(const f32x4 (&acc)[2][2][4][2], const Unit& u, int wr, int wc, int fr, int fq) const {
        const int row0 = u.pm * BM + wr * 64 + fr, col0 = u.pn * BM + wc * 32 + 4 * fq;
#pragma unroll
        for (int ai = 0; ai < 2; ++ai)
#pragma unroll
            for (int m = 0; m < 4; ++m) { const size_t off = (size_t)(row0 + ai * HALF + m * 16) * DM + col0;
#pragma unroll
                for (int bj = 0; bj < 2; ++bj)
#pragma unroll
                    for (int n = 0; n < 2; ++n) *(f32x4*)(out + off + bj * HALF + n * 16) = *(const f32x4*)(base + off + bj * HALF + n * 16) + acc[ai][bj][m][n]; }
    }
};


struct PairOrder {
    static constexpr bool GATHER = false; static constexpr int ESZ = 2;
    StaticOrder so;
    __device__ void init(int M, int N, int G_, int c_) { so.init(M, N, G_, c_); }
    __device__ bool next(int i, Unit& u) const { if (!so.next(i >> 1, u)) return false; u.e = i & 1; return true; }
};
__device__ __forceinline__ float rstd8(const float* p, float inv_n) { const f32x4 a = *(const f32x4*)p, b = *(const f32x4*)(p + 4); return rsqrtf(((a[0] + a[1]) + (a[2] + a[3]) + (b[0] + b[1]) + (b[2] + b[3])) * inv_n + EPS); }
__device__ __forceinline__ float rstd16(const float* p, float inv_n) { float t = 0.f;
#pragma unroll
    for (int i = 0; i < 4; ++i) { const f32x4 a = *(const f32x4*)(p + 4 * i); t += (a[0] + a[1]) + (a[2] + a[3]); } return rsqrtf(t * inv_n + EPS); }
struct EpiOutChain {
    static constexpr bool PERM = false, CHAIN = true;
    const float* x; bf16_t* x1b; const float* SSL; const float* SSF; float* SS1;
    __device__ __forceinline__ bool chain(f32x4 (&acc)[2][2][4][2], const Unit& u, int wr, int wc, int fr, int fq) const {
        if (u.e != 0) return false;
        const int row0 = u.pm * BM + wr * 64 + fr;
        float ratio[8];
#pragma unroll
        for (int i = 0; i < 8; ++i) { const int row = row0 + (i >> 2) * HALF + (i & 3) * 16; ratio[i] = rstd8(SSL + (size_t)row * 8, 1.f / 512.f) / rstd8(SSF + (size_t)row * 8, 1.f / 512.f); }
#pragma unroll
        for (int ai = 0; ai < 2; ++ai)
#pragma unroll
            for (int m = 0; m < 4; ++m)
#pragma unroll
                for (int bj = 0; bj < 2; ++bj)
#pragma unroll
                    for (int n = 0; n < 2; ++n) acc[ai][bj][m][n] *= ratio[ai * 4 + m];
        return true;
    }
    __device__ __forceinline__ void operator()(const f32x4 (&acc)[2][2][4][2], const Unit& u, int wr, int wc, int fr, int fq) const {
        const int row0 = u.pm * BM + wr * 64 + fr, col0 = u.pn * BM + wc * 32 + 4 * fq;
        float rfv[8];
#pragma unroll
        for (int i = 0; i < 8; ++i) rfv[i] = rstd8(SSF + (size_t)(row0 + (i >> 2) * HALF + (i & 3) * 16) * 8, 1.f / 512.f);
#pragma unroll
        for (int pr = 0; pr < 4; ++pr) {
            const int ai = pr >> 1;
            f32x4 xv[2][2][2];
#pragma unroll
            for (int mm = 0; mm < 2; ++mm)
#pragma unroll
                for (int bj = 0; bj < 2; ++bj)
#pragma unroll
                    for (int n = 0; n < 2; ++n) xv[mm][bj][n] = *(const f32x4*)(x + (size_t)(row0 + ai * HALF + (2 * (pr & 1) + mm) * 16) * DM + col0 + bj * HALF + n * 16);
            asm volatile("" ::: "memory");
#pragma unroll
            for (int mm = 0; mm < 2; ++mm) { const int m = 2 * (pr & 1) + mm; const int row = row0 + ai * HALF + m * 16; const size_t off = (size_t)row * DM + col0;
                const float rf = rfv[ai * 4 + m]; float ss = 0.f;
#pragma unroll
                for (int bj = 0; bj < 2; ++bj)
#pragma unroll
                    for (int n = 0; n < 2; ++n) { const f32x4 v = xv[mm][bj][n] + acc[ai][bj][m][n] * rf;
                        ss += (v[0] * v[0] + v[1] * v[1]) + (v[2] * v[2] + v[3] * v[3]);
                        u32x2 w; w.x = cvt_pk_bf16(v[0], v[1]); w.y = cvt_pk_bf16(v[2], v[3]); *(u32x2*)(x1b + off + bj * HALF + n * 16) = w; }
                ss += __shfl_xor(ss, 16); ss += __shfl_xor(ss, 32);
                if (fq == 0) SS1[(size_t)row * 16 + u.pn * 4 + wc] = ss; }
        }
    }
};
struct EpiRowScale {
    static constexpr bool PERM = true, CHAIN = false;
    bf16_t* O; int ldo; const float* SS; float inv_n;
    __device__ __forceinline__ void operator()(const f32x4 (&acc)[2][2][4][2], const Unit& u, int wr, int wc, int fr, int fq) const {
        const int row0 = u.pm * BM + wr * 64 + fr, col0 = u.pn * BM + wc * 32 + 8 * fq;
        float rsv[8];
#pragma unroll
        for (int i = 0; i < 8; ++i) rsv[i] = rstd16(SS + (size_t)(row0 + (i >> 2) * HALF + (i & 3) * 16) * 16, inv_n);
#pragma unroll
        for (int ai = 0; ai < 2; ++ai)
#pragma unroll
            for (int m = 0; m < 4; ++m) { const int row = row0 + ai * HALF + m * 16; const float rs = rsv[ai * 4 + m]; bf16_t* rowp = O + (size_t)row * ldo + col0;
#pragma unroll
                for (int bj = 0; bj < 2; ++bj) { const f32x4 v0 = acc[ai][bj][m][0] * rs, v1 = acc[ai][bj][m][1] * rs;
                    u32x4 w; w.x = cvt_pk_bf16(v0[0], v0[1]); w.y = cvt_pk_bf16(v0[2], v0[3]); w.z = cvt_pk_bf16(v1[0], v1[1]); w.w = cvt_pk_bf16(v1[2], v1[3]);
                    *(u32x4*)(rowp + bj * HALF) = w; } }
    }
};

__device__ __forceinline__ float clamp_fp8(float v) { return __builtin_amdgcn_fmed3f(v, -448.f, 448.f); }
__device__ __forceinline__ unsigned cvt4_fp8(float a, float b, float c, float d) { int w = 0; w = __builtin_amdgcn_cvt_pk_fp8_f32(clamp_fp8(a), clamp_fp8(b), w, false); w = __builtin_amdgcn_cvt_pk_fp8_f32(clamp_fp8(c), clamp_fp8(d), w, true); return (unsigned)w; }
struct EpiX2 {
    static constexpr bool PERM = true, CHAIN = false;
    const bf16_t* x1b; bf16_t* xb; unsigned char* xq; float* SS;
    __device__ __forceinline__ void operator()(const f32x4 (&acc)[2][2][4][2], const Unit& u, int wr, int wc, int fr, int fq) const {
        const int row0 = u.pm * BM + wr * 64 + fr, col0 = u.pn * BM + wc * 32 + 8 * fq;
#pragma unroll
        for (int ai = 0; ai < 2; ++ai) {
            u32x4 xrv[4][2];
#pragma unroll
            for (int m = 0; m < 4; ++m)
#pragma unroll
                for (int bj = 0; bj < 2; ++bj) xrv[m][bj] = *(const u32x4*)(x1b + (size_t)(row0 + ai * HALF + m * 16) * DM + col0 + bj * HALF);
            asm volatile("" ::: "memory");
#pragma unroll
            for (int m = 0; m < 4; ++m) { const int row = row0 + ai * HALF + m * 16; const size_t off = (size_t)row * DM + col0; float ss = 0.f;
#pragma unroll
                for (int bj = 0; bj < 2; ++bj) { const u32x4 xr = xrv[m][bj];
                    f32x4 v0 = acc[ai][bj][m][0], v1 = acc[ai][bj][m][1];
                    v0[0] += __uint_as_float(xr.x << 16); v0[1] += __uint_as_float(xr.x & 0xffff0000u); v0[2] += __uint_as_float(xr.y << 16); v0[3] += __uint_as_float(xr.y & 0xffff0000u);
                    v1[0] += __uint_as_float(xr.z << 16); v1[1] += __uint_as_float(xr.z & 0xffff0000u); v1[2] += __uint_as_float(xr.w << 16); v1[3] += __uint_as_float(xr.w & 0xffff0000u);
                    ss += (v0[0] * v0[0] + v0[1] * v0[1]) + (v0[2] * v0[2] + v0[3] * v0[3]) + (v1[0] * v1[0] + v1[1] * v1[1]) + (v1[2] * v1[2] + v1[3] * v1[3]);
                    u32x4 w; w.x = cvt_pk_bf16(v0[0], v0[1]); w.y = cvt_pk_bf16(v0[2], v0[3]); w.z = cvt_pk_bf16(v1[0], v1[1]); w.w = cvt_pk_bf16(v1[2], v1[3]);
                    *(u32x4*)(xb + off + bj * HALF) = w;
                    u32x2 q; q.x = cvt4_fp8(v0[0], v0[1], v0[2], v0[3]); q.y = cvt4_fp8(v1[0], v1[1], v1[2], v1[3]); *(u32x2*)(xq + off + bj * HALF) = q; }
                ss += __shfl_xor(ss, 16); ss += __shfl_xor(ss, 32);
                if (fq == 0) SS[(size_t)row * 16 + u.pn * 4 + wc] = ss; }
        }
    }
};
template <bool GATHER_>
struct MoeOrder {
    static constexpr bool GATHER = GATHER_; static constexpr int ESZ = 1;
    int nu, G, c; const LAS int* pst  ; const int* LIST;
    __device__ bool next(int i, Unit& u) const {
        const int L = i * G + c; if (L >= nu) return false;
        const int x = L & 7, off = L >> 3, per = nu >> 3, r = nu & 7;
        const int wg = (x < r ? x * (per + 1) : r * (per + 1) + (x - r) * per) + off;
        u.pm = wg >> 2; u.pn = wg & 3;
        const int row = u.pm * BM; const int e = pst[128 + u.pm];
        u.e = e; u.r0 = row - pst[e]; u.cnt = pst[64 + e]; return true;
    }
    __device__ __forceinline__ int assignment(const Unit& u, int r) const { const int rank = u.r0 + r; const bool ok = rank < u.cnt; const int a = LIST[(size_t)u.e * T + (ok ? rank : 0)]; return ok ? a : -1; }
    __device__ __forceinline__ void a_offsets(const Unit& u, int tid, int lda, unsigned (&o0)[2], unsigned (&o1)[2]) const {
#pragma unroll
        for (int i = 0; i < 2; ++i) { int R, C; stage_rc(tid * 16 + i * 8192, R, C);
            const int a0 = assignment(u, R), a1 = assignment(u, HALF + R);
            o0[i] = (unsigned)((a0 < 0 ? 0 : a0 >> 1) * lda * ESZ + C * 2); o1[i] = (unsigned)((a1 < 0 ? 0 : a1 >> 1) * lda * ESZ + C * 2); }
    }
};
struct EpiMoe1 {
    static constexpr bool PERM = true, CHAIN = false;
    unsigned char* HDN; const float* RSTD; MoeOrder<true> S;
    __device__ __forceinline__ void operator()(const f32x4 (&acc)[2][2][4][2], const Unit& u, int wr, int wc, int fr, int fq) const {
        const int r0 = wr * 64 + fr, col0 = u.pn * HALF + wc * 32 + 8 * fq;
        int av[8]; float rsv[8];
#pragma unroll
        for (int i = 0; i < 8; ++i) av[i] = S.assignment(u, r0 + (i >> 2) * HALF + (i & 3) * 16);
#pragma unroll
        for (int i = 0; i < 8; ++i) rsv[i] = RSTD[av[i] < 0 ? 0 : av[i] >> 1];
#pragma unroll
        for (int ai = 0; ai < 2; ++ai)
#pragma unroll
            for (int m = 0; m < 4; ++m) {
                const int r = r0 + ai * HALF + m * 16;
                const float rs = av[ai * 4 + m] < 0 ? 0.f : rsv[ai * 4 + m];
                f32x4 h0, h1;
#pragma unroll
                for (int e = 0; e < 4; ++e) { const float g0 = rs * acc[ai][0][m][0][e], g1 = rs * acc[ai][0][m][1][e];
                    h0[e] = g0 * __builtin_amdgcn_rcpf(1.f + __expf(-g0)) * (rs * acc[ai][1][m][0][e]); h1[e] = g1 * __builtin_amdgcn_rcpf(1.f + __expf(-g1)) * (rs * acc[ai][1][m][1][e]); }
                u32x2 w; w.x = cvt4_fp8(8.f * h0[0], 8.f * h0[1], 8.f * h0[2], 8.f * h0[3]); w.y = cvt4_fp8(8.f * h1[0], 8.f * h1[1], 8.f * h1[2], 8.f * h1[3]);
                *(u32x2*)(HDN + (size_t)(u.pm * BM + r) * D_EXP + col0) = w;
            }
    }
};
struct EpiMoe2 {
    static constexpr bool PERM = true, CHAIN = false;
    unsigned char* YB; const float* RW; MoeOrder<false> S;
    __device__ __forceinline__ void operator()(const f32x4 (&acc)[2][2][4][2], const Unit& u, int wr, int wc, int fr, int fq) const {
        const int r0 = wr * 64 + fr, col0 = u.pn * BM + wc * 32 + 8 * fq;
        int av[8]; float wv[8];
#pragma unroll
        for (int i = 0; i < 8; ++i) av[i] = S.assignment(u, r0 + (i >> 2) * HALF + (i & 3) * 16);
#pragma unroll
        for (int i = 0; i < 8; ++i) wv[i] = RW[av[i] < 0 ? 0 : av[i]];
#pragma unroll
        for (int ai = 0; ai < 2; ++ai)
#pragma unroll
            for (int m = 0; m < 4; ++m) {
                const int a = av[ai * 4 + m];
                const int as = a < 0 ? 0 : a;
                const float w_ = 16.f * wv[ai * 4 + m];
                u32x2 w0, w1;
                { const f32x4 v0 = acc[ai][0][m][0] * w_, v1 = acc[ai][0][m][1] * w_; w0.x = cvt4_fp8(v0[0], v0[1], v0[2], v0[3]); w0.y = cvt4_fp8(v1[0], v1[1], v1[2], v1[3]); }
                { const f32x4 v0 = acc[ai][1][m][0] * w_, v1 = acc[ai][1][m][1] * w_; w1.x = cvt4_fp8(v0[0], v0[1], v0[2], v0[3]); w1.y = cvt4_fp8(v1[0], v1[1], v1[2], v1[3]); }
                unsigned char* rowp = YB + (size_t)as * DM + col0;
                if (a >= 0) { *(u32x2*)rowp = w0; *(u32x2*)(rowp + HALF) = w1; }
                asm volatile("" ::: "memory");
            }
    }
};
}


namespace rtr {
__device__ __forceinline__ void task(int t0, const bf16_t* __restrict__ X2B, const bf16_t* __restrict__ WTR, const float* __restrict__ SS2, const float* __restrict__ bg, const float* __restrict__ be,
                                     float* __restrict__ RW, float* __restrict__ RSTD2, int* __restrict__ cnt, int* __restrict__ LIST, LAS float* lg  , const LAS unsigned char* wr, LAS int* hist  , int lane) {
    int ex0_ = 0, ex1_ = 0, lr0_ = 0, lr1_ = 0;
    const int fr = lane & 15, kq = lane >> 4;
    f32x4 acc[3];
#pragma unroll
    for (int n = 0; n < 3; ++n) acc[n] = (f32x4){0.f, 0.f, 0.f, 0.f};
    const LAS unsigned char* bp0 = wr + fr * 2064 + 16 * kq, *bp1 = wr + (16 + fr) * 2064 + 16 * kq, *bp2 = wr + (32 + (fr & 3)) * 2064 + 16 * kq;
    const bool n2ok = fr < 4;
    LAS unsigned char* xs = (LAS unsigned char*)lg;
#pragma unroll 1
    for (int q = 0; q < 4; ++q) {
#pragma unroll
        for (int i = 0; i < 8; ++i) {
            const int r = 2 * i + (lane >> 5);
            const pg8::u32x4 v = *(const pg8::u32x4*)(X2B + (size_t)(t0 + r) * DM + q * 256 + (lane & 31) * 8);
            *(LAS pg8::u32x4*)(xs + r * 528 + (lane & 31) * 16) = v; }
        asm volatile("s_waitcnt vmcnt(0) lgkmcnt(0)" ::: "memory");
#pragma unroll
        for (int ks = 0; ks < 8; ++ks) {
            const bf16x8 a = *(const LAS bf16x8*)(xs + fr * 528 + ks * 64 + kq * 16);
            const int ko = q * 512 + ks * 64;
            const bf16x8 b0 = *(const LAS bf16x8*)(bp0 + ko), b1 = *(const LAS bf16x8*)(bp1 + ko); bf16x8 b2 = *(const LAS bf16x8*)(bp2 + ko);
            if (!n2ok) b2 = (bf16x8){0, 0, 0, 0, 0, 0, 0, 0};
            acc[0] = __builtin_amdgcn_mfma_f32_16x16x32_bf16(a, b0, acc[0], 0, 0, 0); acc[1] = __builtin_amdgcn_mfma_f32_16x16x32_bf16(a, b1, acc[1], 0, 0, 0); acc[2] = __builtin_amdgcn_mfma_f32_16x16x32_bf16(a, b2, acc[2], 0, 0, 0);
        }
        asm volatile("s_waitcnt lgkmcnt(0)" ::: "memory");
    }
#pragma unroll
    for (int n = 0; n < 3; ++n)
#pragma unroll
        for (int r = 0; r < 4; ++r) lg[(4 * kq + r) * 52 + 16 * n + fr] = acc[n][r];
    asm volatile("s_waitcnt lgkmcnt(0)" ::: "memory");
    if (lane < 16) {
        const int t = t0 + lane;
        const float rs = pg8::rstd16(SS2 + (size_t)t * 16, 1.f / DM);
        float v[36];
#pragma unroll
        for (int q = 0; q < 9; ++q) { const f32x4 x4 = *(const LAS f32x4*)(lg + lane * 52 + 4 * q); v[4 * q] = x4[0] * rs; v[4 * q + 1] = x4[1] * rs; v[4 * q + 2] = x4[2] * rs; v[4 * q + 3] = x4[3] * rs; }
        int gi = 0; float gmax = v[0] + bg[0]; float gl[4];
#pragma unroll
        for (int j = 0; j < 4; ++j) gl[j] = v[j] + bg[j];
#pragma unroll
        for (int j = 1; j < 4; ++j) if (gl[j] > gmax) { gmax = gl[j]; gi = j; }
        float gs = 0.f;
#pragma unroll
        for (int j = 0; j < 4; ++j) gs += __expf(gl[j] - gmax);
        const float gw = 1.f / gs;
        float el[8];
#pragma unroll
        for (int j = 0; j < 8; ++j) { float x = 0.f;
#pragma unroll
            for (int g = 0; g < 4; ++g) if (g == gi) x = v[4 + g * 8 + j] + be[g * 8 + j];
            el[j] = x; }
        int i0 = 0; float v0 = el[0];
#pragma unroll
        for (int j = 1; j < 8; ++j) if (el[j] > v0) { v0 = el[j]; i0 = j; }
        int i1 = -1; float v1 = -INFINITY;
#pragma unroll
        for (int j = 0; j < 8; ++j) if (j != i0 && el[j] > v1) { v1 = el[j]; i1 = j; }
        const float e1 = __expf(v1 - v0);
        const float p0 = 1.f / (1.f + e1), p1 = e1 / (1.f + e1);
        const int ex0 = gi * 8 + i0, ex1 = gi * 8 + i1;
        RW[t * 2 + 0] = gw * p0; RW[t * 2 + 1] = gw * p1; RSTD2[t] = rs;
        ex0_ = ex0; ex1_ = ex1;
        lr0_ = __hip_atomic_fetch_add((int*)hist + ex0, 1, __ATOMIC_RELAXED, __HIP_MEMORY_SCOPE_WORKGROUP); lr1_ = __hip_atomic_fetch_add((int*)hist + ex1, 1, __ATOMIC_RELAXED, __HIP_MEMORY_SCOPE_WORKGROUP);
    }
    asm volatile("s_waitcnt lgkmcnt(0)" ::: "memory");
    __syncthreads();
    if (threadIdx.x < N_EXP) { const int c_ = hist[threadIdx.x]; hist[32 + threadIdx.x] = c_ ? atomicAdd(&cnt[threadIdx.x], c_) : 0; }
    __syncthreads();
    if (lane < 16) { const int t = t0 + lane;
        LIST[(size_t)ex0_ * T + hist[32 + ex0_] + lr0_] = 2 * t; LIST[(size_t)ex1_ * T + hist[32 + ex1_] + lr1_] = 2 * t + 1; }
}
}

template <int ROWMAP>
__device__ __forceinline__ int wt_rowmap(int n) {
    if (ROWMAP == 1) {
        if (n >= 1024 && n < 2048) { const int sec = (n - 1024) >> 9, cc = (n - 1024) & 511, h = cc >> 6, d = cc & 63;
            return 1024 + sec * 512 + (h >> 2) * 256 + 128 * (d >> 5) + 32 * (h & 3) + (d & 31); }
    }
    if (ROWMAP == 2) return 256 * (n >> 7) + (n & 127);
    if (ROWMAP == 3) return 256 * (n >> 7) + 128 + (n & 127);
    return n;
}
template <int ROWMAP, bool GAIN>
__device__ __forceinline__ void p0_transpose_item(const float* __restrict__ W, int ldw, int K, int N, bf16_t* __restrict__ WT, LAS unsigned* scr  , int item, int lane,
                                                  const float* __restrict__ g0, const float* __restrict__ g1, int ksplit) {
    const int nblk = N / 64, kb = item / nblk, nb = item % nblk, k0 = 128 * kb, n0 = 64 * nb;
    const int kp = lane >> 4, nq = lane & 15;
    const float* wp = W + (size_t)(k0 + 2 * kp) * ldw + n0 + 4 * nq;
#pragma unroll 8
    for (int it = 0; it < 16; ++it) {
        f32x4 a = *(const f32x4*)(wp + (size_t)(8 * it) * ldw), b = *(const f32x4*)(wp + (size_t)(8 * it + 1) * ldw);
        if (GAIN) { const int k = k0 + 8 * it + 2 * kp; const float* gp = (k0 < ksplit) ? g0 + k : g1 + (k - ksplit); a *= gp[0]; b *= gp[1]; }
        LAS unsigned* d = scr + (4 * nq) * 68 + 4 * it + kp;
        d[0] = pg8::cvt_pk_bf16(a[0], b[0]); d[68] = pg8::cvt_pk_bf16(a[1], b[1]); d[136] = pg8::cvt_pk_bf16(a[2], b[2]); d[204] = pg8::cvt_pk_bf16(a[3], b[3]);
    }
    asm volatile("s_waitcnt lgkmcnt(0)" ::: "memory");
#pragma unroll 4
    for (int j = 0; j < 16; ++j) { const int n = (lane >> 4) + 4 * j, c = lane & 15;
        const pg8::u32x4 o = *(const LAS pg8::u32x4*)(scr + n * 68 + 4 * c);
        *(pg8::u32x4*)(WT + (size_t)wt_rowmap<ROWMAP>(n0 + n) * K + k0 + 8 * c) = o; }
    asm volatile("s_waitcnt lgkmcnt(0)" ::: "memory");
}


template <int ROWMAP, bool GAIN>
__device__ __forceinline__ void p0_transpose_item_q(const float* __restrict__ W, int ldw, int K, int N, unsigned char* __restrict__ WQ, LAS unsigned char* scr, int item, int lane, const float* __restrict__ g0) {
    const int nblk = N / 64, kb = item / nblk, nb = item % nblk, k0 = 128 * kb, n0 = 64 * nb;
    const int kp = lane >> 4, nq = lane & 15;
    const float* wp = W + (size_t)(k0 + 2 * kp) * ldw + n0 + 4 * nq;
#pragma unroll 8
    for (int it = 0; it < 16; ++it) {
        f32x4 a = *(const f32x4*)(wp + (size_t)(8 * it) * ldw), b = *(const f32x4*)(wp + (size_t)(8 * it + 1) * ldw);
        float ga = 32.f, gb = 32.f;
        if (GAIN) { const int k = k0 + 8 * it + 2 * kp; ga *= g0[k]; gb *= g0[k + 1]; }
        LAS unsigned char* d = scr + (4 * nq) * 144 + 8 * it + 2 * kp;
#pragma unroll
        for (int e = 0; e < 4; ++e) *(LAS unsigned short*)(d + e * 144) = (unsigned short)__builtin_amdgcn_cvt_pk_fp8_f32(__builtin_amdgcn_fmed3f(a[e] * ga, -448.f, 448.f), __builtin_amdgcn_fmed3f(b[e] * gb, -448.f, 448.f), 0, false);
    }
    asm volatile("s_waitcnt lgkmcnt(0)" ::: "memory");
#pragma unroll 4
    for (int j = 0; j < 8; ++j) { const int n = (lane >> 3) + 8 * j, c = lane & 7;
        const pg8::u32x4 o = *(const LAS pg8::u32x4*)(scr + n * 144 + 16 * c);
        *(pg8::u32x4*)(WQ + (size_t)wt_rowmap<ROWMAP>(n0 + n) * K + k0 + 16 * c) = o; }
    asm volatile("s_waitcnt lgkmcnt(0)" ::: "memory");
}

namespace fox {
using bf16 = unsigned short;
using s16x4 = __attribute__((ext_vector_type(4))) short;
using u32x4 = __attribute__((ext_vector_type(4))) unsigned;
constexpr int NHEAD = FOX_H, D = 64, DMP = 512;
constexpr int NW = 8, QBLK = 32, QB = QBLK * NW, KVBLK = 64, NQB = SEQ / QB;
#define SBAR() __builtin_amdgcn_sched_barrier(0)
__device__ __forceinline__ void cmask(f32x16& p0, f32x16& p1, int jb, int qrel, int hi) {
  const float NEG = -INFINITY; int kb = 64 * jb + 4 * hi;
  #pragma unroll
  for (int r = 0; r < 16; ++r) { int kv = kb + (r & 3) + 8 * (r >> 2); if (kv > qrel) p0[r] = NEG; if (kv + 32 > qrel) p1[r] = NEG; }
}
constexpr int NSLOT = 3, SLOTB = 8192;
constexpr int LDS_K = 0, LDS_V = NSLOT * SLOTB, LDS_WS = 2 * NSLOT * SLOTB, LDS_OST = LDS_WS + NW * 64 * 4, LDS_BIAS = LDS_OST + NW * 4096, LDS_BYTES = LDS_BIAS + (SEQ + 64) * 4;
__device__ __forceinline__ void glds16(const void* gsrc, unsigned lds_dst) { unsigned keep;
  asm volatile("s_mov_b32 %0, m0\n\ts_mov_b32 m0, %2\n\ts_nop 0\n\tglobal_load_lds_dwordx4 %1, off\n\ts_mov_b32 m0, %0" : "=&s"(keep) : "v"(gsrc), "s"(lds_dst) : "memory"); }
__device__ __forceinline__ float max3f(float a, float b, float c) { float r; asm("v_max3_f32 %0, %1, %2, %3" : "=v"(r) : "v"(a), "v"(b), "v"(c)); return r; }
__device__ __forceinline__ float max2f(float a, float b) { float r; asm("v_max_f32_e32 %0, %1, %2" : "=v"(r) : "v"(a), "v"(b)); return r; }
__device__ __forceinline__ float fadd_s(float a, float b) { float r; asm("v_add_f32_e32 %0, %1, %2" : "=v"(r) : "v"(a), "v"(b)); return r; }
__device__ __forceinline__ float fsub_s(float a, float b) { float r; asm("v_sub_f32_e32 %0, %1, %2" : "=v"(r) : "v"(a), "v"(b)); return r; }
typedef float f32x2_t __attribute__((ext_vector_type(2))); typedef __bf16 bf16x2_t __attribute__((ext_vector_type(2)));
__device__ __forceinline__ unsigned cvtpk_s(float lo, float hi) { f32x2_t v = {lo, hi}; bf16x2_t b = __builtin_convertvector(v, bf16x2_t); return __builtin_bit_cast(unsigned, b); }
#define WAIT_BAR(N) asm volatile("s_waitcnt vmcnt(" #N ") lgkmcnt(0)\n\ts_barrier" ::: "memory")
typedef __attribute__((address_space(3))) const char* lds_cptr;
typedef short v4i16_t __attribute__((ext_vector_type(4)));
__device__ __forceinline__ void qkt(f32x16& p0, f32x16& p1, const char* Kslot, const bf16x8* qr, int r32, int hi) {
  const char* kb = Kslot + hi * 1024 + r32 * 16;
  #pragma unroll
  for (int d0 = 0; d0 < 4; ++d0) {
    const bf16x8 b0 = *reinterpret_cast<const bf16x8*>(kb + d0 * 2048);
    const bf16x8 b1 = *reinterpret_cast<const bf16x8*>(kb + d0 * 2048 + 512);
    p0 = __builtin_amdgcn_mfma_f32_32x32x16_bf16(b0, qr[d0], p0, 0, 0, 0); p1 = __builtin_amdgcn_mfma_f32_32x32x16_bf16(b1, qr[d0], p1, 0, 0, 0); }
}
__device__ __forceinline__ void kload8(bf16x8* kf, lds_cptr kp) {
  kf[0] = *(const LAS bf16x8*)(kp);        kf[1] = *(const LAS bf16x8*)(kp + 512);
  kf[2] = *(const LAS bf16x8*)(kp + 2048); kf[3] = *(const LAS bf16x8*)(kp + 2560);
  kf[4] = *(const LAS bf16x8*)(kp + 4096); kf[5] = *(const LAS bf16x8*)(kp + 4608);
  kf[6] = *(const LAS bf16x8*)(kp + 6144); kf[7] = *(const LAS bf16x8*)(kp + 6656);
}
__device__ __forceinline__ void kload2(bf16x8* kf, lds_cptr kp, int j) { kf[2 * j] = *(const LAS bf16x8*)(kp + j * 2048); kf[2 * j + 1] = *(const LAS bf16x8*)(kp + j * 2048 + 512); }
__device__ __forceinline__ s16x4 vtr(lds_cptr p) { return __builtin_bit_cast(s16x4, __builtin_amdgcn_ds_read_tr16_b64_v4i16((LAS v4i16_t*)p)); }
__device__ __forceinline__ float rowmax(const f32x16& p0, const f32x16& p1) {
  float a = max3f(p0[0], p0[1], p1[0]), b = max3f(p0[2], p0[3], p1[1]); a = max3f(a, p1[2], p1[3]);
  #pragma unroll
  for (int r = 4; r < 16; r += 4) { a = max3f(a, p0[r], p0[r + 1]); b = max3f(b, p0[r + 2], p0[r + 3]); a = max3f(a, p1[r], p1[r + 1]); b = max3f(b, p1[r + 2], p1[r + 3]); }
  const float m = max2f(a, b);
  auto rr = __builtin_amdgcn_permlane32_swap(__float_as_uint(m), __float_as_uint(m), false, false);
  return max2f(__uint_as_float(rr[0]), __uint_as_float(rr[1]));
}
__device__ __forceinline__ void pv(f32x16* o, int vb, bf16x8 pa0, bf16x8 pa1, bf16x8 pa2, bf16x8 pa3) {
  #pragma unroll
  for (int d0 = 0; d0 < 2; ++d0) { s16x4 lo[4], hi[4];
    #pragma unroll
    for (int ks = 0; ks < 4; ++ks) {
      asm volatile("ds_read_b64_tr_b16 %0,%1 offset:%c2" : "=&v"(lo[ks]) : "v"(vb), "i"(d0 * 4096 + ks * 1024) : "memory");
      asm volatile("ds_read_b64_tr_b16 %0,%1 offset:%c2" : "=&v"(hi[ks]) : "v"(vb), "i"(d0 * 4096 + ks * 1024 + 512) : "memory"); }
    asm volatile("s_waitcnt lgkmcnt(0)" ::: "memory"); SBAR();
    #define PK(k) (bf16x8){lo[k][0], lo[k][1], lo[k][2], lo[k][3], hi[k][0], hi[k][1], hi[k][2], hi[k][3]}
    o[d0] = __builtin_amdgcn_mfma_f32_32x32x16_bf16(pa0, PK(0), o[d0], 0, 0, 0);
    o[d0] = __builtin_amdgcn_mfma_f32_32x32x16_bf16(pa1, PK(1), o[d0], 0, 0, 0);
    o[d0] = __builtin_amdgcn_mfma_f32_32x32x16_bf16(pa2, PK(2), o[d0], 0, 0, 0);
    o[d0] = __builtin_amdgcn_mfma_f32_32x32x16_bf16(pa3, PK(3), o[d0], 0, 0, 0);
    #undef PK
  }
}
#define BLD(X0, X1, bp) do { _Pragma("unroll") for (int g_ = 0; g_ < 4; ++g_) { const f32x4 b0_ = *(const LAS f32x4*)((bp) + 32 * g_), b1_ = *(const LAS f32x4*)((bp) + 128 + 32 * g_); \
    X0[4 * g_] = b0_[0]; X0[4 * g_ + 1] = b0_[1]; X0[4 * g_ + 2] = b0_[2]; X0[4 * g_ + 3] = b0_[3]; X1[4 * g_] = b1_[0]; X1[4 * g_ + 1] = b1_[1]; X1[4 * g_ + 2] = b1_[2]; X1[4 * g_ + 3] = b1_[3]; } } while (0)

template <int THRL> __device__ __forceinline__ void attn_unit(int b, int h, int qb, const bf16* Q, const bf16* __restrict__ K, const bf16* __restrict__ V, bf16* O, const float* __restrict__ CUM, float* __restrict__ SSF, char* shm) {
  int tid = threadIdx.x; asm volatile("" : "+v"(tid));
  const int lane = tid & 63, r32 = lane & 31, hi = lane >> 5; const int wid = __builtin_amdgcn_readfirstlane(tid >> 6);
  const long rowbase = (long)b * SEQ; const int q0 = qb * QB;
  const bf16* Qw = Q + (rowbase + q0 + wid * QBLK) * DMP + h * D;
  const float* cbs = CUM + ((long)b * NHEAD + h) * SEQ;
  int t_start = 0;
  { const int ntile = (q0 + QB) / KVBLK; const float cq = cbs[q0]; const float ce = cbs[(lane < ntile ? lane : ntile - 1) * KVBLK + KVBLK - 1];
    const unsigned long long keep = __ballot(lane < ntile && (cq - ce >= -64.0f));
    t_start = keep ? (int)__builtin_ctzll(keep) : 0; t_start &= ~1; if (t_start > ntile - 4) t_start = ntile - 4;
    t_start = __builtin_amdgcn_readfirstlane(t_start); }
  const int skip_rows = t_start * KVBLK;
  const bf16 *Kh = K + (rowbase + skip_rows) * DMP + h * D, *Vh = V + (rowbase + skip_rows) * DMP + h * D;
  const unsigned lds0 = (unsigned)(uintptr_t)shm;
  float* wsf = (float*)(shm + LDS_WS) + wid * 64;
  const bf16* ksrc = Kh + (long)lane * DMP + wid * 8;
  const bf16* vsrc = Vh + (long)(16 * (wid & 3) + (lane >> 2)) * DMP + (wid >> 2) * 32 + (lane & 3) * 8;
  const unsigned kdst = lds0 + LDS_K + wid * 1024, vdst = lds0 + LDS_V + wid * 1024;
  #define DMA_K(t, slot) glds16(ksrc + (long)(t) * KVBLK * DMP, (unsigned)__builtin_amdgcn_readfirstlane(kdst + (slot)))
  #define DMA_V(t, slot) glds16(vsrc + (long)(t) * KVBLK * DMP, (unsigned)__builtin_amdgcn_readfirstlane(vdst + (slot)))
  const int vb0 = (int)(lds0 + LDS_V) + ((lane >> 4) & 1) * 32 + (lane & 3) * 8 + (4 * hi + ((lane & 15) >> 2)) * 64;
  const char* Kbase = shm + LDS_K; bf16x8 kf[8];
  const lds_cptr shm3 = (lds_cptr)shm; const lds_cptr kp0 = shm3 + LDS_K + hi * 1024 + r32 * 16; const lds_cptr vp0 = shm3 + LDS_V + ((lane >> 4) & 1) * 32 + (lane & 3) * 8 + (4 * hi + ((lane & 15) >> 2)) * 64;
  const lds_cptr bp0 = shm3 + LDS_BIAS + hi * 16;
  const int NT = (q0 + QB) / KVBLK - t_start;
  DMA_K(0, 0); DMA_V(0, 0); DMA_K(1, SLOTB);
  {
    const float* cb = cbs + skip_rows; const float cref = cbs[q0 + QB - 1]; const int nkeys = q0 + QB - skip_rows;
    LAS float* bl = (LAS float*)(shm3 + LDS_BIAS);
    float cv[SEQ / (NW * 64)];
    #pragma unroll
    for (int i = 0; i < SEQ / (NW * 64); ++i) { const int j = tid + i * NW * 64; cv[i] = cb[j < nkeys ? j : 0]; }
    #pragma unroll
    for (int i = 0; i < SEQ / (NW * 64); ++i) { const int j = tid + i * NW * 64; if (j < nkeys) bl[j] = cref - cv[i]; }
  }
  bf16x8 qr[4];
  #pragma unroll
  for (int d0 = 0; d0 < 4; ++d0) qr[d0] = *reinterpret_cast<const bf16x8*>(&Qw[(long)r32 * DMP + d0 * 16 + hi * 8]);
  float mhat = 0.f, l_reg = 0.f; f32x16 o[2]; o[0] = f32x16{}; o[1] = f32x16{};
  const int qrel = wid * QBLK + r32;
  #define CMASK(P0, P1, t) do { int jb_ = (t) - (NT - 4); if (jb_ >= 0) cmask(P0, P1, jb_, qrel, hi); } while (0)
  bool resc = false;
  #define START(P0, P1) do { const float rm = rowmax(P0, P1); resc = false; \
    { const float dl = rm; mhat = fadd_s(mhat, dl); \
      _Pragma("unroll") for (int r = 0; r < 16; ++r) { P0[r] = fsub_s(P0[r], dl); P1[r] = fsub_s(P1[r], dl); } } \
    _Pragma("unroll") for (int r = 0; r < 16; ++r) P0[r] = __builtin_amdgcn_exp2f(P0[r]); } while (0)
  #define RESC() do { if (resc) { asm volatile("s_waitcnt lgkmcnt(0)" ::: "memory"); \
      _Pragma("unroll") for (int d_ = 0; d_ < 2; ++d_) _Pragma("unroll") for (int r = 0; r < 16; ++r) o[d_][r] *= wsf[crow(r, hi)]; } } while (0)
  f32x16 pA0, pA1, pB0, pB1;
  int sl_prev = 0, sl_cur = 0, sl_next = SLOTB;
  #define ROT() do { sl_prev = sl_cur; sl_cur = sl_next; sl_next = (sl_next == (NSLOT - 1) * SLOTB) ? 0 : sl_next + SLOTB; } while (0)
  DMA_K(2, 2 * SLOTB);
  WAIT_BAR(3);
  BLD(pA0, pA1, bp0);
  qkt(pA0, pA1, Kbase, qr, r32, hi); asm volatile("s_nop 15\n\ts_nop 7" : "+v"(pA0), "+v"(pA1)); CMASK(pA0, pA1, 0);
  START(pA0, pA1);
  _Pragma("unroll") for (int r = 0; r < 16; ++r) pA1[r] = __builtin_amdgcn_exp2f(pA1[r]);
  BLD(pB0, pB1, bp0 + 256);
  _Pragma("unroll") for (int r = 0; r < 16; ++r) { pB0[r] = fsub_s(pB0[r], mhat); pB1[r] = fsub_s(pB1[r], mhat); }
  WAIT_BAR(0);
  DMA_K(3, 0); DMA_V(1, SLOTB);
  ROT();
  kload8(kf, kp0 + sl_cur);
  WAIT_BAR(2);
  s16x4 vlo[8], vhi[8]; u32x4 pw0, pw1, pw2, pw3;
  #define PKW(P, B) cvtpk_s(P[B], P[B + 1])
  #define PAF(k) __builtin_bit_cast(bf16x8, pw##k)
  #define VFR(i) (bf16x8){vlo[i][0], vlo[i][1], vlo[i][2], vlo[i][3], vhi[i][0], vhi[i][1], vhi[i][2], vhi[i][3]}
  #define PIN(x) asm volatile("" : "+v"(x))
  #define MX3(a, b, c) __builtin_fmaxf(__builtin_fmaxf((a), (b)), (c))
  #define GAPA(MF, A0, A1, A2, A3, W0, W1, PW) do { MF; sacc += A0; sacc += A1; sacc += A2; sacc += A3; PIN(sacc); W0; W1; PIN(PW); SBAR(); } while (0)
  #define EX(v) __builtin_amdgcn_exp2f(v)
  #define GAPB(MF, X, B, N, NB) do { MF; X[B] = EX(X[B]); X[B + 1] = EX(X[B + 1]); X[B + 2] = EX(X[B + 2]); X[B + 3] = EX(X[B + 3]); PIN(X); \
    N[NB] = fsub_s(N[NB], mhat); N[NB + 1] = fsub_s(N[NB + 1], mhat); N[NB + 2] = fsub_s(N[NB + 2], mhat); N[NB + 3] = fsub_s(N[NB + 3], mhat); PIN(N); SBAR(); } while (0)
  #define VRD(i) do { vlo[i] = vtr(vp_ + (((i) >> 2) * 4096 + ((i) & 3) * 1024)); vhi[i] = vtr(vp_ + (((i) >> 2) * 4096 + ((i) & 3) * 1024 + 512)); } while (0)
  #define KRD(G, j) do { if (G) { kload2(kf, kp0 + sl_next, j); SBAR(); } } while (0)
  #define STEP(C0, C1, P0, P1, t, GK, GV, GL) do { SBAR(); \
    const lds_cptr vp_ = vp0 + sl_prev; \
    VRD(0); SBAR(); float sacc = (P0[0] + P0[1]); \
    GAPA(C0 = __builtin_amdgcn_mfma_f32_32x32x16_bf16(kf[0], qr[0], C0, 0, 0, 0), P0[2], P0[3], P0[4], P0[5],     pw0[0] = PKW(P0, 0), pw0[1] = PKW(P0, 2), pw0); \
    VRD(4); SBAR(); GAPA(C1 = __builtin_amdgcn_mfma_f32_32x32x16_bf16(kf[1], qr[0], C1, 0, 0, 0), P0[6], P0[7], P0[8], P0[9],     pw0[2] = PKW(P0, 4), pw0[3] = PKW(P0, 6), pw0); \
    VRD(1); SBAR(); GAPA(C0 = __builtin_amdgcn_mfma_f32_32x32x16_bf16(kf[2], qr[1], C0, 0, 0, 0),   P0[10], P0[11], P0[12], P0[13], pw1[0] = PKW(P0, 8), pw1[1] = PKW(P0, 10), pw1); \
    VRD(5); SBAR(); GAPA(C1 = __builtin_amdgcn_mfma_f32_32x32x16_bf16(kf[3], qr[1], C1, 0, 0, 0),   P0[14], P0[15], P1[0], P1[1],   pw1[2] = PKW(P0, 12), pw1[3] = PKW(P0, 14), pw1); \
    VRD(2); SBAR(); GAPA(C0 = __builtin_amdgcn_mfma_f32_32x32x16_bf16(kf[4], qr[2], C0, 0, 0, 0),   P1[2], P1[3], P1[4], P1[5],     pw2[0] = PKW(P1, 0), pw2[1] = PKW(P1, 2), pw2); \
    VRD(6); SBAR(); GAPA(C1 = __builtin_amdgcn_mfma_f32_32x32x16_bf16(kf[5], qr[2], C1, 0, 0, 0),   P1[6], P1[7], P1[8], P1[9],     pw2[2] = PKW(P1, 4), pw2[3] = PKW(P1, 6), pw2); \
    VRD(3); SBAR(); GAPA(C0 = __builtin_amdgcn_mfma_f32_32x32x16_bf16(kf[6], qr[3], C0, 0, 0, 0),   P1[10], P1[11], P1[12], P1[13], pw3[0] = PKW(P1, 8), pw3[1] = PKW(P1, 10), pw3); \
    VRD(7); SBAR(); GAPA(C1 = __builtin_amdgcn_mfma_f32_32x32x16_bf16(kf[7], qr[3], C1, 0, 0, 0),   P1[14], P1[15], 0.f, 0.f,       pw3[2] = PKW(P1, 12), pw3[3] = PKW(P1, 14), pw3); \
    l_reg += sacc; \
    if (GK) { DMA_K((t) + 3, sl_cur); } if (GV) { DMA_V((t) + 1, sl_next); } \
    CMASK(C0, C1, t); \
    { float a = MX3(C0[0], C0[1], C1[0]), b = MX3(C0[2], C0[3], C1[1]); a = MX3(a, C1[2], C1[3]); \
      _Pragma("unroll") for (int r = 4; r < 16; r += 4) { a = MX3(a, C0[r], C0[r + 1]); b = MX3(b, C0[r + 2], C0[r + 3]); a = MX3(a, C1[r], C1[r + 1]); b = MX3(b, C1[r + 2], C1[r + 3]); } \
      float rm = __builtin_fmaxf(a, b); { auto rr = __builtin_amdgcn_permlane32_swap(__float_as_uint(rm), __float_as_uint(rm), false, false); rm = __builtin_fmaxf(__uint_as_float(rr[0]), __uint_as_float(rr[1])); } \
      resc = false; \
      if (__builtin_expect(__any(rm > (float)THRL), 0)) { const float dl = __builtin_fmaxf(rm, 0.f); mhat += dl; \
        _Pragma("unroll") for (int r = 0; r < 16; ++r) { C0[r] -= dl; C1[r] -= dl; } \
        const float f = __builtin_amdgcn_exp2f(-dl); l_reg *= f; if (hi == 0) wsf[r32] = f; resc = true; } } \
    SBAR(); \
    BLD(P0, P1, bp0 + ((t) + 1) * 256); SBAR(); \
    GAPB(o[0] = __builtin_amdgcn_mfma_f32_32x32x16_bf16(PAF(0), VFR(0), o[0], 0, 0, 0), C0, 0, P0, 0); \
    GAPB(o[1] = __builtin_amdgcn_mfma_f32_32x32x16_bf16(PAF(0), VFR(4), o[1], 0, 0, 0), C0, 4, P0, 4); \
    KRD(GL, 0); GAPB(o[0] = __builtin_amdgcn_mfma_f32_32x32x16_bf16(PAF(1), VFR(1), o[0], 0, 0, 0), C0, 8, P0, 8); \
    KRD(GL, 1); GAPB(o[1] = __builtin_amdgcn_mfma_f32_32x32x16_bf16(PAF(1), VFR(5), o[1], 0, 0, 0), C0, 12, P0, 12); \
    KRD(GL, 2); GAPB(o[0] = __builtin_amdgcn_mfma_f32_32x32x16_bf16(PAF(2), VFR(2), o[0], 0, 0, 0), C1, 0, P1, 0); \
    KRD(GL, 3); GAPB(o[1] = __builtin_amdgcn_mfma_f32_32x32x16_bf16(PAF(2), VFR(6), o[1], 0, 0, 0), C1, 4, P1, 4); \
    GAPB(o[0] = __builtin_amdgcn_mfma_f32_32x32x16_bf16(PAF(3), VFR(3), o[0], 0, 0, 0), C1, 8, P1, 8); \
    GAPB(o[1] = __builtin_amdgcn_mfma_f32_32x32x16_bf16(PAF(3), VFR(7), o[1], 0, 0, 0), C1, 12, P1, 12); \
    } while (0)
  int t = 1;
  #undef CMASK
  #define CMASK(P0, P1, t) do {} while (0)
  for (; t + 5 < NT; t += 2) {
    STEP(pB0, pB1, pA0, pA1, t, true, true, true);     WAIT_BAR(2); RESC(); ROT();
    STEP(pA0, pA1, pB0, pB1, t + 1, true, true, true);   WAIT_BAR(2); RESC(); ROT();
  }
  #undef CMASK
  #define CMASK(P0, P1, t) do { int jb_ = (t) - (NT - 4); if (jb_ >= 0) cmask(P0, P1, jb_, qrel, hi); } while (0)
  #define ENDW(tt) do { if ((tt) + 3 < NT) { WAIT_BAR(2); } else if ((tt) + 2 < NT) { WAIT_BAR(1); } else { WAIT_BAR(0); } } while (0)
  for (; t + 1 < NT; t += 2) {
    STEP(pB0, pB1, pA0, pA1, t, (t + 3 < NT), (t + 1 < NT), (t + 1 < NT));       ENDW(t);   RESC(); ROT();
    STEP(pA0, pA1, pB0, pB1, t + 1, (t + 4 < NT), (t + 2 < NT), (t + 2 < NT));     ENDW(t + 1); RESC(); ROT();
  }
  STEP(pB0, pB1, pA0, pA1, NT - 1, false, false, false); RESC();
  { float sacc = pB0[0] + pB0[1]; _Pragma("unroll") for (int r = 2; r < 16; ++r) sacc += pB0[r]; _Pragma("unroll") for (int r = 0; r < 16; ++r) sacc += pB1[r]; l_reg += sacc;
    pw0 = (u32x4){PKW(pB0, 0), PKW(pB0, 2), PKW(pB0, 4), PKW(pB0, 6)}; pw1 = (u32x4){PKW(pB0, 8), PKW(pB0, 10), PKW(pB0, 12), PKW(pB0, 14)}; pw2 = (u32x4){PKW(pB1, 0), PKW(pB1, 2), PKW(pB1, 4), PKW(pB1, 6)}; pw3 = (u32x4){PKW(pB1, 8), PKW(pB1, 10), PKW(pB1, 12), PKW(pB1, 14)};
    SBAR(); pv(o, vb0 + sl_cur, PAF(0), PAF(1), PAF(2), PAF(3)); }
  #undef PKW
  #undef PAF
  #undef VFR
  #undef PIN
  #undef MX3
  #undef GAPA
  #undef GAPB
  #undef EX
  #undef VRD
  #undef KRD
  #undef STEP
  #undef ENDW
  { auto rr = __builtin_amdgcn_permlane32_swap(__float_as_uint(l_reg), __float_as_uint(l_reg), false, false); l_reg = __uint_as_float(rr[0]) + __uint_as_float(rr[1]); }
  if (hi == 0) wsf[32 + r32] = l_reg; asm volatile("s_waitcnt lgkmcnt(0)" ::: "memory");
  float rli[16];
  #pragma unroll
  for (int r = 0; r < 16; ++r) rli[r] = __builtin_amdgcn_rcpf(wsf[32 + crow(r, hi)]);
  bf16* Ow = O + (rowbase + q0 + wid * QBLK) * DMP + h * D;
  { bf16* stg = (bf16*)(shm + LDS_OST) + wid * 2048;
    #pragma unroll
    for (int r = 0; r < 16; ++r) { const int orow = crow(r, hi);
      #pragma unroll
      for (int d0 = 0; d0 < 2; ++d0) stg[orow * 64 + d0 * 32 + r32] = f2bf(o[d0][r] * rli[r]); }
    asm volatile("s_waitcnt lgkmcnt(0)" ::: "memory");
    #pragma unroll
    for (int i = 0; i < 4; ++i) { const int row = i * 8 + (lane >> 3), ch = lane & 7; const u32x4 v = *(const u32x4*)(stg + row * 64 + ch * 8); *(u32x4*)(Ow + (long)row * DMP + ch * 8) = v;
      float ss = 0.f;
      #pragma unroll
      for (int j = 0; j < 4; ++j) { const float lo = __uint_as_float(v[j] << 16), hi_ = __uint_as_float(v[j] & 0xffff0000u); ss += lo * lo + hi_ * hi_; }
      ss += __shfl_xor(ss, 1); ss += __shfl_xor(ss, 2); ss += __shfl_xor(ss, 4);
      if (ch == 0) SSF[(rowbase + q0 + wid * QBLK + row) * 8 + h] = ss; } }
  asm volatile("s_waitcnt lgkmcnt(0)\n\ts_barrier" ::: "memory");
  #undef DMA_K
  #undef DMA_V
  #undef CMASK
  #undef START
  #undef RESC
  #undef ROT
}
template <int THRL> __device__ __forceinline__ void attn_phase(char* lds, const bf16* Q, const bf16* K, const bf16* V, bf16* O, const float* CUM, float* SSF, int* counter) {
  LAS int* slot = (LAS int*)((LAS char*)lds + LDS_BYTES);
  int nxt = 0;
  if (threadIdx.x == 0) nxt = atomicAdd(counter, 1);
  for (;;) {
    if (threadIdx.x == 0) *slot = nxt;
    __syncthreads();
    const int u = *slot;
    __syncthreads();
    if (u >= NHEAD * NQB) break;
    if (threadIdx.x == 0) nxt = atomicAdd(counter, 1);
    const int qb = NQB - 1 - (u >> 3), bh = (blockIdx.x & 7) * NHEAD + (u & 7);
    attn_unit<THRL>(bh / NHEAD, bh % NHEAD, qb, Q, K, V, O, CUM, SSF, lds);
  }
}
#undef SBAR
#undef WAIT_BAR
#undef BLD
}


namespace lru {
constexpr int CL = 128, NCH = SEQ / CL;
constexpr int WLDS = 16384;
typedef unsigned u32x4 __attribute__((ext_vector_type(4)));
template <bool PASS2>
__device__ __forceinline__ void unit(int b, int chunk, const bf16_t* __restrict__ U, const bf16_t* __restrict__ GATE, const float* __restrict__ conv_w, const float* __restrict__ conv_b,
                                     const bf16_t* __restrict__ LRUW, const float* __restrict__ ba, const float* __restrict__ bx, const float* __restrict__ a_param,
                                     float* __restrict__ SUMA, float* __restrict__ SUMH, bf16_t* __restrict__ YL, float* __restrict__ SSL, LAS unsigned char* ldsw, int w, int lane) {
    const int cl = lane & 31, hi = lane >> 5;
    LAS float* cp = (LAS float*)ldsw;
    LAS bf16_t* stg = (LAS bf16_t*)(ldsw + 2048);
    for (int i = lane; i < 320; i += 64) { const int tap = i >> 6, c = i & 63; cp[i] = (tap < 4) ? conv_w[tap * 512 + 64 * w + c] : conv_b[64 * w + c]; }
    { const int c = 64 * w + lane; cp[320 + lane] = ba[c]; cp[384 + lane] = bx[c];
      const float ap = -a_param[c]; const float sp = (ap > 20.f) ? ap : log1pf(__expf(ap)); cp[448 + lane] = -8.f * sp * LOG2E; }
    const u32x4* wf = (const u32x4*)LRUW + (size_t)w * 16 * 64 + lane;
    bf16x8 Bi[2];
#pragma unroll
    for (int q = 0; q < 2; ++q)
#pragma unroll
        for (int j = 0; j < 8; ++j) Bi[q][j] = (16 * q + 8 * hi + j == cl) ? (short)0x3F80 : (short)0;
    float h[2], atot[2];
#pragma unroll
    for (int n = 0; n < 2; ++n) { h[n] = 0.f; atot[n] = 1.f; }
    if (PASS2) {
#pragma unroll 1
        for (int c0 = 0; c0 < chunk; c0 += 8) {
            float sa[8][2], sh[8][2];
#pragma unroll
            for (int j = 0; j < 8; ++j)
#pragma unroll
                for (int n = 0; n < 2; ++n) { const bool ok = (c0 + j < chunk); const size_t o = ((size_t)(b * NCH + (ok ? c0 + j : 0))) * 512 + 64 * w + 32 * n + cl;
                    const float av = SUMA[o], hv = SUMH[o]; sa[j][n] = ok ? av : 1.f; sh[j][n] = ok ? hv : 0.f; }
#pragma unroll
            for (int j = 0; j < 8; ++j)
#pragma unroll
                for (int n = 0; n < 2; ++n) h[n] = sa[j][n] * h[n] + sh[j][n];
        }
    }
    asm volatile("s_waitcnt lgkmcnt(0)" ::: "memory");
    const int t0 = b * SEQ + chunk * CL;
    LAS unsigned char* ub0 = ldsw + 6144;
    const int dri = lane >> 3, dch = lane & 7;
#define LRU_DMA_U(tb_, buf_) do { _Pragma("unroll") for (int i_ = 0; i_ < 5; ++i_) { const int ri_ = 8 * i_ + dri; int gr_ = (tb_) - 3 + ri_; gr_ = gr_ < 0 ? 0 : (gr_ > T - 1 ? T - 1 : gr_); \
        __builtin_amdgcn_global_load_lds((const unsigned*)((const char*)U + (unsigned)((gr_ * 512 + 64 * w + 8 * (dch ^ (ri_ & 7))) * 2)), (LAS unsigned*)(ub0 + (buf_) * 5120 + i_ * 1024), 16, 0, 0); } } while (0)
#define LRU_DMA_G(tb_) do { _Pragma("unroll") for (int i_ = 0; i_ < 4; ++i_) \
        __builtin_amdgcn_global_load_lds((const unsigned*)((const char*)GATE + (unsigned)((((tb_) + 8 * i_ + dri) * 512 + 64 * w + 8 * dch) * 2)), (LAS unsigned*)(ldsw + 2048 + i_ * 1024), 16, 0, 0); } while (0)
    LRU_DMA_U(t0, 0);
#pragma unroll 1
    for (int mt = 0; mt < CL / 32; ++mt) {
        int tb = t0 + mt * 32; asm volatile("" : "+s"(tb));
        const int srow = chunk * CL + mt * 32 + cl;
        asm volatile("s_waitcnt vmcnt(0)" ::: "memory");
        if (mt + 1 < CL / 32) LRU_DMA_U(tb + 32, (mt + 1) & 1);
        if (PASS2) LRU_DMA_G(tb);
        const LAS unsigned char* ub = ub0 + (mt & 1) * 5120;
        bf16x8 af[4];
#pragma unroll
        for (int s_ = 0; s_ < 4; ++s_) {
            const int cc = 16 * s_ + 8 * hi;
            float xv[8];
            { const f32x4 b0 = *(const LAS f32x4*)(cp + 256 + cc), b1 = *(const LAS f32x4*)(cp + 256 + cc + 4);
              xv[0] = b0[0]; xv[1] = b0[1]; xv[2] = b0[2]; xv[3] = b0[3]; xv[4] = b1[0]; xv[5] = b1[1]; xv[6] = b1[2]; xv[7] = b1[3]; }
#pragma unroll
            for (int tap = 0; tap < 4; ++tap) {
                const bool inseq = (srow - 3 + tap >= 0);
                const int ri = cl + tap;
                u32x4 uu = *(const LAS u32x4*)(ub + ri * 128 + (((2 * s_ + hi) ^ (ri & 7)) << 4));
                if (!inseq) uu = (u32x4){0u, 0u, 0u, 0u};
                const f32x4 w0 = *(const LAS f32x4*)(cp + tap * 64 + cc), w1 = *(const LAS f32x4*)(cp + tap * 64 + cc + 4);
                xv[0] += w0[0] * __uint_as_float(uu[0] << 16); xv[1] += w0[1] * __uint_as_float(uu[0] & 0xffff0000u);
                xv[2] += w0[2] * __uint_as_float(uu[1] << 16); xv[3] += w0[3] * __uint_as_float(uu[1] & 0xffff0000u);
                xv[4] += w1[0] * __uint_as_float(uu[2] << 16); xv[5] += w1[1] * __uint_as_float(uu[2] & 0xffff0000u);
                xv[6] += w1[2] * __uint_as_float(uu[3] << 16); xv[7] += w1[3] * __uint_as_float(uu[3] & 0xffff0000u);
            }
            u32x4 pk; pk[0] = pg8::cvt_pk_bf16(xv[0], xv[1]); pk[1] = pg8::cvt_pk_bf16(xv[2], xv[3]); pk[2] = pg8::cvt_pk_bf16(xv[4], xv[5]); pk[3] = pg8::cvt_pk_bf16(xv[6], xv[7]);
            af[s_] = __builtin_bit_cast(bf16x8, pk);
            asm volatile("" ::: "memory"); __builtin_amdgcn_sched_barrier(0);
        }
#pragma unroll
        for (int n = 0; n < 2; ++n) {
            f32x16 rCn, iCn, xCn;
#pragma unroll
            for (int r = 0; r < 16; ++r) { rCn[r] = cp[320 + 32 * n + cl]; iCn[r] = cp[384 + 32 * n + cl]; xCn[r] = 0.f; }
            const float c1n = cp[448 + 32 * n + cl];
#pragma unroll
            for (int s_ = 0; s_ < 4; ++s_) {
                const bf16x8 fa = __builtin_bit_cast(bf16x8, wf[(n * 4 + s_) * 64]), fx = __builtin_bit_cast(bf16x8, wf[(8 + n * 4 + s_) * 64]);
                rCn = __builtin_amdgcn_mfma_f32_32x32x16_bf16(af[s_], fa, rCn, 0, 0, 0);
                iCn = __builtin_amdgcn_mfma_f32_32x32x16_bf16(af[s_], fx, iCn, 0, 0, 0);
                if ((s_ >> 1) == n) xCn = __builtin_amdgcn_mfma_f32_32x32x16_bf16(af[s_], Bi[s_ & 1], xCn, 0, 0, 0);
            }
#pragma unroll
            for (int r = 0; r < 16; ++r) {
                const float rr = __builtin_amdgcn_rcpf(1.f + __builtin_amdgcn_exp2f(-LOG2E * rCn[r]));
                const float ii = __builtin_amdgcn_rcpf(1.f + __builtin_amdgcn_exp2f(-LOG2E * iCn[r]));
                const float a = __builtin_amdgcn_exp2f(c1n * rr);
                const float mult = __builtin_amdgcn_sqrtf(fmaxf(1.f - a * a, 0.f));
                rCn[r] = a; iCn[r] = mult * (ii * xCn[r]);
                if ((r & 3) == 3) __builtin_amdgcn_sched_barrier(0);
            }
            float Ao[4], Bo[4], Ap[4], Bp[4];
#pragma unroll
            for (int g = 0; g < 4; ++g) { float A = rCn[4 * g], B = iCn[4 * g];
#pragma unroll
                for (int k = 1; k < 4; ++k) { B = rCn[4 * g + k] * B + iCn[4 * g + k]; A *= rCn[4 * g + k]; }
                Ao[g] = A; Bo[g] = B; Ap[g] = __shfl_xor(A, 32); Bp[g] = __shfl_xor(B, 32); }
            float hh = h[n], at = atot[n];
#pragma unroll
            for (int g = 0; g < 4; ++g) {
                const float A1 = hi ? Ap[g] : Ao[g], B1 = hi ? Bp[g] : Bo[g], A2 = hi ? Ao[g] : Ap[g], B2 = hi ? Bo[g] : Bp[g];
                const float h1 = A1 * hh + B1, h2 = A2 * h1 + B2;
                float hr = hi ? h1 : hh;
                at *= A1 * A2; hh = h2;
                if (PASS2) {
#pragma unroll
                    for (int k = 0; k < 4; ++k) { hr = rCn[4 * g + k] * hr + iCn[4 * g + k]; iCn[4 * g + k] = hr; }
                }
            }
            h[n] = hh; atot[n] = at;
            if (PASS2) {
                if (n == 0) asm volatile("s_waitcnt vmcnt(0)" ::: "memory");
#pragma unroll
                for (int r = 0; r < 16; ++r) {
                    const int tok = crow(r, hi);
                    const float gx = bf2f(stg[tok * 64 + 32 * n + cl]);
                    const float uq = 0.7978845608028654f * (gx + 0.044715f * gx * gx * gx);
                    const float th = 1.f - 2.f * __builtin_amdgcn_rcpf(1.f + __builtin_amdgcn_exp2f(2.f * LOG2E * uq));
                    stg[tok * 64 + 32 * n + cl] = f2bf(iCn[r] * (0.5f * gx * (1.f + th)));
                    if ((r & 3) == 3) __builtin_amdgcn_sched_barrier(0);
                }
            }
        }
        if (PASS2) {
            asm volatile("s_waitcnt lgkmcnt(0)" ::: "memory");
#pragma unroll
            for (int i = 0; i < 4; ++i) { const int row = i * 8 + (lane >> 3), ch = lane & 7; const u32x4 v = *(const LAS u32x4*)(stg + row * 64 + ch * 8);
                *(u32x4*)((char*)YL + (unsigned)(((tb + row) * 512 + 64 * w + ch * 8) * 2)) = v;
                float ss = 0.f;
#pragma unroll
                for (int j = 0; j < 4; ++j) { const float lo = __uint_as_float(v[j] << 16), hi_ = __uint_as_float(v[j] & 0xffff0000u); ss += lo * lo + hi_ * hi_; }
                ss += __shfl_xor(ss, 1); ss += __shfl_xor(ss, 2); ss += __shfl_xor(ss, 4);
                if (ch == 0) SSL[(size_t)(tb + row) * 8 + w] = ss; }
            asm volatile("s_waitcnt lgkmcnt(0)" ::: "memory");
        }
    }
    if (!PASS2) {
        if (hi == 0) {
#pragma unroll
            for (int n = 0; n < 2; ++n) { const size_t o = ((size_t)(b * NCH + chunk)) * 512 + 64 * w + 32 * n + cl; SUMA[o] = atot[n]; SUMH[o] = h[n]; }
        }
    }
}
#undef LRU_DMA_U
#undef LRU_DMA_G
}


namespace xat {
constexpr int KS_BYTES = MEM_LEN * 256, VT_STRIDE = 520, VT_BYTES = MEM_D * VT_STRIDE, LDS_NEED = KS_BYTES + VT_BYTES;
typedef unsigned u32x4 __attribute__((ext_vector_type(4)));
typedef unsigned u32x2 __attribute__((ext_vector_type(2)));
__device__ __forceinline__ void item(int b, int h, int qhalf  , const bf16_t* __restrict__ QM, const bf16_t* __restrict__ KM, const bf16_t* __restrict__ VM, bf16_t* __restrict__ OM,
                                     const float* __restrict__ q_g, const float* __restrict__ k_g, LAS unsigned char* lds) {
    int tid = threadIdx.x; asm volatile("" : "+v"(tid));
    const int lane = tid & 63, wid = __builtin_amdgcn_readfirstlane(tid >> 6), r32 = lane & 31, hi = lane >> 5;
    LAS unsigned char* Ks = lds; LAS unsigned char* VT = lds + KS_BYTES;
    {
        const int ch = tid & 15, k0 = tid >> 4;
        const f32x4 g0 = *(const f32x4*)(k_g + 8 * ch), g1 = *(const f32x4*)(k_g + 8 * ch + 4);
#pragma unroll 2
        for (int p = 0; p < 8; ++p) {
            const int key = p * 32 + k0;
            const size_t goff = ((size_t)(b * MEM_LEN + key)) * 512 + h * MEM_D + 8 * ch;
            const u32x4 kk = *(const u32x4*)(KM + goff), vv = *(const u32x4*)(VM + goff);
            float f[8];
#pragma unroll
            for (int j = 0; j < 4; ++j) { f[2 * j] = __uint_as_float(kk[j] << 16); f[2 * j + 1] = __uint_as_float(kk[j] & 0xffff0000u); }
            float ss = 0.f;
#pragma unroll
            for (int j = 0; j < 8; ++j) ss += f[j] * f[j];
            ss += __shfl_xor(ss, 1); ss += __shfl_xor(ss, 2); ss += __shfl_xor(ss, 4); ss += __shfl_xor(ss, 8);
            const float rs = rsqrtf(ss * (1.f / MEM_D) + EPS);
            u32x4 o; o[0] = pg8::cvt_pk_bf16(f[0] * rs * g0[0], f[1] * rs * g0[1]); o[1] = pg8::cvt_pk_bf16(f[2] * rs * g0[2], f[3] * rs * g0[3]);
                     o[2] = pg8::cvt_pk_bf16(f[4] * rs * g1[0], f[5] * rs * g1[1]); o[3] = pg8::cvt_pk_bf16(f[6] * rs * g1[2], f[7] * rs * g1[3]);
            *(LAS u32x4*)(Ks + key * 256 + ((ch ^ (key & 15)) << 4)) = o;
#pragma unroll
            for (int j = 0; j < 4; ++j) { *(LAS bf16_t*)(VT + (8 * ch + 2 * j) * VT_STRIDE + key * 2) = (bf16_t)(vv[j] & 0xffffu); *(LAS bf16_t*)(VT + (8 * ch + 2 * j + 1) * VT_STRIDE + key * 2) = (bf16_t)(vv[j] >> 16); }
        }
    }
    __syncthreads();
#pragma unroll 1
    for (int qi = 0; qi < 2; ++qi) {
        const int q0 = qhalf * 512 + qi * 256 + wid * 32;
        const bf16_t* Qp = QM + ((size_t)(b * SEQ + q0 + r32)) * 512 + h * MEM_D + hi * 8;
        bf16x8 qf[8];
        {
            float ss = 0.f; u32x4 raw[8];
#pragma unroll
            for (int d0 = 0; d0 < 8; ++d0) { raw[d0] = *(const u32x4*)(Qp + d0 * 16);
#pragma unroll
                for (int j = 0; j < 4; ++j) { const float lo = __uint_as_float(raw[d0][j] << 16), hi_ = __uint_as_float(raw[d0][j] & 0xffff0000u); ss += lo * lo + hi_ * hi_; } }
            ss += __shfl_xor(ss, 32);
            const float rs = rsqrtf(ss * (1.f / MEM_D) + EPS) * (0.08838834764831845f * LOG2E);
#pragma unroll
            for (int d0 = 0; d0 < 8; ++d0) { const f32x4 g0 = *(const f32x4*)(q_g + 16 * d0 + 8 * hi), g1 = *(const f32x4*)(q_g + 16 * d0 + 8 * hi + 4);
                u32x4 o;
                o[0] = pg8::cvt_pk_bf16(__uint_as_float(raw[d0][0] << 16) * rs * g0[0], __uint_as_float(raw[d0][0] & 0xffff0000u) * rs * g0[1]);
                o[1] = pg8::cvt_pk_bf16(__uint_as_float(raw[d0][1] << 16) * rs * g0[2], __uint_as_float(raw[d0][1] & 0xffff0000u) * rs * g0[3]);
                o[2] = pg8::cvt_pk_bf16(__uint_as_float(raw[d0][2] << 16) * rs * g1[0], __uint_as_float(raw[d0][2] & 0xffff0000u) * rs * g1[1]);
                o[3] = pg8::cvt_pk_bf16(__uint_as_float(raw[d0][3] << 16) * rs * g1[2], __uint_as_float(raw[d0][3] & 0xffff0000u) * rs * g1[3]);
                qf[d0] = __builtin_bit_cast(bf16x8, o); }
        }
        f32x16 o[4];
#pragma unroll
        for (int i = 0; i < 4; ++i)
#pragma unroll
            for (int r = 0; r < 16; ++r) o[i][r] = 0.f;
        float m = -1e30f, l = 0.f;
#pragma unroll 1
        for (int kv0 = 0; kv0 < MEM_LEN; kv0 += 32) {
            f32x16 sc;
#pragma unroll
            for (int r = 0; r < 16; ++r) sc[r] = 0.f;
            const int key = kv0 + r32;
#pragma unroll
            for (int d0 = 0; d0 < 8; ++d0) { const bf16x8 kf = *(const LAS bf16x8*)(Ks + key * 256 + (((2 * d0 + hi) ^ (key & 15)) << 4)); sc = __builtin_amdgcn_mfma_f32_32x32x16_bf16(kf, qf[d0], sc, 0, 0, 0); }
            float tmax = sc[0];
#pragma unroll
            for (int r = 1; r < 16; ++r) tmax = fmaxf(tmax, sc[r]);
            tmax = fmaxf(tmax, __shfl_xor(tmax, 32));
            const float mnew = fmaxf(m, tmax), alpha = __builtin_amdgcn_exp2f(m - mnew);
            float ps = 0.f;
#pragma unroll
            for (int r = 0; r < 16; ++r) { sc[r] = __builtin_amdgcn_exp2f(sc[r] - mnew); ps += sc[r]; }
            l = l * alpha + ps; m = mnew;
#pragma unroll
            for (int i = 0; i < 4; ++i)
#pragma unroll
                for (int r = 0; r < 16; ++r) o[i][r] *= alpha;
            bf16x8 pb[2];
#pragma unroll
            for (int s2 = 0; s2 < 2; ++s2) { u32x4 w; w[0] = pg8::cvt_pk_bf16(sc[8 * s2], sc[8 * s2 + 1]); w[1] = pg8::cvt_pk_bf16(sc[8 * s2 + 2], sc[8 * s2 + 3]); w[2] = pg8::cvt_pk_bf16(sc[8 * s2 + 4], sc[8 * s2 + 5]); w[3] = pg8::cvt_pk_bf16(sc[8 * s2 + 6], sc[8 * s2 + 7]); pb[s2] = __builtin_bit_cast(bf16x8, w); }
#pragma unroll
            for (int i = 0; i < 4; ++i)
#pragma unroll
                for (int s2 = 0; s2 < 2; ++s2) {
                    const LAS unsigned char* vp = VT + (32 * i + r32) * VT_STRIDE + (kv0 + 16 * s2 + 4 * hi) * 2;
                    const u32x2 v0 = *(const LAS u32x2*)vp, v1 = *(const LAS u32x2*)(vp + 16);
                    const u32x4 vv = (u32x4){v0[0], v0[1], v1[0], v1[1]};
                    o[i] = __builtin_amdgcn_mfma_f32_32x32x16_bf16(__builtin_bit_cast(bf16x8, vv), pb[s2], o[i], 0, 0, 0);
                }
        }
        l += __shfl_xor(l, 32);
        const float rl = __builtin_amdgcn_rcpf(l);
        bf16_t* Op = OM + ((size_t)(b * SEQ + q0 + r32)) * 512 + h * MEM_D;
#pragma unroll
        for (int i = 0; i < 4; ++i)
#pragma unroll
            for (int g = 0; g < 4; ++g) { u32x2 w; w[0] = pg8::cvt_pk_bf16(o[i][4 * g] * rl, o[i][4 * g + 1] * rl); w[1] = pg8::cvt_pk_bf16(o[i][4 * g + 2] * rl, o[i][4 * g + 3] * rl);
                *(u32x2*)(Op + 32 * i + 8 * g + 4 * hi) = w; }
    }
    __syncthreads();
}
}

struct Params { const float* in[32]; float* out; unsigned char* ws; };

__global__ void __launch_bounds__(NTHREADS, 2) mega_fwd(Params p) {
    extern __shared__ __attribute__((aligned(16))) unsigned char lds[];
    const int bid = blockIdx.x, G = gridDim.x;
    const int NGW = G * NWAVES, NGT = G * NTHREADS;
#define PHASE_IDS int tid = threadIdx.x; asm volatile("" : "+v"(tid)); const int lane = tid & 63, wave = __builtin_amdgcn_readfirstlane(tid >> 6), half = tid >> 8, vt = tid & 255; \
    unsigned char* sm = lds + half * 32768; const int gw = bid * NWAVES + wave, gt = bid * NTHREADS + tid; (void)lane; (void)vt; (void)sm; (void)gw; (void)gt;

    const float* x = p.in[0];            const float* mem = p.in[1];
    const float* norm_mix_g = p.in[2];   const float* w_in = p.in[3];
    const float* b_forget = p.in[4];     const float* conv_w = p.in[5];
    const float* conv_b = p.in[6];       const float* lru_wa = p.in[7];
    const float* lru_ba = p.in[8];       const float* lru_wx = p.in[9];
    const float* lru_bx = p.in[10];      const float* lru_a_param = p.in[11];
    const float* fox_q_g = p.in[12];     const float* fox_k_g = p.in[13];
    const float* lru_out_g = p.in[14];   const float* fox_out_g = p.in[15];
    const float* w_out = p.in[16];       const float* norm_mem_x_g = p.in[17];
    const float* norm_mem_g = p.in[18];  const float* mem_wq = p.in[19];
    const float* mem_wkv = p.in[20];     const float* mem_q_g = p.in[21];
    const float* mem_k_g = p.in[22];     const float* mem_wo = p.in[23];
    const float* norm_ffn_g = p.in[24];  const float* r_gw = p.in[25];
    const float* r_gb = p.in[26];        const float* r_ew = p.in[27];
    const float* r_eb = p.in[28];        const float* w_gate = p.in[29];
    const float* w_up = p.in[30];        const float* w_down = p.in[31];
    float* out = p.out;
    unsigned char* ws = p.ws;
    int* ctl = (int*)(ws + WS_CTL) + CW_MOE;
    float* LOGF = (float*)(ws + WS_LOGF); float* CUM = (float*)(ws + WS_CUM);
    bf16_t* MEMN = (bf16_t*)(ws + WS_MEMN); bf16_t* KM = (bf16_t*)(ws + WS_KM); bf16_t* VM = (bf16_t*)(ws + WS_VM);
    int* RE = (int*)(ws + WS_RE); float* RW = (float*)(ws + WS_RW); int* ROWTOK = (int*)(ws + WS_ROWTOK); int* TILEE = (int*)(ws + WS_TILEE);
    bf16_t* H = (bf16_t*)(ws + WS_H); bf16_t* U = (bf16_t*)(ws + WS_U); bf16_t* GATE = (bf16_t*)(ws + WS_GATE);
    bf16_t* Q = (bf16_t*)(ws + WS_Q); bf16_t* K = (bf16_t*)(ws + WS_K); bf16_t* V = (bf16_t*)(ws + WS_V);
    bf16_t* YL = (bf16_t*)(ws + WS_YL); bf16_t* YF = (bf16_t*)(ws + WS_YF); bf16_t* MIXED = (bf16_t*)(ws + WS_MIXED);
    float* X1F = p.out;     float* LA = (float*)(ws + WS_LA); float* LB = (float*)(ws + WS_LB);
    bf16_t* QM = (bf16_t*)(ws + WS_QM); bf16_t* OM = (bf16_t*)(ws + WS_OM); unsigned char* HDN = ws + WS_HDN; unsigned char* YB = ws + WS_YB;

    bf16_t* WT_IN = (bf16_t*)(ws + WS_WT_IN); bf16_t* WT_KV = (bf16_t*)(ws + WS_WT_KV); bf16_t* WT_OUT = (bf16_t*)(ws + WS_WT_OUT);
    bf16_t* WT_Q = (bf16_t*)(ws + WS_WT_Q); bf16_t* WT_O = (bf16_t*)(ws + WS_WT_O); unsigned char* WT_GU = ws + WS_WT_GU; unsigned char* WT_D = ws + WS_WT_D; unsigned char* X2Q = ws + WS_X2Q;
    bf16_t* LRUW = (bf16_t*)(ws + WS_LRUW);
    bf16_t* WT_R = (bf16_t*)(ws + WS_WT_R); float* RSTD2 = (float*)(ws + WS_RSTD2); int* LIST = (int*)(ws + WS_LIST);
    bf16_t* X1B = (bf16_t*)(ws + WS_X1B); bf16_t* X2B = (bf16_t*)(ws + WS_X2B); float* SSL = (float*)(ws + WS_SSL); float* SSF = (float*)(ws + WS_SSF);
    float* SS1 = (float*)(ws + WS_SS1); float* SS2 = (float*)(ws + WS_SS2);
    float* SUMA = (float*)(ws + WS_SUMA); float* SUMH = (float*)(ws + WS_SUMH);
    LAS unsigned char* ldsl = (LAS unsigned char*)lds;
    volatile LAS unsigned* MISC = (volatile LAS unsigned*)((LAS unsigned char*)lds + MISC_OFF);
    if (threadIdx.x < 32) MISC[threadIdx.x] = 0u;
    __syncthreads();
    XcdBarrier bar = xcd_barrier_post((unsigned*)(ws + WS_CTL) + CW_BAR, MISC + 8);
#define GRID_BAR() xcd_barrier(bar)
#define FOR_VB(NB) for (int _vb0 = 2 * bid; _vb0 < (NB); _vb0 += 2 * G) { const int vb = (_vb0 + half < (NB)) ? (_vb0 + half) : ((NB) - 1);
#define END_VB }

    { PHASE_IDS
    {
        LAS unsigned* scr = (LAS unsigned*)(ldsl + wave * 17408);
        constexpr int I_IN = (DM / 128) * (2560 / 64), I_KV = (DM / 128) * (1024 / 64), I_OUT = (DM / 128) * (DM / 64), I_Q = (DM / 128) * (MEM_W / 64), I_O = (MEM_W / 128) * (DM / 64);
        constexpr int NITEMS = I_IN + I_KV + I_OUT + I_Q + I_O;
        for (int it = gw; it < NITEMS; it += NGW) {
            int r = it;
            if (r < I_IN) { p0_transpose_item<1, false>(w_in, IN_COLS, DM, 2560, WT_IN, scr, r, lane, nullptr, nullptr, 0); continue; } r -= I_IN;
            if (r < I_KV) { p0_transpose_item<0, false>(mem_wkv, 2 * MEM_W, DM, 2 * MEM_W, WT_KV, scr, r, lane, nullptr, nullptr, 0); continue; } r -= I_KV;
            if (r < I_OUT) { p0_transpose_item<0, true>(w_out, DM, DM, DM, WT_OUT, scr, r, lane, lru_out_g, fox_out_g, 512); continue; } r -= I_OUT;
            if (r < I_Q) { p0_transpose_item<0, true>(mem_wq, MEM_W, DM, MEM_W, WT_Q, scr, r, lane, norm_mem_x_g, norm_mem_x_g, 1 << 30); continue; } r -= I_Q;
            p0_transpose_item<0, false>(mem_wo, DM, MEM_W, DM, WT_O, scr, r, lane, nullptr, nullptr, 0);
        }
    }
    __syncthreads();
    }
    { PHASE_IDS
    {
        LAS float* wfT = (LAS float*)ldsl;
        for (int i = tid; i < 8 * 1024; i += NTHREADS) { const int k = i >> 3, h = i & 7; wfT[h * 1024 + k] = w_in[(size_t)k * IN_COLS + 2560 + h]; }
        __syncthreads();
        for (int row = gw; row < T; row += NGW) b_rmsnorm_row_f(x, norm_mix_g, H, wfT, b_forget, LOGF, row, lane);
    }
    __syncthreads();
    }
    { PHASE_IDS
    for (int row = gw; row < TM; row += NGW) b_rmsnorm_row(mem, norm_mem_g, MEMN, row, lane);
    if (bid == 0 && tid < 128) ctl[tid] = 0;
    for (int i = gt; i < 48 * DM; i += NGT) {
        const int col = i >> 10, k = i & 1023; float v = 0.f;
        if (col < 4) v = r_gw[(size_t)k * 4 + col]; else if (col < 36) v = r_ew[(size_t)k * 32 + col - 4];
        WT_R[i] = f2bf(v * norm_ffn_g[k]);
    }
    for (int i = gt; i < 8 * 16 * 64 * 8; i += NGT) {
        const int j = i & 7, ln = (i >> 3) & 63, s_ = (i >> 9) & 3, n = (i >> 11) & 1, mat = (i >> 12) & 1, blk = i >> 13;
        const float* W = mat ? lru_wx : lru_wa;
        LRUW[i] = f2bf(W[(size_t)blk * 4096 + (16 * s_ + 8 * (ln >> 5) + j) * 64 + 32 * n + (ln & 31)]);
    }
    }
    GRID_BAR();
    { PHASE_IDS
    { const pg8::Gemm g{H, WT_IN, DM, DM, DM, 0, 0, 0, 0};
      const pg8::EpiInProj E{U, fox_q_g, fox_k_g};
      static_assert(WS_GATE - WS_U == 32 * MiB && WS_Q - WS_GATE == 32 * MiB && WS_K - WS_Q == 32 * MiB && WS_V - WS_K == 32 * MiB, "EpiInProj: section stride");
      const int split = bid % 5;
      if (split > 0) { pg8::StaticOrder S; S.init(T, 2560, G, bid, 0, split); pg8::gemm_phase<pg8::EpiInProj, pg8::StaticOrder, true>(ldsl, g, S, E); }
      { LAS unsigned char* scq = ldsl + wave * 17408;
        for (int it = gw; it < N_EXP * 192; it += NGW) {
            const int e = it / 192, q = it % 192;
            if (q < 64) p0_transpose_item_q<2, true>(w_gate + (size_t)e * DM * D_EXP, D_EXP, DM, D_EXP, WT_GU + (size_t)e * 1024 * 1024, scq, q, lane, norm_ffn_g);
            else if (q < 128) p0_transpose_item_q<3, true>(w_up + (size_t)e * DM * D_EXP, D_EXP, DM, D_EXP, WT_GU + (size_t)e * 1024 * 1024, scq, q - 64, lane, norm_ffn_g);
            else p0_transpose_item_q<0, false>(w_down + (size_t)e * D_EXP * DM, DM, D_EXP, DM, WT_D + (size_t)e * 1024 * 512, scq, q - 128, lane, norm_ffn_g);
        }
        __syncthreads(); }
      { pg8::StaticOrder S; S.init(T, 2560, G, bid, split, 1 << 30); pg8::gemm_phase<pg8::EpiInProj, pg8::StaticOrder, true>(ldsl, g, S, E); } }
    }
    GRID_BAR();
    { PHASE_IDS
    { constexpr int NB = BATCH * FOX_H;
      FOR_VB(NB) b_cumsum(LOGF, CUM, vb, vt, sm, true); END_VB }
    if (bid >= 32) {
      const pg8::Gemm g{MEMN, WT_KV, DM, DM, DM, 0, 0, 0, 0}; pg8::StaticOrder S; S.init(TM, 2 * MEM_W, G, bid - 32);
      const pg8::EpiBf16 E{KM, VM, 512, 512};
      pg8::gemm_phase<pg8::EpiBf16, pg8::StaticOrder, true>(ldsl, g, S, E); }
    __syncthreads();
    for (int u = bid; u < BATCH * lru::NCH; u += G) lru::unit<false>(u / lru::NCH, u % lru::NCH, U, GATE, conv_w, conv_b, LRUW, lru_ba, lru_bx, lru_a_param, SUMA, SUMH, YL, SSL, ldsl + wave * lru::WLDS, wave, lane);
    }
    GRID_BAR();
    { PHASE_IDS
    for (int u = bid; u < BATCH * lru::NCH; u += G) lru::unit<true>(u / lru::NCH, u % lru::NCH, U, GATE, conv_w, conv_b, LRUW, lru_ba, lru_bx, lru_a_param, SUMA, SUMH, YL, SSL, ldsl + wave * lru::WLDS, wave, lane);
    __syncthreads();
    fox::attn_phase<8>((char*)lds, Q, K, V, YF, CUM, SSF, ctl + 100 + (bid & 7));
    }
    GRID_BAR();
    { PHASE_IDS
    { const pg8::Gemm g{YL, WT_OUT, 512, DM, 512, (size_t)(WS_YF - WS_YL) / 2, 512, 0, 0}; pg8::PairOrder S; S.init(T, DM, G, bid);
      const pg8::EpiOutChain E{x, X1B, SSL, SSF, SS1};
      pg8::gemm_phase<pg8::EpiOutChain, pg8::PairOrder, true>(ldsl, g, S, E); }
    }
    GRID_BAR();
    { PHASE_IDS
    { const pg8::Gemm g{X1B, WT_Q, DM, DM, DM, 0, 0, 0, 0}; pg8::StaticOrder S; S.init(T, MEM_W, G, bid);
      const pg8::EpiRowScale E{QM, 512, SS1, 1.f / DM};
      pg8::gemm_phase<pg8::EpiRowScale, pg8::StaticOrder, true>(ldsl, g, S, E); }
    }
    GRID_BAR();
    { PHASE_IDS
    static_assert(xat::LDS_NEED <= MISC_OFF, "cross-attention LDS");
    for (int it = bid; it < BATCH * MEM_H * 8; it += G) { const int bh = it >> 3; xat::item(bh / MEM_H, bh % MEM_H, it & 7, QM, KM, VM, OM, mem_q_g, mem_k_g, ldsl); }
    }
    GRID_BAR();
    { PHASE_IDS
    { const pg8::Gemm g{OM, WT_O, MEM_W, MEM_W, MEM_W, 0, 0, 0, 0}; pg8::StaticOrder S; S.init(T, DM, G, bid);
      const pg8::EpiX2 E{X1B, X2B, X2Q, SS2};
      pg8::gemm_phase<pg8::EpiX2, pg8::StaticOrder, true>(ldsl, g, S, E); }
    }
    GRID_BAR();
    { PHASE_IDS
    static_assert(T / 16 == 256 * NWAVES, "router: one 16-token task per wave on a 256-workgroup grid");
    LAS int* hist = (LAS int*)(ldsl + 8 * 8448 + 36 * 2064);
    LAS unsigned char* wr = ldsl + 8 * 8448;
    if (tid < 64) hist[tid] = 0;
    for (int i = tid; i < 36 * 128; i += NTHREADS) { const int row = i >> 7, ch = i & 127; *(LAS pg8::u32x4*)(wr + row * 2064 + ch * 16) = *(const pg8::u32x4*)(WT_R + (size_t)row * DM + ch * 8); }
    __syncthreads();
    for (int tk = gw; tk < T / 16; tk += NGW) rtr::task(tk * 16, X2B, WT_R, SS2, r_gb, r_eb, RW, RSTD2, ctl, LIST, (LAS float*)(ldsl + wave * 8448), wr, hist, lane);
    }
    GRID_BAR();
    { PHASE_IDS
    LAS int* mp = (LAS int*)(ldsl + 131072);
    if (tid == 0) { int run = 0; for (int e = 0; e < N_EXP; ++e) { const int c_ = ctl[e]; mp[e] = run; mp[64 + e] = c_; run += (c_ + 255) & ~255; } mp[32] = run; }
    __syncthreads();
    if (tid < N_TILES) { const int row = tid * 256; int e = 0; for (int j = 1; j < N_EXP; ++j) if (mp[j] <= row) e = j; mp[128 + tid] = e; }
    __syncthreads();
    { const pg8::Gemm g{X2Q, WT_GU, DM, DM, DM, 0, (size_t)1024 * 1024, 0x7f7f7f7f, 0x7a7a7a7a};
      const pg8::MoeOrder<true> S{(mp[32] >> 8) * 4, G, bid, mp, LIST};
      const pg8::EpiMoe1 E{HDN, RSTD2, S};
      pg8::gemm_phase<pg8::EpiMoe1, pg8::MoeOrder<true>, true>(ldsl, g, S, E); }
    }
    GRID_BAR();
    { PHASE_IDS
    LAS int* mp = (LAS int*)(ldsl + 131072);
    { const pg8::Gemm g{HDN, WT_D, D_EXP, D_EXP, D_EXP, 0, (size_t)1024 * 512, 0x7c7c7c7c, 0x7a7a7a7a};
      const pg8::MoeOrder<false> S{(mp[32] >> 8) * 4, G, bid, mp, LIST};
      const pg8::EpiMoe2 E{YB, RW, S};
      pg8::gemm_phase<pg8::EpiMoe2, pg8::MoeOrder<false>, true>(ldsl, g, S, E); }
    }
    GRID_BAR();
    { PHASE_IDS
    for (size_t i = (size_t)gt * 8; i < (size_t)T * DM; i += (size_t)NGT * 8) b_final(out, X2B, YB, i);
    }
}

extern "C" void kernel_launch(void* const* d_in, const int* in_sizes, int n_in, void* d_out, int out_size, void* d_ws, size_t ws_size, hipStream_t stream) {
    static int grid = 0;
    if (grid == 0) {
        int dev = 0, cus = 0;
        if (hipGetDevice(&dev) != hipSuccess || hipDeviceGetAttribute(&cus, hipDeviceAttributeMultiprocessorCount, dev) != hipSuccess) { fprintf(stderr, "kernel_launch: device query failed\n"); grid = -1; return; }
        if (hipFuncSetAttribute((const void*)mega_fwd, hipFuncAttributeMaxDynamicSharedMemorySize, LDS_BYTES) != hipSuccess) { fprintf(stderr, "kernel_launch: hipFuncSetAttribute failed\n"); grid = -1; return; }
        if (n_in != 32 || ws_size < WS_END) { fprintf(stderr, "kernel_launch: unexpected inputs (n_in %d, ws %zu)\n", n_in, ws_size); grid = -1; return; }
        grid = cus;
    }
    if (grid < 0) return;
    (void)hipMemsetAsync((char*)d_ws + WS_CTL, 0, CTL_ZERO_BYTES, stream);
    Params p{};
    for (int i = 0; i < 32; ++i) p.in[i] = (const float*)d_in[i];
    p.out = (float*)d_out; p.ws = (unsigned char*)d_ws;
    hipLaunchKernelGGL(mega_fwd, dim3(grid), dim3(NTHREADS), LDS_BYTES, stream, p);
}
```

```cpp
#include <hip/hip_runtime.h>
#include <stdint.h>
#include <math.h>
#include <cstdio>

typedef unsigned short bf16_t;
typedef short bf16x8 __attribute__((ext_vector_type(8)));
typedef float f32x4 __attribute__((ext_vector_type(4)));
typedef float f32x16 __attribute__((ext_vector_type(16)));
#define GAS __attribute__((address_space(1)))
#define LAS __attribute__((address_space(3)))

constexpr int BATCH = 8, SEQ = 4096, T = BATCH * SEQ, DM = 1024;
constexpr int MEM_LEN = 256, TM = BATCH * MEM_LEN;
constexpr int LRU_W = 512, FOX_H = 8, FOX_D = 64, FOX_W = 512;
constexpr int IN_COLS = 2568;
constexpr int MEM_H = 4, MEM_D = 128, MEM_W = 512;
constexpr int N_GROUPS = 4, EPG = 8, N_EXP = 32, D_EXP = 512;
constexpr int NA = T * 2;
constexpr int MOE_PAD = 256;
constexpr int P_MAX = NA + N_EXP * MOE_PAD;
constexpr int N_TILES = P_MAX / MOE_PAD;
constexpr float EPS = 1e-6f;
constexpr float LOG2E = 1.4426950408889634f;
constexpr int NTHREADS = 512, NWAVES = 8;
constexpr int ESPLIT = 12;

constexpr size_t MiB = 1u << 20;
constexpr size_t WS_CTL = 0;
constexpr size_t CTL_ZERO_BYTES = 256 * 1024;
constexpr int CW_MOE = 0;
constexpr int CW_BAR = 4096;
constexpr size_t WS_LOGF = 1 * MiB;
constexpr size_t WS_CUM = 2 * MiB;
constexpr size_t WS_MEMN = 3 * MiB;
constexpr size_t WS_KM = 7 * MiB;
constexpr size_t WS_VM = 9 * MiB;
constexpr size_t WS_RE = 11 * MiB;
constexpr size_t WS_RW = 11 * MiB + 512 * 1024;
constexpr size_t WS_ROWTOK = 12 * MiB;
constexpr size_t WS_TILEE = 13 * MiB;
constexpr size_t WS_SUMA = 14 * MiB;
constexpr size_t WS_SUMH = 14 * MiB + 512 * 1024;
constexpr size_t WS_LRUW = 15 * MiB;
constexpr size_t WS_WT_IN = 16 * MiB;
constexpr size_t WS_WT_KV = 21 * MiB;
constexpr size_t WS_WT_OUT = 23 * MiB;
constexpr size_t WS_WT_Q = 25 * MiB;
constexpr size_t WS_WT_O = 26 * MiB;
constexpr size_t WS_WT_GU = 27 * MiB;
constexpr size_t WS_WT_D = 91 * MiB;
constexpr size_t WS_H = 123 * MiB;
constexpr size_t WS_MIXED = 123 * MiB;
constexpr size_t WS_LA = 123 * MiB;
constexpr size_t WS_YL = 187 * MiB;
constexpr size_t WS_YF = 219 * MiB;
constexpr size_t WS_YB = 123 * MiB;
constexpr size_t WS_U = 251 * MiB;
constexpr size_t WS_GATE = 283 * MiB;
constexpr size_t WS_Q = 315 * MiB;
constexpr size_t WS_K = 347 * MiB;
constexpr size_t WS_V = 379 * MiB;
constexpr size_t WS_QM = 251 * MiB;
constexpr size_t WS_OM = 283 * MiB;
constexpr size_t WS_HDN = 315 * MiB;
constexpr size_t WS_LB = 411 * MiB;
constexpr size_t WS_X1B = 123 * MiB;
constexpr size_t WS_X2Q = 360 * MiB;
constexpr size_t WS_X2B = 411 * MiB;
constexpr size_t WS_LIST = 476 * MiB;
constexpr size_t WS_SSL = 480 * MiB;
constexpr size_t WS_SSF = 481 * MiB;
constexpr size_t WS_SS1 = 482 * MiB;
constexpr size_t WS_SS2 = 484 * MiB;
constexpr size_t WS_RSTD2 = 486 * MiB;
constexpr size_t WS_WT_R = 487 * MiB;
constexpr size_t WS_RSL = 488 * MiB;
constexpr size_t WS_POSR = 492 * MiB;
constexpr size_t WS_END = 493 * MiB;
static_assert(WS_YB + (size_t)P_MAX * DM <= WS_U, "expert outputs: fp8 [P_MAX][1024] in list order");
static_assert((size_t)P_MAX * 512 * 2 <= 96 * MiB && (size_t)NA * DM * 2 <= 128 * MiB, "ws map");

constexpr int LDS_BYTES = 155648;
constexpr int MISC_OFF = LDS_BYTES - 512;

__device__ __forceinline__ bf16_t f2bf(float f) { unsigned u = __float_as_uint(f); return (bf16_t)((u + 0x7fffu + ((u >> 16) & 1u)) >> 16); }
__device__ __forceinline__ float bf2f(bf16_t h) { return __uint_as_float(((unsigned)h) << 16); }
__device__ __forceinline__ float wave_sum(float v) {
#pragma unroll
    for (int o = 1; o < 64; o <<= 1) v += __shfl_xor(v, o);
    return v;
}
__device__ __forceinline__ int crow(int r, int hi) { return (r & 3) + 8 * (r >> 2) + 4 * hi; }
__device__ __forceinline__ float sigmoidf_(float x) { return 1.f / (1.f + __expf(-x)); }
__device__ __forceinline__ float gelu_tanh(float x) {
    const float k0 = 0.7978845608028654f, k1 = 0.044715f;
    float u = k0 * (x + k1 * x * x * x);
    float t = 1.f - 2.f / (1.f + __expf(2.f * u));
    return 0.5f * x * (1.f + t);
}

#define XB_TMO      128
#define XB_XCNT(j)  (256  + 64 * (j))
#define XB_XSUB(j)  (1280 + 64 * (j))
#define XB_XGEN(j)  (2304 + 64 * (j))
#define XB_TOP      3328
#define XB_TOPGEN   3392
#define XCD_BAR_WORDS 3456
#define XB_SPIN_CAP (1u << 20)
__device__ __forceinline__ unsigned xb_ld(unsigned* p)              { return __hip_atomic_load(p, __ATOMIC_RELAXED, __HIP_MEMORY_SCOPE_AGENT); }
__device__ __forceinline__ unsigned xb_add(unsigned* p, unsigned v) { return __hip_atomic_fetch_add(p, v, __ATOMIC_RELAXED, __HIP_MEMORY_SCOPE_AGENT); }
__device__ __forceinline__ unsigned xb_xcc_id() { return (unsigned)__builtin_amdgcn_s_getreg((3 << 11) | 20) & 0xFu; }
#define XB_SPIN(cond, bar) do { unsigned _sp = 0; while (cond) { __builtin_amdgcn_s_sleep(1); \
    if ((++_sp & 255u) == 0u) { if (xb_ld(&(bar)[XB_TMO])) break; if (_sp > XB_SPIN_CAP) { atomicAdd(&(bar)[XB_TMO], 1u); break; } } } } while (0)
struct XcdBarrier { unsigned* bar; unsigned x; volatile LAS unsigned* st; };
__device__ __forceinline__ XcdBarrier xcd_barrier_post(unsigned* bar, volatile LAS unsigned* st) {
    XcdBarrier b; b.bar = bar; b.x = xb_xcc_id(); b.st = st;
    if (threadIdx.x == 0) (void)xb_add(&bar[XB_XCNT(b.x)], 1u);
    return b;
}
__device__ __forceinline__ void xcd_barrier_complete(unsigned* bar, unsigned x, unsigned& nloc, unsigned& nx) {
    const unsigned G = gridDim.x * gridDim.y * gridDim.z;
    unsigned sum, cnt, mine, sp = 0u;
    for (;;) {
        sum = 0u; cnt = 0u; mine = 0u;
#pragma unroll
        for (unsigned j = 0; j < 16; ++j) { const unsigned c = xb_ld(&bar[XB_XCNT(j)]); sum += c; cnt += (c > 0u) ? 1u : 0u; mine = (j == x) ? c : mine; }
        if (sum == G) break;
        __builtin_amdgcn_s_sleep(1);
        if ((++sp & 255u) == 0u) { if (xb_ld(&bar[XB_TMO])) break; if (sp > XB_SPIN_CAP) { atomicAdd(&bar[XB_TMO], 1u); break; } }
    }
    nloc = mine > 0u ? mine : 1u; nx = cnt > 0u ? cnt : 1u;
}
__device__ __forceinline__ void xcd_barrier(const XcdBarrier& b) {
    asm volatile("s_waitcnt vmcnt(0)" ::: "memory");
    __syncthreads();
    if (threadIdx.x == 0) {
        unsigned* bar = b.bar;
        __builtin_amdgcn_s_waitcnt(0);
        unsigned nloc = b.st[0], nx = b.st[1];
        if (nloc == 0u) { xcd_barrier_complete(bar, b.x, nloc, nx); b.st[0] = nloc; b.st[1] = nx; }
        const unsigned old = xb_add(&bar[XB_XSUB(b.x)], 1u);
        const unsigned gen = old / nloc;
        if (old + 1u == (gen + 1u) * nloc) {
            __builtin_amdgcn_fence(__ATOMIC_RELEASE, "agent");
            asm volatile("s_waitcnt vmcnt(0)" ::: "memory");
            const unsigned og = xb_add(&bar[XB_TOP], 1u);
            const unsigned tg = og / nx;
            if (og + 1u == (tg + 1u) * nx) xb_add(&bar[XB_TOPGEN], 1u);
            else XB_SPIN(xb_ld(&bar[XB_TOPGEN]) == tg, bar);
            __builtin_amdgcn_fence(__ATOMIC_ACQUIRE, "agent");
            xb_add(&bar[XB_XGEN(b.x)], 1u);
            asm volatile("s_waitcnt vmcnt(0)" ::: "memory");
        } else {
            XB_SPIN(xb_ld(&bar[XB_XGEN(b.x)]) == gen, bar);
            __builtin_amdgcn_fence(__ATOMIC_ACQUIRE, "agent");
            asm volatile("s_waitcnt vmcnt(0)" ::: "memory");
        }
    }
    __syncthreads();
}

__device__ __forceinline__ void b_rmsnorm_row(const float* __restrict__ x, const float* __restrict__ g, bf16_t* __restrict__ out, int row, int lane) {
    const f32x4* xr = (const f32x4*)(x + (size_t)row * DM) + lane;
    f32x4 v[4]; float s = 0.f;
#pragma unroll
    for (int j = 0; j < 4; ++j) { v[j] = xr[64 * j]; s += v[j].x * v[j].x + v[j].y * v[j].y + v[j].z * v[j].z + v[j].w * v[j].w; }
    const float rstd = rsqrtf(wave_sum(s) * (1.f / DM) + EPS);
    const f32x4* gr = (const f32x4*)g + lane;
    uint2* o = (uint2*)(out + (size_t)row * DM) + lane;
#pragma unroll
    for (int j = 0; j < 4; ++j) {
        f32x4 gg = gr[64 * j];
        uint2 w;
        w.x = (unsigned)f2bf(v[j].x * rstd * gg.x) | ((unsigned)f2bf(v[j].y * rstd * gg.y) << 16);
        w.y = (unsigned)f2bf(v[j].z * rstd * gg.z) | ((unsigned)f2bf(v[j].w * rstd * gg.w) << 16);
        o[64 * j] = w;
    }
}


__device__ __forceinline__ void b_rmsnorm_row_f(const float* __restrict__ x, const float* __restrict__ g, bf16_t* __restrict__ out, const LAS float* wfT, const float* __restrict__ b_forget,
                                                float* __restrict__ LOGF, int row, int lane) {
    const f32x4* xr = (const f32x4*)(x + (size_t)row * DM) + lane;
    f32x4 v[4]; float s = 0.f;
#pragma unroll
    for (int j = 0; j < 4; ++j) { v[j] = xr[64 * j]; s += v[j].x * v[j].x + v[j].y * v[j].y + v[j].z * v[j].z + v[j].w * v[j].w; }
    const float rstd = rsqrtf(wave_sum(s) * (1.f / DM) + EPS);
    const f32x4* gr = (const f32x4*)g + lane;
    uint2* o = (uint2*)(out + (size_t)row * DM) + lane;
#pragma unroll
    for (int j = 0; j < 4; ++j) {
        const f32x4 gg = gr[64 * j];
        v[j].x *= rstd * gg.x; v[j].y *= rstd * gg.y; v[j].z *= rstd * gg.z; v[j].w *= rstd * gg.w;
        uint2 w;
        w.x = (unsigned)f2bf(v[j].x) | ((unsigned)f2bf(v[j].y) << 16);
        w.y = (unsigned)f2bf(v[j].z) | ((unsigned)f2bf(v[j].w) << 16);
        o[64 * j] = w;
    }
    float fl[8];
#pragma unroll
    for (int h = 0; h < 8; ++h) {
        float a = 0.f;
#pragma unroll
        for (int j = 0; j < 4; ++j) { const f32x4 w = *(const LAS f32x4*)(wfT + h * 1024 + 256 * j + 4 * lane); a += (v[j].x * w.x + v[j].y * w.y) + (v[j].z * w.z + v[j].w * w.w); }
        fl[h] = wave_sum(a);
    }
    if (lane == 0) {
#pragma unroll
        for (int h = 0; h < 8; ++h) { const float z = fl[h] + b_forget[h]; LOGF[(size_t)row * 8 + h] = fminf(z, 0.f) - log1pf(__expf(-fabsf(z))); }
    }
}

typedef bf16_t (*As_t)[40];
typedef bf16_t (*Bs_t)[64][40];
template <int NB>
__device__ __forceinline__ void gemm_core64(const bf16_t* aptr, const float* W0, const float* W1, int ldw,
                                            int n0, int N, int K, f32x4 (&acc)[NB][2][2], As_t As, Bs_t Bs, int vt) {
    const int lane = vt & 63, wid = vt >> 6, wr = wid >> 1, wc = wid & 1;
    for (int k0 = 0; k0 < K; k0 += 32) {
        {
            const int r = vt >> 2, c = vt & 3;
            uint4 v = make_uint4(0, 0, 0, 0);
            if (aptr) v = *(const uint4*)(aptr + k0 + c * 8);
            *(uint4*)&As[r][c * 8] = v;
        }
        {
            const int kk = vt >> 3, nc = (vt & 7) * 8;
#pragma unroll
            for (int b = 0; b < NB; ++b) {
                const float* wp = (b == 0 ? W0 : W1) + (size_t)(k0 + kk) * ldw + n0 + nc;
#pragma unroll
                for (int j = 0; j < 8; ++j) { float v = (n0 + nc + j < N) ? wp[j] : 0.f; Bs[b][nc + j][kk] = f2bf(v); }
            }
        }
        __syncthreads();
        bf16x8 a[2];
#pragma unroll
        for (int i = 0; i < 2; ++i) a[i] = *(const bf16x8*)&As[wr * 32 + i * 16 + (lane & 15)][(lane >> 4) * 8];
#pragma unroll
        for (int b = 0; b < NB; ++b)
#pragma unroll
            for (int j = 0; j < 2; ++j) {
                bf16x8 bb = *(const bf16x8*)&Bs[b][wc * 32 + j * 16 + (lane & 15)][(lane >> 4) * 8];
#pragma unroll
                for (int i = 0; i < 2; ++i) acc[b][i][j] = __builtin_amdgcn_mfma_f32_16x16x32_bf16(a[i], bb, acc[b][i][j], 0, 0, 0);
            }
        __syncthreads();
    }
}

template <class Epi>
__device__ __forceinline__ void b_gemm(const bf16_t* __restrict__ A, int lda, const float* __restrict__ W, int ldw, int N, int K, const Epi& epi,
                                       int vbx, int vby, int vt, unsigned char* sm) {
    As_t As = (As_t)sm; Bs_t Bs = (Bs_t)(sm + 64 * 40 * 2);
    const int lane = vt & 63, wid = vt >> 6, wr = wid >> 1, wc = wid & 1;
    const int m0 = vby * 64, n0 = vbx * 64;
    f32x4 acc[1][2][2];
#pragma unroll
    for (int i = 0; i < 2; ++i)
#pragma unroll
        for (int j = 0; j < 2; ++j) acc[0][i][j] = (f32x4){0.f, 0.f, 0.f, 0.f};
    gemm_core64<1>(A + (size_t)(m0 + (vt >> 2)) * lda, W, W, ldw, n0, N, K, acc, As, Bs, vt);
#pragma unroll
    for (int i = 0; i < 2; ++i)
#pragma unroll
        for (int j = 0; j < 2; ++j)
#pragma unroll
            for (int r = 0; r < 4; ++r) {
                const int row = m0 + wr * 32 + i * 16 + (lane >> 4) * 4 + r, col = n0 + wc * 32 + j * 16 + (lane & 15);
                if (col < N) epi(row, col, acc[0][i][j][r]);
            }
}

struct EpiG1 {
    bf16_t *U, *GATE, *Q, *K, *V; float* LOGF; const float* b_forget;
    __device__ __forceinline__ void operator()(int row, int col, float v) const {
        if (col < 512) U[(size_t)row * 512 + col] = f2bf(v);
        else if (col < 1024) GATE[(size_t)row * 512 + col - 512] = f2bf(v);
        else if (col < 1536) Q[(size_t)row * 512 + col - 1024] = f2bf(v);
        else if (col < 2048) K[(size_t)row * 512 + col - 1536] = f2bf(v);
        else if (col < 2560) V[(size_t)row * 512 + col - 2048] = f2bf(v);
        else { const int h = col - 2560; const float z = v + b_forget[h]; LOGF[(size_t)row * 8 + h] = fminf(z, 0.f) - log1pf(__expf(-fabsf(z))); }
    }
};
struct EpiSplit2 { bf16_t *O0, *O1;
    __device__ __forceinline__ void operator()(int row, int col, float v) const {
        if (col < 512) O0[(size_t)row * 512 + col] = f2bf(v); else O1[(size_t)row * 512 + col - 512] = f2bf(v); } };
struct EpiBf16s { bf16_t* O; int ldo;
    __device__ __forceinline__ void operator()(int row, int col, float v) const { O[(size_t)row * ldo + col] = f2bf(v); } };
struct EpiResF32 { const float* base; float* out;
    __device__ __forceinline__ void operator()(int row, int col, float v) const { out[(size_t)row * DM + col] = base[(size_t)row * DM + col] + v; } };

template <int HD>
__device__ __forceinline__ void b_headnorm(bf16_t* __restrict__ X, const float* __restrict__ g, float scale, int idx) {
    const int nh = 512 / HD;
    bf16_t* p = X + (size_t)(idx / nh) * 512 + (idx % nh) * HD;
    float ss = 0.f;
#pragma unroll 8
    for (int d = 0; d < HD; ++d) { float v = bf2f(p[d]); ss += v * v; }
    const float rstd = rsqrtf(ss * (1.f / HD) + EPS) * scale;
#pragma unroll 8
    for (int d = 0; d < HD; ++d) p[d] = f2bf(bf2f(p[d]) * rstd * g[d]);
}

__device__ __forceinline__ void b_cumsum(const float* __restrict__ LOGF, float* __restrict__ CUM, int bh, int vt, unsigned char* sm, bool store) {
    float* part = (float*)sm;
    const int b = bh / FOX_H, h = bh % FOX_H;
    float v[16]; float s = 0.f;
#pragma unroll
    for (int i = 0; i < 16; ++i) { v[i] = LOGF[((size_t)b * SEQ + vt * 16 + i) * 8 + h]; s += v[i]; }
    part[vt] = s; __syncthreads();
    if (vt == 0) { float run = 0.f; for (int i = 0; i < 256; ++i) { float t = part[i]; part[i] = run; run += t; } }
    __syncthreads();
    float run = part[vt];
    if (store) {
#pragma unroll
        for (int i = 0; i < 16; ++i) { run += v[i]; CUM[(size_t)bh * SEQ + vt * 16 + i] = run * LOG2E; }
    }
    __syncthreads();
}

__device__ __forceinline__ void b_lru_ab(const bf16_t* __restrict__ U, const float* __restrict__ conv_w, const float* __restrict__ conv_b,
                                         const float* __restrict__ wa, const float* __restrict__ ba, const float* __restrict__ wx, const float* __restrict__ bx,
                                         const float* __restrict__ a_param, float* __restrict__ LA, float* __restrict__ LB, int t, int ch, unsigned char* sm) {
    float* xc = (float*)sm;
    const int s = t % SEQ;
    float x = conv_b[ch];
#pragma unroll
    for (int tap = 0; tap < 4; ++tap) { const int ss = s - 3 + tap; if (ss >= 0) x += conv_w[tap * 512 + ch] * bf2f(U[(size_t)(t - 3 + tap) * 512 + ch]); }
    xc[ch] = x; __syncthreads();
    const int blk = ch >> 6, j = ch & 63;
    float r = ba[ch], ii = bx[ch];
    const float* wap = wa + (size_t)blk * 4096 + j; const float* wxp = wx + (size_t)blk * 4096 + j;
#pragma unroll 4
    for (int i = 0; i < 64; ++i) { const float xv = xc[blk * 64 + i]; r += xv * wap[i * 64]; ii += xv * wxp[i * 64]; }
    r = sigmoidf_(r); ii = sigmoidf_(ii);
    const float ap = -a_param[ch];
    const float sp = (ap > 20.f) ? ap : log1pf(__expf(ap));
    const float log_a = -8.f * r * sp;
    const float a = __expf(log_a);
    const float mult = sqrtf(fmaxf(-expm1f(2.f * log_a), 0.f));
    LA[(size_t)t * 512 + ch] = a;
    LB[(size_t)t * 512 + ch] = mult * (ii * x);
    __syncthreads();
}
__device__ __forceinline__ void b_lru_scan(const float* __restrict__ LA, const float* __restrict__ LB, const bf16_t* __restrict__ GATE, bf16_t* __restrict__ YL, int vb, int lane) {
    const int b = vb / 8, ch = (vb % 8) * 64 + lane;
    float h = 0.f;
    size_t off = (size_t)b * SEQ * 512 + ch;
    for (int s = 0; s < SEQ; s += 8) {
        float a[8], bb[8], g[8];
#pragma unroll
        for (int i = 0; i < 8; ++i) { a[i] = LA[off + (size_t)(s + i) * 512]; bb[i] = LB[off + (size_t)(s + i) * 512]; g[i] = bf2f(GATE[off + (size_t)(s + i) * 512]); }
#pragma unroll
        for (int i = 0; i < 8; ++i) { h = a[i] * h + bb[i]; YL[off + (size_t)(s + i) * 512] = f2bf(h * gelu_tanh(g[i])); }
    }
}

template <int D, bool CAUSAL, int VB0>
__device__ __forceinline__ void b_attn(const bf16_t* __restrict__ Q, const bf16_t* __restrict__ K, const bf16_t* __restrict__ V, bf16_t* __restrict__ O,
                                       const float* __restrict__ cum, int H, int Sq, int Skv, int pitch, int b, int h, int q0, int lane) {
    const int r32 = lane & 31, hi = lane >> 5;
    const bf16_t* Qp = Q + ((size_t)b * Sq + q0 + r32) * pitch + h * D;
    constexpr bool QREG = (D <= 64);
    bf16x8 qf[QREG ? D / 16 : 1];
    if (QREG) {
#pragma unroll
        for (int d0 = 0; d0 < D / 16; ++d0) qf[QREG ? d0 : 0] = *(const bf16x8*)(Qp + d0 * 16 + hi * 8);
    }
    f32x16 o[2];
#pragma unroll
    for (int i = 0; i < 2; ++i)
#pragma unroll
        for (int r = 0; r < 16; ++r) o[i][r] = 0.f;
    float m = -1e30f, l = 0.f;
    const int nkv = CAUSAL ? (q0 + 32) : Skv;
    const float* cb = cum ? cum + ((size_t)b * H + h) * Skv : nullptr;
    const float cref = cum ? cb[q0] : 0.f;
    const bf16_t* Kb = K + ((size_t)b * Skv) * pitch + h * D;
    const bf16_t* Vb = V + ((size_t)b * Skv) * pitch + h * D;
#pragma unroll 1
    for (int kv0 = 0; kv0 < nkv; kv0 += 32) {
        f32x16 s;
#pragma unroll
        for (int r = 0; r < 16; ++r) s[r] = 0.f;
        const bf16_t* Kp = Kb + (size_t)(kv0 + r32) * pitch;
#pragma unroll
        for (int d0 = 0; d0 < D / 16; ++d0) { bf16x8 kf = *(const bf16x8*)(Kp + d0 * 16 + hi * 8);
            bf16x8 qq; if (QREG) qq = qf[QREG ? d0 : 0]; else qq = *(const bf16x8*)(Qp + d0 * 16 + hi * 8);
            s = __builtin_amdgcn_mfma_f32_32x32x16_bf16(kf, qq, s, 0, 0, 0); }
        float tmax = -INFINITY;
#pragma unroll
        for (int r = 0; r < 16; ++r) {
            const int kv = kv0 + crow(r, hi);
            float v = s[r];
            if (cum) v += cref - cb[kv];
            if (CAUSAL && kv > q0 + r32) v = -INFINITY;
            s[r] = v; tmax = fmaxf(tmax, v);
        }
        tmax = fmaxf(tmax, __shfl_xor(tmax, 32));
        const float mnew = fmaxf(m, tmax);
        const float alpha = exp2f(m - mnew);
        float ps = 0.f;
#pragma unroll
        for (int r = 0; r < 16; ++r) { s[r] = exp2f(s[r] - mnew); ps += s[r]; }
        l = l * alpha + ps; m = mnew;
#pragma unroll
        for (int i = 0; i < 2; ++i)
#pragma unroll
            for (int r = 0; r < 16; ++r) o[i][r] *= alpha;
        bf16x8 pb[2];
#pragma unroll
        for (int s2 = 0; s2 < 2; ++s2)
#pragma unroll
            for (int j = 0; j < 8; ++j) pb[s2][j] = (short)f2bf(s[8 * s2 + j]);
#pragma unroll
        for (int i = 0; i < 2; ++i)
#pragma unroll
            for (int s2 = 0; s2 < 2; ++s2) {
                bf16x8 vf;
#pragma unroll
                for (int j = 0; j < 8; ++j) vf[j] = (short)Vb[(size_t)(kv0 + 16 * s2 + 8 * (j >> 2) + 4 * hi + (j & 3)) * pitch + (VB0 + i) * 32 + r32];
                o[i] = __builtin_amdgcn_mfma_f32_32x32x16_bf16(vf, pb[s2], o[i], 0, 0, 0);
                asm volatile("" ::: "memory");
            }
    }
    l += __shfl_xor(l, 32);
    const float rl = 1.f / l;
    bf16_t* Op = O + ((size_t)b * Sq + q0 + r32) * pitch + h * D;
#pragma unroll
    for (int i = 0; i < 2; ++i)
#pragma unroll
        for (int r = 0; r < 16; ++r) Op[(VB0 + i) * 32 + crow(r, hi)] = f2bf(o[i][r] * rl);
}

__device__ __forceinline__ void b_mixnorm(const bf16_t* __restrict__ YL, const bf16_t* __restrict__ YF, const float* __restrict__ gl, const float* __restrict__ gf, bf16_t* __restrict__ MIXED, int row, int lane) {
#pragma unroll
    for (int part = 0; part < 2; ++part) {
        const bf16_t* src = (part ? YF : YL) + (size_t)row * 512 + lane * 8;
        const float* g = (part ? gf : gl) + lane * 8;
        float v[8]; float ss = 0.f;
#pragma unroll
        for (int j = 0; j < 8; ++j) { v[j] = bf2f(src[j]); ss += v[j] * v[j]; }
        const float rstd = rsqrtf(wave_sum(ss) * (1.f / 512.f) + EPS);
        bf16_t* dst = MIXED + (size_t)row * DM + part * 512 + lane * 8;
#pragma unroll
        for (int j = 0; j < 8; ++j) dst[j] = f2bf(v[j] * rstd * g[j]);
    }
}

__device__ __forceinline__ void b_router(const bf16_t* __restrict__ XN, const float* __restrict__ wg, const float* __restrict__ bg, const float* __restrict__ we, const float* __restrict__ be,
                                         int* __restrict__ RE, float* __restrict__ RW, int* __restrict__ counts, int t, int lane) {
    float acc[36];
#pragma unroll
    for (int o = 0; o < 36; ++o) acc[o] = 0.f;
    const bf16_t* xr = XN + (size_t)t * DM;
#pragma unroll 1
    for (int i = 0; i < 16; ++i) {
        const int k = i * 64 + lane;
        const float xv = bf2f(xr[k]);
        const f32x4 g4 = *(const f32x4*)(wg + (size_t)k * 4);
        acc[0] += xv * g4.x; acc[1] += xv * g4.y; acc[2] += xv * g4.z; acc[3] += xv * g4.w;
        const f32x4* e4 = (const f32x4*)(we + (size_t)k * 32);
#pragma unroll
        for (int q = 0; q < 8; ++q) { const f32x4 e = e4[q]; acc[4 + 4 * q] += xv * e.x; acc[5 + 4 * q] += xv * e.y; acc[6 + 4 * q] += xv * e.z; acc[7 + 4 * q] += xv * e.w; }
    }
#pragma unroll
    for (int o = 0; o < 36; ++o) acc[o] = wave_sum(acc[o]);
    if (lane == 0) {
        float gl[4]; int gi = 0; float gmax;
#pragma unroll
        for (int j = 0; j < 4; ++j) { gl[j] = acc[j] + bg[j]; }
        gmax = gl[0];
#pragma unroll
        for (int j = 1; j < 4; ++j) if (gl[j] > gmax) { gmax = gl[j]; gi = j; }
        float gs = 0.f;
#pragma unroll
        for (int j = 0; j < 4; ++j) gs += __expf(gl[j] - gmax);
        const float gw = 1.f / gs;
        float el[8];
#pragma unroll
        for (int j = 0; j < 8; ++j) {
            float v = 0.f;
#pragma unroll
            for (int g = 0; g < 4; ++g) if (g == gi) v = acc[4 + g * 8 + j] + be[g * 8 + j];
            el[j] = v;
        }
        int i0 = 0; float v0 = el[0];
#pragma unroll
        for (int j = 1; j < 8; ++j) if (el[j] > v0) { v0 = el[j]; i0 = j; }
        int i1 = -1; float v1 = -INFINITY;
#pragma unroll
        for (int j = 0; j < 8; ++j) if (j != i0 && el[j] > v1) { v1 = el[j]; i1 = j; }
        const float e1 = __expf(v1 - v0);
        const float p0 = 1.f / (1.f + e1), p1 = e1 / (1.f + e1);
        const int ex0 = gi * 8 + i0, ex1 = gi * 8 + i1;
        RE[t * 2 + 0] = ex0; RE[t * 2 + 1] = ex1;
        RW[t * 2 + 0] = gw * p0; RW[t * 2 + 1] = gw * p1;
        atomicAdd(&counts[ex0], 1); atomicAdd(&counts[ex1], 1);
    }
}

__device__ __forceinline__ void b_moe_scan(int* __restrict__ ctl, int* __restrict__ TILEE, int tid, unsigned char* sm) {
    int* pst = (int*)sm;
    if (tid == 0) { int run = 0; for (int e = 0; e < N_EXP; ++e) { pst[e] = run; ctl[64 + e] = run; ctl[32 + e] = 0; run += (ctl[e] + MOE_PAD - 1) / MOE_PAD * MOE_PAD; } pst[32] = run; ctl[96] = run / MOE_PAD; }
    __syncthreads();
    for (int tile = tid; tile < N_TILES; tile += NTHREADS) {
        const int p = tile * MOE_PAD; int e = -1;
        for (int j = 0; j < N_EXP; ++j) if (p >= pst[j] && p < pst[j + 1]) e = j;
        TILEE[tile] = e;
    }
}

__device__ __forceinline__ void b_moe_gemm1(const bf16_t* __restrict__ XN, const float* __restrict__ Wg, const float* __restrict__ Wu, const int* __restrict__ ROWTOK, const int* __restrict__ TILEE, bf16_t* __restrict__ HDN,
                                            int vbx, int vby, int vt, unsigned char* sm) {
    As_t As = (As_t)sm; Bs_t Bs = (Bs_t)(sm + 64 * 40 * 2);
    const int e_raw = TILEE[vby];
    const int e = e_raw < 0 ? 0 : e_raw;
    const int lane = vt & 63, wid = vt >> 6, wr = wid >> 1, wc = wid & 1;
    const int p0 = vby * 64, n0 = vbx * 64;
    const int a = ROWTOK[p0 + (vt >> 2)];
    f32x4 acc[2][2][2];
#pragma unroll
    for (int b = 0; b < 2; ++b)
#pragma unroll
        for (int i = 0; i < 2; ++i)
#pragma unroll
            for (int j = 0; j < 2; ++j) acc[b][i][j] = (f32x4){0.f, 0.f, 0.f, 0.f};
    gemm_core64<2>(a >= 0 ? XN + (size_t)(a >> 1) * DM : nullptr, Wg + (size_t)e * DM * D_EXP, Wu + (size_t)e * DM * D_EXP, D_EXP, n0, D_EXP, DM, acc, As, Bs, vt);
    if (e_raw < 0) return;
#pragma unroll
    for (int i = 0; i < 2; ++i)
#pragma unroll
        for (int j = 0; j < 2; ++j)
#pragma unroll
            for (int r = 0; r < 4; ++r) {
                const int row = p0 + wr * 32 + i * 16 + (lane >> 4) * 4 + r, col = n0 + wc * 32 + j * 16 + (lane & 15);
                const float g = acc[0][i][j][r], u = acc[1][i][j][r];
                HDN[(size_t)row * D_EXP + col] = f2bf(g * sigmoidf_(g) * u);
            }
}
__device__ __forceinline__ void b_moe_gemm2(const bf16_t* __restrict__ HDN, const float* __restrict__ Wd, const int* __restrict__ ROWTOK, const int* __restrict__ TILEE, const float* __restrict__ RW, bf16_t* __restrict__ YB,
                                            int vbx, int vby, int vt, unsigned char* sm) {
    As_t As = (As_t)sm; Bs_t Bs = (Bs_t)(sm + 64 * 40 * 2);
    const int e_raw = TILEE[vby];
    const int e = e_raw < 0 ? 0 : e_raw;
    const int lane = vt & 63, wid = vt >> 6, wr = wid >> 1, wc = wid & 1;
    const int p0 = vby * 64, n0 = vbx * 64;
    f32x4 acc[1][2][2];
#pragma unroll
    for (int i = 0; i < 2; ++i)
#pragma unroll
        for (int j = 0; j < 2; ++j) acc[0][i][j] = (f32x4){0.f, 0.f, 0.f, 0.f};
    const int arow = ROWTOK[p0 + (vt >> 2)];
    gemm_core64<1>((arow >= 0 && e_raw >= 0) ? HDN + (size_t)(p0 + (vt >> 2)) * D_EXP : nullptr, Wd + (size_t)e * D_EXP * DM, nullptr, DM, n0, DM, D_EXP, acc, As, Bs, vt);
    if (e_raw < 0) return;
#pragma unroll
    for (int i = 0; i < 2; ++i)
#pragma unroll
        for (int r = 0; r < 4; ++r) {
            const int row = p0 + wr * 32 + i * 16 + (lane >> 4) * 4 + r;
            const int a = ROWTOK[row];
            if (a < 0) continue;
            const float w = RW[a];
#pragma unroll
            for (int j = 0; j < 2; ++j) { const int col = n0 + wc * 32 + j * 16 + (lane & 15); YB[(size_t)a * DM + col] = f2bf(w * acc[0][i][j][r]); }
        }
}
__device__ __forceinline__ void b_final2(float* __restrict__ o, const uint4 xv, const uint2 y0, const uint2 y1, const float w0, const float w1) {
    const unsigned xs[4] = {xv.x, xv.y, xv.z, xv.w};
    f32x4 o0, o1;
    o0[0] = __uint_as_float(xs[0] << 16) + (w0 * __builtin_amdgcn_cvt_f32_fp8(y0.x, 0) + w1 * __builtin_amdgcn_cvt_f32_fp8(y1.x, 0));
    o0[1] = __uint_as_float(xs[0] & 0xffff0000u) + (w0 * __builtin_amdgcn_cvt_f32_fp8(y0.x, 1) + w1 * __builtin_amdgcn_cvt_f32_fp8(y1.x, 1));
    o0[2] = __uint_as_float(xs[1] << 16) + (w0 * __builtin_amdgcn_cvt_f32_fp8(y0.x, 2) + w1 * __builtin_amdgcn_cvt_f32_fp8(y1.x, 2));
    o0[3] = __uint_as_float(xs[1] & 0xffff0000u) + (w0 * __builtin_amdgcn_cvt_f32_fp8(y0.x, 3) + w1 * __builtin_amdgcn_cvt_f32_fp8(y1.x, 3));
    o1[0] = __uint_as_float(xs[2] << 16) + (w0 * __builtin_amdgcn_cvt_f32_fp8(y0.y, 0) + w1 * __builtin_amdgcn_cvt_f32_fp8(y1.y, 0));
    o1[1] = __uint_as_float(xs[2] & 0xffff0000u) + (w0 * __builtin_amdgcn_cvt_f32_fp8(y0.y, 1) + w1 * __builtin_amdgcn_cvt_f32_fp8(y1.y, 1));
    o1[2] = __uint_as_float(xs[3] << 16) + (w0 * __builtin_amdgcn_cvt_f32_fp8(y0.y, 2) + w1 * __builtin_amdgcn_cvt_f32_fp8(y1.y, 2));
    o1[3] = __uint_as_float(xs[3] & 0xffff0000u) + (w0 * __builtin_amdgcn_cvt_f32_fp8(y0.y, 3) + w1 * __builtin_amdgcn_cvt_f32_fp8(y1.y, 3));
    *(f32x4*)o = o0; *(f32x4*)(o + 4) = o1;
}
__device__ __forceinline__ void b_final(float* __restrict__ out, const bf16_t* __restrict__ X2B, const unsigned char* __restrict__ YB, size_t i) {
    const size_t t = i / DM, c = i % DM;
    const uint4 xv = *(const uint4*)(X2B + i); const uint2 y0 = *(const uint2*)(YB + (2 * t) * DM + c), y1 = *(const uint2*)(YB + (2 * t + 1) * DM + c);
    const unsigned xs[4] = {xv.x, xv.y, xv.z, xv.w};
    f32x4 o0, o1;
    o0[0] = __uint_as_float(xs[0] << 16) + 0.0625f * (__builtin_amdgcn_cvt_f32_fp8(y0.x, 0) + __builtin_amdgcn_cvt_f32_fp8(y1.x, 0));
    o0[1] = __uint_as_float(xs[0] & 0xffff0000u) + 0.0625f * (__builtin_amdgcn_cvt_f32_fp8(y0.x, 1) + __builtin_amdgcn_cvt_f32_fp8(y1.x, 1));
    o0[2] = __uint_as_float(xs[1] << 16) + 0.0625f * (__builtin_amdgcn_cvt_f32_fp8(y0.x, 2) + __builtin_amdgcn_cvt_f32_fp8(y1.x, 2));
    o0[3] = __uint_as_float(xs[1] & 0xffff0000u) + 0.0625f * (__builtin_amdgcn_cvt_f32_fp8(y0.x, 3) + __builtin_amdgcn_cvt_f32_fp8(y1.x, 3));
    o1[0] = __uint_as_float(xs[2] << 16) + 0.0625f * (__builtin_amdgcn_cvt_f32_fp8(y0.y, 0) + __builtin_amdgcn_cvt_f32_fp8(y1.y, 0));
    o1[1] = __uint_as_float(xs[2] & 0xffff0000u) + 0.0625f * (__builtin_amdgcn_cvt_f32_fp8(y0.y, 1) + __builtin_amdgcn_cvt_f32_fp8(y1.y, 1));
    o1[2] = __uint_as_float(xs[3] << 16) + 0.0625f * (__builtin_amdgcn_cvt_f32_fp8(y0.y, 2) + __builtin_amdgcn_cvt_f32_fp8(y1.y, 2));
    o1[3] = __uint_as_float(xs[3] & 0xffff0000u) + 0.0625f * (__builtin_amdgcn_cvt_f32_fp8(y0.y, 3) + __builtin_amdgcn_cvt_f32_fp8(y1.y, 3));
    *(f32x4*)(out + i) = o0; *(f32x4*)(out + i + 4) = o1;
}

namespace pg8 {
typedef unsigned u32x4 __attribute__((ext_vector_type(4)));
typedef unsigned u32x2 __attribute__((ext_vector_type(2)));
typedef int v4i_t __attribute__((ext_vector_type(4)));
typedef int v8i_t __attribute__((ext_vector_type(8)));
constexpr int BM = 256, BK = 64, HALF = 128, HTB = HALF * BK * 2, STAGE_BYTES = 8 * HTB, NXCD = 8, WGM = 8;
__host__ __device__ __forceinline__ int lds_byte(int r, int c) { const int st = (r >> 4) * 2 + (c >> 5), rr = r & 15, cc = c & 31, ob = rr * 64 + cc * 2; return st * 1024 + (ob ^ (((ob >> 9) & 1) << 5)); }
__host__ __device__ __forceinline__ void stage_rc(int b, int& R, int& C) { const int st = b / 1024, sb = b % 1024, swz = sb ^ (((sb >> 9) & 1) << 5); R = (st >> 1) * 16 + swz / 64; C = (st & 1) * 32 + (swz % 64) / 2; }
__host__ __device__ __forceinline__ int perm32(int rho) { const int n = rho >> 4, i = rho & 15; return 8 * (i >> 2) + 4 * n + (i & 3); }
struct Unit { int pm, pn, e, r0, cnt; };
struct Gemm { const void* A; const void* Bt; int lda, ldb, K; size_t astride, bstride; int scale_a, scale_b; };
struct StaticOrder {
    static constexpr bool GATHER = false; static constexpr int ESZ = 2;
    int nM, nN, nwg, G, c, i0, i1;
    __device__ void init(int M, int N, int G_, int c_, int i0_ = 0, int i1_ = 1 << 30) { nM = M / BM; nN = N / BM; nwg = nM * nN; G = G_; c = c_; i0 = i0_; i1 = i1_; }
    __device__ bool next(int i, Unit& u) const {
        i += i0; if (i >= i1) return false;
        const long L = (long)i * G + c; if (L >= nwg) return false;
        int wgid = (int)L; { const int q = nwg / NXCD, r = nwg % NXCD, xcd = wgid % NXCD, off = wgid / NXCD; wgid = (xcd < r ? xcd * (q + 1) : r * (q + 1) + (xcd - r) * q) + off; }
        const int nig = WGM * nN, gid = wgid / nig, fm = gid * WGM, gsz = (nM - fm) < WGM ? (nM - fm) : WGM;
        u.pm = fm + ((wgid % nig) % gsz); u.pn = (wgid % nig) / gsz; u.e = 0; return true;
    }
};
__device__ __forceinline__ unsigned cvt_pk_bf16(float lo, float hi) { unsigned r; asm volatile("v_cvt_pk_bf16_f32 %0, %1, %2" : "=v"(r) : "v"(lo), "v"(hi)); return r; }

template <class Epi, class Sched, bool ALIGN_EPI>
__device__ __forceinline__ void gemm_phase(LAS unsigned char* lds, const Gemm g, const Sched& S, const Epi& E) {
    int tid = threadIdx.x; asm volatile("" : "+v"(tid));
    const int wid = __builtin_amdgcn_readfirstlane(tid >> 6), lane = tid & 63, wr = wid >> 2, wc = wid & 3, fr = lane & 15, fq = lane >> 4;
    constexpr int ESZ = Sched::ESZ;
    const int K = g.K, nt = K * ESZ / (BK * 2);
    unsigned voffA[2], voffB[2];
#pragma unroll
    for (int i = 0; i < 2; ++i) { int R, C; stage_rc(tid * 16 + i * 8192, R, C); const int Rb = Epi::PERM ? ((R & ~31) + perm32(R & 31)) : R;
        voffA[i] = (unsigned)(R * g.lda * ESZ + C * 2); voffB[i] = (unsigned)(Rb * g.ldb * ESZ + C * 2); }
    const size_t kstep = (size_t)(BK * 2);
    const size_t hstepA = (size_t)HALF * g.lda * ESZ, tstepA = 2 * hstepA;
    const size_t hstepB = (size_t)HALF * g.ldb * ESZ, tstepB = 2 * hstepB;
    const unsigned ldsw = (unsigned)wid * 1024u;
    const int aoff = lds_byte(wr * 64 + fr, ESZ == 2 ? fq * 8 : fq * 16), boff = lds_byte(wc * 32 + fr, ESZ == 2 ? fq * 8 : fq * 16);
    constexpr int PIECE1 = ESZ == 2 ? 1024 : 16;
    unsigned la_ = (unsigned)(size_t)(lds + aoff), lb_ = (unsigned)(size_t)(lds + 65536 + boff);
    asm volatile("" : "+v"(la_), "+v"(lb_));
    const LAS unsigned char* ldsA = (const LAS unsigned char*)(size_t)la_; const LAS unsigned char* ldsB = (const LAS unsigned char*)(size_t)lb_;
#define PG8_SA(b, h) (((b) * 2 + (h)) * HTB)
#define PG8_SB(b, h) ((4 + (b) * 2 + (h)) * HTB)
#define PG8_STAGE(bufoff, gbase, voff) do { _Pragma("unroll") for (int _i = 0; _i < 2; ++_i) \
        __builtin_amdgcn_global_load_lds((const unsigned*)((const char*)(gbase) + (voff)[_i]), (LAS unsigned*)(lds + (bufoff) + ldsw + _i * 8192), 16, 0, 0); } while (0)
#define PG8_LDA(dst, b, h) do { _Pragma("unroll") for (int m = 0; m < 4; ++m) { dst[m][0] = *(const LAS bf16x8*)(ldsA + PG8_SA(b, h) + m * 2048); dst[m][1] = *(const LAS bf16x8*)(ldsA + PG8_SA(b, h) + m * 2048 + PIECE1); } } while (0)
#define PG8_LDB(dst, b, h) do { _Pragma("unroll") for (int n = 0; n < 2; ++n) { dst[n][0] = *(const LAS bf16x8*)(ldsB + (PG8_SB(b, h) - 65536) + n * 2048); dst[n][1] = *(const LAS bf16x8*)(ldsB + (PG8_SB(b, h) - 65536) + n * 2048 + PIECE1); } } while (0)
#define PG8_V8(x) __builtin_shufflevector(__builtin_bit_cast(v4i_t, (x)[0]), __builtin_bit_cast(v4i_t, (x)[1]), 0, 1, 2, 3, 4, 5, 6, 7)
#define PG8_MMA(ai, bj, At, Bt) do { __builtin_amdgcn_s_setprio(1); _Pragma("unroll") for (int m = 0; m < 4; ++m) _Pragma("unroll") for (int n = 0; n < 2; ++n) { \
        if constexpr (ESZ == 2) { _Pragma("unroll") for (int k = 0; k < 2; ++k) acc[ai][bj][m][n] = __builtin_amdgcn_mfma_f32_16x16x32_bf16(Bt[n][k], At[m][k], acc[ai][bj][m][n], 0, 0, 0); } \
        else { acc[ai][bj][m][n] = __builtin_amdgcn_mfma_scale_f32_16x16x128_f8f6f4(PG8_V8(Bt[n]), PG8_V8(At[m]), acc[ai][bj][m][n], 0, 0, 0, g.scale_b, 0, g.scale_a); \
               asm volatile("" : "+v"(acc[ai][bj][m][n])); } }     \
        __builtin_amdgcn_s_setprio(0); } while (0)
#define PG8_WAIT_V(n) asm volatile("s_waitcnt vmcnt(" #n ")" ::: "memory")
#define PG8_WAIT_L(n) asm volatile("s_waitcnt lgkmcnt(" #n ")" ::: "memory")
#define PG8_BAR __builtin_amdgcn_s_barrier()
#define PG8_SCHED __builtin_amdgcn_sched_barrier(0)
    Unit cur, nxt; int ui = 0;
    if (!S.next(0, cur)) return;
    f32x4 acc[2][2][4][2];
#pragma unroll
    for (int a = 0; a < 2; ++a)
#pragma unroll
        for (int b = 0; b < 2; ++b)
#pragma unroll
            for (int m = 0; m < 4; ++m)
#pragma unroll
                for (int n = 0; n < 2; ++n) acc[a][b][m][n] = (f32x4){0.f, 0.f, 0.f, 0.f};
    bf16x8 At[4][2], B0[2][2], B1[2][2];
    constexpr bool GATHER = Sched::GATHER;
    const size_t hsA = GATHER ? 0 : hstepA;
    unsigned c0[2], c1[2], n0[2], n1[2];
    if constexpr (GATHER) { S.a_offsets(cur, tid, g.lda, c0, c1); n0[0] = c0[0]; n0[1] = c0[1]; n1[0] = c1[0]; n1[1] = c1[1]; }
#define PG8_C0 (GATHER ? c0 : voffA)
#define PG8_C1 (GATHER ? c1 : voffA)
    const char* cA = (const char*)g.A + (GATHER ? (size_t)0 : ((size_t)cur.e * g.astride) * ESZ + (size_t)cur.pm * tstepA); const char* cB = (const char*)g.Bt + ((size_t)cur.e * g.bstride) * ESZ + (size_t)cur.pn * tstepB;
    PG8_STAGE(PG8_SB(0, 0), cB, voffB); PG8_STAGE(PG8_SB(0, 1), cB + hstepB, voffB); PG8_STAGE(PG8_SA(0, 0), cA, PG8_C0); PG8_STAGE(PG8_SA(0, 1), cA + hsA, PG8_C1);
    if (wr == 1) PG8_BAR;
    PG8_WAIT_V(2); PG8_BAR;
    PG8_STAGE(PG8_SB(1, 0), cB + kstep, voffB); PG8_STAGE(PG8_SA(1, 0), cA + kstep, PG8_C0); PG8_STAGE(PG8_SB(1, 1), cB + hstepB + kstep, voffB);
    PG8_WAIT_V(6); PG8_BAR;
    for (;;) {
        const bool has_next = S.next(ui + 1, nxt);
        const char* nA = (has_next && !GATHER) ? (const char*)g.A + ((size_t)nxt.e * g.astride) * ESZ + (size_t)nxt.pm * tstepA : cA; const char* nB = has_next ? (const char*)g.Bt + ((size_t)nxt.e * g.bstride) * ESZ + (size_t)nxt.pn * tstepB : cB;
        if constexpr (GATHER) { if (has_next) S.a_offsets(nxt, tid, g.lda, n0, n1); }
#pragma unroll 1
        for (int t = 0; t < nt; t += 2) {
            const bool last = (t == nt - 2);
            const char* a1 = cA + (size_t)(t + 1) * kstep;
            const char* a2 = last ? nA : cA + (size_t)(t + 2) * kstep; const char* b2 = last ? nB : cB + (size_t)(t + 2) * kstep;
            const char* a3 = a2 + kstep; const char* b3 = b2 + kstep;
            unsigned s0[2], s1[2];
            if constexpr (GATHER) {
#pragma unroll
                for (int i_ = 0; i_ < 2; ++i_) { s0[i_] = last ? n0[i_] : c0[i_]; s1[i_] = last ? n1[i_] : c1[i_]; }
            }
#define PG8_S0 (GATHER ? s0 : voffA)
#define PG8_S1 (GATHER ? s1 : voffA)
            PG8_LDB(B0, 0, 0); PG8_LDB(B1, 0, 1); PG8_SCHED; PG8_LDA(At, 0, 0); PG8_STAGE(PG8_SA(1, 1), a1 + hsA, PG8_C1);
            PG8_WAIT_V(8); PG8_WAIT_L(0); PG8_BAR; PG8_MMA(0, 0, At, B0); PG8_MMA(0, 1, At, B1); PG8_BAR; PG8_SCHED;
            PG8_LDA(At, 0, 1); PG8_STAGE(PG8_SB(0, 0), b2, voffB); PG8_STAGE(PG8_SB(0, 1), b2 + hstepB, voffB); PG8_STAGE(PG8_SA(0, 0), a2, PG8_S0);
            PG8_WAIT_V(8); PG8_WAIT_L(0); PG8_BAR; PG8_MMA(1, 0, At, B0); PG8_MMA(1, 1, At, B1); PG8_BAR; PG8_SCHED;
            PG8_LDB(B0, 1, 0); PG8_LDB(B1, 1, 1); PG8_SCHED; PG8_LDA(At, 1, 0); PG8_STAGE(PG8_SA(0, 1), a2 + hsA, PG8_S1);
            PG8_WAIT_V(8); PG8_WAIT_L(0); PG8_BAR; PG8_MMA(0, 0, At, B0); PG8_MMA(0, 1, At, B1); PG8_BAR; PG8_SCHED;
            PG8_LDA(At, 1, 1); PG8_STAGE(PG8_SB(1, 0), b3, voffB); PG8_STAGE(PG8_SB(1, 1), b3 + hstepB, voffB); PG8_STAGE(PG8_SA(1, 0), a3, PG8_S0);
            PG8_WAIT_V(8); PG8_WAIT_L(0); PG8_BAR; PG8_MMA(1, 0, At, B0); PG8_MMA(1, 1, At, B1); PG8_BAR; PG8_SCHED;
        }
        if constexpr (ALIGN_EPI) { if (wr == 0) PG8_BAR; }
        bool chained = false;
        {
            int te = threadIdx.x; asm volatile("" : "+v"(te));
            const int le = te & 63, fre = le & 15, fqe = le >> 4, we = __builtin_amdgcn_readfirstlane(te >> 6), wre = we >> 2, wce = we & 3;
            if constexpr (Epi::CHAIN) chained = E.chain(acc, cur, wre, wce, fre, fqe);
            if (!chained) E(acc, cur, wre, wce, fre, fqe);
        }
        if (!has_next) break;
        if (!chained) {
#pragma unroll
        for (int a = 0; a < 2; ++a)
#pragma unroll
            for (int b = 0; b < 2; ++b)
#pragma unroll
                for (int m = 0; m < 4; ++m)
#pragma unroll
                    for (int n = 0; n < 2; ++n) acc[a][b][m][n] = (f32x4){0.f, 0.f, 0.f, 0.f};
        }
        cur = nxt; cA = nA; cB = nB; ++ui; if constexpr (GATHER) { c0[0] = n0[0]; c0[1] = n0[1]; c1[0] = n1[0]; c1[1] = n1[1]; }
        if constexpr (ALIGN_EPI) { if (wr == 1) PG8_BAR; }
    }
    PG8_WAIT_V(0);
    if constexpr (!ALIGN_EPI) { if (wr == 0) PG8_BAR; }
    PG8_BAR;
#undef PG8_SA
#undef PG8_SB
#undef PG8_STAGE
#undef PG8_LDA
#undef PG8_LDB
#undef PG8_MMA
#undef PG8_V8
#undef PG8_C0
#undef PG8_C1
#undef PG8_S0
#undef PG8_S1
#undef PG8_WAIT_V
#undef PG8_WAIT_L
#undef PG8_BAR
#undef PG8_SCHED
}

struct EpiInProj {
    static constexpr bool PERM = true, CHAIN = false;
    bf16_t* U; const float *qg, *kg;
    static constexpr size_t SEC_STRIDE = (size_t)16 << 20;
    __device__ __forceinline__ void operator()(const f32x4 (&acc)[2][2][4][2], const Unit& u, int wr, int wc, int fr, int fq) const {
        const int sec = u.pn >> 1, row0 = u.pm * BM + wr * 64 + fr;
        bf16_t* base = U + (size_t)sec * SEC_STRIDE;
        if (sec == 2 || sec == 3) {
            const bool isq = (sec == 2); const float sc = isq ? 0.125f * LOG2E : 1.0f;
            const int head = 4 * (u.pn & 1) + wc;
            const f32x4 q00 = *(const f32x4*)(qg + 8 * fq), q01 = *(const f32x4*)(qg + 8 * fq + 4), q10 = *(const f32x4*)(qg + 32 + 8 * fq), q11 = *(const f32x4*)(qg + 32 + 8 * fq + 4);
            const f32x4 k00 = *(const f32x4*)(kg + 8 * fq), k01 = *(const f32x4*)(kg + 8 * fq + 4), k10 = *(const f32x4*)(kg + 32 + 8 * fq), k11 = *(const f32x4*)(kg + 32 + 8 * fq + 4);
            const f32x4 gv00 = isq ? q00 : k00, gv01 = isq ? q01 : k01, gv10 = isq ? q10 : k10, gv11 = isq ? q11 : k11;
#pragma unroll
            for (int ai = 0; ai < 2; ++ai)
#pragma unroll
                for (int m = 0; m < 4; ++m) {
                    float ss = 0.f;
#pragma unroll
                    for (int bj = 0; bj < 2; ++bj)
#pragma unroll
                        for (int n = 0; n < 2; ++n) { const f32x4 x = acc[ai][bj][m][n]; ss += (x[0] * x[0] + x[1] * x[1]) + (x[2] * x[2] + x[3] * x[3]); }
                    ss += __shfl_xor(ss, 16); ss += __shfl_xor(ss, 32);
                    const float rs = rsqrtf(ss * (1.f / 64.f) + EPS) * sc;
                    bf16_t* rowp = base + (size_t)(row0 + ai * HALF + m * 16) * 512 + head * 64 + 8 * fq;
#pragma unroll
                    for (int bj = 0; bj < 2; ++bj) { const f32x4 v0 = acc[ai][bj][m][0] * rs * (bj ? gv10 : gv00), v1 = acc[ai][bj][m][1] * rs * (bj ? gv11 : gv01);
                        u32x4 w; w.x = cvt_pk_bf16(v0[0], v0[1]); w.y = cvt_pk_bf16(v0[2], v0[3]); w.z = cvt_pk_bf16(v1[0], v1[1]); w.w = cvt_pk_bf16(v1[2], v1[3]);
                        *(u32x4*)(rowp + bj * 32) = w; }
                }
        } else {
            const int col0 = (u.pn & 1) * BM + wc * 32 + 8 * fq;
#pragma unroll
            for (int ai = 0; ai < 2; ++ai)
#pragma unroll
                for (int m = 0; m < 4; ++m) { bf16_t* rowp = base + (size_t)(row0 + ai * HALF + m * 16) * 512 + col0;
#pragma unroll
                    for (int bj = 0; bj < 2; ++bj) { const f32x4 v0 = acc[ai][bj][m][0], v1 = acc[ai][bj][m][1];
                        u32x4 w; w.x = cvt_pk_bf16(v0[0], v0[1]); w.y = cvt_pk_bf16(v0[2], v0[3]); w.z = cvt_pk_bf16(v1[0], v1[1]); w.w = cvt_pk_bf16(v1[2], v1[3]);
                        *(u32x4*)(rowp + bj * HALF) = w; } }
        }
    }
};
struct EpiBf16 {
    static constexpr bool PERM = true, CHAIN = false;
    bf16_t *O0, *O1; int ldo, split;
    __device__ __forceinline__ void operator()(const f32x4 (&acc)[2][2][4][2], const Unit& u, int wr, int wc, int fr, int fq) const {
        int colt = u.pn * BM; bf16_t* base = O0; if (colt >= split) { colt -= split; base = O1; }
        const int row0 = u.pm * BM + wr * 64 + fr, col0 = colt + wc * 32 + 8 * fq;
#pragma unroll
        for (int ai = 0; ai < 2; ++ai)
#pragma unroll
            for (int m = 0; m < 4; ++m) { bf16_t* rowp = base + (size_t)(row0 + ai * HALF + m * 16) * ldo + col0;
#pragma unroll
                for (int bj = 0; bj < 2; ++bj) { const f32x4 v0 = acc[ai][bj][m][0], v1 = acc[ai][bj][m][1];
                    u32x4 w; w.x = cvt_pk_bf16(v0[0], v0[1]); w.y = cvt_pk_bf16(v0[2], v0[3]); w.z = cvt_pk_bf16(v1[0], v1[1]); w.w = cvt_pk_bf16(v1[2], v1[3]);
                    *(u32x4*)(rowp + bj * HALF) = w; } }
    }
};
struct EpiResF32 {
    static constexpr bool PERM = false, CHAIN = false;
    const float* base; float* out;
    __device__ __forceinline__ void operator()(const f32x4 (&acc)[2][2][4][2], const Unit& u, int wr, int wc, int fr, int fq) const {
        const int row0 = u.pm * BM + wr * 64 + fr, col0 = u.pn * BM + wc * 32 + 4 * fq;
#pragma unroll
        for (int ai = 0; ai < 2; ++ai)
#pragma unroll
            for (int m = 0; m < 4; ++m) { const size_t off = (size_t)(row0 + ai * HALF + m * 16) * DM + col0;
#pragma unroll
                for (int bj = 0; bj < 2; ++bj)
#pragma unroll
                    for (int n = 0; n < 2; ++n) *(f32x4*)(out + off + bj * HALF + n * 16) = *(const f32x4*)(base + off + bj * HALF + n * 16) + acc[ai][bj][m][n]; }
    }
};


struct PairOrder {
    static constexpr bool GATHER = false; static constexpr int ESZ = 2;
    StaticOrder so;
    __device__ void init(int M, int N, int G_, int c_) { so.init(M, N, G_, c_); }
    __device__ bool next(int i, Unit& u) const { if (!so.next(i >> 1, u)) return false; u.e = i & 1; return true; }
};
__device__ __forceinline__ float rstd8(const float* p, float inv_n) { const f32x4 a = *(const f32x4*)p, b = *(const f32x4*)(p + 4); return rsqrtf(((a[0] + a[1]) + (a[2] + a[3]) + (b[0] + b[1]) + (b[2] + b[3])) * inv_n + EPS); }
__device__ __forceinline__ float rstd16(const float* p, float inv_n) { float t = 0.f;
#pragma unroll
    for (int i = 0; i < 4; ++i) { const f32x4 a = *(const f32x4*)(p + 4 * i); t += (a[0] + a[1]) + (a[2] + a[3]); } return rsqrtf(t * inv_n + EPS); }
struct EpiOutChain {
    static constexpr bool PERM = true, CHAIN = true;
    const float* x; bf16_t* x1b; const float* SSL; const float* SSF; float* SS1;
    __device__ __forceinline__ bool chain(f32x4 (&acc)[2][2][4][2], const Unit& u, int wr, int wc, int fr, int fq) const {
        if (u.e != 0) return false;
        const int row0 = u.pm * BM + wr * 64 + fr;
        float ratio[8];
#pragma unroll
        for (int i = 0; i < 8; ++i) { const int row = row0 + (i >> 2) * HALF + (i & 3) * 16; ratio[i] = rstd8(SSL + (size_t)row * 8, 1.f / 512.f) / rstd8(SSF + (size_t)row * 8, 1.f / 512.f); }
#pragma unroll
        for (int ai = 0; ai < 2; ++ai)
#pragma unroll
            for (int m = 0; m < 4; ++m)
#pragma unroll
                for (int bj = 0; bj < 2; ++bj)
#pragma unroll
                    for (int n = 0; n < 2; ++n) acc[ai][bj][m][n] *= ratio[ai * 4 + m];
        return true;
    }
    __device__ __forceinline__ void operator()(const f32x4 (&acc)[2][2][4][2], const Unit& u, int wr, int wc, int fr, int fq) const {
        const int row0 = u.pm * BM + wr * 64 + fr, col0 = u.pn * BM + wc * 32 + 8 * fq;
        float rfv[8];
#pragma unroll
        for (int i = 0; i < 8; ++i) rfv[i] = rstd8(SSF + (size_t)(row0 + (i >> 2) * HALF + (i & 3) * 16) * 8, 1.f / 512.f);
#pragma unroll
        for (int pr = 0; pr < 4; ++pr) {
            const int ai = pr >> 1;
            f32x4 xv[2][2][2];
#pragma unroll
            for (int mm = 0; mm < 2; ++mm)
#pragma unroll
                for (int bj = 0; bj < 2; ++bj)
#pragma unroll
                    for (int n = 0; n < 2; ++n) xv[mm][bj][n] = *(const f32x4*)(x + (size_t)(row0 + ai * HALF + (2 * (pr & 1) + mm) * 16) * DM + col0 + bj * HALF + n * 4);
            asm volatile("" ::: "memory");
#pragma unroll
            for (int mm = 0; mm < 2; ++mm) { const int m = 2 * (pr & 1) + mm; const int row = row0 + ai * HALF + m * 16; const size_t off = (size_t)row * DM + col0;
                const float rf = rfv[ai * 4 + m]; float ss = 0.f;
#pragma unroll
                for (int bj = 0; bj < 2; ++bj) { const f32x4 v0 = xv[mm][bj][0] + acc[ai][bj][m][0] * rf, v1 = xv[mm][bj][1] + acc[ai][bj][m][1] * rf;
                    ss += ((v0[0] * v0[0] + v0[1] * v0[1]) + (v0[2] * v0[2] + v0[3] * v0[3])) + ((v1[0] * v1[0] + v1[1] * v1[1]) + (v1[2] * v1[2] + v1[3] * v1[3]));
                    u32x4 w; w.x = cvt_pk_bf16(v0[0], v0[1]); w.y = cvt_pk_bf16(v0[2], v0[3]); w.z = cvt_pk_bf16(v1[0], v1[1]); w.w = cvt_pk_bf16(v1[2], v1[3]);
                    *(u32x4*)(x1b + off + bj * HALF) = w; }
                ss += __shfl_xor(ss, 16); ss += __shfl_xor(ss, 32);
                if (fq == 0) SS1[(size_t)row * 16 + u.pn * 4 + wc] = ss; }
        }
    }
};
struct EpiRowScale {
    static constexpr bool PERM = true, CHAIN = false;
    bf16_t* O; int ldo; const float* SS; float inv_n;
    __device__ __forceinline__ void operator()(const f32x4 (&acc)[2][2][4][2], const Unit& u, int wr, int wc, int fr, int fq) const {
        const int row0 = u.pm * BM + wr * 64 + fr, col0 = u.pn * BM + wc * 32 + 8 * fq;
        float rsv[8];
#pragma unroll
        for (int i = 0; i < 8; ++i) rsv[i] = rstd16(SS + (size_t)(row0 + (i >> 2) * HALF + (i & 3) * 16) * 16, inv_n);
#pragma unroll
        for (int ai = 0; ai < 2; ++ai)
#pragma unroll
            for (int m = 0; m < 4; ++m) { const int row = row0 + ai * HALF + m * 16; const float rs = rsv[ai * 4 + m]; bf16_t* rowp = O + (size_t)row * ldo + col0;
#pragma unroll
                for (int bj = 0; bj < 2; ++bj) { const f32x4 v0 = acc[ai][bj][m][0] * rs, v1 = acc[ai][bj][m][1] * rs;
                    u32x4 w; w.x = cvt_pk_bf16(v0[0], v0[1]); w.y = cvt_pk_bf16(v0[2], v0[3]); w.z = cvt_pk_bf16(v1[0], v1[1]); w.w = cvt_pk_bf16(v1[2], v1[3]);
                    *(u32x4*)(rowp + bj * HALF) = w; } }
    }
};

__device__ __forceinline__ float clamp_fp8(float v) { return __builtin_amdgcn_fmed3f(v, -448.f, 448.f); }
__device__ __forceinline__ unsigned cvt4_fp8(float a, float b, float c, float d) { int w = 0; w = __builtin_amdgcn_cvt_pk_fp8_f32(clamp_fp8(a), clamp_fp8(b), w, false); w = __builtin_amdgcn_cvt_pk_fp8_f32(clamp_fp8(c), clamp_fp8(d), w, true); return (unsigned)w; }
struct EpiX2 {
    static constexpr bool PERM = true, CHAIN = false;
    const bf16_t* x1b; bf16_t* xb; unsigned char* xq; float* SS;
    __device__ __forceinline__ void operator()(const f32x4 (&acc)[2][2][4][2], const Unit& u, int wr, int wc, int fr, int fq) const {
        const int row0 = u.pm * BM + wr * 64 + fr, col0 = u.pn * BM + wc * 32 + 8 * fq;
#pragma unroll
        for (int ai = 0; ai < 2; ++ai) {
            u32x4 xrv[4][2];
#pragma unroll
            for (int m = 0; m < 4; ++m)
#pragma unroll
                for (int bj = 0; bj < 2; ++bj) xrv[m][bj] = *(const u32x4*)(x1b + (size_t)(row0 + ai * HALF + m * 16) * DM + col0 + bj * HALF);
            asm volatile("" ::: "memory");
#pragma unroll
            for (int m = 0; m < 4; ++m) { const int row = row0 + ai * HALF + m * 16; const size_t off = (size_t)row * DM + col0; float ss = 0.f;
#pragma unroll
                for (int bj = 0; bj < 2; ++bj) { const u32x4 xr = xrv[m][bj];
                    f32x4 v0 = acc[ai][bj][m][0], v1 = acc[ai][bj][m][1];
                    v0[0] += __uint_as_float(xr.x << 16); v0[1] += __uint_as_float(xr.x & 0xffff0000u); v0[2] += __uint_as_float(xr.y << 16); v0[3] += __uint_as_float(xr.y & 0xffff0000u);
                    v1[0] += __uint_as_float(xr.z << 16); v1[1] += __uint_as_float(xr.z & 0xffff0000u); v1[2] += __uint_as_float(xr.w << 16); v1[3] += __uint_as_float(xr.w & 0xffff0000u);
                    ss += (v0[0] * v0[0] + v0[1] * v0[1]) + (v0[2] * v0[2] + v0[3] * v0[3]) + (v1[0] * v1[0] + v1[1] * v1[1]) + (v1[2] * v1[2] + v1[3] * v1[3]);
                    u32x4 w; w.x = cvt_pk_bf16(v0[0], v0[1]); w.y = cvt_pk_bf16(v0[2], v0[3]); w.z = cvt_pk_bf16(v1[0], v1[1]); w.w = cvt_pk_bf16(v1[2], v1[3]);
                    *(u32x4*)(xb + off + bj * HALF) = w;
                    u32x2 q; q.x = cvt4_fp8(v0[0], v0[1], v0[2], v0[3]); q.y = cvt4_fp8(v1[0], v1[1], v1[2], v1[3]); *(u32x2*)(xq + off + bj * HALF) = q; }
                ss += __shfl_xor(ss, 16); ss += __shfl_xor(ss, 32);
                if (fq == 0) SS[(size_t)row * 16 + u.pn * 4 + wc] = ss; }
        }
    }
};
template <bool GATHER_>
struct MoeOrder {
    static constexpr bool GATHER = GATHER_; static constexpr int ESZ = 1;
    int nu, G, c; const LAS int* pst  ; const int* LIST;
    __device__ bool next(int i, Unit& u) const {
        const int L = i * G + c; if (L >= nu) return false;
        const int x = L & 7, off = L >> 3, per = nu >> 3, r = nu & 7;
        const int wg = (x < r ? x * (per + 1) : r * (per + 1) + (x - r) * per) + off;
        u.pm = wg >> 2; u.pn = wg & 3;
        const int row = u.pm * BM; const int e = pst[128 + u.pm];
        u.e = e; u.r0 = row - pst[e]; u.cnt = pst[64 + e]; return true;
    }
    __device__ __forceinline__ int assignment(const Unit& u, int r) const { const int rank = u.r0 + r; const bool ok = rank < u.cnt; const int a = LIST[(size_t)u.e * T + (ok ? rank : 0)]; return ok ? a : -1; }
    __device__ __forceinline__ void a_offsets(const Unit& u, int tid, int lda, unsigned (&o0)[2], unsigned (&o1)[2]) const {
#pragma unroll
        for (int i = 0; i < 2; ++i) { int R, C; stage_rc(tid * 16 + i * 8192, R, C);
            const int a0 = assignment(u, R), a1 = assignment(u, HALF + R);
            o0[i] = (unsigned)((a0 < 0 ? 0 : a0 >> 1) * lda * ESZ + C * 2); o1[i] = (unsigned)((a1 < 0 ? 0 : a1 >> 1) * lda * ESZ + C * 2); }
    }
};
struct EpiMoe1 {
    static constexpr bool PERM = true, CHAIN = false;
    unsigned char* HDN; const float* RSL;
    __device__ __forceinline__ void operator()(const f32x4 (&acc)[2][2][4][2], const Unit& u, int wr, int wc, int fr, int fq) const {
        const int r0 = wr * 64 + fr, col0 = u.pn * HALF + wc * 32 + 8 * fq;
        float rsv[8];
#pragma unroll
        for (int i = 0; i < 8; ++i) { const int rank = u.r0 + r0 + (i >> 2) * HALF + (i & 3) * 16; const bool ok = rank < u.cnt; const float v = RSL[(size_t)u.e * T + (ok ? rank : 0)]; rsv[i] = ok ? v : 0.f; }
#pragma unroll
        for (int ai = 0; ai < 2; ++ai)
#pragma unroll
            for (int m = 0; m < 4; ++m) {
                const int r = r0 + ai * HALF + m * 16;
                const float rs = rsv[ai * 4 + m];
                f32x4 h0, h1;
#pragma unroll
                for (int e = 0; e < 4; ++e) { const float g0 = rs * acc[ai][0][m][0][e], g1 = rs * acc[ai][0][m][1][e];
                    h0[e] = g0 * __builtin_amdgcn_rcpf(1.f + __expf(-g0)) * (rs * acc[ai][1][m][0][e]); h1[e] = g1 * __builtin_amdgcn_rcpf(1.f + __expf(-g1)) * (rs * acc[ai][1][m][1][e]); }
                u32x2 w; w.x = cvt4_fp8(8.f * h0[0], 8.f * h0[1], 8.f * h0[2], 8.f * h0[3]); w.y = cvt4_fp8(8.f * h1[0], 8.f * h1[1], 8.f * h1[2], 8.f * h1[3]);
                *(u32x2*)(HDN + (size_t)(u.pm * BM + r) * D_EXP + col0) = w;
            }
    }
};
struct EpiMoe2 {
    static constexpr bool PERM = true, CHAIN = false;
    unsigned char* Y;
    __device__ __forceinline__ void operator()(const f32x4 (&acc)[2][2][4][2], const Unit& u, int wr, int wc, int fr, int fq) const {
        const int r0 = u.pm * BM + wr * 64 + fr, col0 = u.pn * BM + wc * 32 + 8 * fq;
#pragma unroll
        for (int ai = 0; ai < 2; ++ai)
#pragma unroll
            for (int m = 0; m < 4; ++m) {
                u32x2 w0, w1;
                { const f32x4 v0 = acc[ai][0][m][0] * 8.f, v1 = acc[ai][0][m][1] * 8.f; w0.x = cvt4_fp8(v0[0], v0[1], v0[2], v0[3]); w0.y = cvt4_fp8(v1[0], v1[1], v1[2], v1[3]); }
                { const f32x4 v0 = acc[ai][1][m][0] * 8.f, v1 = acc[ai][1][m][1] * 8.f; w1.x = cvt4_fp8(v0[0], v0[1], v0[2], v0[3]); w1.y = cvt4_fp8(v1[0], v1[1], v1[2], v1[3]); }
                unsigned char* rowp = Y + (size_t)(r0 + ai * HALF + m * 16) * DM + col0;
                *(u32x2*)rowp = w0; *(u32x2*)(rowp + HALF) = w1;
            }
    }
};
}


namespace rtr {
__device__ __forceinline__ void task(int t0, const bf16_t* __restrict__ X2B, const bf16_t* __restrict__ WTR, const float* __restrict__ SS2, const float* __restrict__ bg, const float* __restrict__ be,
                                     float* __restrict__ RW, float* __restrict__ RSL, int* __restrict__ POSR, int* __restrict__ cnt, int* __restrict__ LIST, LAS float* lg  , const LAS unsigned char* wr, LAS int* hist  , int lane) {
    int ex0_ = 0, ex1_ = 0, lr0_ = 0, lr1_ = 0; float rs_ = 0.f;
    const int fr = lane & 15, kq = lane >> 4;
    f32x4 acc[3];
#pragma unroll
    for (int n = 0; n < 3; ++n) acc[n] = (f32x4){0.f, 0.f, 0.f, 0.f};
    const LAS unsigned char* bp0 = wr + fr * 2064 + 16 * kq, *bp1 = wr + (16 + fr) * 2064 + 16 * kq, *bp2 = wr + (32 + (fr & 3)) * 2064 + 16 * kq;
    const bool n2ok = fr < 4;
    LAS unsigned char* xs = (LAS unsigned char*)lg;
#pragma unroll 1
    for (int q = 0; q < 4; ++q) {
#pragma unroll
        for (int i = 0; i < 8; ++i) {
            const int r = 2 * i + (lane >> 5);
            const pg8::u32x4 v = *(const pg8::u32x4*)(X2B + (size_t)(t0 + r) * DM + q * 256 + (lane & 31) * 8);
            *(LAS pg8::u32x4*)(xs + r * 528 + (lane & 31) * 16) = v; }
        asm volatile("s_waitcnt vmcnt(0) lgkmcnt(0)" ::: "memory");
#pragma unroll
        for (int ks = 0; ks < 8; ++ks) {
            const bf16x8 a = *(const LAS bf16x8*)(xs + fr * 528 + ks * 64 + kq * 16);
            const int ko = q * 512 + ks * 64;
            const bf16x8 b0 = *(const LAS bf16x8*)(bp0 + ko), b1 = *(const LAS bf16x8*)(bp1 + ko); bf16x8 b2 = *(const LAS bf16x8*)(bp2 + ko);
            if (!n2ok) b2 = (bf16x8){0, 0, 0, 0, 0, 0, 0, 0};
            acc[0] = __builtin_amdgcn_mfma_f32_16x16x32_bf16(a, b0, acc[0], 0, 0, 0); acc[1] = __builtin_amdgcn_mfma_f32_16x16x32_bf16(a, b1, acc[1], 0, 0, 0); acc[2] = __builtin_amdgcn_mfma_f32_16x16x32_bf16(a, b2, acc[2], 0, 0, 0);
        }
        asm volatile("s_waitcnt lgkmcnt(0)" ::: "memory");
    }
#pragma unroll
    for (int n = 0; n < 3; ++n)
#pragma unroll
        for (int r = 0; r < 4; ++r) lg[(4 * kq + r) * 52 + 16 * n + fr] = acc[n][r];
    asm volatile("s_waitcnt lgkmcnt(0)" ::: "memory");
    if (lane < 16) {
        const int t = t0 + lane;
        const float rs = pg8::rstd16(SS2 + (size_t)t * 16, 1.f / DM);
        float v[36];
#pragma unroll
        for (int q = 0; q < 9; ++q) { const f32x4 x4 = *(const LAS f32x4*)(lg + lane * 52 + 4 * q); v[4 * q] = x4[0] * rs; v[4 * q + 1] = x4[1] * rs; v[4 * q + 2] = x4[2] * rs; v[4 * q + 3] = x4[3] * rs; }
        int gi = 0; float gmax = v[0] + bg[0]; float gl[4];
#pragma unroll
        for (int j = 0; j < 4; ++j) gl[j] = v[j] + bg[j];
#pragma unroll
        for (int j = 1; j < 4; ++j) if (gl[j] > gmax) { gmax = gl[j]; gi = j; }
        float gs = 0.f;
#pragma unroll
        for (int j = 0; j < 4; ++j) gs += __expf(gl[j] - gmax);
        const float gw = 1.f / gs;
        float el[8];
#pragma unroll
        for (int j = 0; j < 8; ++j) { float x = 0.f;
#pragma unroll
            for (int g = 0; g < 4; ++g) if (g == gi) x = v[4 + g * 8 + j] + be[g * 8 + j];
            el[j] = x; }
        int i0 = 0; float v0 = el[0];
#pragma unroll
        for (int j = 1; j < 8; ++j) if (el[j] > v0) { v0 = el[j]; i0 = j; }
        int i1 = -1; float v1 = -INFINITY;
#pragma unroll
        for (int j = 0; j < 8; ++j) if (j != i0 && el[j] > v1) { v1 = el[j]; i1 = j; }
        const float e1 = __expf(v1 - v0);
        const float p0 = 1.f / (1.f + e1), p1 = e1 / (1.f + e1);
        const int ex0 = gi * 8 + i0, ex1 = gi * 8 + i1;
        RW[t * 2 + 0] = gw * p0; RW[t * 2 + 1] = gw * p1; rs_ = rs;
        ex0_ = ex0; ex1_ = ex1;
        lr0_ = __hip_atomic_fetch_add((int*)hist + ex0, 1, __ATOMIC_RELAXED, __HIP_MEMORY_SCOPE_WORKGROUP); lr1_ = __hip_atomic_fetch_add((int*)hist + ex1, 1, __ATOMIC_RELAXED, __HIP_MEMORY_SCOPE_WORKGROUP);
    }
    asm volatile("s_waitcnt lgkmcnt(0)" ::: "memory");
    __syncthreads();
    if (threadIdx.x < N_EXP) { const int c_ = hist[threadIdx.x]; hist[32 + threadIdx.x] = c_ ? atomicAdd(&cnt[threadIdx.x], c_) : 0; }
    __syncthreads();
    if (lane < 16) { const int t = t0 + lane;
        const int p0 = hist[32 + ex0_] + lr0_, p1 = hist[32 + ex1_] + lr1_;
        LIST[(size_t)ex0_ * T + p0] = 2 * t; LIST[(size_t)ex1_ * T + p1] = 2 * t + 1;
        RSL[(size_t)ex0_ * T + p0] = rs_; RSL[(size_t)ex1_ * T + p1] = rs_;
        POSR[2 * t] = (ex0_ << 20) | p0; POSR[2 * t + 1] = (ex1_ << 20) | p1; }
}
}

template <int ROWMAP>
__device__ __forceinline__ int wt_rowmap(int n) {
    if (ROWMAP == 1) {
        if (n >= 1024 && n < 2048) { const int sec = (n - 1024) >> 9, cc = (n - 1024) & 511, h = cc >> 6, d = cc & 63;
            return 1024 + sec * 512 + (h >> 2) * 256 + 128 * (d >> 5) + 32 * (h & 3) + (d & 31); }
    }
    if (ROWMAP == 2) return 256 * (n >> 7) + (n & 127);
    if (ROWMAP == 3) return 256 * (n >> 7) + 128 + (n & 127);
    return n;
}
template <int ROWMAP, bool GAIN>
__device__ __forceinline__ void p0_transpose_item(const float* __restrict__ W, int ldw, int K, int N, bf16_t* __restrict__ WT, LAS unsigned* scr  , int item, int lane,
                                                  const float* __restrict__ g0, const float* __restrict__ g1, int ksplit) {
    const int nblk = N / 64, kb = item / nblk, nb = item % nblk, k0 = 128 * kb, n0 = 64 * nb;
    const int kp = lane >> 4, nq = lane & 15;
    const float* wp = W + (size_t)(k0 + 2 * kp) * ldw + n0 + 4 * nq;
#pragma unroll 8
    for (int it = 0; it < 16; ++it) {
        f32x4 a = *(const f32x4*)(wp + (size_t)(8 * it) * ldw), b = *(const f32x4*)(wp + (size_t)(8 * it + 1) * ldw);
        if (GAIN) { const int k = k0 + 8 * it + 2 * kp; const float* gp = (k0 < ksplit) ? g0 + k : g1 + (k - ksplit); a *= gp[0]; b *= gp[1]; }
        LAS unsigned* d = scr + (4 * nq) * 68 + 4 * it + kp;
        d[0] = pg8::cvt_pk_bf16(a[0], b[0]); d[68] = pg8::cvt_pk_bf16(a[1], b[1]); d[136] = pg8::cvt_pk_bf16(a[2], b[2]); d[204] = pg8::cvt_pk_bf16(a[3], b[3]);
    }
    asm volatile("s_waitcnt lgkmcnt(0)" ::: "memory");
#pragma unroll 4
    for (int j = 0; j < 16; ++j) { const int n = (lane >> 4) + 4 * j, c = lane & 15;
        const pg8::u32x4 o = *(const LAS pg8::u32x4*)(scr + n * 68 + 4 * c);
        *(pg8::u32x4*)(WT + (size_t)wt_rowmap<ROWMAP>(n0 + n) * K + k0 + 8 * c) = o; }
    asm volatile("s_waitcnt lgkmcnt(0)" ::: "memory");
}


template <int ROWMAP, bool GAIN>
__device__ __forceinline__ void p0_transpose_item_q(const float* __restrict__ W, int ldw, int K, int N, unsigned char* __restrict__ WQ, LAS unsigned char* scr, int item, int lane, const float* __restrict__ g0) {
    const int nblk = N / 64, kb = item / nblk, nb = item % nblk, k0 = 128 * kb, n0 = 64 * nb;
    const int kp = lane >> 4, nq = lane & 15;
    const float* wp = W + (size_t)(k0 + 2 * kp) * ldw + n0 + 4 * nq;
#pragma unroll
    for (int hb = 0; hb < 2; ++hb) {
        f32x4 a[8], b[8];
#pragma unroll
        for (int i = 0; i < 8; ++i) { const int it = 8 * hb + i; a[i] = *(const f32x4*)(wp + (size_t)(8 * it) * ldw); b[i] = *(const f32x4*)(wp + (size_t)(8 * it + 1) * ldw); }
        asm volatile("" ::: "memory");
#pragma unroll
        for (int i = 0; i < 8; ++i) { const int it = 8 * hb + i;
            float ga = 32.f, gb = 32.f;
            if (GAIN) { const int k = k0 + 8 * it + 2 * kp; ga *= g0[k]; gb *= g0[k + 1]; }
            LAS unsigned char* d = scr + (4 * nq) * 144 + 8 * it + 2 * kp;
#pragma unroll
            for (int e = 0; e < 4; ++e) *(LAS unsigned short*)(d + e * 144) = (unsigned short)__builtin_amdgcn_cvt_pk_fp8_f32(__builtin_amdgcn_fmed3f(a[i][e] * ga, -448.f, 448.f), __builtin_amdgcn_fmed3f(b[i][e] * gb, -448.f, 448.f), 0, false);
        }
    }
    asm volatile("s_waitcnt lgkmcnt(0)" ::: "memory");
#pragma unroll 4
    for (int j = 0; j < 8; ++j) { const int n = (lane >> 3) + 8 * j, c = lane & 7;
        const pg8::u32x4 o = *(const LAS pg8::u32x4*)(scr + n * 144 + 16 * c);
        *(pg8::u32x4*)(WQ + (size_t)wt_rowmap<ROWMAP>(n0 + n) * K + k0 + 16 * c) = o; }
    asm volatile("s_waitcnt lgkmcnt(0)" ::: "memory");
}

namespace fox {
using bf16 = unsigned short;
using s16x4 = __attribute__((ext_vector_type(4))) short;
using u32x4 = __attribute__((ext_vector_type(4))) unsigned;
constexpr int NHEAD = FOX_H, D = 64, DMP = 512;
constexpr int NW = 8, QBLK = 32, QB = QBLK * NW, KVBLK = 64, NQB = SEQ / QB;
#define SBAR() __builtin_amdgcn_sched_barrier(0)
__device__ __forceinline__ void cmask(f32x16& p0, f32x16& p1, int jb, int qrel, int hi) {
  const float NEG = -INFINITY; int kb = 64 * jb + 4 * hi;
  #pragma unroll
  for (int r = 0; r < 16; ++r) { int kv = kb + (r & 3) + 8 * (r >> 2); if (kv > qrel) p0[r] = NEG; if (kv + 32 > qrel) p1[r] = NEG; }
}
constexpr int NSLOT = 3, SLOTB = 8192;
constexpr int LDS_K = 0, LDS_V = NSLOT * SLOTB, LDS_WS = 2 * NSLOT * SLOTB, LDS_OST = LDS_WS + NW * 64 * 4, LDS_BIAS = LDS_OST + NW * 4096, LDS_BYTES = LDS_BIAS + (SEQ + 64) * 4;
__device__ __forceinline__ void glds16(const void* gsrc, unsigned lds_dst) { unsigned keep;
  asm volatile("s_mov_b32 %0, m0\n\ts_mov_b32 m0, %2\n\ts_nop 0\n\tglobal_load_lds_dwordx4 %1, off\n\ts_mov_b32 m0, %0" : "=&s"(keep) : "v"(gsrc), "s"(lds_dst) : "memory"); }
__device__ __forceinline__ float max3f(float a, float b, float c) { float r; asm("v_max3_f32 %0, %1, %2, %3" : "=v"(r) : "v"(a), "v"(b), "v"(c)); return r; }
__device__ __forceinline__ float max2f(float a, float b) { float r; asm("v_max_f32_e32 %0, %1, %2" : "=v"(r) : "v"(a), "v"(b)); return r; }
__device__ __forceinline__ float fadd_s(float a, float b) { float r; asm("v_add_f32_e32 %0, %1, %2" : "=v"(r) : "v"(a), "v"(b)); return r; }
__device__ __forceinline__ float fsub_s(float a, float b) { float r; asm("v_sub_f32_e32 %0, %1, %2" : "=v"(r) : "v"(a), "v"(b)); return r; }
typedef float f32x2_t __attribute__((ext_vector_type(2))); typedef __bf16 bf16x2_t __attribute__((ext_vector_type(2)));
__device__ __forceinline__ unsigned cvtpk_s(float lo, float hi) { f32x2_t v = {lo, hi}; bf16x2_t b = __builtin_convertvector(v, bf16x2_t); return __builtin_bit_cast(unsigned, b); }
#define WAIT_BAR(N) asm volatile("s_waitcnt vmcnt(" #N ") lgkmcnt(0)\n\ts_barrier" ::: "memory")
typedef __attribute__((address_space(3))) const char* lds_cptr;
typedef short v4i16_t __attribute__((ext_vector_type(4)));
__device__ __forceinline__ void qkt(f32x16& p0, f32x16& p1, const char* Kslot, const bf16x8* qr, int r32, int hi) {
  const char* kb = Kslot + hi * 1024 + r32 * 16;
  #pragma unroll
  for (int d0 = 0; d0 < 4; ++d0) {
    const bf16x8 b0 = *reinterpret_cast<const bf16x8*>(kb + d0 * 2048);
    const bf16x8 b1 = *reinterpret_cast<const bf16x8*>(kb + d0 * 2048 + 512);
    p0 = __builtin_amdgcn_mfma_f32_32x32x16_bf16(b0, qr[d0], p0, 0, 0, 0); p1 = __builtin_amdgcn_mfma_f32_32x32x16_bf16(b1, qr[d0], p1, 0, 0, 0); }
}
__device__ __forceinline__ void kload8(bf16x8* kf, lds_cptr kp) {
  kf[0] = *(const LAS bf16x8*)(kp);        kf[1] = *(const LAS bf16x8*)(kp + 512);
  kf[2] = *(const LAS bf16x8*)(kp + 2048); kf[3] = *(const LAS bf16x8*)(kp + 2560);
  kf[4] = *(const LAS bf16x8*)(kp + 4096); kf[5] = *(const LAS bf16x8*)(kp + 4608);
  kf[6] = *(const LAS bf16x8*)(kp + 6144); kf[7] = *(const LAS bf16x8*)(kp + 6656);
}
__device__ __forceinline__ void kload2(bf16x8* kf, lds_cptr kp, int j) { kf[2 * j] = *(const LAS bf16x8*)(kp + j * 2048); kf[2 * j + 1] = *(const LAS bf16x8*)(kp + j * 2048 + 512); }
__device__ __forceinline__ s16x4 vtr(lds_cptr p) { return __builtin_bit_cast(s16x4, __builtin_amdgcn_ds_read_tr16_b64_v4i16((LAS v4i16_t*)p)); }
__device__ __forceinline__ float rowmax(const f32x16& p0, const f32x16& p1) {
  float a = max3f(p0[0], p0[1], p1[0]), b = max3f(p0[2], p0[3], p1[1]); a = max3f(a, p1[2], p1[3]);
  #pragma unroll
  for (int r = 4; r < 16; r += 4) { a = max3f(a, p0[r], p0[r + 1]); b = max3f(b, p0[r + 2], p0[r + 3]); a = max3f(a, p1[r], p1[r + 1]); b = max3f(b, p1[r + 2], p1[r + 3]); }
  const float m = max2f(a, b);
  auto rr = __builtin_amdgcn_permlane32_swap(__float_as_uint(m), __float_as_uint(m), false, false);
  return max2f(__uint_as_float(rr[0]), __uint_as_float(rr[1]));
}
__device__ __forceinline__ void pv(f32x16* o, int vb, bf16x8 pa0, bf16x8 pa1, bf16x8 pa2, bf16x8 pa3) {
  #pragma unroll
  for (int d0 = 0; d0 < 2; ++d0) { s16x4 lo[4], hi[4];
    #pragma unroll
    for (int ks = 0; ks < 4; ++ks) {
      asm volatile("ds_read_b64_tr_b16 %0,%1 offset:%c2" : "=&v"(lo[ks]) : "v"(vb), "i"(d0 * 4096 + ks * 1024) : "memory");
      asm volatile("ds_read_b64_tr_b16 %0,%1 offset:%c2" : "=&v"(hi[ks]) : "v"(vb), "i"(d0 * 4096 + ks * 1024 + 512) : "memory"); }
    asm volatile("s_waitcnt lgkmcnt(0)" ::: "memory"); SBAR();
    #define PK(k) (bf16x8){lo[k][0], lo[k][1], lo[k][2], lo[k][3], hi[k][0], hi[k][1], hi[k][2], hi[k][3]}
    o[d0] = __builtin_amdgcn_mfma_f32_32x32x16_bf16(pa0, PK(0), o[d0], 0, 0, 0);
    o[d0] = __builtin_amdgcn_mfma_f32_32x32x16_bf16(pa1, PK(1), o[d0], 0, 0, 0);
    o[d0] = __builtin_amdgcn_mfma_f32_32x32x16_bf16(pa2, PK(2), o[d0], 0, 0, 0);
    o[d0] = __builtin_amdgcn_mfma_f32_32x32x16_bf16(pa3, PK(3), o[d0], 0, 0, 0);
    #undef PK
  }
}
#define BLD(X0, X1, bp) do { _Pragma("unroll") for (int g_ = 0; g_ < 4; ++g_) { const f32x4 b0_ = *(const LAS f32x4*)((bp) + 32 * g_), b1_ = *(const LAS f32x4*)((bp) + 128 + 32 * g_); \
    X0[4 * g_] = b0_[0]; X0[4 * g_ + 1] = b0_[1]; X0[4 * g_ + 2] = b0_[2]; X0[4 * g_ + 3] = b0_[3]; X1[4 * g_] = b1_[0]; X1[4 * g_ + 1] = b1_[1]; X1[4 * g_ + 2] = b1_[2]; X1[4 * g_ + 3] = b1_[3]; } } while (0)

template <int THRL> __device__ __forceinline__ void attn_unit(int b, int h, int qb, const bf16* Q, const bf16* __restrict__ K, const bf16* __restrict__ V, bf16* O, const float* __restrict__ CUM, float* __restrict__ SSF, char* shm) {
  int tid = threadIdx.x; asm volatile("" : "+v"(tid));
  const int lane = tid & 63, r32 = lane & 31, hi = lane >> 5; const int wid = __builtin_amdgcn_readfirstlane(tid >> 6);
  const long rowbase = (long)b * SEQ; const int q0 = qb * QB;
  const bf16* Qw = Q + (rowbase + q0 + wid * QBLK) * DMP + h * D;
  const float* cbs = CUM + ((long)b * NHEAD + h) * SEQ;
  int t_start = 0;
  { const int ntile = (q0 + QB) / KVBLK; const float cq = cbs[q0]; const float ce = cbs[(lane < ntile ? lane : ntile - 1) * KVBLK + KVBLK - 1];
    const unsigned long long keep = __ballot(lane < ntile && (cq - ce >= -64.0f));
    t_start = keep ? (int)__builtin_ctzll(keep) : 0; t_start &= ~1; if (t_start > ntile - 4) t_start = ntile - 4;
    t_start = __builtin_amdgcn_readfirstlane(t_start); }
  const int skip_rows = t_start * KVBLK;
  const bf16 *Kh = K + (rowbase + skip_rows) * DMP + h * D, *Vh = V + (rowbase + skip_rows) * DMP + h * D;
  const unsigned lds0 = (unsigned)(uintptr_t)shm;
  float* wsf = (float*)(shm + LDS_WS) + wid * 64;
  const bf16* ksrc = Kh + (long)lane * DMP + wid * 8;
  const bf16* vsrc = Vh + (long)(16 * (wid & 3) + (lane >> 2)) * DMP + (wid >> 2) * 32 + (lane & 3) * 8;
  const unsigned kdst = lds0 + LDS_K + wid * 1024, vdst = lds0 + LDS_V + wid * 1024;
  #define DMA_K(t, slot) glds16(ksrc + (long)(t) * KVBLK * DMP, (unsigned)__builtin_amdgcn_readfirstlane(kdst + (slot)))
  #define DMA_V(t, slot) glds16(vsrc + (long)(t) * KVBLK * DMP, (unsigned)__builtin_amdgcn_readfirstlane(vdst + (slot)))
  const int vb0 = (int)(lds0 + LDS_V) + ((lane >> 4) & 1) * 32 + (lane & 3) * 8 + (4 * hi + ((lane & 15) >> 2)) * 64;
  const char* Kbase = shm + LDS_K; bf16x8 kf[8];
  const lds_cptr shm3 = (lds_cptr)shm; const lds_cptr kp0 = shm3 + LDS_K + hi * 1024 + r32 * 16; const lds_cptr vp0 = shm3 + LDS_V + ((lane >> 4) & 1) * 32 + (lane & 3) * 8 + (4 * hi + ((lane & 15) >> 2)) * 64;
  const lds_cptr bp0 = shm3 + LDS_BIAS + hi * 16;
  const int NT = (q0 + QB) / KVBLK - t_start;
  DMA_K(0, 0); DMA_V(0, 0); DMA_K(1, SLOTB);
  {
    const float* cb = cbs + skip_rows; const float cref = cbs[q0 + QB - 1]; const int nkeys = q0 + QB - skip_rows;
    LAS float* bl = (LAS float*)(shm3 + LDS_BIAS);
    float cv[SEQ / (NW * 64)];
    #pragma unroll
    for (int i = 0; i < SEQ / (NW * 64); ++i) { const int j = tid + i * NW * 64; cv[i] = cb[j < nkeys ? j : 0]; }
    #pragma unroll
    for (int i = 0; i < SEQ / (NW * 64); ++i) { const int j = tid + i * NW * 64; if (j < nkeys) bl[j] = cref - cv[i]; }
  }
  bf16x8 qr[4];
  #pragma unroll
  for (int d0 = 0; d0 < 4; ++d0) qr[d0] = *reinterpret_cast<const bf16x8*>(&Qw[(long)r32 * DMP + d0 * 16 + hi * 8]);
  float mhat = 0.f, l_reg = 0.f; f32x16 o[2]; o[0] = f32x16{}; o[1] = f32x16{};
  const int qrel = wid * QBLK + r32;
  #define CMASK(P0, P1, t) do { int jb_ = (t) - (NT - 4); if (jb_ >= 0) cmask(P0, P1, jb_, qrel, hi); } while (0)
  bool resc = false;
  #define START(P0, P1) do { const float rm = rowmax(P0, P1); resc = false; \
    { const float dl = rm; mhat = fadd_s(mhat, dl); \
      _Pragma("unroll") for (int r = 0; r < 16; ++r) { P0[r] = fsub_s(P0[r], dl); P1[r] = fsub_s(P1[r], dl); } } \
    _Pragma("unroll") for (int r = 0; r < 16; ++r) P0[r] = __builtin_amdgcn_exp2f(P0[r]); } while (0)
  #define RESC() do { if (resc) { asm volatile("s_waitcnt lgkmcnt(0)" ::: "memory"); \
      _Pragma("unroll") for (int d_ = 0; d_ < 2; ++d_) _Pragma("unroll") for (int r = 0; r < 16; ++r) o[d_][r] *= wsf[crow(r, hi)]; } } while (0)
  f32x16 pA0, pA1, pB0, pB1;
  int sl_prev = 0, sl_cur = 0, sl_next = SLOTB;
  #define ROT() do { sl_prev = sl_cur; sl_cur = sl_next; sl_next = (sl_next == (NSLOT - 1) * SLOTB) ? 0 : sl_next + SLOTB; } while (0)
  DMA_K(2, 2 * SLOTB);
  WAIT_BAR(3);
  BLD(pA0, pA1, bp0);
  qkt(pA0, pA1, Kbase, qr, r32, hi); asm volatile("s_nop 15\n\ts_nop 7" : "+v"(pA0), "+v"(pA1)); CMASK(pA0, pA1, 0);
  START(pA0, pA1);
  _Pragma("unroll") for (int r = 0; r < 16; ++r) pA1[r] = __builtin_amdgcn_exp2f(pA1[r]);
  BLD(pB0, pB1, bp0 + 256);
  _Pragma("unroll") for (int r = 0; r < 16; ++r) { pB0[r] = fsub_s(pB0[r], mhat); pB1[r] = fsub_s(pB1[r], mhat); }
  WAIT_BAR(0);
  DMA_K(3, 0); DMA_V(1, SLOTB);
  ROT();
  kload8(kf, kp0 + sl_cur);
  WAIT_BAR(2);
  s16x4 vlo[8], vhi[8]; u32x4 pw0, pw1, pw2, pw3;
  #define PKW(P, B) cvtpk_s(P[B], P[B + 1])
  #define PAF(k) __builtin_bit_cast(bf16x8, pw##k)
  #define VFR(i) (bf16x8){vlo[i][0], vlo[i][1], vlo[i][2], vlo[i][3], vhi[i][0], vhi[i][1], vhi[i][2], vhi[i][3]}
  #define PIN(x) asm volatile("" : "+v"(x))
  #define MX3(a, b, c) __builtin_fmaxf(__builtin_fmaxf((a), (b)), (c))
  #define GAPA(MF, A0, A1, A2, A3, W0, W1, PW) do { MF; sacc += A0; sacc += A1; sacc += A2; sacc += A3; PIN(sacc); W0; W1; PIN(PW); SBAR(); } while (0)
  #define EX(v) __builtin_amdgcn_exp2f(v)
  #define GAPB(MF, X, B, N, NB) do { MF; X[B] = EX(X[B]); X[B + 1] = EX(X[B + 1]); X[B + 2] = EX(X[B + 2]); X[B + 3] = EX(X[B + 3]); PIN(X); \
    N[NB] = fsub_s(N[NB], mhat); N[NB + 1] = fsub_s(N[NB + 1], mhat); N[NB + 2] = fsub_s(N[NB + 2], mhat); N[NB + 3] = fsub_s(N[NB + 3], mhat); PIN(N); SBAR(); } while (0)
  #define VRD(i) do { vlo[i] = vtr(vp_ + (((i) >> 2) * 4096 + ((i) & 3) * 1024)); vhi[i] = vtr(vp_ + (((i) >> 2) * 4096 + ((i) & 3) * 1024 + 512)); } while (0)
  #define KRD(G, j) do { if (G) { kload2(kf, kp0 + sl_next, j); SBAR(); } } while (0)
  #define STEP(C0, C1, P0, P1, t, GK, GV, GL) do { SBAR(); \
    const lds_cptr vp_ = vp0 + sl_prev; \
    VRD(0); SBAR(); float sacc = (P0[0] + P0[1]); \
    GAPA(C0 = __builtin_amdgcn_mfma_f32_32x32x16_bf16(kf[0], qr[0], C0, 0, 0, 0), P0[2], P0[3], P0[4], P0[5],     pw0[0] = PKW(P0, 0), pw0[1] = PKW(P0, 2), pw0); \
    VRD(4); SBAR(); GAPA(C1 = __builtin_amdgcn_mfma_f32_32x32x16_bf16(kf[1], qr[0], C1, 0, 0, 0), P0[6], P0[7], P0[8], P0[9],     pw0[2] = PKW(P0, 4), pw0[3] = PKW(P0, 6), pw0); \
    VRD(1); SBAR(); GAPA(C0 = __builtin_amdgcn_mfma_f32_32x32x16_bf16(kf[2], qr[1], C0, 0, 0, 0),   P0[10], P0[11], P0[12], P0[13], pw1[0] = PKW(P0, 8), pw1[1] = PKW(P0, 10), pw1); \
    VRD(5); SBAR(); GAPA(C1 = __builtin_amdgcn_mfma_f32_32x32x16_bf16(kf[3], qr[1], C1, 0, 0, 0),   P0[14], P0[15], P1[0], P1[1],   pw1[2] = PKW(P0, 12), pw1[3] = PKW(P0, 14), pw1); \
    VRD(2); SBAR(); GAPA(C0 = __builtin_amdgcn_mfma_f32_32x32x16_bf16(kf[4], qr[2], C0, 0, 0, 0),   P1[2], P1[3], P1[4], P1[5],     pw2[0] = PKW(P1, 0), pw2[1] = PKW(P1, 2), pw2); \
    VRD(6); SBAR(); GAPA(C1 = __builtin_amdgcn_mfma_f32_32x32x16_bf16(kf[5], qr[2], C1, 0, 0, 0),   P1[6], P1[7], P1[8], P1[9],     pw2[2] = PKW(P1, 4), pw2[3] = PKW(P1, 6), pw2); \
    VRD(3); SBAR(); GAPA(C0 = __builtin_amdgcn_mfma_f32_32x32x16_bf16(kf[6], qr[3], C0, 0, 0, 0),   P1[10], P1[11], P1[12], P1[13], pw3[0] = PKW(P1, 8), pw3[1] = PKW(P1, 10), pw3); \
    VRD(7); SBAR(); GAPA(C1 = __builtin_amdgcn_mfma_f32_32x32x16_bf16(kf[7], qr[3], C1, 0, 0, 0),   P1[14], P1[15], 0.f, 0.f,       pw3[2] = PKW(P1, 12), pw3[3] = PKW(P1, 14), pw3); \
    l_reg += sacc; \
    if (GK) { DMA_K((t) + 3, sl_cur); } if (GV) { DMA_V((t) + 1, sl_next); } \
    CMASK(C0, C1, t); \
    { float a = MX3(C0[0], C0[1], C1[0]), b = MX3(C0[2], C0[3], C1[1]); a = MX3(a, C1[2], C1[3]); \
      _Pragma("unroll") for (int r = 4; r < 16; r += 4) { a = MX3(a, C0[r], C0[r + 1]); b = MX3(b, C0[r + 2], C0[r + 3]); a = MX3(a, C1[r], C1[r + 1]); b = MX3(b, C1[r + 2], C1[r + 3]); } \
      float rm = __builtin_fmaxf(a, b); { auto rr = __builtin_amdgcn_permlane32_swap(__float_as_uint(rm), __float_as_uint(rm), false, false); rm = __builtin_fmaxf(__uint_as_float(rr[0]), __uint_as_float(rr[1])); } \
      resc = false; \
      if (__builtin_expect(__any(rm > (float)THRL), 0)) { const float dl = __builtin_fmaxf(rm, 0.f); mhat += dl; \
        _Pragma("unroll") for (int r = 0; r < 16; ++r) { C0[r] -= dl; C1[r] -= dl; } \
        const float f = __builtin_amdgcn_exp2f(-dl); l_reg *= f; if (hi == 0) wsf[r32] = f; resc = true; } } \
    SBAR(); \
    BLD(P0, P1, bp0 + ((t) + 1) * 256); SBAR(); \
    GAPB(o[0] = __builtin_amdgcn_mfma_f32_32x32x16_bf16(PAF(0), VFR(0), o[0], 0, 0, 0), C0, 0, P0, 0); \
    GAPB(o[1] = __builtin_amdgcn_mfma_f32_32x32x16_bf16(PAF(0), VFR(4), o[1], 0, 0, 0), C0, 4, P0, 4); \
    KRD(GL, 0); GAPB(o[0] = __builtin_amdgcn_mfma_f32_32x32x16_bf16(PAF(1), VFR(1), o[0], 0, 0, 0), C0, 8, P0, 8); \
    KRD(GL, 1); GAPB(o[1] = __builtin_amdgcn_mfma_f32_32x32x16_bf16(PAF(1), VFR(5), o[1], 0, 0, 0), C0, 12, P0, 12); \
    KRD(GL, 2); GAPB(o[0] = __builtin_amdgcn_mfma_f32_32x32x16_bf16(PAF(2), VFR(2), o[0], 0, 0, 0), C1, 0, P1, 0); \
    KRD(GL, 3); GAPB(o[1] = __builtin_amdgcn_mfma_f32_32x32x16_bf16(PAF(2), VFR(6), o[1], 0, 0, 0), C1, 4, P1, 4); \
    GAPB(o[0] = __builtin_amdgcn_mfma_f32_32x32x16_bf16(PAF(3), VFR(3), o[0], 0, 0, 0), C1, 8, P1, 8); \
    GAPB(o[1] = __builtin_amdgcn_mfma_f32_32x32x16_bf16(PAF(3), VFR(7), o[1], 0, 0, 0), C1, 12, P1, 12); \
    } while (0)
  int t = 1;
  #undef CMASK
  #define CMASK(P0, P1, t) do {} while (0)
  for (; t + 5 < NT; t += 2) {
    STEP(pB0, pB1, pA0, pA1, t, true, true, true);     WAIT_BAR(2); RESC(); ROT();
    STEP(pA0, pA1, pB0, pB1, t + 1, true, true, true);   WAIT_BAR(2); RESC(); ROT();
  }
  #undef CMASK
  #define CMASK(P0, P1, t) do { int jb_ = (t) - (NT - 4); if (jb_ >= 0) cmask(P0, P1, jb_, qrel, hi); } while (0)
  #define ENDW(tt) do { if ((tt) + 3 < NT) { WAIT_BAR(2); } else if ((tt) + 2 < NT) { WAIT_BAR(1); } else { WAIT_BAR(0); } } while (0)
  for (; t + 1 < NT; t += 2) {
    STEP(pB0, pB1, pA0, pA1, t, (t + 3 < NT), (t + 1 < NT), (t + 1 < NT));       ENDW(t);   RESC(); ROT();
    STEP(pA0, pA1, pB0, pB1, t + 1, (t + 4 < NT), (t + 2 < NT), (t + 2 < NT));     ENDW(t + 1); RESC(); ROT();
  }
  STEP(pB0, pB1, pA0, pA1, NT - 1, false, false, false); RESC();
  { float sacc = pB0[0] + pB0[1]; _Pragma("unroll") for (int r = 2; r < 16; ++r) sacc += pB0[r]; _Pragma("unroll") for (int r = 0; r < 16; ++r) sacc += pB1[r]; l_reg += sacc;
    pw0 = (u32x4){PKW(pB0, 0), PKW(pB0, 2), PKW(pB0, 4), PKW(pB0, 6)}; pw1 = (u32x4){PKW(pB0, 8), PKW(pB0, 10), PKW(pB0, 12), PKW(pB0, 14)}; pw2 = (u32x4){PKW(pB1, 0), PKW(pB1, 2), PKW(pB1, 4), PKW(pB1, 6)}; pw3 = (u32x4){PKW(pB1, 8), PKW(pB1, 10), PKW(pB1, 12), PKW(pB1, 14)};
    SBAR(); pv(o, vb0 + sl_cur, PAF(0), PAF(1), PAF(2), PAF(3)); }
  #undef PKW
  #undef PAF
  #undef VFR
  #undef PIN
  #undef MX3
  #undef GAPA
  #undef GAPB
  #undef EX
  #undef VRD
  #undef KRD
  #undef STEP
  #undef ENDW
  { auto rr = __builtin_amdgcn_permlane32_swap(__float_as_uint(l_reg), __float_as_uint(l_reg), false, false); l_reg = __uint_as_float(rr[0]) + __uint_as_float(rr[1]); }
  if (hi == 0) wsf[32 + r32] = l_reg; asm volatile("s_waitcnt lgkmcnt(0)" ::: "memory");
  float rli[16];
  #pragma unroll
  for (int r = 0; r < 16; ++r) rli[r] = __builtin_amdgcn_rcpf(wsf[32 + crow(r, hi)]);
  bf16* Ow = O + (rowbase + q0 + wid * QBLK) * DMP + h * D;
  { bf16* stg = (bf16*)(shm + LDS_OST) + wid * 2048;
    #pragma unroll
    for (int r = 0; r < 16; ++r) { const int orow = crow(r, hi);
      #pragma unroll
      for (int d0 = 0; d0 < 2; ++d0) stg[orow * 64 + d0 * 32 + r32] = f2bf(o[d0][r] * rli[r]); }
    asm volatile("s_waitcnt lgkmcnt(0)" ::: "memory");
    #pragma unroll
    for (int i = 0; i < 4; ++i) { const int row = i * 8 + (lane >> 3), ch = lane & 7; const u32x4 v = *(const u32x4*)(stg + row * 64 + ch * 8); *(u32x4*)(Ow + (long)row * DMP + ch * 8) = v;
      float ss = 0.f;
      #pragma unroll
      for (int j = 0; j < 4; ++j) { const float lo = __uint_as_float(v[j] << 16), hi_ = __uint_as_float(v[j] & 0xffff0000u); ss += lo * lo + hi_ * hi_; }
      ss += __shfl_xor(ss, 1); ss += __shfl_xor(ss, 2); ss += __shfl_xor(ss, 4);
      if (ch == 0) SSF[(rowbase + q0 + wid * QBLK + row) * 8 + h] = ss; } }
  asm volatile("s_waitcnt lgkmcnt(0)\n\ts_barrier" ::: "memory");
  #undef DMA_K
  #undef DMA_V
  #undef CMASK
  #undef START
  #undef RESC
  #undef ROT
}
struct ConvArgs { const float *w_gate, *w_up, *w_down, *g; unsigned char *WT_GU, *WT_D; };
template <int THRL> __device__ __forceinline__ void attn_phase(char* lds, const bf16* Q, const bf16* K, const bf16* V, bf16* O, const float* CUM, float* SSF, int* counter, const ConvArgs cv) {
  LAS int* slot = (LAS int*)((LAS char*)lds + 140032);
  constexpr int NENT = NHEAD * NQB / 4 * 7;
  int nxt = 0;
  if (threadIdx.x == 0) nxt = atomicAdd(counter, 1);
  for (;;) {
    if (threadIdx.x == 0) *slot = nxt;
    __syncthreads();
    const int v = *slot;
    __syncthreads();
    if (v >= NENT) break;
    if (threadIdx.x == 0) nxt = atomicAdd(counter, 1);
    const int grp = v / 7, pos = v % 7;
    if (pos & 1) {
      const int chunk = (blockIdx.x & 7) * (NENT / 7 * 3) + grp * 3 + (pos >> 1);
      int tid = threadIdx.x; asm volatile("" : "+v"(tid));
      const int wave = __builtin_amdgcn_readfirstlane(tid >> 6), lane = tid & 63;
      const int it = chunk * 8 + wave, e = it / 192, q = it % 192;
      LAS unsigned char* scq = (LAS unsigned char*)lds + wave * 17408;
      if (q < 64) p0_transpose_item_q<2, true>(cv.w_gate + (size_t)e * DM * D_EXP, D_EXP, DM, D_EXP, cv.WT_GU + (size_t)e * 1024 * 1024, scq, q, lane, cv.g);
      else if (q < 128) p0_transpose_item_q<3, true>(cv.w_up + (size_t)e * DM * D_EXP, D_EXP, DM, D_EXP, cv.WT_GU + (size_t)e * 1024 * 1024, scq, q - 64, lane, cv.g);
      else p0_transpose_item_q<0, false>(cv.w_down + (size_t)e * D_EXP * DM, DM, D_EXP, DM, cv.WT_D + (size_t)e * 1024 * 512, scq, q - 128, lane, cv.g);
    } else {
      const int u = grp * 4 + (pos >> 1);
      const int qb = NQB - 1 - (u >> 3), bh = (blockIdx.x & 7) * NHEAD + (u & 7);
      attn_unit<THRL>(bh / NHEAD, bh % NHEAD, qb, Q, K, V, O, CUM, SSF, lds);
    }
  }
}
#undef SBAR
#undef WAIT_BAR
#undef BLD
}


namespace lru {
constexpr int CL = 128, NCH = SEQ / CL;
constexpr int WLDS = 16384;
typedef unsigned u32x4 __attribute__((ext_vector_type(4)));
template <bool PASS2>
__device__ __forceinline__ void unit(int b, int chunk, const bf16_t* __restrict__ U, const bf16_t* __restrict__ GATE, const float* __restrict__ conv_w, const float* __restrict__ conv_b,
                                     const bf16_t* __restrict__ LRUW, const float* __restrict__ ba, const float* __restrict__ bx, const float* __restrict__ a_param,
                                     float* __restrict__ SUMA, float* __restrict__ SUMH, bf16_t* __restrict__ YL, float* __restrict__ SSL, LAS unsigned char* ldsw, int w, int lane) {
    const int cl = lane & 31, hi = lane >> 5;
    LAS float* cp = (LAS float*)ldsw;
    LAS bf16_t* stg = (LAS bf16_t*)(ldsw + 2048);
    for (int i = lane; i < 320; i += 64) { const int tap = i >> 6, c = i & 63; cp[i] = (tap < 4) ? conv_w[tap * 512 + 64 * w + c] : conv_b[64 * w + c]; }
    { const int c = 64 * w + lane; cp[320 + lane] = ba[c]; cp[384 + lane] = bx[c];
      const float ap = -a_param[c]; const float sp = (ap > 20.f) ? ap : log1pf(__expf(ap)); cp[448 + lane] = -8.f * sp * LOG2E; }
    const u32x4* wf = (const u32x4*)LRUW + (size_t)w * 16 * 64 + lane;
    bf16x8 Bi[2];
#pragma unroll
    for (int q = 0; q < 2; ++q)
#pragma unroll
        for (int j = 0; j < 8; ++j) Bi[q][j] = (16 * q + 8 * hi + j == cl) ? (short)0x3F80 : (short)0;
    float h[2], atot[2];
#pragma unroll
    for (int n = 0; n < 2; ++n) { h[n] = 0.f; atot[n] = 1.f; }
    if (PASS2) {
#pragma unroll 1
        for (int c0 = 0; c0 < chunk; c0 += 8) {
            float sa[8][2], sh[8][2];
#pragma unroll
            for (int j = 0; j < 8; ++j)
#pragma unroll
                for (int n = 0; n < 2; ++n) { const bool ok = (c0 + j < chunk); const size_t o = ((size_t)(b * NCH + (ok ? c0 + j : 0))) * 512 + 64 * w + 32 * n + cl;
                    const float av = SUMA[o], hv = SUMH[o]; sa[j][n] = ok ? av : 1.f; sh[j][n] = ok ? hv : 0.f; }
#pragma unroll
            for (int j = 0; j < 8; ++j)
#pragma unroll
                for (int n = 0; n < 2; ++n) h[n] = sa[j][n] * h[n] + sh[j][n];
        }
    }
    asm volatile("s_waitcnt lgkmcnt(0)" ::: "memory");
    const int t0 = b * SEQ + chunk * CL;
    LAS unsigned char* ub0 = ldsw + 6144;
    const int dri = lane >> 3, dch = lane & 7;
#define LRU_DMA_U(tb_, buf_) do { _Pragma("unroll") for (int i_ = 0; i_ < 5; ++i_) { const int ri_ = 8 * i_ + dri; int gr_ = (tb_) - 3 + ri_; gr_ = gr_ < 0 ? 0 : (gr_ > T - 1 ? T - 1 : gr_); \
        __builtin_amdgcn_global_load_lds((const unsigned*)((const char*)U + (unsigned)((gr_ * 512 + 64 * w + 8 * (dch ^ (ri_ & 7))) * 2)), (LAS unsigned*)(ub0 + (buf_) * 5120 + i_ * 1024), 16, 0, 0); } } while (0)
#define LRU_DMA_G(tb_) do { _Pragma("unroll") for (int i_ = 0; i_ < 4; ++i_) \
        __builtin_amdgcn_global_load_lds((const unsigned*)((const char*)GATE + (unsigned)((((tb_) + 8 * i_ + dri) * 512 + 64 * w + 8 * dch) * 2)), (LAS unsigned*)(ldsw + 2048 + i_ * 1024), 16, 0, 0); } while (0)
    LRU_DMA_U(t0, 0);
#pragma unroll 1
    for (int mt = 0; mt < CL / 32; ++mt) {
        int tb = t0 + mt * 32; asm volatile("" : "+s"(tb));
        const int srow = chunk * CL + mt * 32 + cl;
        asm volatile("s_waitcnt vmcnt(0)" ::: "memory");
        if (mt + 1 < CL / 32) LRU_DMA_U(tb + 32, (mt + 1) & 1);
        if (PASS2) LRU_DMA_G(tb);
        const LAS unsigned char* ub = ub0 + (mt & 1) * 5120;
        bf16x8 af[4];
#pragma unroll
        for (int s_ = 0; s_ < 4; ++s_) {
            const int cc = 16 * s_ + 8 * hi;
            float xv[8];
            { const f32x4 b0 = *(const LAS f32x4*)(cp + 256 + cc), b1 = *(const LAS f32x4*)(cp + 256 + cc + 4);
              xv[0] = b0[0]; xv[1] = b0[1]; xv[2] = b0[2]; xv[3] = b0[3]; xv[4] = b1[0]; xv[5] = b1[1]; xv[6] = b1[2]; xv[7] = b1[3]; }
#pragma unroll
            for (int tap = 0; tap < 4; ++tap) {
                const bool inseq = (srow - 3 + tap >= 0);
                const int ri = cl + tap;
                u32x4 uu = *(const LAS u32x4*)(ub + ri * 128 + (((2 * s_ + hi) ^ (ri & 7)) << 4));
                if (!inseq) uu = (u32x4){0u, 0u, 0u, 0u};
                const f32x4 w0 = *(const LAS f32x4*)(cp + tap * 64 + cc), w1 = *(const LAS f32x4*)(cp + tap * 64 + cc + 4);
                xv[0] += w0[0] * __uint_as_float(uu[0] << 16); xv[1] += w0[1] * __uint_as_float(uu[0] & 0xffff0000u);
                xv[2] += w0[2] * __uint_as_float(uu[1] << 16); xv[3] += w0[3] * __uint_as_float(uu[1] & 0xffff0000u);
                xv[4] += w1[0] * __uint_as_float(uu[2] << 16); xv[5] += w1[1] * __uint_as_float(uu[2] & 0xffff0000u);
                xv[6] += w1[2] * __uint_as_float(uu[3] << 16); xv[7] += w1[3] * __uint_as_float(uu[3] & 0xffff0000u);
            }
            u32x4 pk; pk[0] = pg8::cvt_pk_bf16(xv[0], xv[1]); pk[1] = pg8::cvt_pk_bf16(xv[2], xv[3]); pk[2] = pg8::cvt_pk_bf16(xv[4], xv[5]); pk[3] = pg8::cvt_pk_bf16(xv[6], xv[7]);
            af[s_] = __builtin_bit_cast(bf16x8, pk);
            asm volatile("" ::: "memory"); __builtin_amdgcn_sched_barrier(0);
        }
#pragma unroll
        for (int n = 0; n < 2; ++n) {
            f32x16 rCn, iCn, xCn;
#pragma unroll
            for (int r = 0; r < 16; ++r) { rCn[r] = cp[320 + 32 * n + cl]; iCn[r] = cp[384 + 32 * n + cl]; xCn[r] = 0.f; }
            const float c1n = cp[448 + 32 * n + cl];
#pragma unroll
            for (int s_ = 0; s_ < 4; ++s_) {
                const bf16x8 fa = __builtin_bit_cast(bf16x8, wf[(n * 4 + s_) * 64]), fx = __builtin_bit_cast(bf16x8, wf[(8 + n * 4 + s_) * 64]);
                rCn = __builtin_amdgcn_mfma_f32_32x32x16_bf16(af[s_], fa, rCn, 0, 0, 0);
                iCn = __builtin_amdgcn_mfma_f32_32x32x16_bf16(af[s_], fx, iCn, 0, 0, 0);
                if ((s_ >> 1) == n) xCn = __builtin_amdgcn_mfma_f32_32x32x16_bf16(af[s_], Bi[s_ & 1], xCn, 0, 0, 0);
            }
#pragma unroll
            for (int r = 0; r < 16; ++r) {
                const float rr = __builtin_amdgcn_rcpf(1.f + __builtin_amdgcn_exp2f(-LOG2E * rCn[r]));
                const float ii = __builtin_amdgcn_rcpf(1.f + __builtin_amdgcn_exp2f(-LOG2E * iCn[r]));
                const float a = __builtin_amdgcn_exp2f(c1n * rr);
                const float mult = __builtin_amdgcn_sqrtf(fmaxf(1.f - a * a, 0.f));
                rCn[r] = a; iCn[r] = mult * (ii * xCn[r]);
                if ((r & 3) == 3) __builtin_amdgcn_sched_barrier(0);
            }
            float Ao[4], Bo[4], Ap[4], Bp[4];
#pragma unroll
            for (int g = 0; g < 4; ++g) { float A = rCn[4 * g], B = iCn[4 * g];
#pragma unroll
                for (int k = 1; k < 4; ++k) { B = rCn[4 * g + k] * B + iCn[4 * g + k]; A *= rCn[4 * g + k]; }
                Ao[g] = A; Bo[g] = B; Ap[g] = __shfl_xor(A, 32); Bp[g] = __shfl_xor(B, 32); }
            float hh = h[n], at = atot[n];
#pragma unroll
            for (int g = 0; g < 4; ++g) {
                const float A1 = hi ? Ap[g] : Ao[g], B1 = hi ? Bp[g] : Bo[g], A2 = hi ? Ao[g] : Ap[g], B2 = hi ? Bo[g] : Bp[g];
                const float h1 = A1 * hh + B1, h2 = A2 * h1 + B2;
                float hr = hi ? h1 : hh;
                at *= A1 * A2; hh = h2;
                if (PASS2) {
#pragma unroll
                    for (int k = 0; k < 4; ++k) { hr = rCn[4 * g + k] * hr + iCn[4 * g + k]; iCn[4 * g + k] = hr; }
                }
            }
            h[n] = hh; atot[n] = at;
            if (PASS2) {
                if (n == 0) asm volatile("s_waitcnt vmcnt(0)" ::: "memory");
#pragma unroll
                for (int r = 0; r < 16; ++r) {
                    const int tok = crow(r, hi);
                    const float gx = bf2f(stg[tok * 64 + 32 * n + cl]);
                    const float uq = 0.7978845608028654f * (gx + 0.044715f * gx * gx * gx);
                    const float th = 1.f - 2.f * __builtin_amdgcn_rcpf(1.f + __builtin_amdgcn_exp2f(2.f * LOG2E * uq));
                    stg[tok * 64 + 32 * n + cl] = f2bf(iCn[r] * (0.5f * gx * (1.f + th)));
                    if ((r & 3) == 3) __builtin_amdgcn_sched_barrier(0);
                }
            }
        }
        if (PASS2) {
            asm volatile("s_waitcnt lgkmcnt(0)" ::: "memory");
#pragma unroll
            for (int i = 0; i < 4; ++i) { const int row = i * 8 + (lane >> 3), ch = lane & 7; const u32x4 v = *(const LAS u32x4*)(stg + row * 64 + ch * 8);
                *(u32x4*)((char*)YL + (unsigned)(((tb + row) * 512 + 64 * w + ch * 8) * 2)) = v;
                float ss = 0.f;
#pragma unroll
                for (int j = 0; j < 4; ++j) { const float lo = __uint_as_float(v[j] << 16), hi_ = __uint_as_float(v[j] & 0xffff0000u); ss += lo * lo + hi_ * hi_; }
                ss += __shfl_xor(ss, 1); ss += __shfl_xor(ss, 2); ss += __shfl_xor(ss, 4);
                if (ch == 0) SSL[(size_t)(tb + row) * 8 + w] = ss; }
            asm volatile("s_waitcnt lgkmcnt(0)" ::: "memory");
        }
    }
    if (!PASS2) {
        if (hi == 0) {
#pragma unroll
            for (int n = 0; n < 2; ++n) { const size_t o = ((size_t)(b * NCH + chunk)) * 512 + 64 * w + 32 * n + cl; SUMA[o] = atot[n]; SUMH[o] = h[n]; }
        }
    }
}
#undef LRU_DMA_U
#undef LRU_DMA_G
}


namespace xat {
constexpr int KS_BYTES = MEM_LEN * 256, VT_STRIDE = 520, VT_BYTES = MEM_D * VT_STRIDE, LDS_NEED = KS_BYTES + VT_BYTES;
typedef unsigned u32x4 __attribute__((ext_vector_type(4)));
typedef unsigned u32x2 __attribute__((ext_vector_type(2)));
__device__ __forceinline__ void item(int b, int h, int qhalf  , const bf16_t* __restrict__ QM, const bf16_t* __restrict__ KM, const bf16_t* __restrict__ VM, bf16_t* __restrict__ OM,
                                     const float* __restrict__ q_g, const float* __restrict__ k_g, LAS unsigned char* lds) {
    int tid = threadIdx.x; asm volatile("" : "+v"(tid));
    const int lane = tid & 63, wid = __builtin_amdgcn_readfirstlane(tid >> 6), r32 = lane & 31, hi = lane >> 5;
    LAS unsigned char* Ks = lds; LAS unsigned char* VT = lds + KS_BYTES;
    {
        const int ch = tid & 15, k0 = tid >> 4;
        const f32x4 g0 = *(const f32x4*)(k_g + 8 * ch), g1 = *(const f32x4*)(k_g + 8 * ch + 4);
#pragma unroll 2
        for (int p = 0; p < 8; ++p) {
            const int key = p * 32 + k0;
            const size_t goff = ((size_t)(b * MEM_LEN + key)) * 512 + h * MEM_D + 8 * ch;
            const u32x4 kk = *(const u32x4*)(KM + goff), vv = *(const u32x4*)(VM + goff);
            float f[8];
#pragma unroll
            for (int j = 0; j < 4; ++j) { f[2 * j] = __uint_as_float(kk[j] << 16); f[2 * j + 1] = __uint_as_float(kk[j] & 0xffff0000u); }
            float ss = 0.f;
#pragma unroll
            for (int j = 0; j < 8; ++j) ss += f[j] * f[j];
            ss += __shfl_xor(ss, 1); ss += __shfl_xor(ss, 2); ss += __shfl_xor(ss, 4); ss += __shfl_xor(ss, 8);
            const float rs = rsqrtf(ss * (1.f / MEM_D) + EPS);
            u32x4 o; o[0] = pg8::cvt_pk_bf16(f[0] * rs * g0[0], f[1] * rs * g0[1]); o[1] = pg8::cvt_pk_bf16(f[2] * rs * g0[2], f[3] * rs * g0[3]);
                     o[2] = pg8::cvt_pk_bf16(f[4] * rs * g1[0], f[5] * rs * g1[1]); o[3] = pg8::cvt_pk_bf16(f[6] * rs * g1[2], f[7] * rs * g1[3]);
            *(LAS u32x4*)(Ks + key * 256 + ((ch ^ (key & 15)) << 4)) = o;
#pragma unroll
            for (int j = 0; j < 4; ++j) { *(LAS bf16_t*)(VT + (8 * ch + 2 * j) * VT_STRIDE + key * 2) = (bf16_t)(vv[j] & 0xffffu); *(LAS bf16_t*)(VT + (8 * ch + 2 * j + 1) * VT_STRIDE + key * 2) = (bf16_t)(vv[j] >> 16); }
        }
    }
    __syncthreads();
#pragma unroll 1
    for (int qi = 0; qi < 2; ++qi) {
        const int q0 = qhalf * 512 + qi * 256 + wid * 32;
        const bf16_t* Qp = QM + ((size_t)(b * SEQ + q0 + r32)) * 512 + h * MEM_D + hi * 8;
        bf16x8 qf[8];
        {
            float ss = 0.f; u32x4 raw[8];
#pragma unroll
            for (int d0 = 0; d0 < 8; ++d0) { raw[d0] = *(const u32x4*)(Qp + d0 * 16);
#pragma unroll
                for (int j = 0; j < 4; ++j) { const float lo = __uint_as_float(raw[d0][j] << 16), hi_ = __uint_as_float(raw[d0][j] & 0xffff0000u); ss += lo * lo + hi_ * hi_; } }
            ss += __shfl_xor(ss, 32);
            const float rs = rsqrtf(ss * (1.f / MEM_D) + EPS) * (0.08838834764831845f * LOG2E);
#pragma unroll
            for (int d0 = 0; d0 < 8; ++d0) { const f32x4 g0 = *(const f32x4*)(q_g + 16 * d0 + 8 * hi), g1 = *(const f32x4*)(q_g + 16 * d0 + 8 * hi + 4);
                u32x4 o;
                o[0] = pg8::cvt_pk_bf16(__uint_as_float(raw[d0][0] << 16) * rs * g0[0], __uint_as_float(raw[d0][0] & 0xffff0000u) * rs * g0[1]);
                o[1] = pg8::cvt_pk_bf16(__uint_as_float(raw[d0][1] << 16) * rs * g0[2], __uint_as_float(raw[d0][1] & 0xffff0000u) * rs * g0[3]);
                o[2] = pg8::cvt_pk_bf16(__uint_as_float(raw[d0][2] << 16) * rs * g1[0], __uint_as_float(raw[d0][2] & 0xffff0000u) * rs * g1[1]);
                o[3] = pg8::cvt_pk_bf16(__uint_as_float(raw[d0][3] << 16) * rs * g1[2], __uint_as_float(raw[d0][3] & 0xffff0000u) * rs * g1[3]);
                qf[d0] = __builtin_bit_cast(bf16x8, o); }
        }
        f32x16 o[4];
#pragma unroll
        for (int i = 0; i < 4; ++i)
#pragma unroll
            for (int r = 0; r < 16; ++r) o[i][r] = 0.f;
        float m = -1e30f, l = 0.f;
#pragma unroll 1
        for (int kv0 = 0; kv0 < MEM_LEN; kv0 += 32) {
            f32x16 sc;
#pragma unroll
            for (int r = 0; r < 16; ++r) sc[r] = 0.f;
            const int key = kv0 + r32;
#pragma unroll
            for (int d0 = 0; d0 < 8; ++d0) { const bf16x8 kf = *(const LAS bf16x8*)(Ks + key * 256 + (((2 * d0 + hi) ^ (key & 15)) << 4)); sc = __builtin_amdgcn_mfma_f32_32x32x16_bf16(kf, qf[d0], sc, 0, 0, 0); }
            float tmax = sc[0];
#pragma unroll
            for (int r = 1; r < 16; ++r) tmax = fmaxf(tmax, sc[r]);
            tmax = fmaxf(tmax, __shfl_xor(tmax, 32));
            const float mnew = fmaxf(m, tmax), alpha = __builtin_amdgcn_exp2f(m - mnew);
            float ps = 0.f;
#pragma unroll
            for (int r = 0; r < 16; ++r) { sc[r] = __builtin_amdgcn_exp2f(sc[r] - mnew); ps += sc[r]; }
            l = l * alpha + ps; m = mnew;
#pragma unroll
            for (int i = 0; i < 4; ++i)
#pragma unroll
                for (int r = 0; r < 16; ++r) o[i][r] *= alpha;
            bf16x8 pb[2];
#pragma unroll
            for (int s2 = 0; s2 < 2; ++s2) { u32x4 w; w[0] = pg8::cvt_pk_bf16(sc[8 * s2], sc[8 * s2 + 1]); w[1] = pg8::cvt_pk_bf16(sc[8 * s2 + 2], sc[8 * s2 + 3]); w[2] = pg8::cvt_pk_bf16(sc[8 * s2 + 4], sc[8 * s2 + 5]); w[3] = pg8::cvt_pk_bf16(sc[8 * s2 + 6], sc[8 * s2 + 7]); pb[s2] = __builtin_bit_cast(bf16x8, w); }
#pragma unroll
            for (int i = 0; i < 4; ++i)
#pragma unroll
                for (int s2 = 0; s2 < 2; ++s2) {
                    const LAS unsigned char* vp = VT + (32 * i + r32) * VT_STRIDE + (kv0 + 16 * s2 + 4 * hi) * 2;
                    const u32x2 v0 = *(const LAS u32x2*)vp, v1 = *(const LAS u32x2*)(vp + 16);
                    const u32x4 vv = (u32x4){v0[0], v0[1], v1[0], v1[1]};
                    o[i] = __builtin_amdgcn_mfma_f32_32x32x16_bf16(__builtin_bit_cast(bf16x8, vv), pb[s2], o[i], 0, 0, 0);
                }
        }
        l += __shfl_xor(l, 32);
        const float rl = __builtin_amdgcn_rcpf(l);
        bf16_t* Op = OM + ((size_t)(b * SEQ + q0 + r32)) * 512 + h * MEM_D;
#pragma unroll
        for (int i = 0; i < 4; ++i)
#pragma unroll
            for (int g = 0; g < 4; ++g) { u32x2 w; w[0] = pg8::cvt_pk_bf16(o[i][4 * g] * rl, o[i][4 * g + 1] * rl); w[1] = pg8::cvt_pk_bf16(o[i][4 * g + 2] * rl, o[i][4 * g + 3] * rl);
                *(u32x2*)(Op + 32 * i + 8 * g + 4 * hi) = w; }
    }
    __syncthreads();
}
}

struct Params { const float* in[32]; float* out; unsigned char* ws; };

__global__ void __launch_bounds__(NTHREADS, 2) mega_fwd(Params p) {
    extern __shared__ __attribute__((aligned(16))) unsigned char lds[];
    const int bid = blockIdx.x, G = gridDim.x;
    const int NGW = G * NWAVES, NGT = G * NTHREADS;
#define PHASE_IDS int tid = threadIdx.x; asm volatile("" : "+v"(tid)); const int lane = tid & 63, wave = __builtin_amdgcn_readfirstlane(tid >> 6), half = tid >> 8, vt = tid & 255; \
    unsigned char* sm = lds + half * 32768; const int gw = bid * NWAVES + wave, gt = bid * NTHREADS + tid; (void)lane; (void)vt; (void)sm; (void)gw; (void)gt;

    const float* x = p.in[0];            const float* mem = p.in[1];
    const float* norm_mix_g = p.in[2];   const float* w_in = p.in[3];
    const float* b_forget = p.in[4];     const float* conv_w = p.in[5];
    const float* conv_b = p.in[6];       const float* lru_wa = p.in[7];
    const float* lru_ba = p.in[8];       const float* lru_wx = p.in[9];
    const float* lru_bx = p.in[10];      const float* lru_a_param = p.in[11];
    const float* fox_q_g = p.in[12];     const float* fox_k_g = p.in[13];
    const float* lru_out_g = p.in[14];   const float* fox_out_g = p.in[15];
    const float* w_out = p.in[16];       const float* norm_mem_x_g = p.in[17];
    const float* norm_mem_g = p.in[18];  const float* mem_wq = p.in[19];
    const float* mem_wkv = p.in[20];     const float* mem_q_g = p.in[21];
    const float* mem_k_g = p.in[22];     const float* mem_wo = p.in[23];
    const float* norm_ffn_g = p.in[24];  const float* r_gw = p.in[25];
    const float* r_gb = p.in[26];        const float* r_ew = p.in[27];
    const float* r_eb = p.in[28];        const float* w_gate = p.in[29];
    const float* w_up = p.in[30];        const float* w_down = p.in[31];
    float* out = p.out;
    unsigned char* ws = p.ws;
    int* ctl = (int*)(ws + WS_CTL) + CW_MOE;
    float* LOGF = (float*)(ws + WS_LOGF); float* CUM = (float*)(ws + WS_CUM);
    bf16_t* MEMN = (bf16_t*)(ws + WS_MEMN); bf16_t* KM = (bf16_t*)(ws + WS_KM); bf16_t* VM = (bf16_t*)(ws + WS_VM);
    int* RE = (int*)(ws + WS_RE); float* RW = (float*)(ws + WS_RW); int* ROWTOK = (int*)(ws + WS_ROWTOK); int* TILEE = (int*)(ws + WS_TILEE);
    bf16_t* H = (bf16_t*)(ws + WS_H); bf16_t* U = (bf16_t*)(ws + WS_U); bf16_t* GATE = (bf16_t*)(ws + WS_GATE);
    bf16_t* Q = (bf16_t*)(ws + WS_Q); bf16_t* K = (bf16_t*)(ws + WS_K); bf16_t* V = (bf16_t*)(ws + WS_V);
    bf16_t* YL = (bf16_t*)(ws + WS_YL); bf16_t* YF = (bf16_t*)(ws + WS_YF); bf16_t* MIXED = (bf16_t*)(ws + WS_MIXED);
    float* X1F = p.out;     float* LA = (float*)(ws + WS_LA); float* LB = (float*)(ws + WS_LB);
    bf16_t* QM = (bf16_t*)(ws + WS_QM); bf16_t* OM = (bf16_t*)(ws + WS_OM); unsigned char* HDN = ws + WS_HDN; unsigned char* YB = ws + WS_YB;

    bf16_t* WT_IN = (bf16_t*)(ws + WS_WT_IN); bf16_t* WT_KV = (bf16_t*)(ws + WS_WT_KV); bf16_t* WT_OUT = (bf16_t*)(ws + WS_WT_OUT);
    bf16_t* WT_Q = (bf16_t*)(ws + WS_WT_Q); bf16_t* WT_O = (bf16_t*)(ws + WS_WT_O); unsigned char* WT_GU = ws + WS_WT_GU; unsigned char* WT_D = ws + WS_WT_D; unsigned char* X2Q = ws + WS_X2Q;
    bf16_t* LRUW = (bf16_t*)(ws + WS_LRUW);
    bf16_t* WT_R = (bf16_t*)(ws + WS_WT_R); float* RSTD2 = (float*)(ws + WS_RSTD2); int* LIST = (int*)(ws + WS_LIST);
    bf16_t* X1B = (bf16_t*)(ws + WS_X1B); bf16_t* X2B = (bf16_t*)(ws + WS_X2B); float* SSL = (float*)(ws + WS_SSL); float* SSF = (float*)(ws + WS_SSF);
    float* SS1 = (float*)(ws + WS_SS1); float* SS2 = (float*)(ws + WS_SS2); float* RSL = (float*)(ws + WS_RSL); int* POSR = (int*)(ws + WS_POSR);
    float* SUMA = (float*)(ws + WS_SUMA); float* SUMH = (float*)(ws + WS_SUMH);
    LAS unsigned char* ldsl = (LAS unsigned char*)lds;
    volatile LAS unsigned* MISC = (volatile LAS unsigned*)((LAS unsigned char*)lds + MISC_OFF);
    if (threadIdx.x < 32) MISC[threadIdx.x] = 0u;
    __syncthreads();
    XcdBarrier bar = xcd_barrier_post((unsigned*)(ws + WS_CTL) + CW_BAR, MISC + 8);
#define GRID_BAR() xcd_barrier(bar)
#define FOR_VB(NB) for (int _vb0 = 2 * bid; _vb0 < (NB); _vb0 += 2 * G) { const int vb = (_vb0 + half < (NB)) ? (_vb0 + half) : ((NB) - 1);
#define END_VB }

    { PHASE_IDS
    {
        LAS unsigned* scr = (LAS unsigned*)(ldsl + wave * 17408);
        constexpr int I_IN = (DM / 128) * (2560 / 64), I_KV = (DM / 128) * (1024 / 64), I_OUT = (DM / 128) * (DM / 64), I_Q = (DM / 128) * (MEM_W / 64), I_O = (MEM_W / 128) * (DM / 64);
        constexpr int NITEMS = I_IN + I_KV + I_OUT + I_Q + I_O;
        for (int it = gw; it < NITEMS; it += NGW) {
            int r = it;
            if (r < I_IN) { p0_transpose_item<1, false>(w_in, IN_COLS, DM, 2560, WT_IN, scr, r, lane, nullptr, nullptr, 0); continue; } r -= I_IN;
            if (r < I_KV) { p0_transpose_item<0, false>(mem_wkv, 2 * MEM_W, DM, 2 * MEM_W, WT_KV, scr, r, lane, nullptr, nullptr, 0); continue; } r -= I_KV;
            if (r < I_OUT) { p0_transpose_item<0, true>(w_out, DM, DM, DM, WT_OUT, scr, r, lane, lru_out_g, fox_out_g, 512); continue; } r -= I_OUT;
            if (r < I_Q) { p0_transpose_item<0, true>(mem_wq, MEM_W, DM, MEM_W, WT_Q, scr, r, lane, norm_mem_x_g, norm_mem_x_g, 1 << 30); continue; } r -= I_Q;
            p0_transpose_item<0, false>(mem_wo, DM, MEM_W, DM, WT_O, scr, r, lane, nullptr, nullptr, 0);
        }
    }
    __syncthreads();
    }
    { PHASE_IDS
    {
        LAS float* wfT = (LAS float*)ldsl;
        for (int i = tid; i < 8 * 1024; i += NTHREADS) { const int k = i >> 3, h = i & 7; wfT[h * 1024 + k] = w_in[(size_t)k * IN_COLS + 2560 + h]; }
        __syncthreads();
        for (int row = gw; row < T; row += NGW) b_rmsnorm_row_f(x, norm_mix_g, H, wfT, b_forget, LOGF, row, lane);
    }
    __syncthreads();
    }
    { PHASE_IDS
    for (int row = gw; row < TM; row += NGW) b_rmsnorm_row(mem, norm_mem_g, MEMN, row, lane);
    if (bid == 0 && tid < 128) ctl[tid] = 0;
    for (int i = gt; i < 48 * DM; i += NGT) {
        const int col = i >> 10, k = i & 1023; float v = 0.f;
        if (col < 4) v = r_gw[(size_t)k * 4 + col]; else if (col < 36) v = r_ew[(size_t)k * 32 + col - 4];
        WT_R[i] = f2bf(v * norm_ffn_g[k]);
    }
    for (int i = gt; i < 8 * 16 * 64 * 8; i += NGT) {
        const int j = i & 7, ln = (i >> 3) & 63, s_ = (i >> 9) & 3, n = (i >> 11) & 1, mat = (i >> 12) & 1, blk = i >> 13;
        const float* W = mat ? lru_wx : lru_wa;
        LRUW[i] = f2bf(W[(size_t)blk * 4096 + (16 * s_ + 8 * (ln >> 5) + j) * 64 + 32 * n + (ln & 31)]);
    }
    }
    GRID_BAR();
    { PHASE_IDS
    { const pg8::Gemm g{H, WT_IN, DM, DM, DM, 0, 0, 0, 0};
      const pg8::EpiInProj E{U, fox_q_g, fox_k_g};
      static_assert(WS_GATE - WS_U == 32 * MiB && WS_Q - WS_GATE == 32 * MiB && WS_K - WS_Q == 32 * MiB && WS_V - WS_K == 32 * MiB, "EpiInProj: section stride");
      { pg8::StaticOrder S; S.init(T, 2560, G, bid); pg8::gemm_phase<pg8::EpiInProj, pg8::StaticOrder, true>(ldsl, g, S, E); } }
    }
    GRID_BAR();
    { PHASE_IDS
    { constexpr int NB = BATCH * FOX_H;
      FOR_VB(NB) b_cumsum(LOGF, CUM, vb, vt, sm, true); END_VB }
    if (bid >= 32) {
      const pg8::Gemm g{MEMN, WT_KV, DM, DM, DM, 0, 0, 0, 0}; pg8::StaticOrder S; S.init(TM, 2 * MEM_W, G, bid - 32);
      const pg8::EpiBf16 E{KM, VM, 512, 512};
      pg8::gemm_phase<pg8::EpiBf16, pg8::StaticOrder, true>(ldsl, g, S, E); }
    __syncthreads();
    for (int u = bid; u < BATCH * lru::NCH; u += G) lru::unit<false>(u / lru::NCH, u % lru::NCH, U, GATE, conv_w, conv_b, LRUW, lru_ba, lru_bx, lru_a_param, SUMA, SUMH, YL, SSL, ldsl + wave * lru::WLDS, wave, lane);
    }
    GRID_BAR();
    { PHASE_IDS
    for (int u = bid; u < BATCH * lru::NCH; u += G) lru::unit<true>(u / lru::NCH, u % lru::NCH, U, GATE, conv_w, conv_b, LRUW, lru_ba, lru_bx, lru_a_param, SUMA, SUMH, YL, SSL, ldsl + wave * lru::WLDS, wave, lane);
    __syncthreads();
    fox::attn_phase<8>((char*)lds, Q, K, V, YF, CUM, SSF, ctl + 100 + (bid & 7), fox::ConvArgs{w_gate, w_up, w_down, norm_ffn_g, WT_GU, WT_D});
    }
    GRID_BAR();
    { PHASE_IDS
    { const pg8::Gemm g{YL, WT_OUT, 512, DM, 512, (size_t)(WS_YF - WS_YL) / 2, 512, 0, 0}; pg8::PairOrder S; S.init(T, DM, G, bid);
      const pg8::EpiOutChain E{x, X1B, SSL, SSF, SS1};
      pg8::gemm_phase<pg8::EpiOutChain, pg8::PairOrder, true>(ldsl, g, S, E); }
    }
    GRID_BAR();
    { PHASE_IDS
    { const pg8::Gemm g{X1B, WT_Q, DM, DM, DM, 0, 0, 0, 0}; pg8::StaticOrder S; S.init(T, MEM_W, G, bid);
      const pg8::EpiRowScale E{QM, 512, SS1, 1.f / DM};
      pg8::gemm_phase<pg8::EpiRowScale, pg8::StaticOrder, true>(ldsl, g, S, E); }
    }
    GRID_BAR();
    { PHASE_IDS
    static_assert(xat::LDS_NEED <= MISC_OFF, "cross-attention LDS");
    for (int it = bid; it < BATCH * MEM_H * 8; it += G) { const int bh = it >> 3; xat::item(bh / MEM_H, bh % MEM_H, it & 7, QM, KM, VM, OM, mem_q_g, mem_k_g, ldsl); }
    }
    GRID_BAR();
    { PHASE_IDS
    { const pg8::Gemm g{OM, WT_O, MEM_W, MEM_W, MEM_W, 0, 0, 0, 0}; pg8::StaticOrder S; S.init(T, DM, G, bid);
      const pg8::EpiX2 E{X1B, X2B, X2Q, SS2};
      pg8::gemm_phase<pg8::EpiX2, pg8::StaticOrder, true>(ldsl, g, S, E); }
    }
    GRID_BAR();
    { PHASE_IDS
    static_assert(T / 16 == 256 * NWAVES, "router: one 16-token task per wave on a 256-workgroup grid");
    LAS int* hist = (LAS int*)(ldsl + 8 * 8448 + 36 * 2064);
    LAS unsigned char* wr = ldsl + 8 * 8448;
    if (tid < 64) hist[tid] = 0;
    for (int i = tid; i < 36 * 128; i += NTHREADS) { const int row = i >> 7, ch = i & 127; *(LAS pg8::u32x4*)(wr + row * 2064 + ch * 16) = *(const pg8::u32x4*)(WT_R + (size_t)row * DM + ch * 8); }
    __syncthreads();
    for (int tk = gw; tk < T / 16; tk += NGW) rtr::task(tk * 16, X2B, WT_R, SS2, r_gb, r_eb, RW, RSL, POSR, ctl, LIST, (LAS float*)(ldsl + wave * 8448), wr, hist, lane);
    }
    GRID_BAR();
    { PHASE_IDS
    LAS int* mp = (LAS int*)(ldsl + 131072);
    if (tid == 0) { int run = 0; for (int e = 0; e < N_EXP; ++e) { const int c_ = ctl[e]; mp[e] = run; mp[64 + e] = c_; run += (c_ + 255) & ~255; } mp[32] = run; }
    __syncthreads();
    if (tid < N_TILES) { const int row = tid * 256; int e = 0; for (int j = 1; j < N_EXP; ++j) if (mp[j] <= row) e = j; mp[128 + tid] = e; }
    __syncthreads();
    { const pg8::Gemm g{X2Q, WT_GU, DM, DM, DM, 0, (size_t)1024 * 1024, 0x7f7f7f7f, 0x7a7a7a7a};
      const pg8::MoeOrder<true> S{(mp[32] >> 8) * 4, G, bid, mp, LIST};
      const pg8::EpiMoe1 E{HDN, RSL};
      pg8::gemm_phase<pg8::EpiMoe1, pg8::MoeOrder<true>, true>(ldsl, g, S, E); }
    }
    GRID_BAR();
    { PHASE_IDS
    LAS int* mp = (LAS int*)(ldsl + 131072);
    { const pg8::Gemm g{HDN, WT_D, D_EXP, D_EXP, D_EXP, 0, (size_t)1024 * 512, 0x7c7c7c7c, 0x7a7a7a7a};
      const pg8::MoeOrder<false> S{(mp[32] >> 8) * 4, G, bid, mp, LIST};
      const pg8::EpiMoe2 E{YB};
      pg8::gemm_phase<pg8::EpiMoe2, pg8::MoeOrder<false>, true>(ldsl, g, S, E); }
    }
    GRID_BAR();
    { PHASE_IDS
    const LAS int* mp = (const LAS int*)(ldsl + 131072);
    static_assert((2 * T) % (4 * 256 * NWAVES) == 0, "final combine: four half-row items per wave and iteration");
#pragma unroll 1
    for (int k = 0; k < 2 * T / NGW; k += 4) {
        unsigned pa[4], pb[4]; float wa[4], wb[4];
#pragma unroll
        for (int j = 0; j < 4; ++j) { const int t = ((k + j) * NGW + gw) >> 1; pa[j] = (unsigned)POSR[2 * t]; pb[j] = (unsigned)POSR[2 * t + 1]; wa[j] = RW[2 * t]; wb[j] = RW[2 * t + 1]; }
        uint4 xv[4]; uint2 ya[4], yb[4];
#pragma unroll
        for (int j = 0; j < 4; ++j) { const int hr = (k + j) * NGW + gw; const size_t c = (size_t)(hr & 1) * 512 + lane * 8;
            const size_t ra = (size_t)(mp[pa[j] >> 20] + (int)(pa[j] & 0xfffffu)), rb = (size_t)(mp[pb[j] >> 20] + (int)(pb[j] & 0xfffffu));
            xv[j] = *(const uint4*)(X2B + (size_t)(hr >> 1) * DM + c); ya[j] = *(const uint2*)(YB + ra * DM + c); yb[j] = *(const uint2*)(YB + rb * DM + c); }
#pragma unroll
        for (int j = 0; j < 4; ++j) { const int hr = (k + j) * NGW + gw; b_final2(out + (size_t)(hr >> 1) * DM + (size_t)(hr & 1) * 512 + lane * 8, xv[j], ya[j], yb[j], 0.125f * wa[j], 0.125f * wb[j]); }
    }
    }
}

extern "C" void kernel_launch(void* const* d_in, const int* in_sizes, int n_in, void* d_out, int out_size, void* d_ws, size_t ws_size, hipStream_t stream) {
    static int grid = 0;
    if (grid == 0) {
        int dev = 0, cus = 0;
        if (hipGetDevice(&dev) != hipSuccess || hipDeviceGetAttribute(&cus, hipDeviceAttributeMultiprocessorCount, dev) != hipSuccess) { fprintf(stderr, "kernel_launch: device query failed\n"); grid = -1; return; }
        if (hipFuncSetAttribute((const void*)mega_fwd, hipFuncAttributeMaxDynamicSharedMemorySize, LDS_BYTES) != hipSuccess) { fprintf(stderr, "kernel_launch: hipFuncSetAttribute failed\n"); grid = -1; return; }
        if (n_in != 32 || ws_size < WS_END) { fprintf(stderr, "kernel_launch: unexpected inputs (n_in %d, ws %zu)\n", n_in, ws_size); grid = -1; return; }
        grid = cus;
    }
    if (grid < 0) return;
    (void)hipMemsetAsync((char*)d_ws + WS_CTL, 0, CTL_ZERO_BYTES, stream);
    Params p{};
    for (int i = 0; i < 32; ++i) p.in[i] = (const float*)d_in[i];
    p.out = (float*)d_out; p.ws = (unsigned char*)d_ws;
    hipLaunchKernelGGL(mega_fwd, dim3(grid), dim3(NTHREADS), LDS_BYTES, stream, p);
}
```

```cpp
#include <hip/hip_runtime.h>
#include <stdint.h>
#include <math.h>
#include <cstdio>

typedef unsigned short bf16_t;
typedef short bf16x8 __attribute__((ext_vector_type(8)));
typedef float f32x4 __attribute__((ext_vector_type(4)));
typedef float f32x16 __attribute__((ext_vector_type(16)));
#define GAS __attribute__((address_space(1)))
#define LAS __attribute__((address_space(3)))

constexpr int BATCH = 8, SEQ = 4096, T = BATCH * SEQ, DM = 1024;
constexpr int MEM_LEN = 256, TM = BATCH * MEM_LEN;
constexpr int LRU_W = 512, FOX_H = 8, FOX_D = 64, FOX_W = 512;
constexpr int IN_COLS = 2568;
constexpr int MEM_H = 4, MEM_D = 128, MEM_W = 512;
constexpr int N_GROUPS = 4, EPG = 8, N_EXP = 32, D_EXP = 512;
constexpr int NA = T * 2;
constexpr int MOE_PAD = 256;
constexpr int P_MAX = NA + N_EXP * MOE_PAD;
constexpr int N_TILES = P_MAX / MOE_PAD;
constexpr float EPS = 1e-6f;
constexpr float LOG2E = 1.4426950408889634f;
constexpr int NTHREADS = 512, NWAVES = 8;
constexpr int ESPLIT = 12;

constexpr size_t MiB = 1u << 20;
constexpr size_t WS_CTL = 0;
constexpr size_t CTL_ZERO_BYTES = 256 * 1024;
constexpr int CW_MOE = 0;
constexpr int CW_BAR = 4096;
constexpr size_t WS_LOGF = 1 * MiB;
constexpr size_t WS_CUM = 2 * MiB;
constexpr size_t WS_MEMN = 3 * MiB;
constexpr size_t WS_KM = 7 * MiB;
constexpr size_t WS_VM = 9 * MiB;
constexpr size_t WS_RE = 11 * MiB;
constexpr size_t WS_RW = 11 * MiB + 512 * 1024;
constexpr size_t WS_ROWTOK = 12 * MiB;
constexpr size_t WS_TILEE = 13 * MiB;
constexpr size_t WS_SUMA = 14 * MiB;
constexpr size_t WS_SUMH = 14 * MiB + 512 * 1024;
constexpr size_t WS_LRUW = 15 * MiB;
constexpr size_t WS_WT_IN = 16 * MiB;
constexpr size_t WS_WT_KV = 21 * MiB;
constexpr size_t WS_WT_OUT = 23 * MiB;
constexpr size_t WS_WT_Q = 25 * MiB;
constexpr size_t WS_WT_O = 26 * MiB;
constexpr size_t WS_WT_GU = 27 * MiB;
constexpr size_t WS_WT_D = 91 * MiB;
constexpr size_t WS_H = 123 * MiB;
constexpr size_t WS_MIXED = 123 * MiB;
constexpr size_t WS_LA = 123 * MiB;
constexpr size_t WS_YL = 187 * MiB;
constexpr size_t WS_YF = 219 * MiB;
constexpr size_t WS_YB = 123 * MiB;
constexpr size_t WS_U = 251 * MiB;
constexpr size_t WS_GATE = 283 * MiB;
constexpr size_t WS_Q = 315 * MiB;
constexpr size_t WS_K = 347 * MiB;
constexpr size_t WS_V = 379 * MiB;
constexpr size_t WS_QM = 251 * MiB;
constexpr size_t WS_OM = 283 * MiB;
constexpr size_t WS_HDN = 315 * MiB;
constexpr size_t WS_LB = 411 * MiB;
constexpr size_t WS_X1B = 123 * MiB;
constexpr size_t WS_X2Q = 360 * MiB;
constexpr size_t WS_X2B = 411 * MiB;
constexpr size_t WS_LIST = 476 * MiB;
constexpr size_t WS_SSL = 480 * MiB;
constexpr size_t WS_SSF = 481 * MiB;
constexpr size_t WS_SS1 = 482 * MiB;
constexpr size_t WS_SS2 = 484 * MiB;
constexpr size_t WS_RSTD2 = 486 * MiB;
constexpr size_t WS_WT_R = 487 * MiB;
constexpr size_t WS_RSL = 488 * MiB;
constexpr size_t WS_POSR = 492 * MiB;
constexpr size_t WS_END = 493 * MiB;
static_assert(WS_YB + (size_t)P_MAX * DM <= WS_U, "expert outputs: fp8 [P_MAX][1024] in list order");
static_assert((size_t)P_MAX * 512 * 2 <= 96 * MiB && (size_t)NA * DM * 2 <= 128 * MiB, "ws map");

constexpr int LDS_BYTES = 155648;
constexpr int MISC_OFF = LDS_BYTES - 512;

__device__ __forceinline__ bf16_t f2bf(float f) { unsigned u = __float_as_uint(f); return (bf16_t)((u + 0x7fffu + ((u >> 16) & 1u)) >> 16); }
__device__ __forceinline__ float bf2f(bf16_t h) { return __uint_as_float(((unsigned)h) << 16); }
__device__ __forceinline__ float wave_sum(float v) {
#pragma unroll
    for (int o = 1; o < 64; o <<= 1) v += __shfl_xor(v, o);
    return v;
}
__device__ __forceinline__ int crow(int r, int hi) { return (r & 3) + 8 * (r >> 2) + 4 * hi; }
__device__ __forceinline__ float sigmoidf_(float x) { return 1.f / (1.f + __expf(-x)); }
__device__ __forceinline__ float gelu_tanh(float x) {
    const float k0 = 0.7978845608028654f, k1 = 0.044715f;
    float u = k0 * (x + k1 * x * x * x);
    float t = 1.f - 2.f / (1.f + __expf(2.f * u));
    return 0.5f * x * (1.f + t);
}

#define XB_TMO      128
#define XB_XCNT(j)  (256  + 64 * (j))
#define XB_XSUB(j)  (1280 + 64 * (j))
#define XB_XGEN(j)  (2304 + 64 * (j))
#define XB_TOP      3328
#define XB_TOPGEN   3392
#define XCD_BAR_WORDS 3456
#define XB_SPIN_CAP (1u << 20)
__device__ __forceinline__ unsigned xb_ld(unsigned* p)              { return __hip_atomic_load(p, __ATOMIC_RELAXED, __HIP_MEMORY_SCOPE_AGENT); }
__device__ __forceinline__ unsigned xb_add(unsigned* p, unsigned v) { return __hip_atomic_fetch_add(p, v, __ATOMIC_RELAXED, __HIP_MEMORY_SCOPE_AGENT); }
__device__ __forceinline__ unsigned xb_xcc_id() { return (unsigned)__builtin_amdgcn_s_getreg((3 << 11) | 20) & 0xFu; }
#define XB_SPIN(cond, bar) do { unsigned _sp = 0; while (cond) { __builtin_amdgcn_s_sleep(1); \
    if ((++_sp & 255u) == 0u) { if (xb_ld(&(bar)[XB_TMO])) break; if (_sp > XB_SPIN_CAP) { atomicAdd(&(bar)[XB_TMO], 1u); break; } } } } while (0)
struct XcdBarrier { unsigned* bar; unsigned x; volatile LAS unsigned* st; };
__device__ __forceinline__ XcdBarrier xcd_barrier_post(unsigned* bar, volatile LAS unsigned* st) {
    XcdBarrier b; b.bar = bar; b.x = xb_xcc_id(); b.st = st;
    if (threadIdx.x == 0) (void)xb_add(&bar[XB_XCNT(b.x)], 1u);
    return b;
}
__device__ __forceinline__ void xcd_barrier_complete(unsigned* bar, unsigned x, unsigned& nloc, unsigned& nx) {
    const unsigned G = gridDim.x * gridDim.y * gridDim.z;
    unsigned sum, cnt, mine, sp = 0u;
    for (;;) {
        sum = 0u; cnt = 0u; mine = 0u;
#pragma unroll
        for (unsigned j = 0; j < 16; ++j) { const unsigned c = xb_ld(&bar[XB_XCNT(j)]); sum += c; cnt += (c > 0u) ? 1u : 0u; mine = (j == x) ? c : mine; }
        if (sum == G) break;
        __builtin_amdgcn_s_sleep(1);
        if ((++sp & 255u) == 0u) { if (xb_ld(&bar[XB_TMO])) break; if (sp > XB_SPIN_CAP) { atomicAdd(&bar[XB_TMO], 1u); break; } }
    }
    nloc = mine > 0u ? mine : 1u; nx = cnt > 0u ? cnt : 1u;
}
__device__ __forceinline__ void xcd_barrier(const XcdBarrier& b) {
    asm volatile("s_waitcnt vmcnt(0)" ::: "memory");
    __syncthreads();
    if (threadIdx.x == 0) {
        unsigned* bar = b.bar;
        __builtin_amdgcn_s_waitcnt(0);
        unsigned nloc = b.st[0], nx = b.st[1];
        if (nloc == 0u) { xcd_barrier_complete(bar, b.x, nloc, nx); b.st[0] = nloc; b.st[1] = nx; }
        const unsigned old = xb_add(&bar[XB_XSUB(b.x)], 1u);
        const unsigned gen = old / nloc;
        if (old + 1u == (gen + 1u) * nloc) {
            __builtin_amdgcn_fence(__ATOMIC_RELEASE, "agent");
            asm volatile("s_waitcnt vmcnt(0)" ::: "memory");
            const unsigned og = xb_add(&bar[XB_TOP], 1u);
            const unsigned tg = og / nx;
            if (og + 1u == (tg + 1u) * nx) xb_add(&bar[XB_TOPGEN], 1u);
            else XB_SPIN(xb_ld(&bar[XB_TOPGEN]) == tg, bar);
            __builtin_amdgcn_fence(__ATOMIC_ACQUIRE, "agent");
            xb_add(&bar[XB_XGEN(b.x)], 1u);
            asm volatile("s_waitcnt vmcnt(0)" ::: "memory");
        } else {
            XB_SPIN(xb_ld(&bar[XB_XGEN(b.x)]) == gen, bar);
            __builtin_amdgcn_fence(__ATOMIC_ACQUIRE, "agent");
            asm volatile("s_waitcnt vmcnt(0)" ::: "memory");
        }
    }
    __syncthreads();
}

__device__ __forceinline__ void b_rmsnorm_row(const float* __restrict__ x, const float* __restrict__ g, bf16_t* __restrict__ out, int row, int lane) {
    const f32x4* xr = (const f32x4*)(x + (size_t)row * DM) + lane;
    f32x4 v[4]; float s = 0.f;
#pragma unroll
    for (int j = 0; j < 4; ++j) { v[j] = xr[64 * j]; s += v[j].x * v[j].x + v[j].y * v[j].y + v[j].z * v[j].z + v[j].w * v[j].w; }
    const float rstd = rsqrtf(wave_sum(s) * (1.f / DM) + EPS);
    const f32x4* gr = (const f32x4*)g + lane;
    uint2* o = (uint2*)(out + (size_t)row * DM) + lane;
#pragma unroll
    for (int j = 0; j < 4; ++j) {
        f32x4 gg = gr[64 * j];
        uint2 w;
        w.x = (unsigned)f2bf(v[j].x * rstd * gg.x) | ((unsigned)f2bf(v[j].y * rstd * gg.y) << 16);
        w.y = (unsigned)f2bf(v[j].z * rstd * gg.z) | ((unsigned)f2bf(v[j].w * rstd * gg.w) << 16);
        o[64 * j] = w;
    }
}


__device__ __forceinline__ void b_rmsnorm_row_f(const float* __restrict__ x, const float* __restrict__ g, bf16_t* __restrict__ out, const LAS float* wfT, const float* __restrict__ b_forget,
                                                float* __restrict__ LOGF, int row, int lane) {
    const f32x4* xr = (const f32x4*)(x + (size_t)row * DM) + lane;
    f32x4 v[4]; float s = 0.f;
#pragma unroll
    for (int j = 0; j < 4; ++j) { v[j] = xr[64 * j]; s += v[j].x * v[j].x + v[j].y * v[j].y + v[j].z * v[j].z + v[j].w * v[j].w; }
    const float rstd = rsqrtf(wave_sum(s) * (1.f / DM) + EPS);
    const f32x4* gr = (const f32x4*)g + lane;
    uint2* o = (uint2*)(out + (size_t)row * DM) + lane;
#pragma unroll
    for (int j = 0; j < 4; ++j) {
        const f32x4 gg = gr[64 * j];
        v[j].x *= rstd * gg.x; v[j].y *= rstd * gg.y; v[j].z *= rstd * gg.z; v[j].w *= rstd * gg.w;
        uint2 w;
        w.x = (unsigned)f2bf(v[j].x) | ((unsigned)f2bf(v[j].y) << 16);
        w.y = (unsigned)f2bf(v[j].z) | ((unsigned)f2bf(v[j].w) << 16);
        o[64 * j] = w;
    }
    float fl[8];
#pragma unroll
    for (int h = 0; h < 8; ++h) {
        float a = 0.f;
#pragma unroll
        for (int j = 0; j < 4; ++j) { const f32x4 w = *(const LAS f32x4*)(wfT + h * 1024 + 256 * j + 4 * lane); a += (v[j].x * w.x + v[j].y * w.y) + (v[j].z * w.z + v[j].w * w.w); }
        fl[h] = wave_sum(a);
    }
    if (lane == 0) {
#pragma unroll
        for (int h = 0; h < 8; ++h) { const float z = fl[h] + b_forget[h]; LOGF[(size_t)row * 8 + h] = fminf(z, 0.f) - log1pf(__expf(-fabsf(z))); }
    }
}

typedef bf16_t (*As_t)[40];
typedef bf16_t (*Bs_t)[64][40];
template <int NB>
__device__ __forceinline__ void gemm_core64(const bf16_t* aptr, const float* W0, const float* W1, int ldw,
                                            int n0, int N, int K, f32x4 (&acc)[NB][2][2], As_t As, Bs_t Bs, int vt) {
    const int lane = vt & 63, wid = vt >> 6, wr = wid >> 1, wc = wid & 1;
    for (int k0 = 0; k0 < K; k0 += 32) {
        {
            const int r = vt >> 2, c = vt & 3;
            uint4 v = make_uint4(0, 0, 0, 0);
            if (aptr) v = *(const uint4*)(aptr + k0 + c * 8);
            *(uint4*)&As[r][c * 8] = v;
        }
        {
            const int kk = vt >> 3, nc = (vt & 7) * 8;
#pragma unroll
            for (int b = 0; b < NB; ++b) {
                const float* wp = (b == 0 ? W0 : W1) + (size_t)(k0 + kk) * ldw + n0 + nc;
#pragma unroll
                for (int j = 0; j < 8; ++j) { float v = (n0 + nc + j < N) ? wp[j] : 0.f; Bs[b][nc + j][kk] = f2bf(v); }
            }
        }
        __syncthreads();
        bf16x8 a[2];
#pragma unroll
        for (int i = 0; i < 2; ++i) a[i] = *(const bf16x8*)&As[wr * 32 + i * 16 + (lane & 15)][(lane >> 4) * 8];
#pragma unroll
        for (int b = 0; b < NB; ++b)
#pragma unroll
            for (int j = 0; j < 2; ++j) {
                bf16x8 bb = *(const bf16x8*)&Bs[b][wc * 32 + j * 16 + (lane & 15)][(lane >> 4) * 8];
#pragma unroll
                for (int i = 0; i < 2; ++i) acc[b][i][j] = __builtin_amdgcn_mfma_f32_16x16x32_bf16(a[i], bb, acc[b][i][j], 0, 0, 0);
            }
        __syncthreads();
    }
}

template <class Epi>
__device__ __forceinline__ void b_gemm(const bf16_t* __restrict__ A, int lda, const float* __restrict__ W, int ldw, int N, int K, const Epi& epi,
                                       int vbx, int vby, int vt, unsigned char* sm) {
    As_t As = (As_t)sm; Bs_t Bs = (Bs_t)(sm + 64 * 40 * 2);
    const int lane = vt & 63, wid = vt >> 6, wr = wid >> 1, wc = wid & 1;
    const int m0 = vby * 64, n0 = vbx * 64;
    f32x4 acc[1][2][2];
#pragma unroll
    for (int i = 0; i < 2; ++i)
#pragma unroll
        for (int j = 0; j < 2; ++j) acc[0][i][j] = (f32x4){0.f, 0.f, 0.f, 0.f};
    gemm_core64<1>(A + (size_t)(m0 + (vt >> 2)) * lda, W, W, ldw, n0, N, K, acc, As, Bs, vt);
#pragma unroll
    for (int i = 0; i < 2; ++i)
#pragma unroll
        for (int j = 0; j < 2; ++j)
#pragma unroll
            for (int r = 0; r < 4; ++r) {
                const int row = m0 + wr * 32 + i * 16 + (lane >> 4) * 4 + r, col = n0 + wc * 32 + j * 16 + (lane & 15);
                if (col < N) epi(row, col, acc[0][i][j][r]);
            }
}

struct EpiG1 {
    bf16_t *U, *GATE, *Q, *K, *V; float* LOGF; const float* b_forget;
    __device__ __forceinline__ void operator()(int row, int col, float v) const {
        if (col < 512) U[(size_t)row * 512 + col] = f2bf(v);
        else if (col < 1024) GATE[(size_t)row * 512 + col - 512] = f2bf(v);
        else if (col < 1536) Q[(size_t)row * 512 + col - 1024] = f2bf(v);
        else if (col < 2048) K[(size_t)row * 512 + col - 1536] = f2bf(v);
        else if (col < 2560) V[(size_t)row * 512 + col - 2048] = f2bf(v);
        else { const int h = col - 2560; const float z = v + b_forget[h]; LOGF[(size_t)row * 8 + h] = fminf(z, 0.f) - log1pf(__expf(-fabsf(z))); }
    }
};
struct EpiSplit2 { bf16_t *O0, *O1;
    __device__ __forceinline__ void operator()(int row, int col, float v) const {
        if (col < 512) O0[(size_t)row * 512 + col] = f2bf(v); else O1[(size_t)row * 512 + col - 512] = f2bf(v); } };
struct EpiBf16s { bf16_t* O; int ldo;
    __device__ __forceinline__ void operator()(int row, int col, float v) const { O[(size_t)row * ldo + col] = f2bf(v); } };
struct EpiResF32 { const float* base; float* out;
    __device__ __forceinline__ void operator()(int row, int col, float v) const { out[(size_t)row * DM + col] = base[(size_t)row * DM + col] + v; } };

template <int HD>
__device__ __forceinline__ void b_headnorm(bf16_t* __restrict__ X, const float* __restrict__ g, float scale, int idx) {
    const int nh = 512 / HD;
    bf16_t* p = X + (size_t)(idx / nh) * 512 + (idx % nh) * HD;
    float ss = 0.f;
#pragma unroll 8
    for (int d = 0; d < HD; ++d) { float v = bf2f(p[d]); ss += v * v; }
    const float rstd = rsqrtf(ss * (1.f / HD) + EPS) * scale;
#pragma unroll 8
    for (int d = 0; d < HD; ++d) p[d] = f2bf(bf2f(p[d]) * rstd * g[d]);
}

__device__ __forceinline__ void b_cumsum(const float* __restrict__ LOGF, float* __restrict__ CUM, int bh, int vt, unsigned char* sm, bool store) {
    float* part = (float*)sm;
    const int b = bh / FOX_H, h = bh % FOX_H;
    float v[16]; float s = 0.f;
#pragma unroll
    for (int i = 0; i < 16; ++i) { v[i] = LOGF[((size_t)b * SEQ + vt * 16 + i) * 8 + h]; s += v[i]; }
    part[vt] = s; __syncthreads();
    if (vt == 0) { float run = 0.f; for (int i = 0; i < 256; ++i) { float t = part[i]; part[i] = run; run += t; } }
    __syncthreads();
    float run = part[vt];
    if (store) {
#pragma unroll
        for (int i = 0; i < 16; ++i) { run += v[i]; CUM[(size_t)bh * SEQ + vt * 16 + i] = run * LOG2E; }
    }
    __syncthreads();
}

__device__ __forceinline__ void b_lru_ab(const bf16_t* __restrict__ U, const float* __restrict__ conv_w, const float* __restrict__ conv_b,
                                         const float* __restrict__ wa, const float* __restrict__ ba, const float* __restrict__ wx, const float* __restrict__ bx,
                                         const float* __restrict__ a_param, float* __restrict__ LA, float* __restrict__ LB, int t, int ch, unsigned char* sm) {
    float* xc = (float*)sm;
    const int s = t % SEQ;
    float x = conv_b[ch];
#pragma unroll
    for (int tap = 0; tap < 4; ++tap) { const int ss = s - 3 + tap; if (ss >= 0) x += conv_w[tap * 512 + ch] * bf2f(U[(size_t)(t - 3 + tap) * 512 + ch]); }
    xc[ch] = x; __syncthreads();
    const int blk = ch >> 6, j = ch & 63;
    float r = ba[ch], ii = bx[ch];
    const float* wap = wa + (size_t)blk * 4096 + j; const float* wxp = wx + (size_t)blk * 4096 + j;
#pragma unroll 4
    for (int i = 0; i < 64; ++i) { const float xv = xc[blk * 64 + i]; r += xv * wap[i * 64]; ii += xv * wxp[i * 64]; }
    r = sigmoidf_(r); ii = sigmoidf_(ii);
    const float ap = -a_param[ch];
    const float sp = (ap > 20.f) ? ap : log1pf(__expf(ap));
    const float log_a = -8.f * r * sp;
    const float a = __expf(log_a);
    const float mult = sqrtf(fmaxf(-expm1f(2.f * log_a), 0.f));
    LA[(size_t)t * 512 + ch] = a;
    LB[(size_t)t * 512 + ch] = mult * (ii * x);
    __syncthreads();
}
__device__ __forceinline__ void b_lru_scan(const float* __restrict__ LA, const float* __restrict__ LB, const bf16_t* __restrict__ GATE, bf16_t* __restrict__ YL, int vb, int lane) {
    const int b = vb / 8, ch = (vb % 8) * 64 + lane;
    float h = 0.f;
    size_t off = (size_t)b * SEQ * 512 + ch;
    for (int s = 0; s < SEQ; s += 8) {
        float a[8], bb[8], g[8];
#pragma unroll
        for (int i = 0; i < 8; ++i) { a[i] = LA[off + (size_t)(s + i) * 512]; bb[i] = LB[off + (size_t)(s + i) * 512]; g[i] = bf2f(GATE[off + (size_t)(s + i) * 512]); }
#pragma unroll
        for (int i = 0; i < 8; ++i) { h = a[i] * h + bb[i]; YL[off + (size_t)(s + i) * 512] = f2bf(h * gelu_tanh(g[i])); }
    }
}

template <int D, bool CAUSAL, int VB0>
__device__ __forceinline__ void b_attn(const bf16_t* __restrict__ Q, const bf16_t* __restrict__ K, const bf16_t* __restrict__ V, bf16_t* __restrict__ O,
                                       const float* __restrict__ cum, int H, int Sq, int Skv, int pitch, int b, int h, int q0, int lane) {
    const int r32 = lane & 31, hi = lane >> 5;
    const bf16_t* Qp = Q + ((size_t)b * Sq + q0 + r32) * pitch + h * D;
    constexpr bool QREG = (D <= 64);
    bf16x8 qf[QREG ? D / 16 : 1];
    if (QREG) {
#pragma unroll
        for (int d0 = 0; d0 < D / 16; ++d0) qf[QREG ? d0 : 0] = *(const bf16x8*)(Qp + d0 * 16 + hi * 8);
    }
    f32x16 o[2];
#pragma unroll
    for (int i = 0; i < 2; ++i)
#pragma unroll
        for (int r = 0; r < 16; ++r) o[i][r] = 0.f;
    float m = -1e30f, l = 0.f;
    const int nkv = CAUSAL ? (q0 + 32) : Skv;
    const float* cb = cum ? cum + ((size_t)b * H + h) * Skv : nullptr;
    const float cref = cum ? cb[q0] : 0.f;
    const bf16_t* Kb = K + ((size_t)b * Skv) * pitch + h * D;
    const bf16_t* Vb = V + ((size_t)b * Skv) * pitch + h * D;
#pragma unroll 1
    for (int kv0 = 0; kv0 < nkv; kv0 += 32) {
        f32x16 s;
#pragma unroll
        for (int r = 0; r < 16; ++r) s[r] = 0.f;
        const bf16_t* Kp = Kb + (size_t)(kv0 + r32) * pitch;
#pragma unroll
        for (int d0 = 0; d0 < D / 16; ++d0) { bf16x8 kf = *(const bf16x8*)(Kp + d0 * 16 + hi * 8);
            bf16x8 qq; if (QREG) qq = qf[QREG ? d0 : 0]; else qq = *(const bf16x8*)(Qp + d0 * 16 + hi * 8);
            s = __builtin_amdgcn_mfma_f32_32x32x16_bf16(kf, qq, s, 0, 0, 0); }
        float tmax = -INFINITY;
#pragma unroll
        for (int r = 0; r < 16; ++r) {
            const int kv = kv0 + crow(r, hi);
            float v = s[r];
            if (cum) v += cref - cb[kv];
            if (CAUSAL && kv > q0 + r32) v = -INFINITY;
            s[r] = v; tmax = fmaxf(tmax, v);
        }
        tmax = fmaxf(tmax, __shfl_xor(tmax, 32));
        const float mnew = fmaxf(m, tmax);
        const float alpha = exp2f(m - mnew);
        float ps = 0.f;
#pragma unroll
        for (int r = 0; r < 16; ++r) { s[r] = exp2f(s[r] - mnew); ps += s[r]; }
        l = l * alpha + ps; m = mnew;
#pragma unroll
        for (int i = 0; i < 2; ++i)
#pragma unroll
            for (int r = 0; r < 16; ++r) o[i][r] *= alpha;
        bf16x8 pb[2];
#pragma unroll
        for (int s2 = 0; s2 < 2; ++s2)
#pragma unroll
            for (int j = 0; j < 8; ++j) pb[s2][j] = (short)f2bf(s[8 * s2 + j]);
#pragma unroll
        for (int i = 0; i < 2; ++i)
#pragma unroll
            for (int s2 = 0; s2 < 2; ++s2) {
                bf16x8 vf;
#pragma unroll
                for (int j = 0; j < 8; ++j) vf[j] = (short)Vb[(size_t)(kv0 + 16 * s2 + 8 * (j >> 2) + 4 * hi + (j & 3)) * pitch + (VB0 + i) * 32 + r32];
                o[i] = __builtin_amdgcn_mfma_f32_32x32x16_bf16(vf, pb[s2], o[i], 0, 0, 0);
                asm volatile("" ::: "memory");
            }
    }
    l += __shfl_xor(l, 32);
    const float rl = 1.f / l;
    bf16_t* Op = O + ((size_t)b * Sq + q0 + r32) * pitch + h * D;
#pragma unroll
    for (int i = 0; i < 2; ++i)
#pragma unroll
        for (int r = 0; r < 16; ++r) Op[(VB0 + i) * 32 + crow(r, hi)] = f2bf(o[i][r] * rl);
}

__device__ __forceinline__ void b_mixnorm(const bf16_t* __restrict__ YL, const bf16_t* __restrict__ YF, const float* __restrict__ gl, const float* __restrict__ gf, bf16_t* __restrict__ MIXED, int row, int lane) {
#pragma unroll
    for (int part = 0; part < 2; ++part) {
        const bf16_t* src = (part ? YF : YL) + (size_t)row * 512 + lane * 8;
        const float* g = (part ? gf : gl) + lane * 8;
        float v[8]; float ss = 0.f;
#pragma unroll
        for (int j = 0; j < 8; ++j) { v[j] = bf2f(src[j]); ss += v[j] * v[j]; }
        const float rstd = rsqrtf(wave_sum(ss) * (1.f / 512.f) + EPS);
        bf16_t* dst = MIXED + (size_t)row * DM + part * 512 + lane * 8;
#pragma unroll
        for (int j = 0; j < 8; ++j) dst[j] = f2bf(v[j] * rstd * g[j]);
    }
}

__device__ __forceinline__ void b_router(const bf16_t* __restrict__ XN, const float* __restrict__ wg, const float* __restrict__ bg, const float* __restrict__ we, const float* __restrict__ be,
                                         int* __restrict__ RE, float* __restrict__ RW, int* __restrict__ counts, int t, int lane) {
    float acc[36];
#pragma unroll
    for (int o = 0; o < 36; ++o) acc[o] = 0.f;
    const bf16_t* xr = XN + (size_t)t * DM;
#pragma unroll 1
    for (int i = 0; i < 16; ++i) {
        const int k = i * 64 + lane;
        const float xv = bf2f(xr[k]);
        const f32x4 g4 = *(const f32x4*)(wg + (size_t)k * 4);
        acc[0] += xv * g4.x; acc[1] += xv * g4.y; acc[2] += xv * g4.z; acc[3] += xv * g4.w;
        const f32x4* e4 = (const f32x4*)(we + (size_t)k * 32);
#pragma unroll
        for (int q = 0; q < 8; ++q) { const f32x4 e = e4[q]; acc[4 + 4 * q] += xv * e.x; acc[5 + 4 * q] += xv * e.y; acc[6 + 4 * q] += xv * e.z; acc[7 + 4 * q] += xv * e.w; }
    }
#pragma unroll
    for (int o = 0; o < 36; ++o) acc[o] = wave_sum(acc[o]);
    if (lane == 0) {
        float gl[4]; int gi = 0; float gmax;
#pragma unroll
        for (int j = 0; j < 4; ++j) { gl[j] = acc[j] + bg[j]; }
        gmax = gl[0];
#pragma unroll
        for (int j = 1; j < 4; ++j) if (gl[j] > gmax) { gmax = gl[j]; gi = j; }
        float gs = 0.f;
#pragma unroll
        for (int j = 0; j < 4; ++j) gs += __expf(gl[j] - gmax);
        const float gw = 1.f / gs;
        float el[8];
#pragma unroll
        for (int j = 0; j < 8; ++j) {
            float v = 0.f;
#pragma unroll
            for (int g = 0; g < 4; ++g) if (g == gi) v = acc[4 + g * 8 + j] + be[g * 8 + j];
            el[j] = v;
        }
        int i0 = 0; float v0 = el[0];
#pragma unroll
        for (int j = 1; j < 8; ++j) if (el[j] > v0) { v0 = el[j]; i0 = j; }
        int i1 = -1; float v1 = -INFINITY;
#pragma unroll
        for (int j = 0; j < 8; ++j) if (j != i0 && el[j] > v1) { v1 = el[j]; i1 = j; }
        const float e1 = __expf(v1 - v0);
        const float p0 = 1.f / (1.f + e1), p1 = e1 / (1.f + e1);
        const int ex0 = gi * 8 + i0, ex1 = gi * 8 + i1;
        RE[t * 2 + 0] = ex0; RE[t * 2 + 1] = ex1;
        RW[t * 2 + 0] = gw * p0; RW[t * 2 + 1] = gw * p1;
        atomicAdd(&counts[ex0], 1); atomicAdd(&counts[ex1], 1);
    }
}

__device__ __forceinline__ void b_moe_scan(int* __restrict__ ctl, int* __restrict__ TILEE, int tid, unsigned char* sm) {
    int* pst = (int*)sm;
    if (tid == 0) { int run = 0; for (int e = 0; e < N_EXP; ++e) { pst[e] = run; ctl[64 + e] = run; ctl[32 + e] = 0; run += (ctl[e] + MOE_PAD - 1) / MOE_PAD * MOE_PAD; } pst[32] = run; ctl[96] = run / MOE_PAD; }
    __syncthreads();
    for (int tile = tid; tile < N_TILES; tile += NTHREADS) {
        const int p = tile * MOE_PAD; int e = -1;
        for (int j = 0; j < N_EXP; ++j) if (p >= pst[j] && p < pst[j + 1]) e = j;
        TILEE[tile] = e;
    }
}

__device__ __forceinline__ void b_moe_gemm1(const bf16_t* __restrict__ XN, const float* __restrict__ Wg, const float* __restrict__ Wu, const int* __restrict__ ROWTOK, const int* __restrict__ TILEE, bf16_t* __restrict__ HDN,
                                            int vbx, int vby, int vt, unsigned char* sm) {
    As_t As = (As_t)sm; Bs_t Bs = (Bs_t)(sm + 64 * 40 * 2);
    const int e_raw = TILEE[vby];
    const int e = e_raw < 0 ? 0 : e_raw;
    const int lane = vt & 63, wid = vt >> 6, wr = wid >> 1, wc = wid & 1;
    const int p0 = vby * 64, n0 = vbx * 64;
    const int a = ROWTOK[p0 + (vt >> 2)];
    f32x4 acc[2][2][2];
#pragma unroll
    for (int b = 0; b < 2; ++b)
#pragma unroll
        for (int i = 0; i < 2; ++i)
#pragma unroll
            for (int j = 0; j < 2; ++j) acc[b][i][j] = (f32x4){0.f, 0.f, 0.f, 0.f};
    gemm_core64<2>(a >= 0 ? XN + (size_t)(a >> 1) * DM : nullptr, Wg + (size_t)e * DM * D_EXP, Wu + (size_t)e * DM * D_EXP, D_EXP, n0, D_EXP, DM, acc, As, Bs, vt);
    if (e_raw < 0) return;
#pragma unroll
    for (int i = 0; i < 2; ++i)
#pragma unroll
        for (int j = 0; j < 2; ++j)
#pragma unroll
            for (int r = 0; r < 4; ++r) {
                const int row = p0 + wr * 32 + i * 16 + (lane >> 4) * 4 + r, col = n0 + wc * 32 + j * 16 + (lane & 15);
                const float g = acc[0][i][j][r], u = acc[1][i][j][r];
                HDN[(size_t)row * D_EXP + col] = f2bf(g * sigmoidf_(g) * u);
            }
}
__device__ __forceinline__ void b_moe_gemm2(const bf16_t* __restrict__ HDN, const float* __restrict__ Wd, const int* __restrict__ ROWTOK, const int* __restrict__ TILEE, const float* __restrict__ RW, bf16_t* __restrict__ YB,
                                            int vbx, int vby, int vt, unsigned char* sm) {
    As_t As = (As_t)sm; Bs_t Bs = (Bs_t)(sm + 64 * 40 * 2);
    const int e_raw = TILEE[vby];
    const int e = e_raw < 0 ? 0 : e_raw;
    const int lane = vt & 63, wid = vt >> 6, wr = wid >> 1, wc = wid & 1;
    const int p0 = vby * 64, n0 = vbx * 64;
    f32x4 acc[1][2][2];
#pragma unroll
    for (int i = 0; i < 2; ++i)
#pragma unroll
        for (int j = 0; j < 2; ++j) acc[0][i][j] = (f32x4){0.f, 0.f, 0.f, 0.f};
    const int arow = ROWTOK[p0 + (vt >> 2)];
    gemm_core64<1>((arow >= 0 && e_raw >= 0) ? HDN + (size_t)(p0 + (vt >> 2)) * D_EXP : nullptr, Wd + (size_t)e * D_EXP * DM, nullptr, DM, n0, DM, D_EXP, acc, As, Bs, vt);
    if (e_raw < 0) return;
#pragma unroll
    for (int i = 0; i < 2; ++i)
#pragma unroll
        for (int r = 0; r < 4; ++r) {
            const int row = p0 + wr * 32 + i * 16 + (lane >> 4) * 4 + r;
            const int a = ROWTOK[row];
            if (a < 0) continue;
            const float w = RW[a];
#pragma unroll
            for (int j = 0; j < 2; ++j) { const int col = n0 + wc * 32 + j * 16 + (lane & 15); YB[(size_t)a * DM + col] = f2bf(w * acc[0][i][j][r]); }
        }
}
__device__ __forceinline__ void b_final2(float* __restrict__ o, const uint4 xv, const uint2 y0, const uint2 y1, const float w0, const float w1) {
    const unsigned xs[4] = {xv.x, xv.y, xv.z, xv.w};
    f32x4 o0, o1;
    o0[0] = __uint_as_float(xs[0] << 16) + (w0 * __builtin_amdgcn_cvt_f32_fp8(y0.x, 0) + w1 * __builtin_amdgcn_cvt_f32_fp8(y1.x, 0));
    o0[1] = __uint_as_float(xs[0] & 0xffff0000u) + (w0 * __builtin_amdgcn_cvt_f32_fp8(y0.x, 1) + w1 * __builtin_amdgcn_cvt_f32_fp8(y1.x, 1));
    o0[2] = __uint_as_float(xs[1] << 16) + (w0 * __builtin_amdgcn_cvt_f32_fp8(y0.x, 2) + w1 * __builtin_amdgcn_cvt_f32_fp8(y1.x, 2));
    o0[3] = __uint_as_float(xs[1] & 0xffff0000u) + (w0 * __builtin_amdgcn_cvt_f32_fp8(y0.x, 3) + w1 * __builtin_amdgcn_cvt_f32_fp8(y1.x, 3));
    o1[0] = __uint_as_float(xs[2] << 16) + (w0 * __builtin_amdgcn_cvt_f32_fp8(y0.y, 0) + w1 * __builtin_amdgcn_cvt_f32_fp8(y1.y, 0));
    o1[1] = __uint_as_float(xs[2] & 0xffff0000u) + (w0 * __builtin_amdgcn_cvt_f32_fp8(y0.y, 1) + w1 * __builtin_amdgcn_cvt_f32_fp8(y1.y, 1));
    o1[2] = __uint_as_float(xs[3] << 16) + (w0 * __builtin_amdgcn_cvt_f32_fp8(y0.y, 2) + w1 * __builtin_amdgcn_cvt_f32_fp8(y1.y, 2));
    o1[3] = __uint_as_float(xs[3] & 0xffff0000u) + (w0 * __builtin_amdgcn_cvt_f32_fp8(y0.y, 3) + w1 * __builtin_amdgcn_cvt_f32_fp8(y1.y, 3));
    *(f32x4*)o = o0; *(f32x4*)(o + 4) = o1;
}
__device__ __forceinline__ void b_final(float* __restrict__ out, const bf16_t* __restrict__ X2B, const unsigned char* __restrict__ YB, size_t i) {
    const size_t t = i / DM, c = i % DM;
    const uint4 xv = *(const uint4*)(X2B + i); const uint2 y0 = *(const uint2*)(YB + (2 * t) * DM + c), y1 = *(const uint2*)(YB + (2 * t + 1) * DM + c);
    const unsigned xs[4] = {xv.x, xv.y, xv.z, xv.w};
    f32x4 o0, o1;
    o0[0] = __uint_as_float(xs[0] << 16) + 0.0625f * (__builtin_amdgcn_cvt_f32_fp8(y0.x, 0) + __builtin_amdgcn_cvt_f32_fp8(y1.x, 0));
    o0[1] = __uint_as_float(xs[0] & 0xffff0000u) + 0.0625f * (__builtin_amdgcn_cvt_f32_fp8(y0.x, 1) + __builtin_amdgcn_cvt_f32_fp8(y1.x, 1));
    o0[2] = __uint_as_float(xs[1] << 16) + 0.0625f * (__builtin_amdgcn_cvt_f32_fp8(y0.x, 2) + __builtin_amdgcn_cvt_f32_fp8(y1.x, 2));
    o0[3] = __uint_as_float(xs[1] & 0xffff0000u) + 0.0625f * (__builtin_amdgcn_cvt_f32_fp8(y0.x, 3) + __builtin_amdgcn_cvt_f32_fp8(y1.x, 3));
    o1[0] = __uint_as_float(xs[2] << 16) + 0.0625f * (__builtin_amdgcn_cvt_f32_fp8(y0.y, 0) + __builtin_amdgcn_cvt_f32_fp8(y1.y, 0));
    o1[1] = __uint_as_float(xs[2] & 0xffff0000u) + 0.0625f * (__builtin_amdgcn_cvt_f32_fp8(y0.y, 1) + __builtin_amdgcn_cvt_f32_fp8(y1.y, 1));
    o1[2] = __uint_as_float(xs[3] << 16) + 0.0625f * (__builtin_amdgcn_cvt_f32_fp8(y0.y, 2) + __builtin_amdgcn_cvt_f32_fp8(y1.y, 2));
    o1[3] = __uint_as_float(xs[3] & 0xffff0000u) + 0.0625f * (__builtin_amdgcn_cvt_f32_fp8(y0.y, 3) + __builtin_amdgcn_cvt_f32_fp8(y1.y, 3));
    *(f32x4*)(out + i) = o0; *(f32x4*)(out + i + 4) = o1;
}

namespace pg8 {
typedef unsigned u32x4 __attribute__((ext_vector_type(4)));
typedef unsigned u32x2 __attribute__((ext_vector_type(2)));
typedef int v4i_t __attribute__((ext_vector_type(4)));
typedef int v8i_t __attribute__((ext_vector_type(8)));
constexpr int BM = 256, BK = 64, HALF = 128, HTB = HALF * BK * 2, STAGE_BYTES = 8 * HTB, NXCD = 8, WGM = 8;
__host__ __device__ __forceinline__ int lds_byte(int r, int c) { const int st = (r >> 4) * 2 + (c >> 5), rr = r & 15, cc = c & 31, ob = rr * 64 + cc * 2; return st * 1024 + (ob ^ (((ob >> 9) & 1) << 5)); }
__host__ __device__ __forceinline__ void stage_rc(int b, int& R, int& C) { const int st = b / 1024, sb = b % 1024, swz = sb ^ (((sb >> 9) & 1) << 5); R = (st >> 1) * 16 + swz / 64; C = (st & 1) * 32 + (swz % 64) / 2; }
__host__ __device__ __forceinline__ int perm32(int rho) { const int n = rho >> 4, i = rho & 15; return 8 * (i >> 2) + 4 * n + (i & 3); }
struct Unit { int pm, pn, e, r0, cnt; };
struct Gemm { const void* A; const void* Bt; int lda, ldb, K; size_t astride, bstride; int scale_a, scale_b; };
struct StaticOrder {
    static constexpr bool GATHER = false; static constexpr int ESZ = 2;
    int nM, nN, nwg, G, c, i0, i1;
    __device__ void init(int M, int N, int G_, int c_, int i0_ = 0, int i1_ = 1 << 30) { nM = M / BM; nN = N / BM; nwg = nM * nN; G = G_; c = c_; i0 = i0_; i1 = i1_; }
    __device__ bool next(int i, Unit& u) const {
        i += i0; if (i >= i1) return false;
        const long L = (long)i * G + c; if (L >= nwg) return false;
        int wgid = (int)L; { const int q = nwg / NXCD, r = nwg % NXCD, xcd = wgid % NXCD, off = wgid / NXCD; wgid = (xcd < r ? xcd * (q + 1) : r * (q + 1) + (xcd - r) * q) + off; }
        const int nig = WGM * nN, gid = wgid / nig, fm = gid * WGM, gsz = (nM - fm) < WGM ? (nM - fm) : WGM;
        u.pm = fm + ((wgid % nig) % gsz); u.pn = (wgid % nig) / gsz; u.e = 0; return true;
    }
};
__device__ __forceinline__ unsigned cvt_pk_bf16(float lo, float hi) { unsigned r; asm volatile("v_cvt_pk_bf16_f32 %0, %1, %2" : "=v"(r) : "v"(lo), "v"(hi)); return r; }

template <class Epi, class Sched, bool ALIGN_EPI>
__device__ __forceinline__ void gemm_phase(LAS unsigned char* lds, const Gemm g, const Sched& S, const Epi& E) {
    int tid = threadIdx.x; asm volatile("" : "+v"(tid));
    const int wid = __builtin_amdgcn_readfirstlane(tid >> 6), lane = tid & 63, wr = wid >> 2, wc = wid & 3, fr = lane & 15, fq = lane >> 4;
    constexpr int ESZ = Sched::ESZ;
    const int K = g.K, nt = K * ESZ / (BK * 2);
    unsigned voffA[2], voffB[2];
#pragma unroll
    for (int i = 0; i < 2; ++i) { int R, C; stage_rc(tid * 16 + i * 8192, R, C); const int Rb = Epi::PERM ? ((R & ~31) + perm32(R & 31)) : R;
        voffA[i] = (unsigned)(R * g.lda * ESZ + C * 2); voffB[i] = (unsigned)(Rb * g.ldb * ESZ + C * 2); }
    const size_t kstep = (size_t)(BK * 2);
    const size_t hstepA = (size_t)HALF * g.lda * ESZ, tstepA = 2 * hstepA;
    const size_t hstepB = (size_t)HALF * g.ldb * ESZ, tstepB = 2 * hstepB;
    const unsigned ldsw = (unsigned)wid * 1024u;
    const int aoff = lds_byte(wr * 64 + fr, ESZ == 2 ? fq * 8 : fq * 16), boff = lds_byte(wc * 32 + fr, ESZ == 2 ? fq * 8 : fq * 16);
    constexpr int PIECE1 = ESZ == 2 ? 1024 : 16;
    unsigned la_ = (unsigned)(size_t)(lds + aoff), lb_ = (unsigned)(size_t)(lds + 65536 + boff);
    asm volatile("" : "+v"(la_), "+v"(lb_));
    const LAS unsigned char* ldsA = (const LAS unsigned char*)(size_t)la_; const LAS unsigned char* ldsB = (const LAS unsigned char*)(size_t)lb_;
#define PG8_SA(b, h) (((b) * 2 + (h)) * HTB)
#define PG8_SB(b, h) ((4 + (b) * 2 + (h)) * HTB)
#define PG8_STAGE(bufoff, gbase, voff) do { _Pragma("unroll") for (int _i = 0; _i < 2; ++_i) \
        __builtin_amdgcn_global_load_lds((const unsigned*)((const char*)(gbase) + (voff)[_i]), (LAS unsigned*)(lds + (bufoff) + ldsw + _i * 8192), 16, 0, 0); } while (0)
#define PG8_LDA(dst, b, h) do { _Pragma("unroll") for (int m = 0; m < 4; ++m) { dst[m][0] = *(const LAS bf16x8*)(ldsA + PG8_SA(b, h) + m * 2048); dst[m][1] = *(const LAS bf16x8*)(ldsA + PG8_SA(b, h) + m * 2048 + PIECE1); } } while (0)
#define PG8_LDB(dst, b, h) do { _Pragma("unroll") for (int n = 0; n < 2; ++n) { dst[n][0] = *(const LAS bf16x8*)(ldsB + (PG8_SB(b, h) - 65536) + n * 2048); dst[n][1] = *(const LAS bf16x8*)(ldsB + (PG8_SB(b, h) - 65536) + n * 2048 + PIECE1); } } while (0)
#define PG8_V8(x) __builtin_shufflevector(__builtin_bit_cast(v4i_t, (x)[0]), __builtin_bit_cast(v4i_t, (x)[1]), 0, 1, 2, 3, 4, 5, 6, 7)
#define PG8_MMA(ai, bj, At, Bt) do { __builtin_amdgcn_s_setprio(1); _Pragma("unroll") for (int m = 0; m < 4; ++m) _Pragma("unroll") for (int n = 0; n < 2; ++n) { \
        if constexpr (ESZ == 2) { _Pragma("unroll") for (int k = 0; k < 2; ++k) acc[ai][bj][m][n] = __builtin_amdgcn_mfma_f32_16x16x32_bf16(Bt[n][k], At[m][k], acc[ai][bj][m][n], 0, 0, 0); } \
        else { acc[ai][bj][m][n] = __builtin_amdgcn_mfma_scale_f32_16x16x128_f8f6f4(PG8_V8(Bt[n]), PG8_V8(At[m]), acc[ai][bj][m][n], 0, 0, 0, g.scale_b, 0, g.scale_a); \
               asm volatile("" : "+v"(acc[ai][bj][m][n])); } }     \
        __builtin_amdgcn_s_setprio(0); } while (0)
#define PG8_WAIT_V(n) asm volatile("s_waitcnt vmcnt(" #n ")" ::: "memory")
#define PG8_WAIT_L(n) asm volatile("s_waitcnt lgkmcnt(" #n ")" ::: "memory")
#define PG8_BAR __builtin_amdgcn_s_barrier()
#define PG8_SCHED __builtin_amdgcn_sched_barrier(0)
    Unit cur, nxt; int ui = 0;
    if (!S.next(0, cur)) return;
    f32x4 acc[2][2][4][2];
#pragma unroll
    for (int a = 0; a < 2; ++a)
#pragma unroll
        for (int b = 0; b < 2; ++b)
#pragma unroll
            for (int m = 0; m < 4; ++m)
#pragma unroll
                for (int n = 0; n < 2; ++n) acc[a][b][m][n] = (f32x4){0.f, 0.f, 0.f, 0.f};
    bf16x8 At[4][2], B0[2][2], B1[2][2];
    constexpr bool GATHER = Sched::GATHER;
    const size_t hsA = GATHER ? 0 : hstepA;
    unsigned c0[2], c1[2], n0[2], n1[2];
    if constexpr (GATHER) { S.a_offsets(cur, tid, g.lda, c0, c1); n0[0] = c0[0]; n0[1] = c0[1]; n1[0] = c1[0]; n1[1] = c1[1]; }
#define PG8_C0 (GATHER ? c0 : voffA)
#define PG8_C1 (GATHER ? c1 : voffA)
    const char* cA = (const char*)g.A + (GATHER ? (size_t)0 : ((size_t)cur.e * g.astride) * ESZ + (size_t)cur.pm * tstepA); const char* cB = (const char*)g.Bt + ((size_t)cur.e * g.bstride) * ESZ + (size_t)cur.pn * tstepB;
    PG8_STAGE(PG8_SB(0, 0), cB, voffB); PG8_STAGE(PG8_SB(0, 1), cB + hstepB, voffB); PG8_STAGE(PG8_SA(0, 0), cA, PG8_C0); PG8_STAGE(PG8_SA(0, 1), cA + hsA, PG8_C1);
    if (wr == 1) PG8_BAR;
    PG8_WAIT_V(2); PG8_BAR;
    PG8_STAGE(PG8_SB(1, 0), cB + kstep, voffB); PG8_STAGE(PG8_SA(1, 0), cA + kstep, PG8_C0); PG8_STAGE(PG8_SB(1, 1), cB + hstepB + kstep, voffB);
    PG8_WAIT_V(6); PG8_BAR;
    for (;;) {
        const bool has_next = S.next(ui + 1, nxt);
        const char* nA = (has_next && !GATHER) ? (const char*)g.A + ((size_t)nxt.e * g.astride) * ESZ + (size_t)nxt.pm * tstepA : cA; const char* nB = has_next ? (const char*)g.Bt + ((size_t)nxt.e * g.bstride) * ESZ + (size_t)nxt.pn * tstepB : cB;
        if constexpr (GATHER) { if (has_next) S.a_offsets(nxt, tid, g.lda, n0, n1); }
#pragma unroll 1
        for (int t = 0; t < nt; t += 2) {
            const bool last = (t == nt - 2);
            const char* a1 = cA + (size_t)(t + 1) * kstep;
            const char* a2 = last ? nA : cA + (size_t)(t + 2) * kstep; const char* b2 = last ? nB : cB + (size_t)(t + 2) * kstep;
            const char* a3 = a2 + kstep; const char* b3 = b2 + kstep;
            unsigned s0[2], s1[2];
            if constexpr (GATHER) {
#pragma unroll
                for (int i_ = 0; i_ < 2; ++i_) { s0[i_] = last ? n0[i_] : c0[i_]; s1[i_] = last ? n1[i_] : c1[i_]; }
            }
#define PG8_S0 (GATHER ? s0 : voffA)
#define PG8_S1 (GATHER ? s1 : voffA)
            PG8_LDB(B0, 0, 0); PG8_LDB(B1, 0, 1); PG8_SCHED; PG8_LDA(At, 0, 0); PG8_STAGE(PG8_SA(1, 1), a1 + hsA, PG8_C1);
            PG8_WAIT_V(8); PG8_WAIT_L(0); PG8_BAR; PG8_MMA(0, 0, At, B0); PG8_MMA(0, 1, At, B1); PG8_BAR; PG8_SCHED;
            PG8_LDA(At, 0, 1); PG8_STAGE(PG8_SB(0, 0), b2, voffB); PG8_STAGE(PG8_SB(0, 1), b2 + hstepB, voffB); PG8_STAGE(PG8_SA(0, 0), a2, PG8_S0);
            PG8_WAIT_V(8); PG8_WAIT_L(0); PG8_BAR; PG8_MMA(1, 0, At, B0); PG8_MMA(1, 1, At, B1); PG8_BAR; PG8_SCHED;
            PG8_LDB(B0, 1, 0); PG8_LDB(B1, 1, 1); PG8_SCHED; PG8_LDA(At, 1, 0); PG8_STAGE(PG8_SA(0, 1), a2 + hsA, PG8_S1);
            PG8_WAIT_V(8); PG8_WAIT_L(0); PG8_BAR; PG8_MMA(0, 0, At, B0); PG8_MMA(0, 1, At, B1); PG8_BAR; PG8_SCHED;
            PG8_LDA(At, 1, 1); PG8_STAGE(PG8_SB(1, 0), b3, voffB); PG8_STAGE(PG8_SB(1, 1), b3 + hstepB, voffB); PG8_STAGE(PG8_SA(1, 0), a3, PG8_S0);
            PG8_WAIT_V(8); PG8_WAIT_L(0); PG8_BAR; PG8_MMA(1, 0, At, B0); PG8_MMA(1, 1, At, B1); PG8_BAR; PG8_SCHED;
        }
        if constexpr (ALIGN_EPI) { if (wr == 0) PG8_BAR; }
        bool chained = false;
        {
            int te = threadIdx.x; asm volatile("" : "+v"(te));
            const int le = te & 63, fre = le & 15, fqe = le >> 4, we = __builtin_amdgcn_readfirstlane(te >> 6), wre = we >> 2, wce = we & 3;
            if constexpr (Epi::CHAIN) chained = E.chain(acc, cur, wre, wce, fre, fqe);
            if (!chained) E(acc, cur, wre, wce, fre, fqe);
        }
        if (!has_next) break;
        if (!chained) {
#pragma unroll
        for (int a = 0; a < 2; ++a)
#pragma unroll
            for (int b = 0; b < 2; ++b)
#pragma unroll
                for (int m = 0; m < 4; ++m)
#pragma unroll
                    for (int n = 0; n < 2; ++n) acc[a][b][m][n] = (f32x4){0.f, 0.f, 0.f, 0.f};
        }
        cur = nxt; cA = nA; cB = nB; ++ui; if constexpr (GATHER) { c0[0] = n0[0]; c0[1] = n0[1]; c1[0] = n1[0]; c1[1] = n1[1]; }
        if constexpr (ALIGN_EPI) { if (wr == 1) PG8_BAR; }
    }
    PG8_WAIT_V(0);
    if constexpr (!ALIGN_EPI) { if (wr == 0) PG8_BAR; }
    PG8_BAR;
#undef PG8_SA
#undef PG8_SB
#undef PG8_STAGE
#undef PG8_LDA
#undef PG8_LDB
#undef PG8_MMA
#undef PG8_V8
#undef PG8_C0
#undef PG8_C1
#undef PG8_S0
#undef PG8_S1
#undef PG8_WAIT_V
#undef PG8_WAIT_L
#undef PG8_BAR
#undef PG8_SCHED
}

struct EpiInProj {
    static constexpr bool PERM = true, CHAIN = false;
    bf16_t* U; const float *qg, *kg;
    static constexpr size_t SEC_STRIDE = (size_t)16 << 20;
    __device__ __forceinline__ void operator()(const f32x4 (&acc)[2][2][4][2], const Unit& u, int wr, int wc, int fr, int fq) const {
        const int sec = u.pn >> 1, row0 = u.pm * BM + wr * 64 + fr;
        bf16_t* base = U + (size_t)sec * SEC_STRIDE;
        if (sec == 2 || sec == 3) {
            const bool isq = (sec == 2); const float sc = isq ? 0.125f * LOG2E : 1.0f;
            const int head = 4 * (u.pn & 1) + wc;
            const f32x4 q00 = *(const f32x4*)(qg + 8 * fq), q01 = *(const f32x4*)(qg + 8 * fq + 4), q10 = *(const f32x4*)(qg + 32 + 8 * fq), q11 = *(const f32x4*)(qg + 32 + 8 * fq + 4);
            const f32x4 k00 = *(const f32x4*)(kg + 8 * fq), k01 = *(const f32x4*)(kg + 8 * fq + 4), k10 = *(const f32x4*)(kg + 32 + 8 * fq), k11 = *(const f32x4*)(kg + 32 + 8 * fq + 4);
            const f32x4 gv00 = isq ? q00 : k00, gv01 = isq ? q01 : k01, gv10 = isq ? q10 : k10, gv11 = isq ? q11 : k11;
#pragma unroll
            for (int ai = 0; ai < 2; ++ai)
#pragma unroll
                for (int m = 0; m < 4; ++m) {
                    float ss = 0.f;
#pragma unroll
                    for (int bj = 0; bj < 2; ++bj)
#pragma unroll
                        for (int n = 0; n < 2; ++n) { const f32x4 x = acc[ai][bj][m][n]; ss += (x[0] * x[0] + x[1] * x[1]) + (x[2] * x[2] + x[3] * x[3]); }
                    ss += __shfl_xor(ss, 16); ss += __shfl_xor(ss, 32);
                    const float rs = rsqrtf(ss * (1.f / 64.f) + EPS) * sc;
                    bf16_t* rowp = base + (size_t)(row0 + ai * HALF + m * 16) * 512 + head * 64 + 8 * fq;
#pragma unroll
                    for (int bj = 0; bj < 2; ++bj) { const f32x4 v0 = acc[ai][bj][m][0] * rs * (bj ? gv10 : gv00), v1 = acc[ai][bj][m][1] * rs * (bj ? gv11 : gv01);
                        u32x4 w; w.x = cvt_pk_bf16(v0[0], v0[1]); w.y = cvt_pk_bf16(v0[2], v0[3]); w.z = cvt_pk_bf16(v1[0], v1[1]); w.w = cvt_pk_bf16(v1[2], v1[3]);
                        *(u32x4*)(rowp + bj * 32) = w; }
                }
        } else {
            const int col0 = (u.pn & 1) * BM + wc * 32 + 8 * fq;
#pragma unroll
            for (int ai = 0; ai < 2; ++ai)
#pragma unroll
                for (int m = 0; m < 4; ++m) { bf16_t* rowp = base + (size_t)(row0 + ai * HALF + m * 16) * 512 + col0;
#pragma unroll
                    for (int bj = 0; bj < 2; ++bj) { const f32x4 v0 = acc[ai][bj][m][0], v1 = acc[ai][bj][m][1];
                        u32x4 w; w.x = cvt_pk_bf16(v0[0], v0[1]); w.y = cvt_pk_bf16(v0[2], v0[3]); w.z = cvt_pk_bf16(v1[0], v1[1]); w.w = cvt_pk_bf16(v1[2], v1[3]);
                        *(u32x4*)(rowp + bj * HALF) = w; } }
        }
    }
};
struct EpiBf16 {
    static constexpr bool PERM = true, CHAIN = false;
    bf16_t *O0, *O1; int ldo, split;
    __device__ __forceinline__ void operator()(const f32x4 (&acc)[2][2][4][2], const Unit& u, int wr, int wc, int fr, int fq) const {
        int colt = u.pn * BM; bf16_t* base = O0; if (colt >= split) { colt -= split; base = O1; }
        const int row0 = u.pm * BM + wr * 64 + fr, col0 = colt + wc * 32 + 8 * fq;
#pragma unroll
        for (int ai = 0; ai < 2; ++ai)
#pragma unroll
            for (int m = 0; m < 4; ++m) { bf16_t* rowp = base + (size_t)(row0 + ai * HALF + m * 16) * ldo + col0;
#pragma unroll
                for (int bj = 0; bj < 2; ++bj) { const f32x4 v0 = acc[ai][bj][m][0], v1 = acc[ai][bj][m][1];
                    u32x4 w; w.x = cvt_pk_bf16(v0[0], v0[1]); w.y = cvt_pk_bf16(v0[2], v0[3]); w.z = cvt_pk_bf16(v1[0], v1[1]); w.w = cvt_pk_bf16(v1[2], v1[3]);
                    *(u32x4*)(rowp + bj * HALF) = w; } }
    }
};
struct EpiResF32 {
    static constexpr bool PERM = false, CHAIN = false;
    const float* base; float* out;
    __device__ __forceinline__ void operator()(const f32x4 (&acc)[2][2][4][2], const Unit& u, int wr, int wc, int fr, int fq) const {
        const int row0 = u.pm * BM + wr * 64 + fr, col0 = u.pn * BM + wc * 32 + 4 * fq;
#pragma unroll
        for (int ai = 0; ai < 2; ++ai)
#pragma unroll
            for (int m = 0; m < 4; ++m) { const size_t off = (size_t)(row0 + ai * HALF + m * 16) * DM + col0;
#pragma unroll
                for (int bj = 0; bj < 2; ++bj)
#pragma unroll
                    for (int n = 0; n < 2; ++n) *(f32x4*)(out + off + bj * HALF + n * 16) = *(const f32x4*)(base + off + bj * HALF + n * 16) + acc[ai][bj][m][n]; }
    }
};


struct PairOrder {
    static constexpr bool GATHER = false; static constexpr int ESZ = 2;
    StaticOrder so;
    __device__ void init(int M, int N, int G_, int c_) { so.init(M, N, G_, c_); }
    __device__ bool next(int i, Unit& u) const { if (!so.next(i >> 1, u)) return false; u.e = i & 1; return true; }
};
__device__ __forceinline__ float rstd8(const float* p, float inv_n) { const f32x4 a = *(const f32x4*)p, b = *(const f32x4*)(p + 4); return rsqrtf(((a[0] + a[1]) + (a[2] + a[3]) + (b[0] + b[1]) + (b[2] + b[3])) * inv_n + EPS); }
__device__ __forceinline__ float rstd16(const float* p, float inv_n) { float t = 0.f;
#pragma unroll
    for (int i = 0; i < 4; ++i) { const f32x4 a = *(const f32x4*)(p + 4 * i); t += (a[0] + a[1]) + (a[2] + a[3]); } return rsqrtf(t * inv_n + EPS); }
struct EpiOutChain {
    static constexpr bool PERM = true, CHAIN = true;
    const float* x; bf16_t* x1b; const float* SSL; const float* SSF; float* SS1;
    __device__ __forceinline__ bool chain(f32x4 (&acc)[2][2][4][2], const Unit& u, int wr, int wc, int fr, int fq) const {
        if (u.e != 0) return false;
        const int row0 = u.pm * BM + wr * 64 + fr;
        float ratio[8];
#pragma unroll
        for (int i = 0; i < 8; ++i) { const int row = row0 + (i >> 2) * HALF + (i & 3) * 16; ratio[i] = rstd8(SSL + (size_t)row * 8, 1.f / 512.f) / rstd8(SSF + (size_t)row * 8, 1.f / 512.f); }
#pragma unroll
        for (int ai = 0; ai < 2; ++ai)
#pragma unroll
            for (int m = 0; m < 4; ++m)
#pragma unroll
                for (int bj = 0; bj < 2; ++bj)
#pragma unroll
                    for (int n = 0; n < 2; ++n) acc[ai][bj][m][n] *= ratio[ai * 4 + m];
        return true;
    }
    __device__ __forceinline__ void operator()(const f32x4 (&acc)[2][2][4][2], const Unit& u, int wr, int wc, int fr, int fq) const {
        const int row0 = u.pm * BM + wr * 64 + fr, col0 = u.pn * BM + wc * 32 + 8 * fq;
        float rfv[8];
#pragma unroll
        for (int i = 0; i < 8; ++i) rfv[i] = rstd8(SSF + (size_t)(row0 + (i >> 2) * HALF + (i & 3) * 16) * 8, 1.f / 512.f);
#pragma unroll
        for (int pr = 0; pr < 4; ++pr) {
            const int ai = pr >> 1;
            f32x4 xv[2][2][2];
#pragma unroll
            for (int mm = 0; mm < 2; ++mm)
#pragma unroll
                for (int bj = 0; bj < 2; ++bj)
#pragma unroll
                    for (int n = 0; n < 2; ++n) xv[mm][bj][n] = *(const f32x4*)(x + (size_t)(row0 + ai * HALF + (2 * (pr & 1) + mm) * 16) * DM + col0 + bj * HALF + n * 4);
            asm volatile("" ::: "memory");
#pragma unroll
            for (int mm = 0; mm < 2; ++mm) { const int m = 2 * (pr & 1) + mm; const int row = row0 + ai * HALF + m * 16; const size_t off = (size_t)row * DM + col0;
                const float rf = rfv[ai * 4 + m]; float ss = 0.f;
#pragma unroll
                for (int bj = 0; bj < 2; ++bj) { const f32x4 v0 = xv[mm][bj][0] + acc[ai][bj][m][0] * rf, v1 = xv[mm][bj][1] + acc[ai][bj][m][1] * rf;
                    ss += ((v0[0] * v0[0] + v0[1] * v0[1]) + (v0[2] * v0[2] + v0[3] * v0[3])) + ((v1[0] * v1[0] + v1[1] * v1[1]) + (v1[2] * v1[2] + v1[3] * v1[3]));
                    u32x4 w; w.x = cvt_pk_bf16(v0[0], v0[1]); w.y = cvt_pk_bf16(v0[2], v0[3]); w.z = cvt_pk_bf16(v1[0], v1[1]); w.w = cvt_pk_bf16(v1[2], v1[3]);
                    *(u32x4*)(x1b + off + bj * HALF) = w; }
                ss += __shfl_xor(ss, 16); ss += __shfl_xor(ss, 32);
                if (fq == 0) SS1[(size_t)row * 16 + u.pn * 4 + wc] = ss; }
        }
    }
};
struct EpiRowScale {
    static constexpr bool PERM = true, CHAIN = false;
    bf16_t* O; int ldo; const float* SS; float inv_n;
    __device__ __forceinline__ void operator()(const f32x4 (&acc)[2][2][4][2], const Unit& u, int wr, int wc, int fr, int fq) const {
        const int row0 = u.pm * BM + wr * 64 + fr, col0 = u.pn * BM + wc * 32 + 8 * fq;
        float rsv[8];
#pragma unroll
        for (int i = 0; i < 8; ++i) rsv[i] = rstd16(SS + (size_t)(row0 + (i >> 2) * HALF + (i & 3) * 16) * 16, inv_n);
#pragma unroll
        for (int ai = 0; ai < 2; ++ai)
#pragma unroll
            for (int m = 0; m < 4; ++m) { const int row = row0 + ai * HALF + m * 16; const float rs = rsv[ai * 4 + m]; bf16_t* rowp = O + (size_t)row * ldo + col0;
#pragma unroll
                for (int bj = 0; bj < 2; ++bj) { const f32x4 v0 = acc[ai][bj][m][0] * rs, v1 = acc[ai][bj][m][1] * rs;
                    u32x4 w; w.x = cvt_pk_bf16(v0[0], v0[1]); w.y = cvt_pk_bf16(v0[2], v0[3]); w.z = cvt_pk_bf16(v1[0], v1[1]); w.w = cvt_pk_bf16(v1[2], v1[3]);
                    *(u32x4*)(rowp + bj * HALF) = w; } }
    }
};

__device__ __forceinline__ float clamp_fp8(float v) { return __builtin_amdgcn_fmed3f(v, -448.f, 448.f); }
__device__ __forceinline__ unsigned cvt4_fp8(float a, float b, float c, float d) { int w = 0; w = __builtin_amdgcn_cvt_pk_fp8_f32(clamp_fp8(a), clamp_fp8(b), w, false); w = __builtin_amdgcn_cvt_pk_fp8_f32(clamp_fp8(c), clamp_fp8(d), w, true); return (unsigned)w; }
struct EpiX2 {
    static constexpr bool PERM = true, CHAIN = false;
    const bf16_t* x1b; bf16_t* xb; unsigned char* xq; float* SS;
    __device__ __forceinline__ void operator()(const f32x4 (&acc)[2][2][4][2], const Unit& u, int wr, int wc, int fr, int fq) const {
        const int row0 = u.pm * BM + wr * 64 + fr, col0 = u.pn * BM + wc * 32 + 8 * fq;
#pragma unroll
        for (int ai = 0; ai < 2; ++ai) {
            u32x4 xrv[4][2];
#pragma unroll
            for (int m = 0; m < 4; ++m)
#pragma unroll
                for (int bj = 0; bj < 2; ++bj) xrv[m][bj] = *(const u32x4*)(x1b + (size_t)(row0 + ai * HALF + m * 16) * DM + col0 + bj * HALF);
            asm volatile("" ::: "memory");
#pragma unroll
            for (int m = 0; m < 4; ++m) { const int row = row0 + ai * HALF + m * 16; const size_t off = (size_t)row * DM + col0; float ss = 0.f;
#pragma unroll
                for (int bj = 0; bj < 2; ++bj) { const u32x4 xr = xrv[m][bj];
                    f32x4 v0 = acc[ai][bj][m][0], v1 = acc[ai][bj][m][1];
                    v0[0] += __uint_as_float(xr.x << 16); v0[1] += __uint_as_float(xr.x & 0xffff0000u); v0[2] += __uint_as_float(xr.y << 16); v0[3] += __uint_as_float(xr.y & 0xffff0000u);
                    v1[0] += __uint_as_float(xr.z << 16); v1[1] += __uint_as_float(xr.z & 0xffff0000u); v1[2] += __uint_as_float(xr.w << 16); v1[3] += __uint_as_float(xr.w & 0xffff0000u);
                    ss += (v0[0] * v0[0] + v0[1] * v0[1]) + (v0[2] * v0[2] + v0[3] * v0[3]) + (v1[0] * v1[0] + v1[1] * v1[1]) + (v1[2] * v1[2] + v1[3] * v1[3]);
                    u32x4 w; w.x = cvt_pk_bf16(v0[0], v0[1]); w.y = cvt_pk_bf16(v0[2], v0[3]); w.z = cvt_pk_bf16(v1[0], v1[1]); w.w = cvt_pk_bf16(v1[2], v1[3]);
                    *(u32x4*)(xb + off + bj * HALF) = w;
                    u32x2 q; q.x = cvt4_fp8(v0[0], v0[1], v0[2], v0[3]); q.y = cvt4_fp8(v1[0], v1[1], v1[2], v1[3]); *(u32x2*)(xq + off + bj * HALF) = q; }
                ss += __shfl_xor(ss, 16); ss += __shfl_xor(ss, 32);
                if (fq == 0) SS[(size_t)row * 16 + u.pn * 4 + wc] = ss; }
        }
    }
};
template <bool GATHER_>
struct MoeOrder {
    static constexpr bool GATHER = GATHER_; static constexpr int ESZ = 1;
    int nu, G, c; const LAS int* pst  ; const int* LIST;
    __device__ bool next(int i, Unit& u) const {
        const int L = i * G + c; if (L >= nu) return false;
        const int x = L & 7, off = L >> 3, per = nu >> 3, r = nu & 7;
        const int wg = (x < r ? x * (per + 1) : r * (per + 1) + (x - r) * per) + off;
        u.pm = wg >> 2; u.pn = wg & 3;
        const int row = u.pm * BM; const int e = pst[128 + u.pm];
        u.e = e; u.r0 = row - pst[e]; u.cnt = pst[64 + e]; return true;
    }
    __device__ __forceinline__ int assignment(const Unit& u, int r) const { const int rank = u.r0 + r; const bool ok = rank < u.cnt; const int a = LIST[(size_t)u.e * T + (ok ? rank : 0)]; return ok ? a : -1; }
    __device__ __forceinline__ void a_offsets(const Unit& u, int tid, int lda, unsigned (&o0)[2], unsigned (&o1)[2]) const {
#pragma unroll
        for (int i = 0; i < 2; ++i) { int R, C; stage_rc(tid * 16 + i * 8192, R, C);
            const int a0 = assignment(u, R), a1 = assignment(u, HALF + R);
            o0[i] = (unsigned)((a0 < 0 ? 0 : a0 >> 1) * lda * ESZ + C * 2); o1[i] = (unsigned)((a1 < 0 ? 0 : a1 >> 1) * lda * ESZ + C * 2); }
    }
};
struct EpiMoe1 {
    static constexpr bool PERM = true, CHAIN = false;
    unsigned char* HDN; const float* RSL;
    __device__ __forceinline__ void operator()(const f32x4 (&acc)[2][2][4][2], const Unit& u, int wr, int wc, int fr, int fq) const {
        const int r0 = wr * 64 + fr, col0 = u.pn * HALF + wc * 32 + 8 * fq;
        float rsv[8];
#pragma unroll
        for (int i = 0; i < 8; ++i) { const int rank = u.r0 + r0 + (i >> 2) * HALF + (i & 3) * 16; const bool ok = rank < u.cnt; const float v = RSL[(size_t)u.e * T + (ok ? rank : 0)]; rsv[i] = ok ? v : 0.f; }
#pragma unroll
        for (int ai = 0; ai < 2; ++ai)
#pragma unroll
            for (int m = 0; m < 4; ++m) {
                const int r = r0 + ai * HALF + m * 16;
                const float rs = rsv[ai * 4 + m];
                f32x4 h0, h1;
#pragma unroll
                for (int e = 0; e < 4; ++e) { const float g0 = rs * acc[ai][0][m][0][e], g1 = rs * acc[ai][0][m][1][e];
                    h0[e] = g0 * __builtin_amdgcn_rcpf(1.f + __expf(-g0)) * (rs * acc[ai][1][m][0][e]); h1[e] = g1 * __builtin_amdgcn_rcpf(1.f + __expf(-g1)) * (rs * acc[ai][1][m][1][e]); }
                u32x2 w; w.x = cvt4_fp8(8.f * h0[0], 8.f * h0[1], 8.f * h0[2], 8.f * h0[3]); w.y = cvt4_fp8(8.f * h1[0], 8.f * h1[1], 8.f * h1[2], 8.f * h1[3]);
                *(u32x2*)(HDN + (size_t)(u.pm * BM + r) * D_EXP + col0) = w;
            }
    }
};
struct EpiMoe2 {
    static constexpr bool PERM = true, CHAIN = false;
    unsigned char* Y;
    __device__ __forceinline__ void operator()(const f32x4 (&acc)[2][2][4][2], const Unit& u, int wr, int wc, int fr, int fq) const {
        const int r0 = u.pm * BM + wr * 64 + fr, col0 = u.pn * BM + wc * 32 + 8 * fq;
#pragma unroll
        for (int ai = 0; ai < 2; ++ai)
#pragma unroll
            for (int m = 0; m < 4; ++m) {
                u32x2 w0, w1;
                { const f32x4 v0 = acc[ai][0][m][0] * 8.f, v1 = acc[ai][0][m][1] * 8.f; w0.x = cvt4_fp8(v0[0], v0[1], v0[2], v0[3]); w0.y = cvt4_fp8(v1[0], v1[1], v1[2], v1[3]); }
                { const f32x4 v0 = acc[ai][1][m][0] * 8.f, v1 = acc[ai][1][m][1] * 8.f; w1.x = cvt4_fp8(v0[0], v0[1], v0[2], v0[3]); w1.y = cvt4_fp8(v1[0], v1[1], v1[2], v1[3]); }
                unsigned char* rowp = Y + (size_t)(r0 + ai * HALF + m * 16) * DM + col0;
                *(u32x2*)rowp = w0; *(u32x2*)(rowp + HALF) = w1;
            }
    }
};
}


namespace rtr {
__device__ __forceinline__ void task(int t0, const bf16_t* __restrict__ X2B, const bf16_t* __restrict__ WTR, const float* __restrict__ SS2, const float* __restrict__ bg, const float* __restrict__ be,
                                     float* __restrict__ RW, float* __restrict__ RSL, int* __restrict__ POSR, int* __restrict__ cnt, int* __restrict__ LIST, LAS float* lg  , const LAS unsigned char* wr, LAS int* hist  , int lane) {
    int ex0_ = 0, ex1_ = 0, lr0_ = 0, lr1_ = 0; float rs_ = 0.f;
    const int fr = lane & 15, kq = lane >> 4;
    f32x4 acc[3];
#pragma unroll
    for (int n = 0; n < 3; ++n) acc[n] = (f32x4){0.f, 0.f, 0.f, 0.f};
    const LAS unsigned char* bp0 = wr + fr * 2064 + 16 * kq, *bp1 = wr + (16 + fr) * 2064 + 16 * kq, *bp2 = wr + (32 + (fr & 3)) * 2064 + 16 * kq;
    const bool n2ok = fr < 4;
    LAS unsigned char* xs = (LAS unsigned char*)lg;
#pragma unroll 1
    for (int q = 0; q < 4; ++q) {
#pragma unroll
        for (int i = 0; i < 8; ++i) {
            const int r = 2 * i + (lane >> 5);
            const pg8::u32x4 v = *(const pg8::u32x4*)(X2B + (size_t)(t0 + r) * DM + q * 256 + (lane & 31) * 8);
            *(LAS pg8::u32x4*)(xs + r * 528 + (lane & 31) * 16) = v; }
        asm volatile("s_waitcnt vmcnt(0) lgkmcnt(0)" ::: "memory");
#pragma unroll
        for (int ks = 0; ks < 8; ++ks) {
            const bf16x8 a = *(const LAS bf16x8*)(xs + fr * 528 + ks * 64 + kq * 16);
            const int ko = q * 512 + ks * 64;
            const bf16x8 b0 = *(const LAS bf16x8*)(bp0 + ko), b1 = *(const LAS bf16x8*)(bp1 + ko); bf16x8 b2 = *(const LAS bf16x8*)(bp2 + ko);
            if (!n2ok) b2 = (bf16x8){0, 0, 0, 0, 0, 0, 0, 0};
            acc[0] = __builtin_amdgcn_mfma_f32_16x16x32_bf16(a, b0, acc[0], 0, 0, 0); acc[1] = __builtin_amdgcn_mfma_f32_16x16x32_bf16(a, b1, acc[1], 0, 0, 0); acc[2] = __builtin_amdgcn_mfma_f32_16x16x32_bf16(a, b2, acc[2], 0, 0, 0);
        }
        asm volatile("s_waitcnt lgkmcnt(0)" ::: "memory");
    }
#pragma unroll
    for (int n = 0; n < 3; ++n)
#pragma unroll
        for (int r = 0; r < 4; ++r) lg[(4 * kq + r) * 52 + 16 * n + fr] = acc[n][r];
    asm volatile("s_waitcnt lgkmcnt(0)" ::: "memory");
    if (lane < 16) {
        const int t = t0 + lane;
        const float rs = pg8::rstd16(SS2 + (size_t)t * 16, 1.f / DM);
        float v[36];
#pragma unroll
        for (int q = 0; q < 9; ++q) { const f32x4 x4 = *(const LAS f32x4*)(lg + lane * 52 + 4 * q); v[4 * q] = x4[0] * rs; v[4 * q + 1] = x4[1] * rs; v[4 * q + 2] = x4[2] * rs; v[4 * q + 3] = x4[3] * rs; }
        int gi = 0; float gmax = v[0] + bg[0]; float gl[4];
#pragma unroll
        for (int j = 0; j < 4; ++j) gl[j] = v[j] + bg[j];
#pragma unroll
        for (int j = 1; j < 4; ++j) if (gl[j] > gmax) { gmax = gl[j]; gi = j; }
        float gs = 0.f;
#pragma unroll
        for (int j = 0; j < 4; ++j) gs += __expf(gl[j] - gmax);
        const float gw = 1.f / gs;
        float el[8];
#pragma unroll
        for (int j = 0; j < 8; ++j) { float x = 0.f;
#pragma unroll
            for (int g = 0; g < 4; ++g) if (g == gi) x = v[4 + g * 8 + j] + be[g * 8 + j];
            el[j] = x; }
        int i0 = 0; float v0 = el[0];
#pragma unroll
        for (int j = 1; j < 8; ++j) if (el[j] > v0) { v0 = el[j]; i0 = j; }
        int i1 = -1; float v1 = -INFINITY;
#pragma unroll
        for (int j = 0; j < 8; ++j) if (j != i0 && el[j] > v1) { v1 = el[j]; i1 = j; }
        const float e1 = __expf(v1 - v0);
        const float p0 = 1.f / (1.f + e1), p1 = e1 / (1.f + e1);
        const int ex0 = gi * 8 + i0, ex1 = gi * 8 + i1;
        RW[t * 2 + 0] = gw * p0; RW[t * 2 + 1] = gw * p1; rs_ = rs;
        ex0_ = ex0; ex1_ = ex1;
        lr0_ = __hip_atomic_fetch_add((int*)hist + ex0, 1, __ATOMIC_RELAXED, __HIP_MEMORY_SCOPE_WORKGROUP); lr1_ = __hip_atomic_fetch_add((int*)hist + ex1, 1, __ATOMIC_RELAXED, __HIP_MEMORY_SCOPE_WORKGROUP);
    }
    asm volatile("s_waitcnt lgkmcnt(0)" ::: "memory");
    __syncthreads();
    if (threadIdx.x < N_EXP) { const int c_ = hist[threadIdx.x]; hist[32 + threadIdx.x] = c_ ? atomicAdd(&cnt[threadIdx.x], c_) : 0; }
    __syncthreads();
    if (lane < 16) { const int t = t0 + lane;
        const int p0 = hist[32 + ex0_] + lr0_, p1 = hist[32 + ex1_] + lr1_;
        LIST[(size_t)ex0_ * T + p0] = 2 * t; LIST[(size_t)ex1_ * T + p1] = 2 * t + 1;
        RSL[(size_t)ex0_ * T + p0] = rs_; RSL[(size_t)ex1_ * T + p1] = rs_;
        POSR[2 * t] = (ex0_ << 20) | p0; POSR[2 * t + 1] = (ex1_ << 20) | p1; }
}
}

template <int ROWMAP>
__device__ __forceinline__ int wt_rowmap(int n) {
    if (ROWMAP == 1) {
        if (n >= 1024 && n < 2048) { const int sec = (n - 1024) >> 9, cc = (n - 1024) & 511, h = cc >> 6, d = cc & 63;
            return 1024 + sec * 512 + (h >> 2) * 256 + 128 * (d >> 5) + 32 * (h & 3) + (d & 31); }
    }
    if (ROWMAP == 2) return 256 * (n >> 7) + (n & 127);
    if (ROWMAP == 3) return 256 * (n >> 7) + 128 + (n & 127);
    return n;
}
template <int ROWMAP, bool GAIN>
__device__ __forceinline__ void p0_transpose_item(const float* __restrict__ W, int ldw, int K, int N, bf16_t* __restrict__ WT, LAS unsigned* scr  , int item, int lane,
                                                  const float* __restrict__ g0, const float* __restrict__ g1, int ksplit) {
    const int nblk = N / 64, kb = item / nblk, nb = item % nblk, k0 = 128 * kb, n0 = 64 * nb;
    const int kp = lane >> 4, nq = lane & 15;
    const float* wp = W + (size_t)(k0 + 2 * kp) * ldw + n0 + 4 * nq;
#pragma unroll
    for (int hb = 0; hb < 2; ++hb) {
        f32x4 av[8], bv[8];
#pragma unroll
        for (int i = 0; i < 8; ++i) { const int it = 8 * hb + i; av[i] = *(const f32x4*)(wp + (size_t)(8 * it) * ldw); bv[i] = *(const f32x4*)(wp + (size_t)(8 * it + 1) * ldw); }
        asm volatile("" ::: "memory");
#pragma unroll
        for (int i = 0; i < 8; ++i) { const int it = 8 * hb + i; f32x4 a = av[i], b = bv[i];
            if (GAIN) { const int k = k0 + 8 * it + 2 * kp; const float* gp = (k0 < ksplit) ? g0 + k : g1 + (k - ksplit); a *= gp[0]; b *= gp[1]; }
            LAS unsigned* d = scr + (4 * nq) * 68 + 4 * it + kp;
            d[0] = pg8::cvt_pk_bf16(a[0], b[0]); d[68] = pg8::cvt_pk_bf16(a[1], b[1]); d[136] = pg8::cvt_pk_bf16(a[2], b[2]); d[204] = pg8::cvt_pk_bf16(a[3], b[3]); }
    }
    asm volatile("s_waitcnt lgkmcnt(0)" ::: "memory");
#pragma unroll 4
    for (int j = 0; j < 16; ++j) { const int n = (lane >> 4) + 4 * j, c = lane & 15;
        const pg8::u32x4 o = *(const LAS pg8::u32x4*)(scr + n * 68 + 4 * c);
        *(pg8::u32x4*)(WT + (size_t)wt_rowmap<ROWMAP>(n0 + n) * K + k0 + 8 * c) = o; }
    asm volatile("s_waitcnt lgkmcnt(0)" ::: "memory");
}


__device__ __forceinline__ float clampq(float v) { return __builtin_amdgcn_fmed3f(v, -448.f, 448.f); }
template <int ROWMAP, bool GAIN>
__device__ __forceinline__ void p0_transpose_item_q(const float* __restrict__ W, int ldw, int K, int N, unsigned char* __restrict__ WQ, LAS unsigned char* scr, int item, int lane, const float* __restrict__ g0) {
    const int nblk = N / 64, kb = item / nblk, nb = item % nblk, k0 = 128 * kb, n0 = 64 * nb;
    const int kp = lane >> 4, nq = lane & 15;
    const float* wp = W + (size_t)(k0 + 8 * kp) * ldw + n0 + 4 * nq;
#pragma unroll
    for (int hb = 0; hb < 2; ++hb) {
        f32x4 v[2][8];
#pragma unroll
        for (int jj = 0; jj < 2; ++jj)
#pragma unroll
            for (int r = 0; r < 8; ++r) v[jj][r] = *(const f32x4*)(wp + (size_t)(32 * (2 * hb + jj) + r) * ldw);
        asm volatile("" ::: "memory");
#pragma unroll
        for (int jj = 0; jj < 2; ++jj) { const int j = 2 * hb + jj;
            f32x4 g0v = {32.f, 32.f, 32.f, 32.f}, g1v = g0v;
            if (GAIN) { const float* gp = g0 + k0 + 32 * j + 8 * kp; g0v *= *(const f32x4*)gp; g1v *= *(const f32x4*)(gp + 4); }
#pragma unroll
            for (int e = 0; e < 4; ++e) {
                int w0 = 0, w1 = 0;
                w0 = __builtin_amdgcn_cvt_pk_fp8_f32(clampq(v[jj][0][e] * g0v[0]), clampq(v[jj][1][e] * g0v[1]), w0, false); w0 = __builtin_amdgcn_cvt_pk_fp8_f32(clampq(v[jj][2][e] * g0v[2]), clampq(v[jj][3][e] * g0v[3]), w0, true);
                w1 = __builtin_amdgcn_cvt_pk_fp8_f32(clampq(v[jj][4][e] * g1v[0]), clampq(v[jj][5][e] * g1v[1]), w1, false); w1 = __builtin_amdgcn_cvt_pk_fp8_f32(clampq(v[jj][6][e] * g1v[2]), clampq(v[jj][7][e] * g1v[3]), w1, true);
                pg8::u32x2 w; w.x = (unsigned)w0; w.y = (unsigned)w1;
                *(LAS pg8::u32x2*)(scr + (4 * nq + e) * 144 + 32 * j + 8 * kp) = w; }
        }
    }
    asm volatile("s_waitcnt lgkmcnt(0)" ::: "memory");
#pragma unroll 4
    for (int j = 0; j < 8; ++j) { const int n = (lane >> 3) + 8 * j, c = lane & 7;
        const pg8::u32x4 o = *(const LAS pg8::u32x4*)(scr + n * 144 + 16 * c);
        *(pg8::u32x4*)(WQ + (size_t)wt_rowmap<ROWMAP>(n0 + n) * K + k0 + 16 * c) = o; }
    asm volatile("s_waitcnt lgkmcnt(0)" ::: "memory");
}

namespace fox {
using bf16 = unsigned short;
using s16x4 = __attribute__((ext_vector_type(4))) short;
using u32x4 = __attribute__((ext_vector_type(4))) unsigned;
constexpr int NHEAD = FOX_H, D = 64, DMP = 512;
constexpr int NW = 8, QBLK = 32, QB = QBLK * NW, KVBLK = 64, NQB = SEQ / QB;
#define SBAR() __builtin_amdgcn_sched_barrier(0)
__device__ __forceinline__ void cmask(f32x16& p0, f32x16& p1, int jb, int qrel, int hi) {
  const float NEG = -INFINITY; int kb = 64 * jb + 4 * hi;
  #pragma unroll
  for (int r = 0; r < 16; ++r) { int kv = kb + (r & 3) + 8 * (r >> 2); if (kv > qrel) p0[r] = NEG; if (kv + 32 > qrel) p1[r] = NEG; }
}
constexpr int NSLOT = 3, SLOTB = 8192;
constexpr int LDS_K = 0, LDS_V = NSLOT * SLOTB, LDS_WS = 2 * NSLOT * SLOTB, LDS_OST = LDS_WS + NW * 64 * 4, LDS_BIAS = LDS_OST + NW * 4096, LDS_BYTES = LDS_BIAS + (SEQ + 64) * 4;
__device__ __forceinline__ void glds16(const void* gsrc, unsigned lds_dst) { unsigned keep;
  asm volatile("s_mov_b32 %0, m0\n\ts_mov_b32 m0, %2\n\ts_nop 0\n\tglobal_load_lds_dwordx4 %1, off\n\ts_mov_b32 m0, %0" : "=&s"(keep) : "v"(gsrc), "s"(lds_dst) : "memory"); }
__device__ __forceinline__ float max3f(float a, float b, float c) { float r; asm("v_max3_f32 %0, %1, %2, %3" : "=v"(r) : "v"(a), "v"(b), "v"(c)); return r; }
__device__ __forceinline__ float max2f(float a, float b) { float r; asm("v_max_f32_e32 %0, %1, %2" : "=v"(r) : "v"(a), "v"(b)); return r; }
__device__ __forceinline__ float fadd_s(float a, float b) { float r; asm("v_add_f32_e32 %0, %1, %2" : "=v"(r) : "v"(a), "v"(b)); return r; }
__device__ __forceinline__ float fsub_s(float a, float b) { float r; asm("v_sub_f32_e32 %0, %1, %2" : "=v"(r) : "v"(a), "v"(b)); return r; }
typedef float f32x2_t __attribute__((ext_vector_type(2))); typedef __bf16 bf16x2_t __attribute__((ext_vector_type(2)));
__device__ __forceinline__ unsigned cvtpk_s(float lo, float hi) { f32x2_t v = {lo, hi}; bf16x2_t b = __builtin_convertvector(v, bf16x2_t); return __builtin_bit_cast(unsigned, b); }
#define WAIT_BAR(N) asm volatile("s_waitcnt vmcnt(" #N ") lgkmcnt(0)\n\ts_barrier" ::: "memory")
typedef __attribute__((address_space(3))) const char* lds_cptr;
typedef short v4i16_t __attribute__((ext_vector_type(4)));
__device__ __forceinline__ void qkt(f32x16& p0, f32x16& p1, const char* Kslot, const bf16x8* qr, int r32, int hi) {
  const char* kb = Kslot + hi * 1024 + r32 * 16;
  #pragma unroll
  for (int d0 = 0; d0 < 4; ++d0) {
    const bf16x8 b0 = *reinterpret_cast<const bf16x8*>(kb + d0 * 2048);
    const bf16x8 b1 = *reinterpret_cast<const bf16x8*>(kb + d0 * 2048 + 512);
    p0 = __builtin_amdgcn_mfma_f32_32x32x16_bf16(b0, qr[d0], p0, 0, 0, 0); p1 = __builtin_amdgcn_mfma_f32_32x32x16_bf16(b1, qr[d0], p1, 0, 0, 0); }
}
__device__ __forceinline__ void kload8(bf16x8* kf, lds_cptr kp) {
  kf[0] = *(const LAS bf16x8*)(kp);        kf[1] = *(const LAS bf16x8*)(kp + 512);
  kf[2] = *(const LAS bf16x8*)(kp + 2048); kf[3] = *(const LAS bf16x8*)(kp + 2560);
  kf[4] = *(const LAS bf16x8*)(kp + 4096); kf[5] = *(const LAS bf16x8*)(kp + 4608);
  kf[6] = *(const LAS bf16x8*)(kp + 6144); kf[7] = *(const LAS bf16x8*)(kp + 6656);
}
__device__ __forceinline__ void kload2(bf16x8* kf, lds_cptr kp, int j) { kf[2 * j] = *(const LAS bf16x8*)(kp + j * 2048); kf[2 * j + 1] = *(const LAS bf16x8*)(kp + j * 2048 + 512); }
__device__ __forceinline__ s16x4 vtr(lds_cptr p) { return __builtin_bit_cast(s16x4, __builtin_amdgcn_ds_read_tr16_b64_v4i16((LAS v4i16_t*)p)); }
__device__ __forceinline__ float rowmax(const f32x16& p0, const f32x16& p1) {
  float a = max3f(p0[0], p0[1], p1[0]), b = max3f(p0[2], p0[3], p1[1]); a = max3f(a, p1[2], p1[3]);
  #pragma unroll
  for (int r = 4; r < 16; r += 4) { a = max3f(a, p0[r], p0[r + 1]); b = max3f(b, p0[r + 2], p0[r + 3]); a = max3f(a, p1[r], p1[r + 1]); b = max3f(b, p1[r + 2], p1[r + 3]); }
  const float m = max2f(a, b);
  auto rr = __builtin_amdgcn_permlane32_swap(__float_as_uint(m), __float_as_uint(m), false, false);
  return max2f(__uint_as_float(rr[0]), __uint_as_float(rr[1]));
}
__device__ __forceinline__ void pv(f32x16* o, int vb, bf16x8 pa0, bf16x8 pa1, bf16x8 pa2, bf16x8 pa3) {
  #pragma unroll
  for (int d0 = 0; d0 < 2; ++d0) { s16x4 lo[4], hi[4];
    #pragma unroll
    for (int ks = 0; ks < 4; ++ks) {
      asm volatile("ds_read_b64_tr_b16 %0,%1 offset:%c2" : "=&v"(lo[ks]) : "v"(vb), "i"(d0 * 4096 + ks * 1024) : "memory");
      asm volatile("ds_read_b64_tr_b16 %0,%1 offset:%c2" : "=&v"(hi[ks]) : "v"(vb), "i"(d0 * 4096 + ks * 1024 + 512) : "memory"); }
    asm volatile("s_waitcnt lgkmcnt(0)" ::: "memory"); SBAR();
    #define PK(k) (bf16x8){lo[k][0], lo[k][1], lo[k][2], lo[k][3], hi[k][0], hi[k][1], hi[k][2], hi[k][3]}
    o[d0] = __builtin_amdgcn_mfma_f32_32x32x16_bf16(pa0, PK(0), o[d0], 0, 0, 0);
    o[d0] = __builtin_amdgcn_mfma_f32_32x32x16_bf16(pa1, PK(1), o[d0], 0, 0, 0);
    o[d0] = __builtin_amdgcn_mfma_f32_32x32x16_bf16(pa2, PK(2), o[d0], 0, 0, 0);
    o[d0] = __builtin_amdgcn_mfma_f32_32x32x16_bf16(pa3, PK(3), o[d0], 0, 0, 0);
    #undef PK
  }
}
#define BLD(X0, X1, bp) do { _Pragma("unroll") for (int g_ = 0; g_ < 4; ++g_) { const f32x4 b0_ = *(const LAS f32x4*)((bp) + 32 * g_), b1_ = *(const LAS f32x4*)((bp) + 128 + 32 * g_); \
    X0[4 * g_] = b0_[0]; X0[4 * g_ + 1] = b0_[1]; X0[4 * g_ + 2] = b0_[2]; X0[4 * g_ + 3] = b0_[3]; X1[4 * g_] = b1_[0]; X1[4 * g_ + 1] = b1_[1]; X1[4 * g_ + 2] = b1_[2]; X1[4 * g_ + 3] = b1_[3]; } } while (0)

template <int THRL> __device__ __forceinline__ void attn_unit(int b, int h, int qb, const bf16* Q, const bf16* __restrict__ K, const bf16* __restrict__ V, bf16* O, const float* __restrict__ CUM, float* __restrict__ SSF, char* shm) {
  int tid = threadIdx.x; asm volatile("" : "+v"(tid));
  const int lane = tid & 63, r32 = lane & 31, hi = lane >> 5; const int wid = __builtin_amdgcn_readfirstlane(tid >> 6);
  const long rowbase = (long)b * SEQ; const int q0 = qb * QB;
  const bf16* Qw = Q + (rowbase + q0 + wid * QBLK) * DMP + h * D;
  const float* cbs = CUM + ((long)b * NHEAD + h) * SEQ;
  int t_start = 0;
  { const int ntile = (q0 + QB) / KVBLK; const float cq = cbs[q0]; const float ce = cbs[(lane < ntile ? lane : ntile - 1) * KVBLK + KVBLK - 1];
    const unsigned long long keep = __ballot(lane < ntile && (cq - ce >= -64.0f));
    t_start = keep ? (int)__builtin_ctzll(keep) : 0; t_start &= ~1; if (t_start > ntile - 4) t_start = ntile - 4;
    t_start = __builtin_amdgcn_readfirstlane(t_start); }
  const int skip_rows = t_start * KVBLK;
  const bf16 *Kh = K + (rowbase + skip_rows) * DMP + h * D, *Vh = V + (rowbase + skip_rows) * DMP + h * D;
  const unsigned lds0 = (unsigned)(uintptr_t)shm;
  float* wsf = (float*)(shm + LDS_WS) + wid * 64;
  const bf16* ksrc = Kh + (long)lane * DMP + wid * 8;
  const bf16* vsrc = Vh + (long)(16 * (wid & 3) + (lane >> 2)) * DMP + (wid >> 2) * 32 + (lane & 3) * 8;
  const unsigned kdst = lds0 + LDS_K + wid * 1024, vdst = lds0 + LDS_V + wid * 1024;
  #define DMA_K(t, slot) glds16(ksrc + (long)(t) * KVBLK * DMP, (unsigned)__builtin_amdgcn_readfirstlane(kdst + (slot)))
  #define DMA_V(t, slot) glds16(vsrc + (long)(t) * KVBLK * DMP, (unsigned)__builtin_amdgcn_readfirstlane(vdst + (slot)))
  const int vb0 = (int)(lds0 + LDS_V) + ((lane >> 4) & 1) * 32 + (lane & 3) * 8 + (4 * hi + ((lane & 15) >> 2)) * 64;
  const char* Kbase = shm + LDS_K; bf16x8 kf[8];
  const lds_cptr shm3 = (lds_cptr)shm; const lds_cptr kp0 = shm3 + LDS_K + hi * 1024 + r32 * 16; const lds_cptr vp0 = shm3 + LDS_V + ((lane >> 4) & 1) * 32 + (lane & 3) * 8 + (4 * hi + ((lane & 15) >> 2)) * 64;
  const lds_cptr bp0 = shm3 + LDS_BIAS + hi * 16;
  const int NT = (q0 + QB) / KVBLK - t_start;
  DMA_K(0, 0); DMA_V(0, 0); DMA_K(1, SLOTB);
  {
    const float* cb = cbs + skip_rows; const float cref = cbs[q0 + QB - 1]; const int nkeys = q0 + QB - skip_rows;
    LAS float* bl = (LAS float*)(shm3 + LDS_BIAS);
    float cv[SEQ / (NW * 64)];
    #pragma unroll
    for (int i = 0; i < SEQ / (NW * 64); ++i) { const int j = tid + i * NW * 64; cv[i] = cb[j < nkeys ? j : 0]; }
    #pragma unroll
    for (int i = 0; i < SEQ / (NW * 64); ++i) { const int j = tid + i * NW * 64; if (j < nkeys) bl[j] = cref - cv[i]; }
  }
  bf16x8 qr[4];
  #pragma unroll
  for (int d0 = 0; d0 < 4; ++d0) qr[d0] = *reinterpret_cast<const bf16x8*>(&Qw[(long)r32 * DMP + d0 * 16 + hi * 8]);
  float mhat = 0.f, l_reg = 0.f; f32x16 o[2]; o[0] = f32x16{}; o[1] = f32x16{};
  const int qrel = wid * QBLK + r32;
  #define CMASK(P0, P1, t) do { int jb_ = (t) - (NT - 4); if (jb_ >= 0) cmask(P0, P1, jb_, qrel, hi); } while (0)
  bool resc = false;
  #define START(P0, P1) do { const float rm = rowmax(P0, P1); resc = false; \
    { const float dl = rm; mhat = fadd_s(mhat, dl); \
      _Pragma("unroll") for (int r = 0; r < 16; ++r) { P0[r] = fsub_s(P0[r], dl); P1[r] = fsub_s(P1[r], dl); } } \
    _Pragma("unroll") for (int r = 0; r < 16; ++r) P0[r] = __builtin_amdgcn_exp2f(P0[r]); } while (0)
  #define RESC() do { if (resc) { asm volatile("s_waitcnt lgkmcnt(0)" ::: "memory"); \
      _Pragma("unroll") for (int d_ = 0; d_ < 2; ++d_) _Pragma("unroll") for (int r = 0; r < 16; ++r) o[d_][r] *= wsf[crow(r, hi)]; } } while (0)
  f32x16 pA0, pA1, pB0, pB1;
  int sl_prev = 0, sl_cur = 0, sl_next = SLOTB;
  #define ROT() do { sl_prev = sl_cur; sl_cur = sl_next; sl_next = (sl_next == (NSLOT - 1) * SLOTB) ? 0 : sl_next + SLOTB; } while (0)
  DMA_K(2, 2 * SLOTB);
  WAIT_BAR(3);
  BLD(pA0, pA1, bp0);
  qkt(pA0, pA1, Kbase, qr, r32, hi); asm volatile("s_nop 15\n\ts_nop 7" : "+v"(pA0), "+v"(pA1)); CMASK(pA0, pA1, 0);
  START(pA0, pA1);
  _Pragma("unroll") for (int r = 0; r < 16; ++r) pA1[r] = __builtin_amdgcn_exp2f(pA1[r]);
  BLD(pB0, pB1, bp0 + 256);
  _Pragma("unroll") for (int r = 0; r < 16; ++r) { pB0[r] = fsub_s(pB0[r], mhat); pB1[r] = fsub_s(pB1[r], mhat); }
  WAIT_BAR(0);
  DMA_K(3, 0); DMA_V(1, SLOTB);
  ROT();
  kload8(kf, kp0 + sl_cur);
  WAIT_BAR(2);
  s16x4 vlo[8], vhi[8]; u32x4 pw0, pw1, pw2, pw3;
  #define PKW(P, B) cvtpk_s(P[B], P[B + 1])
  #define PAF(k) __builtin_bit_cast(bf16x8, pw##k)
  #define VFR(i) (bf16x8){vlo[i][0], vlo[i][1], vlo[i][2], vlo[i][3], vhi[i][0], vhi[i][1], vhi[i][2], vhi[i][3]}
  #define PIN(x) asm volatile("" : "+v"(x))
  #define MX3(a, b, c) __builtin_fmaxf(__builtin_fmaxf((a), (b)), (c))
  #define GAPA(MF, A0, A1, A2, A3, W0, W1, PW) do { MF; sacc += A0; sacc += A1; sacc += A2; sacc += A3; PIN(sacc); W0; W1; PIN(PW); SBAR(); } while (0)
  #define EX(v) __builtin_amdgcn_exp2f(v)
  #define GAPB(MF, X, B, N, NB) do { MF; X[B] = EX(X[B]); X[B + 1] = EX(X[B + 1]); X[B + 2] = EX(X[B + 2]); X[B + 3] = EX(X[B + 3]); PIN(X); \
    N[NB] = fsub_s(N[NB], mhat); N[NB + 1] = fsub_s(N[NB + 1], mhat); N[NB + 2] = fsub_s(N[NB + 2], mhat); N[NB + 3] = fsub_s(N[NB + 3], mhat); PIN(N); SBAR(); } while (0)
  #define VRD(i) do { vlo[i] = vtr(vp_ + (((i) >> 2) * 4096 + ((i) & 3) * 1024)); vhi[i] = vtr(vp_ + (((i) >> 2) * 4096 + ((i) & 3) * 1024 + 512)); } while (0)
  #define KRD(G, j) do { if (G) { kload2(kf, kp0 + sl_next, j); SBAR(); } } while (0)
  #define STEP(C0, C1, P0, P1, t, GK, GV, GL) do { SBAR(); \
    const lds_cptr vp_ = vp0 + sl_prev; \
    VRD(0); SBAR(); float sacc = (P0[0] + P0[1]); \
    GAPA(C0 = __builtin_amdgcn_mfma_f32_32x32x16_bf16(kf[0], qr[0], C0, 0, 0, 0), P0[2], P0[3], P0[4], P0[5],     pw0[0] = PKW(P0, 0), pw0[1] = PKW(P0, 2), pw0); \
    VRD(4); SBAR(); GAPA(C1 = __builtin_amdgcn_mfma_f32_32x32x16_bf16(kf[1], qr[0], C1, 0, 0, 0), P0[6], P0[7], P0[8], P0[9],     pw0[2] = PKW(P0, 4), pw0[3] = PKW(P0, 6), pw0); \
    VRD(1); SBAR(); GAPA(C0 = __builtin_amdgcn_mfma_f32_32x32x16_bf16(kf[2], qr[1], C0, 0, 0, 0),   P0[10], P0[11], P0[12], P0[13], pw1[0] = PKW(P0, 8), pw1[1] = PKW(P0, 10), pw1); \
    VRD(5); SBAR(); GAPA(C1 = __builtin_amdgcn_mfma_f32_32x32x16_bf16(kf[3], qr[1], C1, 0, 0, 0),   P0[14], P0[15], P1[0], P1[1],   pw1[2] = PKW(P0, 12), pw1[3] = PKW(P0, 14), pw1); \
    VRD(2); SBAR(); GAPA(C0 = __builtin_amdgcn_mfma_f32_32x32x16_bf16(kf[4], qr[2], C0, 0, 0, 0),   P1[2], P1[3], P1[4], P1[5],     pw2[0] = PKW(P1, 0), pw2[1] = PKW(P1, 2), pw2); \
    VRD(6); SBAR(); GAPA(C1 = __builtin_amdgcn_mfma_f32_32x32x16_bf16(kf[5], qr[2], C1, 0, 0, 0),   P1[6], P1[7], P1[8], P1[9],     pw2[2] = PKW(P1, 4), pw2[3] = PKW(P1, 6), pw2); \
    VRD(3); SBAR(); GAPA(C0 = __builtin_amdgcn_mfma_f32_32x32x16_bf16(kf[6], qr[3], C0, 0, 0, 0),   P1[10], P1[11], P1[12], P1[13], pw3[0] = PKW(P1, 8), pw3[1] = PKW(P1, 10), pw3); \
    VRD(7); SBAR(); GAPA(C1 = __builtin_amdgcn_mfma_f32_32x32x16_bf16(kf[7], qr[3], C1, 0, 0, 0),   P1[14], P1[15], 0.f, 0.f,       pw3[2] = PKW(P1, 12), pw3[3] = PKW(P1, 14), pw3); \
    l_reg += sacc; \
    if (GK) { DMA_K((t) + 3, sl_cur); } if (GV) { DMA_V((t) + 1, sl_next); } \
    CMASK(C0, C1, t); \
    { float a = MX3(C0[0], C0[1], C1[0]), b = MX3(C0[2], C0[3], C1[1]); a = MX3(a, C1[2], C1[3]); \
      _Pragma("unroll") for (int r = 4; r < 16; r += 4) { a = MX3(a, C0[r], C0[r + 1]); b = MX3(b, C0[r + 2], C0[r + 3]); a = MX3(a, C1[r], C1[r + 1]); b = MX3(b, C1[r + 2], C1[r + 3]); } \
      float rm = __builtin_fmaxf(a, b); { auto rr = __builtin_amdgcn_permlane32_swap(__float_as_uint(rm), __float_as_uint(rm), false, false); rm = __builtin_fmaxf(__uint_as_float(rr[0]), __uint_as_float(rr[1])); } \
      resc = false; \
      if (__builtin_expect(__any(rm > (float)THRL), 0)) { const float dl = __builtin_fmaxf(rm, 0.f); mhat += dl; \
        _Pragma("unroll") for (int r = 0; r < 16; ++r) { C0[r] -= dl; C1[r] -= dl; } \
        const float f = __builtin_amdgcn_exp2f(-dl); l_reg *= f; if (hi == 0) wsf[r32] = f; resc = true; } } \
    SBAR(); \
    BLD(P0, P1, bp0 + ((t) + 1) * 256); SBAR(); \
    GAPB(o[0] = __builtin_amdgcn_mfma_f32_32x32x16_bf16(PAF(0), VFR(0), o[0], 0, 0, 0), C0, 0, P0, 0); \
    GAPB(o[1] = __builtin_amdgcn_mfma_f32_32x32x16_bf16(PAF(0), VFR(4), o[1], 0, 0, 0), C0, 4, P0, 4); \
    KRD(GL, 0); GAPB(o[0] = __builtin_amdgcn_mfma_f32_32x32x16_bf16(PAF(1), VFR(1), o[0], 0, 0, 0), C0, 8, P0, 8); \
    KRD(GL, 1); GAPB(o[1] = __builtin_amdgcn_mfma_f32_32x32x16_bf16(PAF(1), VFR(5), o[1], 0, 0, 0), C0, 12, P0, 12); \
    KRD(GL, 2); GAPB(o[0] = __builtin_amdgcn_mfma_f32_32x32x16_bf16(PAF(2), VFR(2), o[0], 0, 0, 0), C1, 0, P1, 0); \
    KRD(GL, 3); GAPB(o[1] = __builtin_amdgcn_mfma_f32_32x32x16_bf16(PAF(2), VFR(6), o[1], 0, 0, 0), C1, 4, P1, 4); \
    GAPB(o[0] = __builtin_amdgcn_mfma_f32_32x32x16_bf16(PAF(3), VFR(3), o[0], 0, 0, 0), C1, 8, P1, 8); \
    GAPB(o[1] = __builtin_amdgcn_mfma_f32_32x32x16_bf16(PAF(3), VFR(7), o[1], 0, 0, 0), C1, 12, P1, 12); \
    } while (0)
  int t = 1;
  #undef CMASK
  #define CMASK(P0, P1, t) do {} while (0)
  for (; t + 5 < NT; t += 2) {
    STEP(pB0, pB1, pA0, pA1, t, true, true, true);     WAIT_BAR(2); RESC(); ROT();
    STEP(pA0, pA1, pB0, pB1, t + 1, true, true, true);   WAIT_BAR(2); RESC(); ROT();
  }
  #undef CMASK
  #define CMASK(P0, P1, t) do { int jb_ = (t) - (NT - 4); if (jb_ >= 0) cmask(P0, P1, jb_, qrel, hi); } while (0)
  #define ENDW(tt) do { if ((tt) + 3 < NT) { WAIT_BAR(2); } else if ((tt) + 2 < NT) { WAIT_BAR(1); } else { WAIT_BAR(0); } } while (0)
  for (; t + 1 < NT; t += 2) {
    STEP(pB0, pB1, pA0, pA1, t, (t + 3 < NT), (t + 1 < NT), (t + 1 < NT));       ENDW(t);   RESC(); ROT();
    STEP(pA0, pA1, pB0, pB1, t + 1, (t + 4 < NT), (t + 2 < NT), (t + 2 < NT));     ENDW(t + 1); RESC(); ROT();
  }
  STEP(pB0, pB1, pA0, pA1, NT - 1, false, false, false); RESC();
  { float sacc = pB0[0] + pB0[1]; _Pragma("unroll") for (int r = 2; r < 16; ++r) sacc += pB0[r]; _Pragma("unroll") for (int r = 0; r < 16; ++r) sacc += pB1[r]; l_reg += sacc;
    pw0 = (u32x4){PKW(pB0, 0), PKW(pB0, 2), PKW(pB0, 4), PKW(pB0, 6)}; pw1 = (u32x4){PKW(pB0, 8), PKW(pB0, 10), PKW(pB0, 12), PKW(pB0, 14)}; pw2 = (u32x4){PKW(pB1, 0), PKW(pB1, 2), PKW(pB1, 4), PKW(pB1, 6)}; pw3 = (u32x4){PKW(pB1, 8), PKW(pB1, 10), PKW(pB1, 12), PKW(pB1, 14)};
    SBAR(); pv(o, vb0 + sl_cur, PAF(0), PAF(1), PAF(2), PAF(3)); }
  #undef PKW
  #undef PAF
  #undef VFR
  #undef PIN
  #undef MX3
  #undef GAPA
  #undef GAPB
  #undef EX
  #undef VRD
  #undef KRD
  #undef STEP
  #undef ENDW
  { auto rr = __builtin_amdgcn_permlane32_swap(__float_as_uint(l_reg), __float_as_uint(l_reg), false, false); l_reg = __uint_as_float(rr[0]) + __uint_as_float(rr[1]); }
  if (hi == 0) wsf[32 + r32] = l_reg; asm volatile("s_waitcnt lgkmcnt(0)" ::: "memory");
  float rli[16];
  #pragma unroll
  for (int r = 0; r < 16; ++r) rli[r] = __builtin_amdgcn_rcpf(wsf[32 + crow(r, hi)]);
  bf16* Ow = O + (rowbase + q0 + wid * QBLK) * DMP + h * D;
  { bf16* stg = (bf16*)(shm + LDS_OST) + wid * 2048;
    #pragma unroll
    for (int r = 0; r < 16; ++r) { const int orow = crow(r, hi);
      #pragma unroll
      for (int d0 = 0; d0 < 2; ++d0) stg[orow * 64 + d0 * 32 + r32] = f2bf(o[d0][r] * rli[r]); }
    asm volatile("s_waitcnt lgkmcnt(0)" ::: "memory");
    #pragma unroll
    for (int i = 0; i < 4; ++i) { const int row = i * 8 + (lane >> 3), ch = lane & 7; const u32x4 v = *(const u32x4*)(stg + row * 64 + ch * 8); *(u32x4*)(Ow + (long)row * DMP + ch * 8) = v;
      float ss = 0.f;
      #pragma unroll
      for (int j = 0; j < 4; ++j) { const float lo = __uint_as_float(v[j] << 16), hi_ = __uint_as_float(v[j] & 0xffff0000u); ss += lo * lo + hi_ * hi_; }
      ss += __shfl_xor(ss, 1); ss += __shfl_xor(ss, 2); ss += __shfl_xor(ss, 4);
      if (ch == 0) SSF[(rowbase + q0 + wid * QBLK + row) * 8 + h] = ss; } }
  asm volatile("s_waitcnt lgkmcnt(0)\n\ts_barrier" ::: "memory");
  #undef DMA_K
  #undef DMA_V
  #undef CMASK
  #undef START
  #undef RESC
  #undef ROT
}
struct ConvArgs { const float *w_gate, *w_up, *w_down, *g; unsigned char *WT_GU, *WT_D; };
template <int THRL> __device__ __forceinline__ void attn_phase(char* lds, const bf16* Q, const bf16* K, const bf16* V, bf16* O, const float* CUM, float* SSF, int* counter, const ConvArgs cv) {
  LAS int* slot = (LAS int*)((LAS char*)lds + 140032);
  constexpr int NENT = NHEAD * NQB / 4 * 7;
  int nxt = 0;
  if (threadIdx.x == 0) nxt = atomicAdd(counter, 1);
  for (;;) {
    if (threadIdx.x == 0) *slot = nxt;
    __syncthreads();
    const int v = *slot;
    __syncthreads();
    if (v >= NENT) break;
    if (threadIdx.x == 0) nxt = atomicAdd(counter, 1);
    const int grp = v / 7, pos = v % 7;
    if (pos & 1) {
      const int chunk = (blockIdx.x & 7) * (NENT / 7 * 3) + grp * 3 + (pos >> 1);
      int tid = threadIdx.x; asm volatile("" : "+v"(tid));
      const int wave = __builtin_amdgcn_readfirstlane(tid >> 6), lane = tid & 63;
      const int it = chunk * 8 + wave, e = it / 192, q = it % 192;
      LAS unsigned char* scq = (LAS unsigned char*)lds + wave * 17408;
      if (q < 64) p0_transpose_item_q<2, true>(cv.w_gate + (size_t)e * DM * D_EXP, D_EXP, DM, D_EXP, cv.WT_GU + (size_t)e * 1024 * 1024, scq, q, lane, cv.g);
      else if (q < 128) p0_transpose_item_q<3, true>(cv.w_up + (size_t)e * DM * D_EXP, D_EXP, DM, D_EXP, cv.WT_GU + (size_t)e * 1024 * 1024, scq, q - 64, lane, cv.g);
      else p0_transpose_item_q<0, false>(cv.w_down + (size_t)e * D_EXP * DM, DM, D_EXP, DM, cv.WT_D + (size_t)e * 1024 * 512, scq, q - 128, lane, cv.g);
    } else {
      const int u = grp * 4 + (pos >> 1);
      const int qb = NQB - 1 - (u >> 3), bh = (blockIdx.x & 7) * NHEAD + (u & 7);
      attn_unit<THRL>(bh / NHEAD, bh % NHEAD, qb, Q, K, V, O, CUM, SSF, lds);
    }
  }
}
#undef SBAR
#undef WAIT_BAR
#undef BLD
}


namespace lru {
constexpr int CL = 128, NCH = SEQ / CL;
constexpr int WLDS = 16384;
typedef unsigned u32x4 __attribute__((ext_vector_type(4)));
template <bool PASS2>
__device__ __forceinline__ void unit(int b, int chunk, const bf16_t* __restrict__ U, const bf16_t* __restrict__ GATE, const float* __restrict__ conv_w, const float* __restrict__ conv_b,
                                     const bf16_t* __restrict__ LRUW, const float* __restrict__ ba, const float* __restrict__ bx, const float* __restrict__ a_param,
                                     float* __restrict__ SUMA, float* __restrict__ SUMH, bf16_t* __restrict__ YL, float* __restrict__ SSL, LAS unsigned char* ldsw, int w, int lane) {
    const int cl = lane & 31, hi = lane >> 5;
    LAS float* cp = (LAS float*)ldsw;
    LAS bf16_t* stg = (LAS bf16_t*)(ldsw + 2048);
    for (int i = lane; i < 320; i += 64) { const int tap = i >> 6, c = i & 63; cp[i] = (tap < 4) ? conv_w[tap * 512 + 64 * w + c] : conv_b[64 * w + c]; }
    { const int c = 64 * w + lane; cp[320 + lane] = ba[c]; cp[384 + lane] = bx[c];
      const float ap = -a_param[c]; const float sp = (ap > 20.f) ? ap : log1pf(__expf(ap)); cp[448 + lane] = -8.f * sp * LOG2E; }
    const u32x4* wf = (const u32x4*)LRUW + (size_t)w * 16 * 64 + lane;
    bf16x8 Bi[2];
#pragma unroll
    for (int q = 0; q < 2; ++q)
#pragma unroll
        for (int j = 0; j < 8; ++j) Bi[q][j] = (16 * q + 8 * hi + j == cl) ? (short)0x3F80 : (short)0;
    float h[2], atot[2];
#pragma unroll
    for (int n = 0; n < 2; ++n) { h[n] = 0.f; atot[n] = 1.f; }
    if (PASS2) {
#pragma unroll 1
        for (int c0 = 0; c0 < chunk; c0 += 8) {
            float sa[8][2], sh[8][2];
#pragma unroll
            for (int j = 0; j < 8; ++j)
#pragma unroll
                for (int n = 0; n < 2; ++n) { const bool ok = (c0 + j < chunk); const size_t o = ((size_t)(b * NCH + (ok ? c0 + j : 0))) * 512 + 64 * w + 32 * n + cl;
                    const float av = SUMA[o], hv = SUMH[o]; sa[j][n] = ok ? av : 1.f; sh[j][n] = ok ? hv : 0.f; }
#pragma unroll
            for (int j = 0; j < 8; ++j)
#pragma unroll
                for (int n = 0; n < 2; ++n) h[n] = sa[j][n] * h[n] + sh[j][n];
        }
    }
    asm volatile("s_waitcnt lgkmcnt(0)" ::: "memory");
    const int t0 = b * SEQ + chunk * CL;
    LAS unsigned char* ub0 = ldsw + 6144;
    const int dri = lane >> 3, dch = lane & 7;
#define LRU_DMA_U(tb_, buf_) do { _Pragma("unroll") for (int i_ = 0; i_ < 5; ++i_) { const int ri_ = 8 * i_ + dri; int gr_ = (tb_) - 3 + ri_; gr_ = gr_ < 0 ? 0 : (gr_ > T - 1 ? T - 1 : gr_); \
        __builtin_amdgcn_global_load_lds((const unsigned*)((const char*)U + (unsigned)((gr_ * 512 + 64 * w + 8 * (dch ^ (ri_ & 7))) * 2)), (LAS unsigned*)(ub0 + (buf_) * 5120 + i_ * 1024), 16, 0, 0); } } while (0)
#define LRU_DMA_G(tb_) do { _Pragma("unroll") for (int i_ = 0; i_ < 4; ++i_) \
        __builtin_amdgcn_global_load_lds((const unsigned*)((const char*)GATE + (unsigned)((((tb_) + 8 * i_ + dri) * 512 + 64 * w + 8 * dch) * 2)), (LAS unsigned*)(ldsw + 2048 + i_ * 1024), 16, 0, 0); } while (0)
    LRU_DMA_U(t0, 0);
#pragma unroll 1
    for (int mt = 0; mt < CL / 32; ++mt) {
        int tb = t0 + mt * 32; asm volatile("" : "+s"(tb));
        const int srow = chunk * CL + mt * 32 + cl;
        asm volatile("s_waitcnt vmcnt(0)" ::: "memory");
        if (mt + 1 < CL / 32) LRU_DMA_U(tb + 32, (mt + 1) & 1);
        if (PASS2) LRU_DMA_G(tb);
        const LAS unsigned char* ub = ub0 + (mt & 1) * 5120;
        bf16x8 af[4];
#pragma unroll
        for (int s_ = 0; s_ < 4; ++s_) {
            const int cc = 16 * s_ + 8 * hi;
            float xv[8];
            { const f32x4 b0 = *(const LAS f32x4*)(cp + 256 + cc), b1 = *(const LAS f32x4*)(cp + 256 + cc + 4);
              xv[0] = b0[0]; xv[1] = b0[1]; xv[2] = b0[2]; xv[3] = b0[3]; xv[4] = b1[0]; xv[5] = b1[1]; xv[6] = b1[2]; xv[7] = b1[3]; }
#pragma unroll
            for (int tap = 0; tap < 4; ++tap) {
                const bool inseq = (srow - 3 + tap >= 0);
                const int ri = cl + tap;
                u32x4 uu = *(const LAS u32x4*)(ub + ri * 128 + (((2 * s_ + hi) ^ (ri & 7)) << 4));
                if (!inseq) uu = (u32x4){0u, 0u, 0u, 0u};
                const f32x4 w0 = *(const LAS f32x4*)(cp + tap * 64 + cc), w1 = *(const LAS f32x4*)(cp + tap * 64 + cc + 4);
                xv[0] += w0[0] * __uint_as_float(uu[0] << 16); xv[1] += w0[1] * __uint_as_float(uu[0] & 0xffff0000u);
                xv[2] += w0[2] * __uint_as_float(uu[1] << 16); xv[3] += w0[3] * __uint_as_float(uu[1] & 0xffff0000u);
                xv[4] += w1[0] * __uint_as_float(uu[2] << 16); xv[5] += w1[1] * __uint_as_float(uu[2] & 0xffff0000u);
                xv[6] += w1[2] * __uint_as_float(uu[3] << 16); xv[7] += w1[3] * __uint_as_float(uu[3] & 0xffff0000u);
            }
            u32x4 pk; pk[0] = pg8::cvt_pk_bf16(xv[0], xv[1]); pk[1] = pg8::cvt_pk_bf16(xv[2], xv[3]); pk[2] = pg8::cvt_pk_bf16(xv[4], xv[5]); pk[3] = pg8::cvt_pk_bf16(xv[6], xv[7]);
            af[s_] = __builtin_bit_cast(bf16x8, pk);
            asm volatile("" ::: "memory"); __builtin_amdgcn_sched_barrier(0);
        }
#pragma unroll
        for (int n = 0; n < 2; ++n) {
            f32x16 rCn, iCn, xCn;
#pragma unroll
            for (int r = 0; r < 16; ++r) { rCn[r] = cp[320 + 32 * n + cl]; iCn[r] = cp[384 + 32 * n + cl]; xCn[r] = 0.f; }
            const float c1n = cp[448 + 32 * n + cl];
#pragma unroll
            for (int s_ = 0; s_ < 4; ++s_) {
                const bf16x8 fa = __builtin_bit_cast(bf16x8, wf[(n * 4 + s_) * 64]), fx = __builtin_bit_cast(bf16x8, wf[(8 + n * 4 + s_) * 64]);
                rCn = __builtin_amdgcn_mfma_f32_32x32x16_bf16(af[s_], fa, rCn, 0, 0, 0);
                iCn = __builtin_amdgcn_mfma_f32_32x32x16_bf16(af[s_], fx, iCn, 0, 0, 0);
                if ((s_ >> 1) == n) xCn = __builtin_amdgcn_mfma_f32_32x32x16_bf16(af[s_], Bi[s_ & 1], xCn, 0, 0, 0);
            }
#pragma unroll
            for (int r = 0; r < 16; ++r) {
                const float rr = __builtin_amdgcn_rcpf(1.f + __builtin_amdgcn_exp2f(-LOG2E * rCn[r]));
                const float ii = __builtin_amdgcn_rcpf(1.f + __builtin_amdgcn_exp2f(-LOG2E * iCn[r]));
                const float a = __builtin_amdgcn_exp2f(c1n * rr);
                const float mult = __builtin_amdgcn_sqrtf(fmaxf(1.f - a * a, 0.f));
                rCn[r] = a; iCn[r] = mult * (ii * xCn[r]);
                if ((r & 3) == 3) __builtin_amdgcn_sched_barrier(0);
            }
            float Ao[4], Bo[4], Ap[4], Bp[4];
#pragma unroll
            for (int g = 0; g < 4; ++g) { float A = rCn[4 * g], B = iCn[4 * g];
#pragma unroll
                for (int k = 1; k < 4; ++k) { B = rCn[4 * g + k] * B + iCn[4 * g + k]; A *= rCn[4 * g + k]; }
                Ao[g] = A; Bo[g] = B; Ap[g] = __shfl_xor(A, 32); Bp[g] = __shfl_xor(B, 32); }
            float hh = h[n], at = atot[n];
#pragma unroll
            for (int g = 0; g < 4; ++g) {
                const float A1 = hi ? Ap[g] : Ao[g], B1 = hi ? Bp[g] : Bo[g], A2 = hi ? Ao[g] : Ap[g], B2 = hi ? Bo[g] : Bp[g];
                const float h1 = A1 * hh + B1, h2 = A2 * h1 + B2;
                float hr = hi ? h1 : hh;
                at *= A1 * A2; hh = h2;
                if (PASS2) {
#pragma unroll
                    for (int k = 0; k < 4; ++k) { hr = rCn[4 * g + k] * hr + iCn[4 * g + k]; iCn[4 * g + k] = hr; }
                }
            }
            h[n] = hh; atot[n] = at;
            if (PASS2) {
                if (n == 0) asm volatile("s_waitcnt vmcnt(0)" ::: "memory");
#pragma unroll
                for (int r = 0; r < 16; ++r) {
                    const int tok = crow(r, hi);
                    const float gx = bf2f(stg[tok * 64 + 32 * n + cl]);
                    const float uq = 0.7978845608028654f * (gx + 0.044715f * gx * gx * gx);
                    const float th = 1.f - 2.f * __builtin_amdgcn_rcpf(1.f + __builtin_amdgcn_exp2f(2.f * LOG2E * uq));
                    stg[tok * 64 + 32 * n + cl] = f2bf(iCn[r] * (0.5f * gx * (1.f + th)));
                    if ((r & 3) == 3) __builtin_amdgcn_sched_barrier(0);
                }
            }
        }
        if (PASS2) {
            asm volatile("s_waitcnt lgkmcnt(0)" ::: "memory");
#pragma unroll
            for (int i = 0; i < 4; ++i) { const int row = i * 8 + (lane >> 3), ch = lane & 7; const u32x4 v = *(const LAS u32x4*)(stg + row * 64 + ch * 8);
                *(u32x4*)((char*)YL + (unsigned)(((tb + row) * 512 + 64 * w + ch * 8) * 2)) = v;
                float ss = 0.f;
#pragma unroll
                for (int j = 0; j < 4; ++j) { const float lo = __uint_as_float(v[j] << 16), hi_ = __uint_as_float(v[j] & 0xffff0000u); ss += lo * lo + hi_ * hi_; }
                ss += __shfl_xor(ss, 1); ss += __shfl_xor(ss, 2); ss += __shfl_xor(ss, 4);
                if (ch == 0) SSL[(size_t)(tb + row) * 8 + w] = ss; }
            asm volatile("s_waitcnt lgkmcnt(0)" ::: "memory");
        }
    }
    if (!PASS2) {
        if (hi == 0) {
#pragma unroll
            for (int n = 0; n < 2; ++n) { const size_t o = ((size_t)(b * NCH + chunk)) * 512 + 64 * w + 32 * n + cl; SUMA[o] = atot[n]; SUMH[o] = h[n]; }
        }
    }
}
#undef LRU_DMA_U
#undef LRU_DMA_G
}


namespace xat {
constexpr int KS_BYTES = MEM_LEN * 256, VT_STRIDE = 520, VT_BYTES = MEM_D * VT_STRIDE, LDS_NEED = KS_BYTES + VT_BYTES;
typedef unsigned u32x4 __attribute__((ext_vector_type(4)));
typedef unsigned u32x2 __attribute__((ext_vector_type(2)));
__device__ __forceinline__ void item(int b, int h, int qhalf  , const bf16_t* __restrict__ QM, const bf16_t* __restrict__ KM, const bf16_t* __restrict__ VM, bf16_t* __restrict__ OM,
                                     const float* __restrict__ q_g, const float* __restrict__ k_g, LAS unsigned char* lds) {
    int tid = threadIdx.x; asm volatile("" : "+v"(tid));
    const int lane = tid & 63, wid = __builtin_amdgcn_readfirstlane(tid >> 6), r32 = lane & 31, hi = lane >> 5;
    LAS unsigned char* Ks = lds; LAS unsigned char* VT = lds + KS_BYTES;
    {
        const int ch = tid & 15, k0 = tid >> 4;
        const f32x4 g0 = *(const f32x4*)(k_g + 8 * ch), g1 = *(const f32x4*)(k_g + 8 * ch + 4);
#pragma unroll 2
        for (int p = 0; p < 8; ++p) {
            const int key = p * 32 + k0;
            const size_t goff = ((size_t)(b * MEM_LEN + key)) * 512 + h * MEM_D + 8 * ch;
            const u32x4 kk = *(const u32x4*)(KM + goff), vv = *(const u32x4*)(VM + goff);
            float f[8];
#pragma unroll
            for (int j = 0; j < 4; ++j) { f[2 * j] = __uint_as_float(kk[j] << 16); f[2 * j + 1] = __uint_as_float(kk[j] & 0xffff0000u); }
            float ss = 0.f;
#pragma unroll
            for (int j = 0; j < 8; ++j) ss += f[j] * f[j];
            ss += __shfl_xor(ss, 1); ss += __shfl_xor(ss, 2); ss += __shfl_xor(ss, 4); ss += __shfl_xor(ss, 8);
            const float rs = rsqrtf(ss * (1.f / MEM_D) + EPS);
            u32x4 o; o[0] = pg8::cvt_pk_bf16(f[0] * rs * g0[0], f[1] * rs * g0[1]); o[1] = pg8::cvt_pk_bf16(f[2] * rs * g0[2], f[3] * rs * g0[3]);
                     o[2] = pg8::cvt_pk_bf16(f[4] * rs * g1[0], f[5] * rs * g1[1]); o[3] = pg8::cvt_pk_bf16(f[6] * rs * g1[2], f[7] * rs * g1[3]);
            *(LAS u32x4*)(Ks + key * 256 + ((ch ^ (key & 15)) << 4)) = o;
#pragma unroll
            for (int j = 0; j < 4; ++j) { *(LAS bf16_t*)(VT + (8 * ch + 2 * j) * VT_STRIDE + key * 2) = (bf16_t)(vv[j] & 0xffffu); *(LAS bf16_t*)(VT + (8 * ch + 2 * j + 1) * VT_STRIDE + key * 2) = (bf16_t)(vv[j] >> 16); }
        }
    }
    __syncthreads();
#pragma unroll 1
    for (int qi = 0; qi < 2; ++qi) {
        const int q0 = qhalf * 512 + qi * 256 + wid * 32;
        const bf16_t* Qp = QM + ((size_t)(b * SEQ + q0 + r32)) * 512 + h * MEM_D + hi * 8;
        bf16x8 qf[8];
        {
            float ss = 0.f; u32x4 raw[8];
#pragma unroll
            for (int d0 = 0; d0 < 8; ++d0) { raw[d0] = *(const u32x4*)(Qp + d0 * 16);
#pragma unroll
                for (int j = 0; j < 4; ++j) { const float lo = __uint_as_float(raw[d0][j] << 16), hi_ = __uint_as_float(raw[d0][j] & 0xffff0000u); ss += lo * lo + hi_ * hi_; } }
            ss += __shfl_xor(ss, 32);
            const float rs = rsqrtf(ss * (1.f / MEM_D) + EPS) * (0.08838834764831845f * LOG2E);
#pragma unroll
            for (int d0 = 0; d0 < 8; ++d0) { const f32x4 g0 = *(const f32x4*)(q_g + 16 * d0 + 8 * hi), g1 = *(const f32x4*)(q_g + 16 * d0 + 8 * hi + 4);
                u32x4 o;
                o[0] = pg8::cvt_pk_bf16(__uint_as_float(raw[d0][0] << 16) * rs * g0[0], __uint_as_float(raw[d0][0] & 0xffff0000u) * rs * g0[1]);
                o[1] = pg8::cvt_pk_bf16(__uint_as_float(raw[d0][1] << 16) * rs * g0[2], __uint_as_float(raw[d0][1] & 0xffff0000u) * rs * g0[3]);
                o[2] = pg8::cvt_pk_bf16(__uint_as_float(raw[d0][2] << 16) * rs * g1[0], __uint_as_float(raw[d0][2] & 0xffff0000u) * rs * g1[1]);
                o[3] = pg8::cvt_pk_bf16(__uint_as_float(raw[d0][3] << 16) * rs * g1[2], __uint_as_float(raw[d0][3] & 0xffff0000u) * rs * g1[3]);
                qf[d0] = __builtin_bit_cast(bf16x8, o); }
        }
        f32x16 o[4];
#pragma unroll
        for (int i = 0; i < 4; ++i)
#pragma unroll
            for (int r = 0; r < 16; ++r) o[i][r] = 0.f;
        float m = -1e30f, l = 0.f;
#pragma unroll 1
        for (int kv0 = 0; kv0 < MEM_LEN; kv0 += 32) {
            f32x16 sc;
#pragma unroll
            for (int r = 0; r < 16; ++r) sc[r] = 0.f;
            const int key = kv0 + r32;
#pragma unroll
            for (int d0 = 0; d0 < 8; ++d0) { const bf16x8 kf = *(const LAS bf16x8*)(Ks + key * 256 + (((2 * d0 + hi) ^ (key & 15)) << 4)); sc = __builtin_amdgcn_mfma_f32_32x32x16_bf16(kf, qf[d0], sc, 0, 0, 0); }
            float tmax = sc[0];
#pragma unroll
            for (int r = 1; r < 16; ++r) tmax = fmaxf(tmax, sc[r]);
            tmax = fmaxf(tmax, __shfl_xor(tmax, 32));
            const float mnew = fmaxf(m, tmax), alpha = __builtin_amdgcn_exp2f(m - mnew);
            float ps = 0.f;
#pragma unroll
            for (int r = 0; r < 16; ++r) { sc[r] = __builtin_amdgcn_exp2f(sc[r] - mnew); ps += sc[r]; }
            l = l * alpha + ps; m = mnew;
#pragma unroll
            for (int i = 0; i < 4; ++i)
#pragma unroll
                for (int r = 0; r < 16; ++r) o[i][r] *= alpha;
            bf16x8 pb[2];
#pragma unroll
            for (int s2 = 0; s2 < 2; ++s2) { u32x4 w; w[0] = pg8::cvt_pk_bf16(sc[8 * s2], sc[8 * s2 + 1]); w[1] = pg8::cvt_pk_bf16(sc[8 * s2 + 2], sc[8 * s2 + 3]); w[2] = pg8::cvt_pk_bf16(sc[8 * s2 + 4], sc[8 * s2 + 5]); w[3] = pg8::cvt_pk_bf16(sc[8 * s2 + 6], sc[8 * s2 + 7]); pb[s2] = __builtin_bit_cast(bf16x8, w); }
#pragma unroll
            for (int i = 0; i < 4; ++i)
#pragma unroll
                for (int s2 = 0; s2 < 2; ++s2) {
                    const LAS unsigned char* vp = VT + (32 * i + r32) * VT_STRIDE + (kv0 + 16 * s2 + 4 * hi) * 2;
                    const u32x2 v0 = *(const LAS u32x2*)vp, v1 = *(const LAS u32x2*)(vp + 16);
                    const u32x4 vv = (u32x4){v0[0], v0[1], v1[0], v1[1]};
                    o[i] = __builtin_amdgcn_mfma_f32_32x32x16_bf16(__builtin_bit_cast(bf16x8, vv), pb[s2], o[i], 0, 0, 0);
                }
        }
        l += __shfl_xor(l, 32);
        const float rl = __builtin_amdgcn_rcpf(l);
        bf16_t* Op = OM + ((size_t)(b * SEQ + q0 + r32)) * 512 + h * MEM_D;
#pragma unroll
        for (int i = 0; i < 4; ++i)
#pragma unroll
            for (int g = 0; g < 4; ++g) { u32x2 w; w[0] = pg8::cvt_pk_bf16(o[i][4 * g] * rl, o[i][4 * g + 1] * rl); w[1] = pg8::cvt_pk_bf16(o[i][4 * g + 2] * rl, o[i][4 * g + 3] * rl);
                *(u32x2*)(Op + 32 * i + 8 * g + 4 * hi) = w; }
    }
    __syncthreads();
}
}

struct Params { const float* in[32]; float* out; unsigned char* ws; };

__global__ void __launch_bounds__(NTHREADS, 2) mega_fwd(Params p) {
    extern __shared__ __attribute__((aligned(16))) unsigned char lds[];
    const int bid = blockIdx.x, G = gridDim.x;
    const int NGW = G * NWAVES, NGT = G * NTHREADS;
#define PHASE_IDS int tid = threadIdx.x; asm volatile("" : "+v"(tid)); const int lane = tid & 63, wave = __builtin_amdgcn_readfirstlane(tid >> 6), half = tid >> 8, vt = tid & 255; \
    unsigned char* sm = lds + half * 32768; const int gw = bid * NWAVES + wave, gt = bid * NTHREADS + tid; (void)lane; (void)vt; (void)sm; (void)gw; (void)gt;

    const float* x = p.in[0];            const float* mem = p.in[1];
    const float* norm_mix_g = p.in[2];   const float* w_in = p.in[3];
    const float* b_forget = p.in[4];     const float* conv_w = p.in[5];
    const float* conv_b = p.in[6];       const float* lru_wa = p.in[7];
    const float* lru_ba = p.in[8];       const float* lru_wx = p.in[9];
    const float* lru_bx = p.in[10];      const float* lru_a_param = p.in[11];
    const float* fox_q_g = p.in[12];     const float* fox_k_g = p.in[13];
    const float* lru_out_g = p.in[14];   const float* fox_out_g = p.in[15];
    const float* w_out = p.in[16];       const float* norm_mem_x_g = p.in[17];
    const float* norm_mem_g = p.in[18];  const float* mem_wq = p.in[19];
    const float* mem_wkv = p.in[20];     const float* mem_q_g = p.in[21];
    const float* mem_k_g = p.in[22];     const float* mem_wo = p.in[23];
    const float* norm_ffn_g = p.in[24];  const float* r_gw = p.in[25];
    const float* r_gb = p.in[26];        const float* r_ew = p.in[27];
    const float* r_eb = p.in[28];        const float* w_gate = p.in[29];
    const float* w_up = p.in[30];        const float* w_down = p.in[31];
    float* out = p.out;
    unsigned char* ws = p.ws;
    int* ctl = (int*)(ws + WS_CTL) + CW_MOE;
    float* LOGF = (float*)(ws + WS_LOGF); float* CUM = (float*)(ws + WS_CUM);
    bf16_t* MEMN = (bf16_t*)(ws + WS_MEMN); bf16_t* KM = (bf16_t*)(ws + WS_KM); bf16_t* VM = (bf16_t*)(ws + WS_VM);
    int* RE = (int*)(ws + WS_RE); float* RW = (float*)(ws + WS_RW); int* ROWTOK = (int*)(ws + WS_ROWTOK); int* TILEE = (int*)(ws + WS_TILEE);
    bf16_t* H = (bf16_t*)(ws + WS_H); bf16_t* U = (bf16_t*)(ws + WS_U); bf16_t* GATE = (bf16_t*)(ws + WS_GATE);
    bf16_t* Q = (bf16_t*)(ws + WS_Q); bf16_t* K = (bf16_t*)(ws + WS_K); bf16_t* V = (bf16_t*)(ws + WS_V);
    bf16_t* YL = (bf16_t*)(ws + WS_YL); bf16_t* YF = (bf16_t*)(ws + WS_YF); bf16_t* MIXED = (bf16_t*)(ws + WS_MIXED);
    float* X1F = p.out;     float* LA = (float*)(ws + WS_LA); float* LB = (float*)(ws + WS_LB);
    bf16_t* QM = (bf16_t*)(ws + WS_QM); bf16_t* OM = (bf16_t*)(ws + WS_OM); unsigned char* HDN = ws + WS_HDN; unsigned char* YB = ws + WS_YB;

    bf16_t* WT_IN = (bf16_t*)(ws + WS_WT_IN); bf16_t* WT_KV = (bf16_t*)(ws + WS_WT_KV); bf16_t* WT_OUT = (bf16_t*)(ws + WS_WT_OUT);
    bf16_t* WT_Q = (bf16_t*)(ws + WS_WT_Q); bf16_t* WT_O = (bf16_t*)(ws + WS_WT_O); unsigned char* WT_GU = ws + WS_WT_GU; unsigned char* WT_D = ws + WS_WT_D; unsigned char* X2Q = ws + WS_X2Q;
    bf16_t* LRUW = (bf16_t*)(ws + WS_LRUW);
    bf16_t* WT_R = (bf16_t*)(ws + WS_WT_R); float* RSTD2 = (float*)(ws + WS_RSTD2); int* LIST = (int*)(ws + WS_LIST);
    bf16_t* X1B = (bf16_t*)(ws + WS_X1B); bf16_t* X2B = (bf16_t*)(ws + WS_X2B); float* SSL = (float*)(ws + WS_SSL); float* SSF = (float*)(ws + WS_SSF);
    float* SS1 = (float*)(ws + WS_SS1); float* SS2 = (float*)(ws + WS_SS2); float* RSL = (float*)(ws + WS_RSL); int* POSR = (int*)(ws + WS_POSR);
    float* SUMA = (float*)(ws + WS_SUMA); float* SUMH = (float*)(ws + WS_SUMH);
    LAS unsigned char* ldsl = (LAS unsigned char*)lds;
    volatile LAS unsigned* MISC = (volatile LAS unsigned*)((LAS unsigned char*)lds + MISC_OFF);
    if (threadIdx.x < 32) MISC[threadIdx.x] = 0u;
    __syncthreads();
    XcdBarrier bar = xcd_barrier_post((unsigned*)(ws + WS_CTL) + CW_BAR, MISC + 8);
#define GRID_BAR() xcd_barrier(bar)
#define FOR_VB(NB) for (int _vb0 = 2 * bid; _vb0 < (NB); _vb0 += 2 * G) { const int vb = (_vb0 + half < (NB)) ? (_vb0 + half) : ((NB) - 1);
#define END_VB }

    { PHASE_IDS
    {
        LAS unsigned* scr = (LAS unsigned*)(ldsl + wave * 17408);
        constexpr int I_IN = (DM / 128) * (2560 / 64), I_KV = (DM / 128) * (1024 / 64), I_OUT = (DM / 128) * (DM / 64), I_Q = (DM / 128) * (MEM_W / 64), I_O = (MEM_W / 128) * (DM / 64);
        constexpr int NITEMS = I_IN + I_KV + I_OUT + I_Q + I_O;
        for (int it = gw; it < NITEMS; it += NGW) {
            int r = it;
            if (r < I_IN) { p0_transpose_item<1, false>(w_in, IN_COLS, DM, 2560, WT_IN, scr, r, lane, nullptr, nullptr, 0); continue; } r -= I_IN;
            if (r < I_KV) { p0_transpose_item<0, false>(mem_wkv, 2 * MEM_W, DM, 2 * MEM_W, WT_KV, scr, r, lane, nullptr, nullptr, 0); continue; } r -= I_KV;
            if (r < I_OUT) { p0_transpose_item<0, true>(w_out, DM, DM, DM, WT_OUT, scr, r, lane, lru_out_g, fox_out_g, 512); continue; } r -= I_OUT;
            if (r < I_Q) { p0_transpose_item<0, true>(mem_wq, MEM_W, DM, MEM_W, WT_Q, scr, r, lane, norm_mem_x_g, norm_mem_x_g, 1 << 30); continue; } r -= I_Q;
            p0_transpose_item<0, false>(mem_wo, DM, MEM_W, DM, WT_O, scr, r, lane, nullptr, nullptr, 0);
        }
    }
    __syncthreads();
    }
    { PHASE_IDS
    {
        LAS float* wfT = (LAS float*)ldsl;
        for (int i = tid; i < 8 * 1024; i += NTHREADS) { const int k = i >> 3, h = i & 7; wfT[h * 1024 + k] = w_in[(size_t)k * IN_COLS + 2560 + h]; }
        __syncthreads();
        for (int row = gw; row < T; row += NGW) b_rmsnorm_row_f(x, norm_mix_g, H, wfT, b_forget, LOGF, row, lane);
    }
    __syncthreads();
    }
    { PHASE_IDS
    for (int row = gw; row < TM; row += NGW) b_rmsnorm_row(mem, norm_mem_g, MEMN, row, lane);
    if (bid == 0 && tid < 128) ctl[tid] = 0;
    for (int i = gt; i < 48 * DM; i += NGT) {
        const int col = i >> 10, k = i & 1023; float v = 0.f;
        if (col < 4) v = r_gw[(size_t)k * 4 + col]; else if (col < 36) v = r_ew[(size_t)k * 32 + col - 4];
        WT_R[i] = f2bf(v * norm_ffn_g[k]);
    }
    for (int i = gt; i < 8 * 16 * 64 * 8; i += NGT) {
        const int j = i & 7, ln = (i >> 3) & 63, s_ = (i >> 9) & 3, n = (i >> 11) & 1, mat = (i >> 12) & 1, blk = i >> 13;
        const float* W = mat ? lru_wx : lru_wa;
        LRUW[i] = f2bf(W[(size_t)blk * 4096 + (16 * s_ + 8 * (ln >> 5) + j) * 64 + 32 * n + (ln & 31)]);
    }
    }
    GRID_BAR();
    { PHASE_IDS
    { const pg8::Gemm g{H, WT_IN, DM, DM, DM, 0, 0, 0, 0};
      const pg8::EpiInProj E{U, fox_q_g, fox_k_g};
      static_assert(WS_GATE - WS_U == 32 * MiB && WS_Q - WS_GATE == 32 * MiB && WS_K - WS_Q == 32 * MiB && WS_V - WS_K == 32 * MiB, "EpiInProj: section stride");
      { pg8::StaticOrder S; S.init(T, 2560, G, bid); pg8::gemm_phase<pg8::EpiInProj, pg8::StaticOrder, true>(ldsl, g, S, E); } }
    }
    GRID_BAR();
    { PHASE_IDS
    { constexpr int NB = BATCH * FOX_H;
      FOR_VB(NB) b_cumsum(LOGF, CUM, vb, vt, sm, true); END_VB }
    if (bid >= 32) {
      const pg8::Gemm g{MEMN, WT_KV, DM, DM, DM, 0, 0, 0, 0}; pg8::StaticOrder S; S.init(TM, 2 * MEM_W, G, bid - 32);
      const pg8::EpiBf16 E{KM, VM, 512, 512};
      pg8::gemm_phase<pg8::EpiBf16, pg8::StaticOrder, true>(ldsl, g, S, E); }
    __syncthreads();
    for (int u = bid; u < BATCH * lru::NCH; u += G) lru::unit<false>(u / lru::NCH, u % lru::NCH, U, GATE, conv_w, conv_b, LRUW, lru_ba, lru_bx, lru_a_param, SUMA, SUMH, YL, SSL, ldsl + wave * lru::WLDS, wave, lane);
    }
    GRID_BAR();
    { PHASE_IDS
    for (int u = bid; u < BATCH * lru::NCH; u += G) lru::unit<true>(u / lru::NCH, u % lru::NCH, U, GATE, conv_w, conv_b, LRUW, lru_ba, lru_bx, lru_a_param, SUMA, SUMH, YL, SSL, ldsl + wave * lru::WLDS, wave, lane);
    __syncthreads();
    fox::attn_phase<8>((char*)lds, Q, K, V, YF, CUM, SSF, ctl + 100 + (bid & 7), fox::ConvArgs{w_gate, w_up, w_down, norm_ffn_g, WT_GU, WT_D});
    }
    GRID_BAR();
    { PHASE_IDS
    { const pg8::Gemm g{YL, WT_OUT, 512, DM, 512, (size_t)(WS_YF - WS_YL) / 2, 512, 0, 0}; pg8::PairOrder S; S.init(T, DM, G, bid);
      const pg8::EpiOutChain E{x, X1B, SSL, SSF, SS1};
      pg8::gemm_phase<pg8::EpiOutChain, pg8::PairOrder, true>(ldsl, g, S, E); }
    }
    GRID_BAR();
    { PHASE_IDS
    { const pg8::Gemm g{X1B, WT_Q, DM, DM, DM, 0, 0, 0, 0}; pg8::StaticOrder S; S.init(T, MEM_W, G, bid);
      const pg8::EpiRowScale E{QM, 512, SS1, 1.f / DM};
      pg8::gemm_phase<pg8::EpiRowScale, pg8::StaticOrder, true>(ldsl, g, S, E); }
    }
    GRID_BAR();
    { PHASE_IDS
    static_assert(xat::LDS_NEED <= MISC_OFF, "cross-attention LDS");
    for (int it = bid; it < BATCH * MEM_H * 8; it += G) { const int bh = it >> 3; xat::item(bh / MEM_H, bh % MEM_H, it & 7, QM, KM, VM, OM, mem_q_g, mem_k_g, ldsl); }
    }
    GRID_BAR();
    { PHASE_IDS
    { const pg8::Gemm g{OM, WT_O, MEM_W, MEM_W, MEM_W, 0, 0, 0, 0}; pg8::StaticOrder S; S.init(T, DM, G, bid);
      const pg8::EpiX2 E{X1B, X2B, X2Q, SS2};
      pg8::gemm_phase<pg8::EpiX2, pg8::StaticOrder, true>(ldsl, g, S, E); }
    }
    GRID_BAR();
    { PHASE_IDS
    static_assert(T / 16 == 256 * NWAVES, "router: one 16-token task per wave on a 256-workgroup grid");
    LAS int* hist = (LAS int*)(ldsl + 8 * 8448 + 36 * 2064);
    LAS unsigned char* wr = ldsl + 8 * 8448;
    if (tid < 64) hist[tid] = 0;
    for (int i = tid; i < 36 * 128; i += NTHREADS) { const int row = i >> 7, ch = i & 127; *(LAS pg8::u32x4*)(wr + row * 2064 + ch * 16) = *(const pg8::u32x4*)(WT_R + (size_t)row * DM + ch * 8); }
    __syncthreads();
    for (int tk = gw; tk < T / 16; tk += NGW) rtr::task(tk * 16, X2B, WT_R, SS2, r_gb, r_eb, RW, RSL, POSR, ctl, LIST, (LAS float*)(ldsl + wave * 8448), wr, hist, lane);
    }
    GRID_BAR();
    { PHASE_IDS
    LAS int* mp = (LAS int*)(ldsl + 131072);
    if (tid == 0) { int run = 0; for (int e = 0; e < N_EXP; ++e) { const int c_ = ctl[e]; mp[e] = run; mp[64 + e] = c_; run += (c_ + 255) & ~255; } mp[32] = run; }
    __syncthreads();
    if (tid < N_TILES) { const int row = tid * 256; int e = 0; for (int j = 1; j < N_EXP; ++j) if (mp[j] <= row) e = j; mp[128 + tid] = e; }
    __syncthreads();
    { const pg8::Gemm g{X2Q, WT_GU, DM, DM, DM, 0, (size_t)1024 * 1024, 0x7f7f7f7f, 0x7a7a7a7a};
      const pg8::MoeOrder<true> S{(mp[32] >> 8) * 4, G, bid, mp, LIST};
      const pg8::EpiMoe1 E{HDN, RSL};
      pg8::gemm_phase<pg8::EpiMoe1, pg8::MoeOrder<true>, true>(ldsl, g, S, E); }
    }
    GRID_BAR();
    { PHASE_IDS
    LAS int* mp = (LAS int*)(ldsl + 131072);
    { const pg8::Gemm g{HDN, WT_D, D_EXP, D_EXP, D_EXP, 0, (size_t)1024 * 512, 0x7c7c7c7c, 0x7a7a7a7a};
      const pg8::MoeOrder<false> S{(mp[32] >> 8) * 4, G, bid, mp, LIST};
      const pg8::EpiMoe2 E{YB};
      pg8::gemm_phase<pg8::EpiMoe2, pg8::MoeOrder<false>, true>(ldsl, g, S, E); }
    }
    GRID_BAR();
    { PHASE_IDS
    const LAS int* mp = (const LAS int*)(ldsl + 131072);
    static_assert((2 * T) % (4 * 256 * NWAVES) == 0, "final combine: four half-row items per wave and iteration");
#pragma unroll 1
    for (int k = 0; k < 2 * T / NGW; k += 4) {
        unsigned pa[4], pb[4]; float wa[4], wb[4];
#pragma unroll
        for (int j = 0; j < 4; ++j) { const int t = ((k + j) * NGW + gw) >> 1; pa[j] = (unsigned)POSR[2 * t]; pb[j] = (unsigned)POSR[2 * t + 1]; wa[j] = RW[2 * t]; wb[j] = RW[2 * t + 1]; }
        uint4 xv[4]; uint2 ya[4], yb[4];
#pragma unroll
        for (int j = 0; j < 4; ++j) { const int hr = (k + j) * NGW + gw; const size_t c = (size_t)(hr & 1) * 512 + lane * 8;
            const size_t ra = (size_t)(mp[pa[j] >> 20] + (int)(pa[j] & 0xfffffu)), rb = (size_t)(mp[pb[j] >> 20] + (int)(pb[j] & 0xfffffu));
            xv[j] = *(const uint4*)(X2B + (size_t)(hr >> 1) * DM + c); ya[j] = *(const uint2*)(YB + ra * DM + c); yb[j] = *(const uint2*)(YB + rb * DM + c); }
#pragma unroll
        for (int j = 0; j < 4; ++j) { const int hr = (k + j) * NGW + gw; b_final2(out + (size_t)(hr >> 1) * DM + (size_t)(hr & 1) * 512 + lane * 8, xv[j], ya[j], yb[j], 0.125f * wa[j], 0.125f * wb[j]); }
    }
    }
}

extern "C" void kernel_launch(void* const* d_in, const int* in_sizes, int n_in, void* d_out, int out_size, void* d_ws, size_t ws_size, hipStream_t stream) {
    static int grid = 0;
    if (grid == 0) {
        int dev = 0, cus = 0;
        if (hipGetDevice(&dev) != hipSuccess || hipDeviceGetAttribute(&cus, hipDeviceAttributeMultiprocessorCount, dev) != hipSuccess) { fprintf(stderr, "kernel_launch: device query failed\n"); grid = -1; return; }
        if (hipFuncSetAttribute((const void*)mega_fwd, hipFuncAttributeMaxDynamicSharedMemorySize, LDS_BYTES) != hipSuccess) { fprintf(stderr, "kernel_launch: hipFuncSetAttribute failed\n"); grid = -1; return; }
        if (n_in != 32 || ws_size < WS_END) { fprintf(stderr, "kernel_launch: unexpected inputs (n_in %d, ws %zu)\n", n_in, ws_size); grid = -1; return; }
        grid = cus;
    }
    if (grid < 0) return;
    (void)hipMemsetAsync((char*)d_ws + WS_CTL, 0, CTL_ZERO_BYTES, stream);
    Params p{};
    for (int i = 0; i < 32; ++i) p.in[i] = (const float*)d_in[i];
    p.out = (float*)d_out; p.ws = (unsigned char*)d_ws;
    hipLaunchKernelGGL(mega_fwd, dim3(grid), dim3(NTHREADS), LDS_BYTES, stream, p);
}
```

```cpp
#include <hip/hip_runtime.h>
#include <stdint.h>
#include <math.h>
#include <cstdio>

typedef unsigned short bf16_t;
typedef short bf16x8 __attribute__((ext_vector_type(8)));
typedef float f32x4 __attribute__((ext_vector_type(4)));
typedef float f32x16 __attribute__((ext_vector_type(16)));
#define GAS __attribute__((address_space(1)))
typedef unsigned wt_u32x4 __attribute__((ext_vector_type(4)));
typedef unsigned wt_u32x2 __attribute__((ext_vector_type(2)));
__device__ __forceinline__ __amdgpu_buffer_rsrc_t wt_rsrc(const void* base  ) { return __builtin_amdgcn_make_buffer_rsrc((void*)base, 0, 0x7ffffff0, 0x00020000); }
#define WT0 16
#define WTA 0
#define WTB 0
#define WTC 0
#define WTD 0
#ifndef WT0
#define WT0 16
#endif
#ifndef WTA
#define WTA 16
#endif
#ifndef WTB
#define WTB 16
#endif
#ifndef WTC
#define WTC 16
#endif
#ifndef WTD
#define WTD 16
#endif
template <int AUX = 16> __device__ __forceinline__ void st16_wt(__amdgpu_buffer_rsrc_t r, unsigned byte_off, wt_u32x4 v) { __builtin_amdgcn_raw_buffer_store_b128(v, r, byte_off, 0, AUX); }
template <int AUX = 16> __device__ __forceinline__ void st8_wt(__amdgpu_buffer_rsrc_t r, unsigned byte_off, wt_u32x2 v) { __builtin_amdgcn_raw_buffer_store_b64(v, r, byte_off, 0, AUX); }
#define LAS __attribute__((address_space(3)))

constexpr int BATCH = 8, SEQ = 4096, T = BATCH * SEQ, DM = 1024;
constexpr int MEM_LEN = 256, TM = BATCH * MEM_LEN;
constexpr int LRU_W = 512, FOX_H = 8, FOX_D = 64, FOX_W = 512;
constexpr int IN_COLS = 2568;
constexpr int MEM_H = 4, MEM_D = 128, MEM_W = 512;
constexpr int N_GROUPS = 4, EPG = 8, N_EXP = 32, D_EXP = 512;
constexpr int NA = T * 2;
constexpr int MOE_PAD = 256;
constexpr int P_MAX = NA + N_EXP * MOE_PAD;
constexpr int N_TILES = P_MAX / MOE_PAD;
constexpr float EPS = 1e-6f;
constexpr float LOG2E = 1.4426950408889634f;
constexpr int NTHREADS = 512, NWAVES = 8;
constexpr int ESPLIT = 12;

constexpr size_t MiB = 1u << 20;
constexpr size_t WS_CTL = 0;
constexpr size_t CTL_ZERO_BYTES = 256 * 1024;
constexpr int CW_MOE = 0;
constexpr int CW_BAR = 4096;
constexpr size_t WS_LOGF = 1 * MiB;
constexpr size_t WS_CUM = 2 * MiB;
constexpr size_t WS_MEMN = 3 * MiB;
constexpr size_t WS_KM = 7 * MiB;
constexpr size_t WS_VM = 9 * MiB;
constexpr size_t WS_RE = 11 * MiB;
constexpr size_t WS_RW = 11 * MiB + 512 * 1024;
constexpr size_t WS_ROWTOK = 12 * MiB;
constexpr size_t WS_TILEE = 13 * MiB;
constexpr size_t WS_SUMA = 14 * MiB;
constexpr size_t WS_SUMH = 14 * MiB + 512 * 1024;
constexpr size_t WS_LRUW = 15 * MiB;
constexpr size_t WS_WT_IN = 16 * MiB;
constexpr size_t WS_WT_KV = 21 * MiB;
constexpr size_t WS_WT_OUT = 23 * MiB;
constexpr size_t WS_WT_Q = 25 * MiB;
constexpr size_t WS_WT_O = 26 * MiB;
constexpr size_t WS_WT_GU = 27 * MiB;
constexpr size_t WS_WT_D = 91 * MiB;
constexpr size_t WS_H = 123 * MiB;
constexpr size_t WS_MIXED = 123 * MiB;
constexpr size_t WS_LA = 123 * MiB;
constexpr size_t WS_YL = 187 * MiB;
constexpr size_t WS_YF = 219 * MiB;
constexpr size_t WS_YB = 123 * MiB;
constexpr size_t WS_U = 251 * MiB;
constexpr size_t WS_GATE = 283 * MiB;
constexpr size_t WS_Q = 315 * MiB;
constexpr size_t WS_K = 347 * MiB;
constexpr size_t WS_V = 379 * MiB;
constexpr size_t WS_QM = 251 * MiB;
constexpr size_t WS_OM = 283 * MiB;
constexpr size_t WS_HDN = 315 * MiB;
constexpr size_t WS_LB = 411 * MiB;
constexpr size_t WS_X1B = 123 * MiB;
constexpr size_t WS_X2Q = 360 * MiB;
constexpr size_t WS_X2B = 411 * MiB;
constexpr size_t WS_LIST = 476 * MiB;
constexpr size_t WS_SSL = 480 * MiB;
constexpr size_t WS_SSF = 481 * MiB;
constexpr size_t WS_SS1 = 482 * MiB;
constexpr size_t WS_SS2 = 484 * MiB;
constexpr size_t WS_RSTD2 = 486 * MiB;
constexpr size_t WS_WT_R = 487 * MiB;
constexpr size_t WS_RSL = 488 * MiB;
constexpr size_t WS_POSR = 492 * MiB;
constexpr size_t WS_END = 493 * MiB;
static_assert(WS_YB + (size_t)P_MAX * DM <= WS_U, "expert outputs: fp8 [P_MAX][1024] in list order");
static_assert((size_t)P_MAX * 512 * 2 <= 96 * MiB && (size_t)NA * DM * 2 <= 128 * MiB, "ws map");

constexpr int LDS_BYTES = 155648;
constexpr int MISC_OFF = LDS_BYTES - 512;

__device__ __forceinline__ bf16_t f2bf(float f) { unsigned u = __float_as_uint(f); return (bf16_t)((u + 0x7fffu + ((u >> 16) & 1u)) >> 16); }
__device__ __forceinline__ float bf2f(bf16_t h) { return __uint_as_float(((unsigned)h) << 16); }
__device__ __forceinline__ float wave_sum(float v) {
#pragma unroll
    for (int o = 1; o < 64; o <<= 1) v += __shfl_xor(v, o);
    return v;
}
__device__ __forceinline__ int crow(int r, int hi) { return (r & 3) + 8 * (r >> 2) + 4 * hi; }
__device__ __forceinline__ float sigmoidf_(float x) { return 1.f / (1.f + __expf(-x)); }
__device__ __forceinline__ float gelu_tanh(float x) {
    const float k0 = 0.7978845608028654f, k1 = 0.044715f;
    float u = k0 * (x + k1 * x * x * x);
    float t = 1.f - 2.f / (1.f + __expf(2.f * u));
    return 0.5f * x * (1.f + t);
}

#define XB_TMO      128
#define XB_XCNT(j)  (256  + 64 * (j))
#define XB_XSUB(j)  (1280 + 64 * (j))
#define XB_XGEN(j)  (2304 + 64 * (j))
#define XB_TOP      3328
#define XB_TOPGEN   3392
#define XCD_BAR_WORDS 3456
#define XB_SPIN_CAP (1u << 20)
__device__ __forceinline__ unsigned xb_ld(unsigned* p)              { return __hip_atomic_load(p, __ATOMIC_RELAXED, __HIP_MEMORY_SCOPE_AGENT); }
__device__ __forceinline__ unsigned xb_add(unsigned* p, unsigned v) { return __hip_atomic_fetch_add(p, v, __ATOMIC_RELAXED, __HIP_MEMORY_SCOPE_AGENT); }
__device__ __forceinline__ unsigned xb_xcc_id() { return (unsigned)__builtin_amdgcn_s_getreg((3 << 11) | 20) & 0xFu; }
#define XB_SPIN(cond, bar) do { unsigned _sp = 0; while (cond) { __builtin_amdgcn_s_sleep(1); \
    if ((++_sp & 255u) == 0u) { if (xb_ld(&(bar)[XB_TMO])) break; if (_sp > XB_SPIN_CAP) { atomicAdd(&(bar)[XB_TMO], 1u); break; } } } } while (0)
struct XcdBarrier { unsigned* bar; unsigned x; volatile LAS unsigned* st; };
__device__ __forceinline__ XcdBarrier xcd_barrier_post(unsigned* bar, volatile LAS unsigned* st) {
    XcdBarrier b; b.bar = bar; b.x = xb_xcc_id(); b.st = st;
    if (threadIdx.x == 0) (void)xb_add(&bar[XB_XCNT(b.x)], 1u);
    return b;
}
__device__ __forceinline__ void xcd_barrier_complete(unsigned* bar, unsigned x, unsigned& nloc, unsigned& nx) {
    const unsigned G = gridDim.x * gridDim.y * gridDim.z;
    unsigned sum, cnt, mine, sp = 0u;
    for (;;) {
        sum = 0u; cnt = 0u; mine = 0u;
#pragma unroll
        for (unsigned j = 0; j < 16; ++j) { const unsigned c = xb_ld(&bar[XB_XCNT(j)]); sum += c; cnt += (c > 0u) ? 1u : 0u; mine = (j == x) ? c : mine; }
        if (sum == G) break;
        __builtin_amdgcn_s_sleep(1);
        if ((++sp & 255u) == 0u) { if (xb_ld(&bar[XB_TMO])) break; if (sp > XB_SPIN_CAP) { atomicAdd(&bar[XB_TMO], 1u); break; } }
    }
    nloc = mine > 0u ? mine : 1u; nx = cnt > 0u ? cnt : 1u;
}
__device__ __forceinline__ void xcd_barrier(const XcdBarrier& b) {
    asm volatile("s_waitcnt vmcnt(0)" ::: "memory");
    __syncthreads();
    if (threadIdx.x == 0) {
        unsigned* bar = b.bar;
        __builtin_amdgcn_s_waitcnt(0);
        unsigned nloc = b.st[0], nx = b.st[1];
        if (nloc == 0u) { xcd_barrier_complete(bar, b.x, nloc, nx); b.st[0] = nloc; b.st[1] = nx; }
        const unsigned old = xb_add(&bar[XB_XSUB(b.x)], 1u);
        const unsigned gen = old / nloc;
        if (old + 1u == (gen + 1u) * nloc) {
            __builtin_amdgcn_fence(__ATOMIC_RELEASE, "agent");
            asm volatile("s_waitcnt vmcnt(0)" ::: "memory");
            const unsigned og = xb_add(&bar[XB_TOP], 1u);
            const unsigned tg = og / nx;
            if (og + 1u == (tg + 1u) * nx) xb_add(&bar[XB_TOPGEN], 1u);
            else XB_SPIN(xb_ld(&bar[XB_TOPGEN]) == tg, bar);
            __builtin_amdgcn_fence(__ATOMIC_ACQUIRE, "agent");
            xb_add(&bar[XB_XGEN(b.x)], 1u);
            asm volatile("s_waitcnt vmcnt(0)" ::: "memory");
        } else {
            XB_SPIN(xb_ld(&bar[XB_XGEN(b.x)]) == gen, bar);
            __builtin_amdgcn_fence(__ATOMIC_ACQUIRE, "agent");
            asm volatile("s_waitcnt vmcnt(0)" ::: "memory");
        }
    }
    __syncthreads();
}

__device__ __forceinline__ void b_rmsnorm_row(const float* __restrict__ x, const float* __restrict__ g, bf16_t* __restrict__ out, int row, int lane) {
    const f32x4* xr = (const f32x4*)(x + (size_t)row * DM) + lane;
    f32x4 v[4]; float s = 0.f;
#pragma unroll
    for (int j = 0; j < 4; ++j) { v[j] = xr[64 * j]; s += v[j].x * v[j].x + v[j].y * v[j].y + v[j].z * v[j].z + v[j].w * v[j].w; }
    const float rstd = rsqrtf(wave_sum(s) * (1.f / DM) + EPS);
    const f32x4* gr = (const f32x4*)g + lane;
    uint2* o = (uint2*)(out + (size_t)row * DM) + lane;
#pragma unroll
    for (int j = 0; j < 4; ++j) {
        f32x4 gg = gr[64 * j];
        uint2 w;
        w.x = (unsigned)f2bf(v[j].x * rstd * gg.x) | ((unsigned)f2bf(v[j].y * rstd * gg.y) << 16);
        w.y = (unsigned)f2bf(v[j].z * rstd * gg.z) | ((unsigned)f2bf(v[j].w * rstd * gg.w) << 16);
        o[64 * j] = w;
    }
}


__device__ __forceinline__ unsigned pk_bf16_hw(float lo, float hi) { unsigned r; asm volatile("v_cvt_pk_bf16_f32 %0, %1, %2" : "=v"(r) : "v"(lo), "v"(hi)); return r; }
__device__ __forceinline__ void b_rmsnorm_rows_f(const float* __restrict__ x, const float* __restrict__ g, bf16_t* __restrict__ out, const LAS float* wfT, const float* __restrict__ b_forget,
                                                 float* __restrict__ LOGF, int row0, int rstep, int rend, int lane) {
    f32x4 gg[4];
#pragma unroll
    for (int j = 0; j < 4; ++j) gg[j] = ((const f32x4*)g + lane)[64 * j];
    const int hh = 4 * (lane >> 5) + 2 * ((lane >> 4) & 1) + ((lane >> 3) & 1);
    const float bfh = b_forget[hh];
#pragma unroll 1
    for (int row = row0; row < rend; row += rstep) {
        const f32x4* xr = (const f32x4*)(x + (size_t)row * DM) + lane;
        f32x4 v[4]; float s = 0.f;
#pragma unroll
        for (int j = 0; j < 4; ++j) { v[j] = __builtin_nontemporal_load(xr + 64 * j); s += v[j].x * v[j].x + v[j].y * v[j].y + v[j].z * v[j].z + v[j].w * v[j].w; }
        const float rstd = rsqrtf(wave_sum(s) * (1.f / DM) + EPS);
        const __amdgpu_buffer_rsrc_t orr = wt_rsrc(out);
#pragma unroll
        for (int j = 0; j < 4; ++j) {
            v[j].x *= rstd * gg[j].x; v[j].y *= rstd * gg[j].y; v[j].z *= rstd * gg[j].z; v[j].w *= rstd * gg[j].w;
            wt_u32x2 w; w.x = pk_bf16_hw(v[j].x, v[j].y); w.y = pk_bf16_hw(v[j].z, v[j].w);
            st8_wt<WT0>(orr, (unsigned)(row * (DM * 2) + (lane + 64 * j) * 8), w);
        }
        float a[8];
#pragma unroll
        for (int h = 0; h < 8; ++h) {
            float t = 0.f;
#pragma unroll
            for (int j = 0; j < 4; ++j) { const f32x4 w = *(const LAS f32x4*)(wfT + h * 1024 + 256 * j + 4 * lane); t += (v[j].x * w.x + v[j].y * w.y) + (v[j].z * w.z + v[j].w * w.w); }
            a[h] = t;
        }
        float b4[4], c2[2];
#pragma unroll
        for (int i = 0; i < 4; ++i) { const bool up = (lane & 32) != 0; const float keep = up ? a[i + 4] : a[i], send = up ? a[i] : a[i + 4]; b4[i] = keep + __shfl_xor(send, 32); }
#pragma unroll
        for (int i = 0; i < 2; ++i) { const bool up = (lane & 16) != 0; const float keep = up ? b4[i + 2] : b4[i], send = up ? b4[i] : b4[i + 2]; c2[i] = keep + __shfl_xor(send, 16); }
        float d; { const bool up = (lane & 8) != 0; const float keep = up ? c2[1] : c2[0], send = up ? c2[0] : c2[1]; d = keep + __shfl_xor(send, 8); }
        d += __shfl_xor(d, 4); d += __shfl_xor(d, 2); d += __shfl_xor(d, 1);
        if ((lane & 7) == 0) { const float z = d + bfh; LOGF[(size_t)row * 8 + hh] = fminf(z, 0.f) - log1pf(__expf(-fabsf(z))); }
    }
}
typedef bf16_t (*As_t)[40];
typedef bf16_t (*Bs_t)[64][40];
template <int NB>
__device__ __forceinline__ void gemm_core64(const bf16_t* aptr, const float* W0, const float* W1, int ldw,
                                            int n0, int N, int K, f32x4 (&acc)[NB][2][2], As_t As, Bs_t Bs, int vt) {
    const int lane = vt & 63, wid = vt >> 6, wr = wid >> 1, wc = wid & 1;
    for (int k0 = 0; k0 < K; k0 += 32) {
        {
            const int r = vt >> 2, c = vt & 3;
            uint4 v = make_uint4(0, 0, 0, 0);
            if (aptr) v = *(const uint4*)(aptr + k0 + c * 8);
            *(uint4*)&As[r][c * 8] = v;
        }
        {
            const int kk = vt >> 3, nc = (vt & 7) * 8;
#pragma unroll
            for (int b = 0; b < NB; ++b) {
                const float* wp = (b == 0 ? W0 : W1) + (size_t)(k0 + kk) * ldw + n0 + nc;
#pragma unroll
                for (int j = 0; j < 8; ++j) { float v = (n0 + nc + j < N) ? wp[j] : 0.f; Bs[b][nc + j][kk] = f2bf(v); }
            }
        }
        __syncthreads();
        bf16x8 a[2];
#pragma unroll
        for (int i = 0; i < 2; ++i) a[i] = *(const bf16x8*)&As[wr * 32 + i * 16 + (lane & 15)][(lane >> 4) * 8];
#pragma unroll
        for (int b = 0; b < NB; ++b)
#pragma unroll
            for (int j = 0; j < 2; ++j) {
                bf16x8 bb = *(const bf16x8*)&Bs[b][wc * 32 + j * 16 + (lane & 15)][(lane >> 4) * 8];
#pragma unroll
                for (int i = 0; i < 2; ++i) acc[b][i][j] = __builtin_amdgcn_mfma_f32_16x16x32_bf16(a[i], bb, acc[b][i][j], 0, 0, 0);
            }
        __syncthreads();
    }
}

template <class Epi>
__device__ __forceinline__ void b_gemm(const bf16_t* __restrict__ A, int lda, const float* __restrict__ W, int ldw, int N, int K, const Epi& epi,
                                       int vbx, int vby, int vt, unsigned char* sm) {
    As_t As = (As_t)sm; Bs_t Bs = (Bs_t)(sm + 64 * 40 * 2);
    const int lane = vt & 63, wid = vt >> 6, wr = wid >> 1, wc = wid & 1;
    const int m0 = vby * 64, n0 = vbx * 64;
    f32x4 acc[1][2][2];
#pragma unroll
    for (int i = 0; i < 2; ++i)
#pragma unroll
        for (int j = 0; j < 2; ++j) acc[0][i][j] = (f32x4){0.f, 0.f, 0.f, 0.f};
    gemm_core64<1>(A + (size_t)(m0 + (vt >> 2)) * lda, W, W, ldw, n0, N, K, acc, As, Bs, vt);
#pragma unroll
    for (int i = 0; i < 2; ++i)
#pragma unroll
        for (int j = 0; j < 2; ++j)
#pragma unroll
            for (int r = 0; r < 4; ++r) {
                const int row = m0 + wr * 32 + i * 16 + (lane >> 4) * 4 + r, col = n0 + wc * 32 + j * 16 + (lane & 15);
                if (col < N) epi(row, col, acc[0][i][j][r]);
            }
}

struct EpiG1 {
    bf16_t *U, *GATE, *Q, *K, *V; float* LOGF; const float* b_forget;
    __device__ __forceinline__ void operator()(int row, int col, float v) const {
        if (col < 512) U[(size_t)row * 512 + col] = f2bf(v);
        else if (col < 1024) GATE[(size_t)row * 512 + col - 512] = f2bf(v);
        else if (col < 1536) Q[(size_t)row * 512 + col - 1024] = f2bf(v);
        else if (col < 2048) K[(size_t)row * 512 + col - 1536] = f2bf(v);
        else if (col < 2560) V[(size_t)row * 512 + col - 2048] = f2bf(v);
        else { const int h = col - 2560; const float z = v + b_forget[h]; LOGF[(size_t)row * 8 + h] = fminf(z, 0.f) - log1pf(__expf(-fabsf(z))); }
    }
};
struct EpiSplit2 { bf16_t *O0, *O1;
    __device__ __forceinline__ void operator()(int row, int col, float v) const {
        if (col < 512) O0[(size_t)row * 512 + col] = f2bf(v); else O1[(size_t)row * 512 + col - 512] = f2bf(v); } };
struct EpiBf16s { bf16_t* O; int ldo;
    __device__ __forceinline__ void operator()(int row, int col, float v) const { O[(size_t)row * ldo + col] = f2bf(v); } };
struct EpiResF32 { const float* base; float* out;
    __device__ __forceinline__ void operator()(int row, int col, float v) const { out[(size_t)row * DM + col] = base[(size_t)row * DM + col] + v; } };

template <int HD>
__device__ __forceinline__ void b_headnorm(bf16_t* __restrict__ X, const float* __restrict__ g, float scale, int idx) {
    const int nh = 512 / HD;
    bf16_t* p = X + (size_t)(idx / nh) * 512 + (idx % nh) * HD;
    float ss = 0.f;
#pragma unroll 8
    for (int d = 0; d < HD; ++d) { float v = bf2f(p[d]); ss += v * v; }
    const float rstd = rsqrtf(ss * (1.f / HD) + EPS) * scale;
#pragma unroll 8
    for (int d = 0; d < HD; ++d) p[d] = f2bf(bf2f(p[d]) * rstd * g[d]);
}

__device__ __forceinline__ void b_cumsum(const float* __restrict__ LOGF, float* __restrict__ CUM, int bh, int vt, unsigned char* sm, bool store) {
    float* part = (float*)sm;
    const int b = bh / FOX_H, h = bh % FOX_H;
    float v[16]; float s = 0.f;
#pragma unroll
    for (int i = 0; i < 16; ++i) { v[i] = LOGF[((size_t)b * SEQ + vt * 16 + i) * 8 + h]; s += v[i]; }
    part[vt] = s; __syncthreads();
    if (vt == 0) { float run = 0.f; for (int i = 0; i < 256; ++i) { float t = part[i]; part[i] = run; run += t; } }
    __syncthreads();
    float run = part[vt];
    if (store) {
#pragma unroll
        for (int i = 0; i < 16; ++i) { run += v[i]; v[i] = run * LOG2E; }
        const __amdgpu_buffer_rsrc_t cr_ = wt_rsrc(CUM);
#pragma unroll
        for (int q = 0; q < 4; ++q) { wt_u32x4 w; w.x = __float_as_uint(v[4 * q]); w.y = __float_as_uint(v[4 * q + 1]); w.z = __float_as_uint(v[4 * q + 2]); w.w = __float_as_uint(v[4 * q + 3]);
            st16_wt<16>(cr_, (unsigned)(((size_t)bh * SEQ + vt * 16 + 4 * q) * 4), w); }
    }
    __syncthreads();
}

__device__ __forceinline__ void b_lru_ab(const bf16_t* __restrict__ U, const float* __restrict__ conv_w, const float* __restrict__ conv_b,
                                         const float* __restrict__ wa, const float* __restrict__ ba, const float* __restrict__ wx, const float* __restrict__ bx,
                                         const float* __restrict__ a_param, float* __restrict__ LA, float* __restrict__ LB, int t, int ch, unsigned char* sm) {
    float* xc = (float*)sm;
    const int s = t % SEQ;
    float x = conv_b[ch];
#pragma unroll
    for (int tap = 0; tap < 4; ++tap) { const int ss = s - 3 + tap; if (ss >= 0) x += conv_w[tap * 512 + ch] * bf2f(U[(size_t)(t - 3 + tap) * 512 + ch]); }
    xc[ch] = x; __syncthreads();
    const int blk = ch >> 6, j = ch & 63;
    float r = ba[ch], ii = bx[ch];
    const float* wap = wa + (size_t)blk * 4096 + j; const float* wxp = wx + (size_t)blk * 4096 + j;
#pragma unroll 4
    for (int i = 0; i < 64; ++i) { const float xv = xc[blk * 64 + i]; r += xv * wap[i * 64]; ii += xv * wxp[i * 64]; }
    r = sigmoidf_(r); ii = sigmoidf_(ii);
    const float ap = -a_param[ch];
    const float sp = (ap > 20.f) ? ap : log1pf(__expf(ap));
    const float log_a = -8.f * r * sp;
    const float a = __expf(log_a);
    const float mult = sqrtf(fmaxf(-expm1f(2.f * log_a), 0.f));
    LA[(size_t)t * 512 + ch] = a;
    LB[(size_t)t * 512 + ch] = mult * (ii * x);
    __syncthreads();
}
__device__ __forceinline__ void b_lru_scan(const float* __restrict__ LA, const float* __restrict__ LB, const bf16_t* __restrict__ GATE, bf16_t* __restrict__ YL, int vb, int lane) {
    const int b = vb / 8, ch = (vb % 8) * 64 + lane;
    float h = 0.f;
    size_t off = (size_t)b * SEQ * 512 + ch;
    for (int s = 0; s < SEQ; s += 8) {
        float a[8], bb[8], g[8];
#pragma unroll
        for (int i = 0; i < 8; ++i) { a[i] = LA[off + (size_t)(s + i) * 512]; bb[i] = LB[off + (size_t)(s + i) * 512]; g[i] = bf2f(GATE[off + (size_t)(s + i) * 512]); }
#pragma unroll
        for (int i = 0; i < 8; ++i) { h = a[i] * h + bb[i]; YL[off + (size_t)(s + i) * 512] = f2bf(h * gelu_tanh(g[i])); }
    }
}

template <int D, bool CAUSAL, int VB0>
__device__ __forceinline__ void b_attn(const bf16_t* __restrict__ Q, const bf16_t* __restrict__ K, const bf16_t* __restrict__ V, bf16_t* __restrict__ O,
                                       const float* __restrict__ cum, int H, int Sq, int Skv, int pitch, int b, int h, int q0, int lane) {
    const int r32 = lane & 31, hi = lane >> 5;
    const bf16_t* Qp = Q + ((size_t)b * Sq + q0 + r32) * pitch + h * D;
    constexpr bool QREG = (D <= 64);
    bf16x8 qf[QREG ? D / 16 : 1];
    if (QREG) {
#pragma unroll
        for (int d0 = 0; d0 < D / 16; ++d0) qf[QREG ? d0 : 0] = *(const bf16x8*)(Qp + d0 * 16 + hi * 8);
    }
    f32x16 o[2];
#pragma unroll
    for (int i = 0; i < 2; ++i)
#pragma unroll
        for (int r = 0; r < 16; ++r) o[i][r] = 0.f;
    float m = -1e30f, l = 0.f;
    const int nkv = CAUSAL ? (q0 + 32) : Skv;
    const float* cb = cum ? cum + ((size_t)b * H + h) * Skv : nullptr;
    const float cref = cum ? cb[q0] : 0.f;
    const bf16_t* Kb = K + ((size_t)b * Skv) * pitch + h * D;
    const bf16_t* Vb = V + ((size_t)b * Skv) * pitch + h * D;
#pragma unroll 1
    for (int kv0 = 0; kv0 < nkv; kv0 += 32) {
        f32x16 s;
#pragma unroll
        for (int r = 0; r < 16; ++r) s[r] = 0.f;
        const bf16_t* Kp = Kb + (size_t)(kv0 + r32) * pitch;
#pragma unroll
        for (int d0 = 0; d0 < D / 16; ++d0) { bf16x8 kf = *(const bf16x8*)(Kp + d0 * 16 + hi * 8);
            bf16x8 qq; if (QREG) qq = qf[QREG ? d0 : 0]; else qq = *(const bf16x8*)(Qp + d0 * 16 + hi * 8);
            s = __builtin_amdgcn_mfma_f32_32x32x16_bf16(kf, qq, s, 0, 0, 0); }
        float tmax = -INFINITY;
#pragma unroll
        for (int r = 0; r < 16; ++r) {
            const int kv = kv0 + crow(r, hi);
            float v = s[r];
            if (cum) v += cref - cb[kv];
            if (CAUSAL && kv > q0 + r32) v = -INFINITY;
            s[r] = v; tmax = fmaxf(tmax, v);
        }
        tmax = fmaxf(tmax, __shfl_xor(tmax, 32));
        const float mnew = fmaxf(m, tmax);
        const float alpha = exp2f(m - mnew);
        float ps = 0.f;
#pragma unroll
        for (int r = 0; r < 16; ++r) { s[r] = exp2f(s[r] - mnew); ps += s[r]; }
        l = l * alpha + ps; m = mnew;
#pragma unroll
        for (int i = 0; i < 2; ++i)
#pragma unroll
            for (int r = 0; r < 16; ++r) o[i][r] *= alpha;
        bf16x8 pb[2];
#pragma unroll
        for (int s2 = 0; s2 < 2; ++s2)
#pragma unroll
            for (int j = 0; j < 8; ++j) pb[s2][j] = (short)f2bf(s[8 * s2 + j]);
#pragma unroll
        for (int i = 0; i < 2; ++i)
#pragma unroll
            for (int s2 = 0; s2 < 2; ++s2) {
                bf16x8 vf;
#pragma unroll
                for (int j = 0; j < 8; ++j) vf[j] = (short)Vb[(size_t)(kv0 + 16 * s2 + 8 * (j >> 2) + 4 * hi + (j & 3)) * pitch + (VB0 + i) * 32 + r32];
                o[i] = __builtin_amdgcn_mfma_f32_32x32x16_bf16(vf, pb[s2], o[i], 0, 0, 0);
                asm volatile("" ::: "memory");
            }
    }
    l += __shfl_xor(l, 32);
    const float rl = 1.f / l;
    bf16_t* Op = O + ((size_t)b * Sq + q0 + r32) * pitch + h * D;
#pragma unroll
    for (int i = 0; i < 2; ++i)
#pragma unroll
        for (int r = 0; r < 16; ++r) Op[(VB0 + i) * 32 + crow(r, hi)] = f2bf(o[i][r] * rl);
}

__device__ __forceinline__ void b_mixnorm(const bf16_t* __restrict__ YL, const bf16_t* __restrict__ YF, const float* __restrict__ gl, const float* __restrict__ gf, bf16_t* __restrict__ MIXED, int row, int lane) {
#pragma unroll
    for (int part = 0; part < 2; ++part) {
        const bf16_t* src = (part ? YF : YL) + (size_t)row * 512 + lane * 8;
        const float* g = (part ? gf : gl) + lane * 8;
        float v[8]; float ss = 0.f;
#pragma unroll
        for (int j = 0; j < 8; ++j) { v[j] = bf2f(src[j]); ss += v[j] * v[j]; }
        const float rstd = rsqrtf(wave_sum(ss) * (1.f / 512.f) + EPS);
        bf16_t* dst = MIXED + (size_t)row * DM + part * 512 + lane * 8;
#pragma unroll
        for (int j = 0; j < 8; ++j) dst[j] = f2bf(v[j] * rstd * g[j]);
    }
}

__device__ __forceinline__ void b_router(const bf16_t* __restrict__ XN, const float* __restrict__ wg, const float* __restrict__ bg, const float* __restrict__ we, const float* __restrict__ be,
                                         int* __restrict__ RE, float* __restrict__ RW, int* __restrict__ counts, int t, int lane) {
    float acc[36];
#pragma unroll
    for (int o = 0; o < 36; ++o) acc[o] = 0.f;
    const bf16_t* xr = XN + (size_t)t * DM;
#pragma unroll 1
    for (int i = 0; i < 16; ++i) {
        const int k = i * 64 + lane;
        const float xv = bf2f(xr[k]);
        const f32x4 g4 = *(const f32x4*)(wg + (size_t)k * 4);
        acc[0] += xv * g4.x; acc[1] += xv * g4.y; acc[2] += xv * g4.z; acc[3] += xv * g4.w;
        const f32x4* e4 = (const f32x4*)(we + (size_t)k * 32);
#pragma unroll
        for (int q = 0; q < 8; ++q) { const f32x4 e = e4[q]; acc[4 + 4 * q] += xv * e.x; acc[5 + 4 * q] += xv * e.y; acc[6 + 4 * q] += xv * e.z; acc[7 + 4 * q] += xv * e.w; }
    }
#pragma unroll
    for (int o = 0; o < 36; ++o) acc[o] = wave_sum(acc[o]);
    if (lane == 0) {
        float gl[4]; int gi = 0; float gmax;
#pragma unroll
        for (int j = 0; j < 4; ++j) { gl[j] = acc[j] + bg[j]; }
        gmax = gl[0];
#pragma unroll
        for (int j = 1; j < 4; ++j) if (gl[j] > gmax) { gmax = gl[j]; gi = j; }
        float gs = 0.f;
#pragma unroll
        for (int j = 0; j < 4; ++j) gs += __expf(gl[j] - gmax);
        const float gw = 1.f / gs;
        float el[8];
#pragma unroll
        for (int j = 0; j < 8; ++j) {
            float v = 0.f;
#pragma unroll
            for (int g = 0; g < 4; ++g) if (g == gi) v = acc[4 + g * 8 + j] + be[g * 8 + j];
            el[j] = v;
        }
        int i0 = 0; float v0 = el[0];
#pragma unroll
        for (int j = 1; j < 8; ++j) if (el[j] > v0) { v0 = el[j]; i0 = j; }
        int i1 = -1; float v1 = -INFINITY;
#pragma unroll
        for (int j = 0; j < 8; ++j) if (j != i0 && el[j] > v1) { v1 = el[j]; i1 = j; }
        const float e1 = __expf(v1 - v0);
        const float p0 = 1.f / (1.f + e1), p1 = e1 / (1.f + e1);
        const int ex0 = gi * 8 + i0, ex1 = gi * 8 + i1;
        RE[t * 2 + 0] = ex0; RE[t * 2 + 1] = ex1;
        RW[t * 2 + 0] = gw * p0; RW[t * 2 + 1] = gw * p1;
        atomicAdd(&counts[ex0], 1); atomicAdd(&counts[ex1], 1);
    }
}

__device__ __forceinline__ void b_moe_scan(int* __restrict__ ctl, int* __restrict__ TILEE, int tid, unsigned char* sm) {
    int* pst = (int*)sm;
    if (tid == 0) { int run = 0; for (int e = 0; e < N_EXP; ++e) { pst[e] = run; ctl[64 + e] = run; ctl[32 + e] = 0; run += (ctl[e] + MOE_PAD - 1) / MOE_PAD * MOE_PAD; } pst[32] = run; ctl[96] = run / MOE_PAD; }
    __syncthreads();
    for (int tile = tid; tile < N_TILES; tile += NTHREADS) {
        const int p = tile * MOE_PAD; int e = -1;
        for (int j = 0; j < N_EXP; ++j) if (p >= pst[j] && p < pst[j + 1]) e = j;
        TILEE[tile] = e;
    }
}

__device__ __forceinline__ void b_moe_gemm1(const bf16_t* __restrict__ XN, const float* __restrict__ Wg, const float* __restrict__ Wu, const int* __restrict__ ROWTOK, const int* __restrict__ TILEE, bf16_t* __restrict__ HDN,
                                            int vbx, int vby, int vt, unsigned char* sm) {
    As_t As = (As_t)sm; Bs_t Bs = (Bs_t)(sm + 64 * 40 * 2);
    const int e_raw = TILEE[vby];
    const int e = e_raw < 0 ? 0 : e_raw;
    const int lane = vt & 63, wid = vt >> 6, wr = wid >> 1, wc = wid & 1;
    const int p0 = vby * 64, n0 = vbx * 64;
    const int a = ROWTOK[p0 + (vt >> 2)];
    f32x4 acc[2][2][2];
#pragma unroll
    for (int b = 0; b < 2; ++b)
#pragma unroll
        for (int i = 0; i < 2; ++i)
#pragma unroll
            for (int j = 0; j < 2; ++j) acc[b][i][j] = (f32x4){0.f, 0.f, 0.f, 0.f};
    gemm_core64<2>(a >= 0 ? XN + (size_t)(a >> 1) * DM : nullptr, Wg + (size_t)e * DM * D_EXP, Wu + (size_t)e * DM * D_EXP, D_EXP, n0, D_EXP, DM, acc, As, Bs, vt);
    if (e_raw < 0) return;
#pragma unroll
    for (int i = 0; i < 2; ++i)
#pragma unroll
        for (int j = 0; j < 2; ++j)
#pragma unroll
            for (int r = 0; r < 4; ++r) {
                const int row = p0 + wr * 32 + i * 16 + (lane >> 4) * 4 + r, col = n0 + wc * 32 + j * 16 + (lane & 15);
                const float g = acc[0][i][j][r], u = acc[1][i][j][r];
                HDN[(size_t)row * D_EXP + col] = f2bf(g * sigmoidf_(g) * u);
            }
}
__device__ __forceinline__ void b_moe_gemm2(const bf16_t* __restrict__ HDN, const float* __restrict__ Wd, const int* __restrict__ ROWTOK, const int* __restrict__ TILEE, const float* __restrict__ RW, bf16_t* __restrict__ YB,
                                            int vbx, int vby, int vt, unsigned char* sm) {
    As_t As = (As_t)sm; Bs_t Bs = (Bs_t)(sm + 64 * 40 * 2);
    const int e_raw = TILEE[vby];
    const int e = e_raw < 0 ? 0 : e_raw;
    const int lane = vt & 63, wid = vt >> 6, wr = wid >> 1, wc = wid & 1;
    const int p0 = vby * 64, n0 = vbx * 64;
    f32x4 acc[1][2][2];
#pragma unroll
    for (int i = 0; i < 2; ++i)
#pragma unroll
        for (int j = 0; j < 2; ++j) acc[0][i][j] = (f32x4){0.f, 0.f, 0.f, 0.f};
    const int arow = ROWTOK[p0 + (vt >> 2)];
    gemm_core64<1>((arow >= 0 && e_raw >= 0) ? HDN + (size_t)(p0 + (vt >> 2)) * D_EXP : nullptr, Wd + (size_t)e * D_EXP * DM, nullptr, DM, n0, DM, D_EXP, acc, As, Bs, vt);
    if (e_raw < 0) return;
#pragma unroll
    for (int i = 0; i < 2; ++i)
#pragma unroll
        for (int r = 0; r < 4; ++r) {
            const int row = p0 + wr * 32 + i * 16 + (lane >> 4) * 4 + r;
            const int a = ROWTOK[row];
            if (a < 0) continue;
            const float w = RW[a];
#pragma unroll
            for (int j = 0; j < 2; ++j) { const int col = n0 + wc * 32 + j * 16 + (lane & 15); YB[(size_t)a * DM + col] = f2bf(w * acc[0][i][j][r]); }
        }
}
__device__ __forceinline__ void b_final2(float* __restrict__ o, const uint4 xv, const uint2 y0, const uint2 y1, const float w0, const float w1) {
    const unsigned xs[4] = {xv.x, xv.y, xv.z, xv.w};
    f32x4 o0, o1;
    o0[0] = __uint_as_float(xs[0] << 16) + (w0 * __builtin_amdgcn_cvt_f32_fp8(y0.x, 0) + w1 * __builtin_amdgcn_cvt_f32_fp8(y1.x, 0));
    o0[1] = __uint_as_float(xs[0] & 0xffff0000u) + (w0 * __builtin_amdgcn_cvt_f32_fp8(y0.x, 1) + w1 * __builtin_amdgcn_cvt_f32_fp8(y1.x, 1));
    o0[2] = __uint_as_float(xs[1] << 16) + (w0 * __builtin_amdgcn_cvt_f32_fp8(y0.x, 2) + w1 * __builtin_amdgcn_cvt_f32_fp8(y1.x, 2));
    o0[3] = __uint_as_float(xs[1] & 0xffff0000u) + (w0 * __builtin_amdgcn_cvt_f32_fp8(y0.x, 3) + w1 * __builtin_amdgcn_cvt_f32_fp8(y1.x, 3));
    o1[0] = __uint_as_float(xs[2] << 16) + (w0 * __builtin_amdgcn_cvt_f32_fp8(y0.y, 0) + w1 * __builtin_amdgcn_cvt_f32_fp8(y1.y, 0));
    o1[1] = __uint_as_float(xs[2] & 0xffff0000u) + (w0 * __builtin_amdgcn_cvt_f32_fp8(y0.y, 1) + w1 * __builtin_amdgcn_cvt_f32_fp8(y1.y, 1));
    o1[2] = __uint_as_float(xs[3] << 16) + (w0 * __builtin_amdgcn_cvt_f32_fp8(y0.y, 2) + w1 * __builtin_amdgcn_cvt_f32_fp8(y1.y, 2));
    o1[3] = __uint_as_float(xs[3] & 0xffff0000u) + (w0 * __builtin_amdgcn_cvt_f32_fp8(y0.y, 3) + w1 * __builtin_amdgcn_cvt_f32_fp8(y1.y, 3));
    *(f32x4*)o = o0; *(f32x4*)(o + 4) = o1;
}
__device__ __forceinline__ void b_final(float* __restrict__ out, const bf16_t* __restrict__ X2B, const unsigned char* __restrict__ YB, size_t i) {
    const size_t t = i / DM, c = i % DM;
    const uint4 xv = *(const uint4*)(X2B + i); const uint2 y0 = *(const uint2*)(YB + (2 * t) * DM + c), y1 = *(const uint2*)(YB + (2 * t + 1) * DM + c);
    const unsigned xs[4] = {xv.x, xv.y, xv.z, xv.w};
    f32x4 o0, o1;
    o0[0] = __uint_as_float(xs[0] << 16) + 0.0625f * (__builtin_amdgcn_cvt_f32_fp8(y0.x, 0) + __builtin_amdgcn_cvt_f32_fp8(y1.x, 0));
    o0[1] = __uint_as_float(xs[0] & 0xffff0000u) + 0.0625f * (__builtin_amdgcn_cvt_f32_fp8(y0.x, 1) + __builtin_amdgcn_cvt_f32_fp8(y1.x, 1));
    o0[2] = __uint_as_float(xs[1] << 16) + 0.0625f * (__builtin_amdgcn_cvt_f32_fp8(y0.x, 2) + __builtin_amdgcn_cvt_f32_fp8(y1.x, 2));
    o0[3] = __uint_as_float(xs[1] & 0xffff0000u) + 0.0625f * (__builtin_amdgcn_cvt_f32_fp8(y0.x, 3) + __builtin_amdgcn_cvt_f32_fp8(y1.x, 3));
    o1[0] = __uint_as_float(xs[2] << 16) + 0.0625f * (__builtin_amdgcn_cvt_f32_fp8(y0.y, 0) + __builtin_amdgcn_cvt_f32_fp8(y1.y, 0));
    o1[1] = __uint_as_float(xs[2] & 0xffff0000u) + 0.0625f * (__builtin_amdgcn_cvt_f32_fp8(y0.y, 1) + __builtin_amdgcn_cvt_f32_fp8(y1.y, 1));
    o1[2] = __uint_as_float(xs[3] << 16) + 0.0625f * (__builtin_amdgcn_cvt_f32_fp8(y0.y, 2) + __builtin_amdgcn_cvt_f32_fp8(y1.y, 2));
    o1[3] = __uint_as_float(xs[3] & 0xffff0000u) + 0.0625f * (__builtin_amdgcn_cvt_f32_fp8(y0.y, 3) + __builtin_amdgcn_cvt_f32_fp8(y1.y, 3));
    *(f32x4*)(out + i) = o0; *(f32x4*)(out + i + 4) = o1;
}

namespace pg8 {
typedef unsigned u32x4 __attribute__((ext_vector_type(4)));
typedef unsigned u32x2 __attribute__((ext_vector_type(2)));
typedef int v4i_t __attribute__((ext_vector_type(4)));
typedef int v8i_t __attribute__((ext_vector_type(8)));
constexpr int BM = 256, BK = 64, HALF = 128, HTB = HALF * BK * 2, STAGE_BYTES = 8 * HTB, NXCD = 8, WGM = 8;
__host__ __device__ __forceinline__ int lds_byte(int r, int c) { const int st = (r >> 4) * 2 + (c >> 5), rr = r & 15, cc = c & 31, ob = rr * 64 + cc * 2; return st * 1024 + (ob ^ (((ob >> 9) & 1) << 5)); }
__host__ __device__ __forceinline__ void stage_rc(int b, int& R, int& C) { const int st = b / 1024, sb = b % 1024, swz = sb ^ (((sb >> 9) & 1) << 5); R = (st >> 1) * 16 + swz / 64; C = (st & 1) * 32 + (swz % 64) / 2; }
__host__ __device__ __forceinline__ int perm32(int rho) { const int n = rho >> 4, i = rho & 15; return 8 * (i >> 2) + 4 * n + (i & 3); }
struct Unit { int pm, pn, e, r0, cnt; };
struct Gemm { const void* A; const void* Bt; int lda, ldb, K; size_t astride, bstride; int scale_a, scale_b; };
struct StaticOrder {
    static constexpr bool GATHER = false; static constexpr int ESZ = 2;
    int nM, nN, nwg, G, c, i0, i1;
    __device__ void init(int M, int N, int G_, int c_, int i0_ = 0, int i1_ = 1 << 30) { nM = M / BM; nN = N / BM; nwg = nM * nN; G = G_; c = c_; i0 = i0_; i1 = i1_; }
    __device__ bool next(int i, Unit& u) const {
        i += i0; if (i >= i1) return false;
        const long L = (long)i * G + c; if (L >= nwg) return false;
        int wgid = (int)L; { const int q = nwg / NXCD, r = nwg % NXCD, xcd = wgid % NXCD, off = wgid / NXCD; wgid = (xcd < r ? xcd * (q + 1) : r * (q + 1) + (xcd - r) * q) + off; }
        const int nig = WGM * nN, gid = wgid / nig, fm = gid * WGM, gsz = (nM - fm) < WGM ? (nM - fm) : WGM;
        u.pm = fm + ((wgid % nig) % gsz); u.pn = (wgid % nig) / gsz; u.e = 0; return true;
    }
};
__device__ __forceinline__ unsigned cvt_pk_bf16(float lo, float hi) { unsigned r; asm volatile("v_cvt_pk_bf16_f32 %0, %1, %2" : "=v"(r) : "v"(lo), "v"(hi)); return r; }

template <class E, class = void> struct epi_perm16 { static constexpr bool value = false; };
template <class E> struct epi_perm16<E, decltype((void)E::PERM16)> { static constexpr bool value = E::PERM16; };
__host__ __device__ __forceinline__ int perm16_row(int R) { return 64 * (R >> 5) + 16 * ((R >> 2) & 3) + 4 * ((R >> 4) & 1) + (R & 3); }
template <class Epi, class Sched, bool ALIGN_EPI>
__device__ __forceinline__ void gemm_phase(LAS unsigned char* lds, const Gemm g, const Sched& S, const Epi& E) {
    int tid = threadIdx.x; asm volatile("" : "+v"(tid));
    const int wid = __builtin_amdgcn_readfirstlane(tid >> 6), lane = tid & 63, wr = wid >> 2, wc = wid & 3, fr = lane & 15, fq = lane >> 4;
    constexpr int ESZ = Sched::ESZ;
    const int K = g.K, nt = K * ESZ / (BK * 2);
    unsigned voffA[2], voffB[2];
    constexpr bool P16 = epi_perm16<Epi>::value;
#pragma unroll
    for (int i = 0; i < 2; ++i) { int R, C; stage_rc(tid * 16 + i * 8192, R, C); const int Rb = P16 ? perm16_row(R) : Epi::PERM ? ((R & ~31) + perm32(R & 31)) : R;
        voffA[i] = (unsigned)(R * g.lda * ESZ + C * 2); voffB[i] = (unsigned)(Rb * g.ldb * ESZ + C * 2); }
    const size_t kstep = (size_t)(BK * 2);
    const size_t hstepA = (size_t)HALF * g.lda * ESZ, tstepA = 2 * hstepA;
    const size_t hstepB = (size_t)(P16 ? 8 : HALF) * g.ldb * ESZ, tstepB = (size_t)BM * g.ldb * ESZ;
    const unsigned ldsw = (unsigned)wid * 1024u;
    const int aoff = lds_byte(wr * 64 + fr, ESZ == 2 ? fq * 8 : fq * 16), boff = lds_byte(wc * 32 + fr, ESZ == 2 ? fq * 8 : fq * 16);
    constexpr int PIECE1 = ESZ == 2 ? 1024 : 16;
    unsigned la_ = (unsigned)(size_t)(lds + aoff), lb_ = (unsigned)(size_t)(lds + 65536 + boff);
    asm volatile("" : "+v"(la_), "+v"(lb_));
    const LAS unsigned char* ldsA = (const LAS unsigned char*)(size_t)la_; const LAS unsigned char* ldsB = (const LAS unsigned char*)(size_t)lb_;
#define PG8_SA(b, h) (((b) * 2 + (h)) * HTB)
#define PG8_SB(b, h) ((4 + (b) * 2 + (h)) * HTB)
#define PG8_STAGE(bufoff, gbase, voff) do { _Pragma("unroll") for (int _i = 0; _i < 2; ++_i) \
        __builtin_amdgcn_global_load_lds((const unsigned*)((const char*)(gbase) + (voff)[_i]), (LAS unsigned*)(lds + (bufoff) + ldsw + _i * 8192), 16, 0, 0); } while (0)
#define PG8_LDA(dst, b, h) do { _Pragma("unroll") for (int m = 0; m < 4; ++m) { dst[m][0] = *(const LAS bf16x8*)(ldsA + PG8_SA(b, h) + m * 2048); dst[m][1] = *(const LAS bf16x8*)(ldsA + PG8_SA(b, h) + m * 2048 + PIECE1); } } while (0)
#define PG8_LDB(dst, b, h) do { _Pragma("unroll") for (int n = 0; n < 2; ++n) { dst[n][0] = *(const LAS bf16x8*)(ldsB + (PG8_SB(b, h) - 65536) + n * 2048); dst[n][1] = *(const LAS bf16x8*)(ldsB + (PG8_SB(b, h) - 65536) + n * 2048 + PIECE1); } } while (0)
#define PG8_V8(x) __builtin_shufflevector(__builtin_bit_cast(v4i_t, (x)[0]), __builtin_bit_cast(v4i_t, (x)[1]), 0, 1, 2, 3, 4, 5, 6, 7)
#define PG8_MMA(ai, bj, At, Bt) do { __builtin_amdgcn_s_setprio(1); _Pragma("unroll") for (int m = 0; m < 4; ++m) _Pragma("unroll") for (int n = 0; n < 2; ++n) { \
        if constexpr (ESZ == 2) { _Pragma("unroll") for (int k = 0; k < 2; ++k) acc[ai][bj][m][n] = __builtin_amdgcn_mfma_f32_16x16x32_bf16(Bt[n][k], At[m][k], acc[ai][bj][m][n], 0, 0, 0); } \
        else { acc[ai][bj][m][n] = __builtin_amdgcn_mfma_scale_f32_16x16x128_f8f6f4(PG8_V8(Bt[n]), PG8_V8(At[m]), acc[ai][bj][m][n], 0, 0, 0, g.scale_b, 0, g.scale_a); \
               asm volatile("" : "+v"(acc[ai][bj][m][n])); } }     \
        __builtin_amdgcn_s_setprio(0); } while (0)
#define PG8_WAIT_V(n) asm volatile("s_waitcnt vmcnt(" #n ")" ::: "memory")
#define PG8_WAIT_L(n) asm volatile("s_waitcnt lgkmcnt(" #n ")" ::: "memory")
#define PG8_BAR __builtin_amdgcn_s_barrier()
#define PG8_SCHED __builtin_amdgcn_sched_barrier(0)
    Unit cur, nxt; int ui = 0;
    if (!S.next(0, cur)) return;
    f32x4 acc[2][2][4][2];
#pragma unroll
    for (int a = 0; a < 2; ++a)
#pragma unroll
        for (int b = 0; b < 2; ++b)
#pragma unroll
            for (int m = 0; m < 4; ++m)
#pragma unroll
                for (int n = 0; n < 2; ++n) acc[a][b][m][n] = (f32x4){0.f, 0.f, 0.f, 0.f};
    bf16x8 At[4][2], B0[2][2], B1[2][2];
    constexpr bool GATHER = Sched::GATHER;
    const size_t hsA = GATHER ? 0 : hstepA;
    unsigned c0[2], c1[2], n0[2], n1[2];
    if constexpr (GATHER) { S.a_offsets(cur, tid, g.lda, c0, c1); n0[0] = c0[0]; n0[1] = c0[1]; n1[0] = c1[0]; n1[1] = c1[1]; }
#define PG8_C0 (GATHER ? c0 : voffA)
#define PG8_C1 (GATHER ? c1 : voffA)
    const char* cA = (const char*)g.A + (GATHER ? (size_t)0 : ((size_t)cur.e * g.astride) * ESZ + (size_t)cur.pm * tstepA); const char* cB = (const char*)g.Bt + ((size_t)cur.e * g.bstride) * ESZ + (size_t)cur.pn * tstepB;
    PG8_STAGE(PG8_SB(0, 0), cB, voffB); PG8_STAGE(PG8_SB(0, 1), cB + hstepB, voffB); PG8_STAGE(PG8_SA(0, 0), cA, PG8_C0); PG8_STAGE(PG8_SA(0, 1), cA + hsA, PG8_C1);
    if (wr == 1) PG8_BAR;
    PG8_WAIT_V(2); PG8_BAR;
    PG8_STAGE(PG8_SB(1, 0), cB + kstep, voffB); PG8_STAGE(PG8_SA(1, 0), cA + kstep, PG8_C0); PG8_STAGE(PG8_SB(1, 1), cB + hstepB + kstep, voffB);
    PG8_WAIT_V(6); PG8_BAR;
    for (;;) {
        const bool has_next = S.next(ui + 1, nxt);
        const char* nA = (has_next && !GATHER) ? (const char*)g.A + ((size_t)nxt.e * g.astride) * ESZ + (size_t)nxt.pm * tstepA : cA; const char* nB = has_next ? (const char*)g.Bt + ((size_t)nxt.e * g.bstride) * ESZ + (size_t)nxt.pn * tstepB : cB;
        if constexpr (GATHER) { if (has_next) S.a_offsets(nxt, tid, g.lda, n0, n1); }
#pragma unroll 1
        for (int t = 0; t < nt; t += 2) {
            const bool last = (t == nt - 2);
            const char* a1 = cA + (size_t)(t + 1) * kstep;
            const char* a2 = last ? nA : cA + (size_t)(t + 2) * kstep; const char* b2 = last ? nB : cB + (size_t)(t + 2) * kstep;
            const char* a3 = a2 + kstep; const char* b3 = b2 + kstep;
            unsigned s0[2], s1[2];
            if constexpr (GATHER) {
#pragma unroll
                for (int i_ = 0; i_ < 2; ++i_) { s0[i_] = last ? n0[i_] : c0[i_]; s1[i_] = last ? n1[i_] : c1[i_]; }
            }
#define PG8_S0 (GATHER ? s0 : voffA)
#define PG8_S1 (GATHER ? s1 : voffA)
            PG8_LDB(B0, 0, 0); PG8_LDB(B1, 0, 1); PG8_SCHED; PG8_LDA(At, 0, 0); PG8_STAGE(PG8_SA(1, 1), a1 + hsA, PG8_C1);
            PG8_WAIT_V(8); PG8_WAIT_L(0); PG8_BAR; PG8_MMA(0, 0, At, B0); PG8_MMA(0, 1, At, B1); PG8_BAR; PG8_SCHED;
            PG8_LDA(At, 0, 1); PG8_STAGE(PG8_SB(0, 0), b2, voffB); PG8_STAGE(PG8_SB(0, 1), b2 + hstepB, voffB); PG8_STAGE(PG8_SA(0, 0), a2, PG8_S0);
            PG8_WAIT_V(8); PG8_WAIT_L(0); PG8_BAR; PG8_MMA(1, 0, At, B0); PG8_MMA(1, 1, At, B1); PG8_BAR; PG8_SCHED;
            PG8_LDB(B0, 1, 0); PG8_LDB(B1, 1, 1); PG8_SCHED; PG8_LDA(At, 1, 0); PG8_STAGE(PG8_SA(0, 1), a2 + hsA, PG8_S1);
            PG8_WAIT_V(8); PG8_WAIT_L(0); PG8_BAR; PG8_MMA(0, 0, At, B0); PG8_MMA(0, 1, At, B1); PG8_BAR; PG8_SCHED;
            PG8_LDA(At, 1, 1); PG8_STAGE(PG8_SB(1, 0), b3, voffB); PG8_STAGE(PG8_SB(1, 1), b3 + hstepB, voffB); PG8_STAGE(PG8_SA(1, 0), a3, PG8_S0);
            PG8_WAIT_V(8); PG8_WAIT_L(0); PG8_BAR; PG8_MMA(1, 0, At, B0); PG8_MMA(1, 1, At, B1); PG8_BAR; PG8_SCHED;
        }
        if constexpr (ALIGN_EPI) { if (wr == 0) PG8_BAR; }
        bool chained = false;
        {
            int te = threadIdx.x; asm volatile("" : "+v"(te));
            const int le = te & 63, fre = le & 15, fqe = le >> 4, we = __builtin_amdgcn_readfirstlane(te >> 6), wre = we >> 2, wce = we & 3;
            if constexpr (Epi::CHAIN) chained = E.chain(acc, cur, wre, wce, fre, fqe);
            if (!chained) E(acc, cur, wre, wce, fre, fqe);
        }
        if (!has_next) break;
        if (!chained) {
#pragma unroll
        for (int a = 0; a < 2; ++a)
#pragma unroll
            for (int b = 0; b < 2; ++b)
#pragma unroll
                for (int m = 0; m < 4; ++m)
#pragma unroll
                    for (int n = 0; n < 2; ++n) acc[a][b][m][n] = (f32x4){0.f, 0.f, 0.f, 0.f};
        }
        cur = nxt; cA = nA; cB = nB; ++ui; if constexpr (GATHER) { c0[0] = n0[0]; c0[1] = n0[1]; c1[0] = n1[0]; c1[1] = n1[1]; }
        if constexpr (ALIGN_EPI) { if (wr == 1) PG8_BAR; }
    }
    PG8_WAIT_V(0);
    if constexpr (!ALIGN_EPI) { if (wr == 0) PG8_BAR; }
    PG8_BAR;
#undef PG8_SA
#undef PG8_SB
#undef PG8_STAGE
#undef PG8_LDA
#undef PG8_LDB
#undef PG8_MMA
#undef PG8_V8
#undef PG8_C0
#undef PG8_C1
#undef PG8_S0
#undef PG8_S1
#undef PG8_WAIT_V
#undef PG8_WAIT_L
#undef PG8_BAR
#undef PG8_SCHED
}

struct EpiInProj {
    static constexpr bool PERM = true, CHAIN = false;
    bf16_t* U; const float *qg, *kg;
    static constexpr size_t SEC_STRIDE = (size_t)16 << 20;
    __device__ __forceinline__ void operator()(const f32x4 (&acc)[2][2][4][2], const Unit& u, int wr, int wc, int fr, int fq) const {
        const int sec = u.pn >> 1, row0 = u.pm * BM + wr * 64 + fr;
        const __amdgpu_buffer_rsrc_t ur = wt_rsrc(U);
        if (sec == 2 || sec == 3) {
            const bool isq = (sec == 2); const float sc = isq ? 0.125f * LOG2E : 1.0f;
            const int head = 4 * (u.pn & 1) + wc;
            const f32x4 q00 = *(const f32x4*)(qg + 8 * fq), q01 = *(const f32x4*)(qg + 8 * fq + 4), q10 = *(const f32x4*)(qg + 32 + 8 * fq), q11 = *(const f32x4*)(qg + 32 + 8 * fq + 4);
            const f32x4 k00 = *(const f32x4*)(kg + 8 * fq), k01 = *(const f32x4*)(kg + 8 * fq + 4), k10 = *(const f32x4*)(kg + 32 + 8 * fq), k11 = *(const f32x4*)(kg + 32 + 8 * fq + 4);
            const f32x4 gv00 = isq ? q00 : k00, gv01 = isq ? q01 : k01, gv10 = isq ? q10 : k10, gv11 = isq ? q11 : k11;
#pragma unroll
            for (int ai = 0; ai < 2; ++ai)
#pragma unroll
                for (int m = 0; m < 4; ++m) {
                    float ss = 0.f;
#pragma unroll
                    for (int bj = 0; bj < 2; ++bj)
#pragma unroll
                        for (int n = 0; n < 2; ++n) { const f32x4 x = acc[ai][bj][m][n]; ss += (x[0] * x[0] + x[1] * x[1]) + (x[2] * x[2] + x[3] * x[3]); }
                    ss += __shfl_xor(ss, 16); ss += __shfl_xor(ss, 32);
                    const float rs = rsqrtf(ss * (1.f / 64.f) + EPS) * sc;
                    const unsigned rowo = (unsigned)((sec * SEC_STRIDE + (size_t)(row0 + ai * HALF + m * 16) * 512 + head * 64 + 8 * fq) * 2);
#pragma unroll
                    for (int bj = 0; bj < 2; ++bj) { const f32x4 v0 = acc[ai][bj][m][0] * rs * (bj ? gv10 : gv00), v1 = acc[ai][bj][m][1] * rs * (bj ? gv11 : gv01);
                        u32x4 w; w.x = cvt_pk_bf16(v0[0], v0[1]); w.y = cvt_pk_bf16(v0[2], v0[3]); w.z = cvt_pk_bf16(v1[0], v1[1]); w.w = cvt_pk_bf16(v1[2], v1[3]);
                        st16_wt<WT0>(ur, rowo + bj * 64, w); }
                }
        } else {
            const int col0 = (u.pn & 1) * BM + wc * 32 + 8 * fq;
#pragma unroll
            for (int ai = 0; ai < 2; ++ai)
#pragma unroll
                for (int m = 0; m < 4; ++m) { const unsigned rowo = (unsigned)((sec * SEC_STRIDE + (size_t)(row0 + ai * HALF + m * 16) * 512 + col0) * 2);
#pragma unroll
                    for (int bj = 0; bj < 2; ++bj) { const f32x4 v0 = acc[ai][bj][m][0], v1 = acc[ai][bj][m][1];
                        u32x4 w; w.x = cvt_pk_bf16(v0[0], v0[1]); w.y = cvt_pk_bf16(v0[2], v0[3]); w.z = cvt_pk_bf16(v1[0], v1[1]); w.w = cvt_pk_bf16(v1[2], v1[3]);
                        st16_wt<WT0>(ur, rowo + bj * (HALF * 2), w); } }
        }
    }
};
struct EpiBf16 {
    static constexpr bool PERM = true, CHAIN = false;
    bf16_t *O0, *O1; int ldo, split;
    __device__ __forceinline__ void operator()(const f32x4 (&acc)[2][2][4][2], const Unit& u, int wr, int wc, int fr, int fq) const {
        int colt = u.pn * BM; bf16_t* base = O0; if (colt >= split) { colt -= split; base = O1; }
        const int row0 = u.pm * BM + wr * 64 + fr, col0 = colt + wc * 32 + 8 * fq;
        const __amdgpu_buffer_rsrc_t br = wt_rsrc(base);
#pragma unroll
        for (int ai = 0; ai < 2; ++ai)
#pragma unroll
            for (int m = 0; m < 4; ++m) { const unsigned rowo = (unsigned)(((size_t)(row0 + ai * HALF + m * 16) * ldo + col0) * 2);
#pragma unroll
                for (int bj = 0; bj < 2; ++bj) { const f32x4 v0 = acc[ai][bj][m][0], v1 = acc[ai][bj][m][1];
                    u32x4 w; w.x = cvt_pk_bf16(v0[0], v0[1]); w.y = cvt_pk_bf16(v0[2], v0[3]); w.z = cvt_pk_bf16(v1[0], v1[1]); w.w = cvt_pk_bf16(v1[2], v1[3]);
                    st16_wt<WTC>(br, rowo + bj * (HALF * 2), w); } }
    }
};
struct EpiResF32 {
    static constexpr bool PERM = false, CHAIN = false;
    const float* base; float* out;
    __device__ __forceinline__ void operator()(const f32x4 (&acc)[2][2][4][2], const Unit& u, int wr, int wc, int fr, int fq) const {
        const int row0 = u.pm * BM + wr * 64 + fr, col0 = u.pn * BM + wc * 32 + 4 * fq;
#pragma unroll
        for (int ai = 0; ai < 2; ++ai)
#pragma unroll
            for (int m = 0; m < 4; ++m) { const size_t off = (size_t)(row0 + ai * HALF + m * 16) * DM + col0;
#pragma unroll
                for (int bj = 0; bj < 2; ++bj)
#pragma unroll
                    for (int n = 0; n < 2; ++n) *(f32x4*)(out + off + bj * HALF + n * 16) = *(const f32x4*)(base + off + bj * HALF + n * 16) + acc[ai][bj][m][n]; }
    }
};


struct PairOrder {
    static constexpr bool GATHER = false; static constexpr int ESZ = 2;
    StaticOrder so;
    __device__ void init(int M, int N, int G_, int c_) { so.init(M, N, G_, c_); }
    __device__ bool next(int i, Unit& u) const { if (!so.next(i >> 1, u)) return false; u.e = i & 1; return true; }
};
struct OneTile {
    static constexpr bool GATHER = false; static constexpr int ESZ = 2;
    int pm, pn;
    __device__ bool next(int i, Unit& u) const { if (i >= 1) return false; u.pm = pm; u.pn = pn; u.e = 0; return true; }
};
__device__ __forceinline__ float rstd8(const float* p, float inv_n) { const f32x4 a = *(const f32x4*)p, b = *(const f32x4*)(p + 4); return rsqrtf(((a[0] + a[1]) + (a[2] + a[3]) + (b[0] + b[1]) + (b[2] + b[3])) * inv_n + EPS); }
__device__ __forceinline__ float rstd16(const float* p, float inv_n) { float t = 0.f;
#pragma unroll
    for (int i = 0; i < 4; ++i) { const f32x4 a = *(const f32x4*)(p + 4 * i); t += (a[0] + a[1]) + (a[2] + a[3]); } return rsqrtf(t * inv_n + EPS); }
struct EpiOutChain {
    static constexpr bool PERM = true, CHAIN = true;
    const float* x; bf16_t* x1b; const float* SSL; const float* SSF; float* SS1;
    __device__ __forceinline__ bool chain(f32x4 (&acc)[2][2][4][2], const Unit& u, int wr, int wc, int fr, int fq) const {
        if (u.e != 0) return false;
        const int row0 = u.pm * BM + wr * 64 + fr;
        float ratio[8];
#pragma unroll
        for (int i = 0; i < 8; ++i) { const int row = row0 + (i >> 2) * HALF + (i & 3) * 16; ratio[i] = rstd8(SSL + (size_t)row * 8, 1.f / 512.f) / rstd8(SSF + (size_t)row * 8, 1.f / 512.f); }
#pragma unroll
        for (int ai = 0; ai < 2; ++ai)
#pragma unroll
            for (int m = 0; m < 4; ++m)
#pragma unroll
                for (int bj = 0; bj < 2; ++bj)
#pragma unroll
                    for (int n = 0; n < 2; ++n) acc[ai][bj][m][n] *= ratio[ai * 4 + m];
        return true;
    }
    __device__ __forceinline__ void operator()(const f32x4 (&acc)[2][2][4][2], const Unit& u, int wr, int wc, int fr, int fq) const {
        const int row0 = u.pm * BM + wr * 64 + fr, col0 = u.pn * BM + wc * 32 + 8 * fq;
        const __amdgpu_buffer_rsrc_t xr_ = wt_rsrc(x1b);
        float rfv[8];
#pragma unroll
        for (int i = 0; i < 8; ++i) rfv[i] = rstd8(SSF + (size_t)(row0 + (i >> 2) * HALF + (i & 3) * 16) * 8, 1.f / 512.f);
#pragma unroll
        for (int pr = 0; pr < 4; ++pr) {
            const int ai = pr >> 1;
            f32x4 xv[2][2][2];
#pragma unroll
            for (int mm = 0; mm < 2; ++mm)
#pragma unroll
                for (int bj = 0; bj < 2; ++bj)
#pragma unroll
                    for (int n = 0; n < 2; ++n) xv[mm][bj][n] = *(const f32x4*)(x + (size_t)(row0 + ai * HALF + (2 * (pr & 1) + mm) * 16) * DM + col0 + bj * HALF + n * 4);
            asm volatile("" ::: "memory");
#pragma unroll
            for (int mm = 0; mm < 2; ++mm) { const int m = 2 * (pr & 1) + mm; const int row = row0 + ai * HALF + m * 16; const size_t off = (size_t)row * DM + col0;
                const float rf = rfv[ai * 4 + m]; float ss = 0.f;
#pragma unroll
                for (int bj = 0; bj < 2; ++bj) { const f32x4 v0 = xv[mm][bj][0] + acc[ai][bj][m][0] * rf, v1 = xv[mm][bj][1] + acc[ai][bj][m][1] * rf;
                    ss += ((v0[0] * v0[0] + v0[1] * v0[1]) + (v0[2] * v0[2] + v0[3] * v0[3])) + ((v1[0] * v1[0] + v1[1] * v1[1]) + (v1[2] * v1[2] + v1[3] * v1[3]));
                    u32x4 w; w.x = cvt_pk_bf16(v0[0], v0[1]); w.y = cvt_pk_bf16(v0[2], v0[3]); w.z = cvt_pk_bf16(v1[0], v1[1]); w.w = cvt_pk_bf16(v1[2], v1[3]);
                    st16_wt<WTA>(xr_, (unsigned)((off + bj * HALF) * 2), w); }
                ss += __shfl_xor(ss, 16); ss += __shfl_xor(ss, 32);
                if (fq == 0) SS1[(size_t)row * 16 + u.pn * 4 + wc] = ss; }
        }
    }
};
struct EpiRowScale {
    static constexpr bool PERM = true, CHAIN = false;
    bf16_t* O; int ldo; const float* SS; float inv_n;
    __device__ __forceinline__ void operator()(const f32x4 (&acc)[2][2][4][2], const Unit& u, int wr, int wc, int fr, int fq) const {
        const int row0 = u.pm * BM + wr * 64 + fr, col0 = u.pn * BM + wc * 32 + 8 * fq;
        const __amdgpu_buffer_rsrc_t orr = wt_rsrc(O);
        float rsv[8];
#pragma unroll
        for (int i = 0; i < 8; ++i) rsv[i] = rstd16(SS + (size_t)(row0 + (i >> 2) * HALF + (i & 3) * 16) * 16, inv_n);
#pragma unroll
        for (int ai = 0; ai < 2; ++ai)
#pragma unroll
            for (int m = 0; m < 4; ++m) { const int row = row0 + ai * HALF + m * 16; const float rs = rsv[ai * 4 + m]; const unsigned rowo = (unsigned)(((size_t)row * ldo + col0) * 2);
#pragma unroll
                for (int bj = 0; bj < 2; ++bj) { const f32x4 v0 = acc[ai][bj][m][0] * rs, v1 = acc[ai][bj][m][1] * rs;
                    u32x4 w; w.x = cvt_pk_bf16(v0[0], v0[1]); w.y = cvt_pk_bf16(v0[2], v0[3]); w.z = cvt_pk_bf16(v1[0], v1[1]); w.w = cvt_pk_bf16(v1[2], v1[3]);
                    st16_wt<WTA>(orr, rowo + bj * (HALF * 2), w); } }
    }
};

__device__ __forceinline__ float clamp_fp8(float v) { return __builtin_amdgcn_fmed3f(v, -448.f, 448.f); }
__device__ __forceinline__ unsigned cvt4_fp8(float a, float b, float c, float d) { int w = 0; w = __builtin_amdgcn_cvt_pk_fp8_f32(clamp_fp8(a), clamp_fp8(b), w, false); w = __builtin_amdgcn_cvt_pk_fp8_f32(clamp_fp8(c), clamp_fp8(d), w, true); return (unsigned)w; }
struct EpiX2 {
    static constexpr bool PERM = true, CHAIN = false;
    const bf16_t* x1b; bf16_t* xb; unsigned char* xq; float* SS;
    __device__ __forceinline__ void operator()(const f32x4 (&acc)[2][2][4][2], const Unit& u, int wr, int wc, int fr, int fq) const {
        const int row0 = u.pm * BM + wr * 64 + fr, col0 = u.pn * BM + wc * 32 + 8 * fq;
        const __amdgpu_buffer_rsrc_t xbr = wt_rsrc(xb), xqr = wt_rsrc(xq);
#pragma unroll
        for (int ai = 0; ai < 2; ++ai) {
            u32x4 xrv[4][2];
#pragma unroll
            for (int m = 0; m < 4; ++m)
#pragma unroll
                for (int bj = 0; bj < 2; ++bj) xrv[m][bj] = *(const u32x4*)(x1b + (size_t)(row0 + ai * HALF + m * 16) * DM + col0 + bj * HALF);
            asm volatile("" ::: "memory");
#pragma unroll
            for (int m = 0; m < 4; ++m) { const int row = row0 + ai * HALF + m * 16; const size_t off = (size_t)row * DM + col0; float ss = 0.f;
#pragma unroll
                for (int bj = 0; bj < 2; ++bj) { const u32x4 xr = xrv[m][bj];
                    f32x4 v0 = acc[ai][bj][m][0], v1 = acc[ai][bj][m][1];
                    v0[0] += __uint_as_float(xr.x << 16); v0[1] += __uint_as_float(xr.x & 0xffff0000u); v0[2] += __uint_as_float(xr.y << 16); v0[3] += __uint_as_float(xr.y & 0xffff0000u);
                    v1[0] += __uint_as_float(xr.z << 16); v1[1] += __uint_as_float(xr.z & 0xffff0000u); v1[2] += __uint_as_float(xr.w << 16); v1[3] += __uint_as_float(xr.w & 0xffff0000u);
                    ss += (v0[0] * v0[0] + v0[1] * v0[1]) + (v0[2] * v0[2] + v0[3] * v0[3]) + (v1[0] * v1[0] + v1[1] * v1[1]) + (v1[2] * v1[2] + v1[3] * v1[3]);
                    u32x4 w; w.x = cvt_pk_bf16(v0[0], v0[1]); w.y = cvt_pk_bf16(v0[2], v0[3]); w.z = cvt_pk_bf16(v1[0], v1[1]); w.w = cvt_pk_bf16(v1[2], v1[3]);
                    st16_wt<WTA>(xbr, (unsigned)((off + bj * HALF) * 2), w);
                    u32x2 q; q.x = cvt4_fp8(v0[0], v0[1], v0[2], v0[3]); q.y = cvt4_fp8(v1[0], v1[1], v1[2], v1[3]); st8_wt<WTA>(xqr, (unsigned)(off + bj * HALF), q); }
                ss += __shfl_xor(ss, 16); ss += __shfl_xor(ss, 32);
                if (fq == 0) SS[(size_t)row * 16 + u.pn * 4 + wc] = ss; }
        }
    }
};
template <bool GATHER_>
struct MoeOrder {
    static constexpr bool GATHER = GATHER_; static constexpr int ESZ = 1;
    int nu, G, c; const LAS int* pst  ; const int* LIST;
    __device__ bool next(int i, Unit& u) const {
        const int L = i * G + c; if (L >= nu) return false;
        const int x = L & 7, off = L >> 3, per = nu >> 3, r = nu & 7;
        const int wg = (x < r ? x * (per + 1) : r * (per + 1) + (x - r) * per) + off;
        u.pm = wg >> 2; u.pn = wg & 3;
        const int row = u.pm * BM; const int e = pst[128 + u.pm];
        u.e = e; u.r0 = row - pst[e]; u.cnt = pst[64 + e]; return true;
    }
    __device__ __forceinline__ int assignment(const Unit& u, int r) const { const int rank = u.r0 + r; const bool ok = rank < u.cnt; const int a = LIST[(size_t)u.e * T + (ok ? rank : 0)]; return ok ? a : -1; }
    __device__ __forceinline__ void a_offsets(const Unit& u, int tid, int lda, unsigned (&o0)[2], unsigned (&o1)[2]) const {
#pragma unroll
        for (int i = 0; i < 2; ++i) { int R, C; stage_rc(tid * 16 + i * 8192, R, C);
            const int a0 = assignment(u, R), a1 = assignment(u, HALF + R);
            o0[i] = (unsigned)((a0 < 0 ? 0 : a0 >> 1) * lda * ESZ + C * 2); o1[i] = (unsigned)((a1 < 0 ? 0 : a1 >> 1) * lda * ESZ + C * 2); }
    }
};
struct EpiMoe1 {
    static constexpr bool PERM = true, CHAIN = false;
    unsigned char* HDN; const float* RSL;
    __device__ __forceinline__ void operator()(const f32x4 (&acc)[2][2][4][2], const Unit& u, int wr, int wc, int fr, int fq) const {
        const int r0 = wr * 64 + fr, col0 = u.pn * HALF + wc * 32 + 8 * fq;
        float rsv[8];
#pragma unroll
        for (int i = 0; i < 8; ++i) { const int rank = u.r0 + r0 + (i >> 2) * HALF + (i & 3) * 16; const bool ok = rank < u.cnt; const float v = RSL[(size_t)u.e * T + (ok ? rank : 0)]; rsv[i] = ok ? v : 0.f; }
#pragma unroll
        for (int ai = 0; ai < 2; ++ai)
#pragma unroll
            for (int m = 0; m < 4; ++m) {
                const int r = r0 + ai * HALF + m * 16;
                const float rs = rsv[ai * 4 + m], rl = -LOG2E * rs, r8 = 8.f * rs;
                f32x4 h0, h1;
#pragma unroll
                for (int e = 0; e < 4; ++e) { const float a0 = acc[ai][0][m][0][e], a1 = acc[ai][0][m][1][e];
                    h0[e] = (rs * a0) * (r8 * acc[ai][1][m][0][e]) * __builtin_amdgcn_rcpf(1.f + __builtin_amdgcn_exp2f(rl * a0));
                    h1[e] = (rs * a1) * (r8 * acc[ai][1][m][1][e]) * __builtin_amdgcn_rcpf(1.f + __builtin_amdgcn_exp2f(rl * a1)); }
                u32x2 w; w.x = cvt4_fp8(h0[0], h0[1], h0[2], h0[3]); w.y = cvt4_fp8(h1[0], h1[1], h1[2], h1[3]);
                st8_wt<WTB>(wt_rsrc(HDN), (unsigned)((size_t)(u.pm * BM + r) * D_EXP + col0), w);
            }
    }
};
struct EpiMoe2 {
    static constexpr bool PERM = true, CHAIN = false, PERM16 = true;
    unsigned char* Y;
    __device__ __forceinline__ void operator()(const f32x4 (&acc)[2][2][4][2], const Unit& u, int wr, int wc, int fr, int fq) const {
        const int r0 = u.pm * BM + wr * 64 + fr, col0 = u.pn * BM + wc * 64 + 16 * fq;
#pragma unroll
        for (int ai = 0; ai < 2; ++ai)
#pragma unroll
            for (int m = 0; m < 4; ++m) {
                u32x4 w;
                { const f32x4 v0 = acc[ai][0][m][0] * 8.f, v1 = acc[ai][0][m][1] * 8.f; w.x = cvt4_fp8(v0[0], v0[1], v0[2], v0[3]); w.y = cvt4_fp8(v1[0], v1[1], v1[2], v1[3]); }
                { const f32x4 v0 = acc[ai][1][m][0] * 8.f, v1 = acc[ai][1][m][1] * 8.f; w.z = cvt4_fp8(v0[0], v0[1], v0[2], v0[3]); w.w = cvt4_fp8(v1[0], v1[1], v1[2], v1[3]); }
                st16_wt<WTB>(wt_rsrc(Y), (unsigned)((size_t)(r0 + ai * HALF + m * 16) * DM + col0), w);
            }
    }
};
}


namespace rtr {
__device__ __forceinline__ void task(int t0, const bf16_t* __restrict__ X2B, const bf16_t* __restrict__ WTR, const float* __restrict__ SS2, const float* __restrict__ bg, const float* __restrict__ be,
                                     float* __restrict__ RW, float* __restrict__ RSL, int* __restrict__ POSR, int* __restrict__ cnt, int* __restrict__ LIST, LAS float* lg  , const LAS unsigned char* wr, LAS int* hist  , int lane) {
    int ex0_ = 0, ex1_ = 0, lr0_ = 0, lr1_ = 0; float rs_ = 0.f;
    const int fr = lane & 15, kq = lane >> 4;
    f32x4 acc[3];
#pragma unroll
    for (int n = 0; n < 3; ++n) acc[n] = (f32x4){0.f, 0.f, 0.f, 0.f};
    const LAS unsigned char* bp0 = wr + fr * 2064 + 16 * kq, *bp1 = wr + (16 + fr) * 2064 + 16 * kq, *bp2 = wr + (32 + (fr & 3)) * 2064 + 16 * kq;
    const bool n2ok = fr < 4;
    LAS unsigned char* xs = (LAS unsigned char*)lg;
#pragma unroll 1
    for (int q = 0; q < 4; ++q) {
#pragma unroll
        for (int i = 0; i < 8; ++i) {
            const int r = 2 * i + (lane >> 5);
            const pg8::u32x4 v = *(const pg8::u32x4*)(X2B + (size_t)(t0 + r) * DM + q * 256 + (lane & 31) * 8);
            *(LAS pg8::u32x4*)(xs + r * 528 + (lane & 31) * 16) = v; }
        asm volatile("s_waitcnt vmcnt(0) lgkmcnt(0)" ::: "memory");
#pragma unroll
        for (int ks = 0; ks < 8; ++ks) {
            const bf16x8 a = *(const LAS bf16x8*)(xs + fr * 528 + ks * 64 + kq * 16);
            const int ko = q * 512 + ks * 64;
            const bf16x8 b0 = *(const LAS bf16x8*)(bp0 + ko), b1 = *(const LAS bf16x8*)(bp1 + ko); bf16x8 b2 = *(const LAS bf16x8*)(bp2 + ko);
            if (!n2ok) b2 = (bf16x8){0, 0, 0, 0, 0, 0, 0, 0};
            acc[0] = __builtin_amdgcn_mfma_f32_16x16x32_bf16(a, b0, acc[0], 0, 0, 0); acc[1] = __builtin_amdgcn_mfma_f32_16x16x32_bf16(a, b1, acc[1], 0, 0, 0); acc[2] = __builtin_amdgcn_mfma_f32_16x16x32_bf16(a, b2, acc[2], 0, 0, 0);
        }
        asm volatile("s_waitcnt lgkmcnt(0)" ::: "memory");
    }
#pragma unroll
    for (int n = 0; n < 3; ++n)
#pragma unroll
        for (int r = 0; r < 4; ++r) lg[(4 * kq + r) * 52 + 16 * n + fr] = acc[n][r];
    asm volatile("s_waitcnt lgkmcnt(0)" ::: "memory");
    if (lane < 16) {
        const int t = t0 + lane;
        const float rs = pg8::rstd16(SS2 + (size_t)t * 16, 1.f / DM);
        float v[36];
#pragma unroll
        for (int q = 0; q < 9; ++q) { const f32x4 x4 = *(const LAS f32x4*)(lg + lane * 52 + 4 * q); v[4 * q] = x4[0] * rs; v[4 * q + 1] = x4[1] * rs; v[4 * q + 2] = x4[2] * rs; v[4 * q + 3] = x4[3] * rs; }
        int gi = 0; float gmax = v[0] + bg[0]; float gl[4];
#pragma unroll
        for (int j = 0; j < 4; ++j) gl[j] = v[j] + bg[j];
#pragma unroll
        for (int j = 1; j < 4; ++j) if (gl[j] > gmax) { gmax = gl[j]; gi = j; }
        float gs = 0.f;
#pragma unroll
        for (int j = 0; j < 4; ++j) gs += __expf(gl[j] - gmax);
        const float gw = 1.f / gs;
        float el[8];
#pragma unroll
        for (int j = 0; j < 8; ++j) { float x = 0.f;
#pragma unroll
            for (int g = 0; g < 4; ++g) if (g == gi) x = v[4 + g * 8 + j] + be[g * 8 + j];
            el[j] = x; }
        int i0 = 0; float v0 = el[0];
#pragma unroll
        for (int j = 1; j < 8; ++j) if (el[j] > v0) { v0 = el[j]; i0 = j; }
        int i1 = -1; float v1 = -INFINITY;
#pragma unroll
        for (int j = 0; j < 8; ++j) if (j != i0 && el[j] > v1) { v1 = el[j]; i1 = j; }
        const float e1 = __expf(v1 - v0);
        const float p0 = 1.f / (1.f + e1), p1 = e1 / (1.f + e1);
        const int ex0 = gi * 8 + i0, ex1 = gi * 8 + i1;
        RW[t * 2 + 0] = gw * p0; RW[t * 2 + 1] = gw * p1; rs_ = rs;
        ex0_ = ex0; ex1_ = ex1;
        lr0_ = __hip_atomic_fetch_add((int*)hist + ex0, 1, __ATOMIC_RELAXED, __HIP_MEMORY_SCOPE_WORKGROUP); lr1_ = __hip_atomic_fetch_add((int*)hist + ex1, 1, __ATOMIC_RELAXED, __HIP_MEMORY_SCOPE_WORKGROUP);
    }
    asm volatile("s_waitcnt lgkmcnt(0)" ::: "memory");
    __syncthreads();
    if (threadIdx.x < N_EXP) { const int c_ = hist[threadIdx.x]; hist[32 + threadIdx.x] = c_ ? atomicAdd(&cnt[threadIdx.x], c_) : 0; }
    __syncthreads();
    if (lane < 16) { const int t = t0 + lane;
        const int p0 = hist[32 + ex0_] + lr0_, p1 = hist[32 + ex1_] + lr1_;
        LIST[(size_t)ex0_ * T + p0] = 2 * t; LIST[(size_t)ex1_ * T + p1] = 2 * t + 1;
        RSL[(size_t)ex0_ * T + p0] = rs_; RSL[(size_t)ex1_ * T + p1] = rs_;
        POSR[2 * t] = (ex0_ << 20) | p0; POSR[2 * t + 1] = (ex1_ << 20) | p1; }
}
}

template <int ROWMAP>
__device__ __forceinline__ int wt_rowmap(int n) {
    if (ROWMAP == 1) {
        if (n >= 1024 && n < 2048) { const int sec = (n - 1024) >> 9, cc = (n - 1024) & 511, h = cc >> 6, d = cc & 63;
            return 1024 + sec * 512 + (h >> 2) * 256 + 128 * (d >> 5) + 32 * (h & 3) + (d & 31); }
    }
    if (ROWMAP == 2) return 256 * (n >> 7) + (n & 127);
    if (ROWMAP == 3) return 256 * (n >> 7) + 128 + (n & 127);
    return n;
}
template <int ROWMAP, bool GAIN>
__device__ __forceinline__ void p0_transpose_item(const float* __restrict__ W, int ldw, int K, int N, bf16_t* __restrict__ WT, LAS unsigned* scr  , int item, int lane,
                                                  const float* __restrict__ g0, const float* __restrict__ g1, int ksplit) {
    const int nblk = N / 64, kb = item / nblk, nb = item % nblk, k0 = 128 * kb, n0 = 64 * nb;
    const int kp = lane >> 4, nq = lane & 15;
    const float* wp = W + (size_t)(k0 + 2 * kp) * ldw + n0 + 4 * nq;
#pragma unroll
    for (int hb = 0; hb < 2; ++hb) {
        f32x4 av[8], bv[8];
#pragma unroll
        for (int i = 0; i < 8; ++i) { const int it = 8 * hb + i; av[i] = *(const f32x4*)(wp + (size_t)(8 * it) * ldw); bv[i] = *(const f32x4*)(wp + (size_t)(8 * it + 1) * ldw); }
        asm volatile("" ::: "memory");
#pragma unroll
        for (int i = 0; i < 8; ++i) { const int it = 8 * hb + i; f32x4 a = av[i], b = bv[i];
            if (GAIN) { const int k = k0 + 8 * it + 2 * kp; const float* gp = (k0 < ksplit) ? g0 + k : g1 + (k - ksplit); a *= gp[0]; b *= gp[1]; }
            LAS unsigned* d = scr + (4 * nq) * 68 + 4 * it + kp;
            d[0] = pg8::cvt_pk_bf16(a[0], b[0]); d[68] = pg8::cvt_pk_bf16(a[1], b[1]); d[136] = pg8::cvt_pk_bf16(a[2], b[2]); d[204] = pg8::cvt_pk_bf16(a[3], b[3]); }
    }
    asm volatile("s_waitcnt lgkmcnt(0)" ::: "memory");
#pragma unroll 4
    for (int j = 0; j < 16; ++j) { const int n = (lane >> 4) + 4 * j, c = lane & 15;
        const pg8::u32x4 o = *(const LAS pg8::u32x4*)(scr + n * 68 + 4 * c);
        st16_wt<16>(wt_rsrc(WT), (unsigned)(((size_t)wt_rowmap<ROWMAP>(n0 + n) * K + k0 + 8 * c) * 2), o); }
    asm volatile("s_waitcnt lgkmcnt(0)" ::: "memory");
}


__device__ __forceinline__ float clampq(float v) { return __builtin_amdgcn_fmed3f(v, -448.f, 448.f); }
template <int ROWMAP, bool GAIN>
__device__ __forceinline__ void p0_transpose_item_q(const float* __restrict__ W, int ldw, int K, int N, unsigned char* __restrict__ WQ, LAS unsigned char* scr, int item, int lane, const float* __restrict__ g0) {
    const int nblk = N / 64, kb = item / nblk, nb = item % nblk, k0 = 128 * kb, n0 = 64 * nb;
    const int kp = lane >> 4, nq = lane & 15;
    const float* wp = W + (size_t)(k0 + 8 * kp) * ldw + n0 + 4 * nq;
#pragma unroll
    for (int hb = 0; hb < 2; ++hb) {
        f32x4 v[2][8];
#pragma unroll
        for (int jj = 0; jj < 2; ++jj)
#pragma unroll
            for (int r = 0; r < 8; ++r) v[jj][r] = *(const f32x4*)(wp + (size_t)(32 * (2 * hb + jj) + r) * ldw);
        asm volatile("" ::: "memory");
#pragma unroll
        for (int jj = 0; jj < 2; ++jj) { const int j = 2 * hb + jj;
            f32x4 g0v = {32.f, 32.f, 32.f, 32.f}, g1v = g0v;
            if (GAIN) { const float* gp = g0 + k0 + 32 * j + 8 * kp; g0v *= *(const f32x4*)gp; g1v *= *(const f32x4*)(gp + 4); }
#pragma unroll
            for (int e = 0; e < 4; ++e) {
                int w0 = 0, w1 = 0;
                w0 = __builtin_amdgcn_cvt_pk_fp8_f32(clampq(v[jj][0][e] * g0v[0]), clampq(v[jj][1][e] * g0v[1]), w0, false); w0 = __builtin_amdgcn_cvt_pk_fp8_f32(clampq(v[jj][2][e] * g0v[2]), clampq(v[jj][3][e] * g0v[3]), w0, true);
                w1 = __builtin_amdgcn_cvt_pk_fp8_f32(clampq(v[jj][4][e] * g1v[0]), clampq(v[jj][5][e] * g1v[1]), w1, false); w1 = __builtin_amdgcn_cvt_pk_fp8_f32(clampq(v[jj][6][e] * g1v[2]), clampq(v[jj][7][e] * g1v[3]), w1, true);
                pg8::u32x2 w; w.x = (unsigned)w0; w.y = (unsigned)w1;
                *(LAS pg8::u32x2*)(scr + (4 * nq + e) * 144 + 32 * j + 8 * kp) = w; }
        }
    }
    asm volatile("s_waitcnt lgkmcnt(0)" ::: "memory");
#pragma unroll 4
    for (int j = 0; j < 8; ++j) { const int n = (lane >> 3) + 8 * j, c = lane & 7;
        const pg8::u32x4 o = *(const LAS pg8::u32x4*)(scr + n * 144 + 16 * c);
        st16_wt<WTD>(wt_rsrc(WQ), (unsigned)((size_t)wt_rowmap<ROWMAP>(n0 + n) * K + k0 + 16 * c), o); }
    asm volatile("s_waitcnt lgkmcnt(0)" ::: "memory");
}

constexpr int CW_P0A = 1056, CW_P0B = 1072;
constexpr int CW_LRUC = 1024, CW_CUMC = 1040;
namespace fox {
using bf16 = unsigned short;
using s16x4 = __attribute__((ext_vector_type(4))) short;
using u32x4 = __attribute__((ext_vector_type(4))) unsigned;
constexpr int NHEAD = FOX_H, D = 64, DMP = 512;
constexpr int NW = 8, QBLK = 32, QB = QBLK * NW, KVBLK = 64, NQB = SEQ / QB;
#define SBAR() __builtin_amdgcn_sched_barrier(0)
__device__ __forceinline__ void cmask(f32x16& p0, f32x16& p1, int jb, int qrel, int hi) {
  const float NEG = -INFINITY; int kb = 64 * jb + 4 * hi;
  #pragma unroll
  for (int r = 0; r < 16; ++r) { int kv = kb + (r & 3) + 8 * (r >> 2); if (kv > qrel) p0[r] = NEG; if (kv + 32 > qrel) p1[r] = NEG; }
}
constexpr int NSLOT = 3, SLOTB = 8192;
constexpr int LDS_K = 0, LDS_V = NSLOT * SLOTB, LDS_WS = 2 * NSLOT * SLOTB, LDS_OST = LDS_WS + NW * 64 * 4, LDS_BIAS = LDS_OST + NW * 4096, LDS_BYTES = LDS_BIAS + (SEQ + 64) * 4;
__device__ __forceinline__ void glds16(const void* gsrc, unsigned lds_dst) { unsigned keep;
  asm volatile("s_mov_b32 %0, m0\n\ts_mov_b32 m0, %2\n\ts_nop 0\n\tglobal_load_lds_dwordx4 %1, off\n\ts_mov_b32 m0, %0" : "=&s"(keep) : "v"(gsrc), "s"(lds_dst) : "memory"); }
__device__ __forceinline__ float max3f(float a, float b, float c) { float r; asm("v_max3_f32 %0, %1, %2, %3" : "=v"(r) : "v"(a), "v"(b), "v"(c)); return r; }
__device__ __forceinline__ float max2f(float a, float b) { float r; asm("v_max_f32_e32 %0, %1, %2" : "=v"(r) : "v"(a), "v"(b)); return r; }
__device__ __forceinline__ float fadd_s(float a, float b) { float r; asm("v_add_f32_e32 %0, %1, %2" : "=v"(r) : "v"(a), "v"(b)); return r; }
__device__ __forceinline__ float fsub_s(float a, float b) { float r; asm("v_sub_f32_e32 %0, %1, %2" : "=v"(r) : "v"(a), "v"(b)); return r; }
typedef float f32x2_t __attribute__((ext_vector_type(2))); typedef __bf16 bf16x2_t __attribute__((ext_vector_type(2)));
__device__ __forceinline__ unsigned cvtpk_s(float lo, float hi) { f32x2_t v = {lo, hi}; bf16x2_t b = __builtin_convertvector(v, bf16x2_t); return __builtin_bit_cast(unsigned, b); }
#define WAIT_BAR(N) asm volatile("s_waitcnt vmcnt(" #N ") lgkmcnt(0)\n\ts_barrier" ::: "memory")
typedef __attribute__((address_space(3))) const char* lds_cptr;
typedef short v4i16_t __attribute__((ext_vector_type(4)));
__device__ __forceinline__ void qkt(f32x16& p0, f32x16& p1, const char* Kslot, const bf16x8* qr, int r32, int hi) {
  const char* kb = Kslot + hi * 1024 + r32 * 16;
  #pragma unroll
  for (int d0 = 0; d0 < 4; ++d0) {
    const bf16x8 b0 = *reinterpret_cast<const bf16x8*>(kb + d0 * 2048);
    const bf16x8 b1 = *reinterpret_cast<const bf16x8*>(kb + d0 * 2048 + 512);
    p0 = __builtin_amdgcn_mfma_f32_32x32x16_bf16(b0, qr[d0], p0, 0, 0, 0); p1 = __builtin_amdgcn_mfma_f32_32x32x16_bf16(b1, qr[d0], p1, 0, 0, 0); }
}
__device__ __forceinline__ void kload8(bf16x8* kf, lds_cptr kp) {
  kf[0] = *(const LAS bf16x8*)(kp);        kf[1] = *(const LAS bf16x8*)(kp + 512);
  kf[2] = *(const LAS bf16x8*)(kp + 2048); kf[3] = *(const LAS bf16x8*)(kp + 2560);
  kf[4] = *(const LAS bf16x8*)(kp + 4096); kf[5] = *(const LAS bf16x8*)(kp + 4608);
  kf[6] = *(const LAS bf16x8*)(kp + 6144); kf[7] = *(const LAS bf16x8*)(kp + 6656);
}
__device__ __forceinline__ void kload2(bf16x8* kf, lds_cptr kp, int j) { kf[2 * j] = *(const LAS bf16x8*)(kp + j * 2048); kf[2 * j + 1] = *(const LAS bf16x8*)(kp + j * 2048 + 512); }
__device__ __forceinline__ s16x4 vtr(lds_cptr p) { return __builtin_bit_cast(s16x4, __builtin_amdgcn_ds_read_tr16_b64_v4i16((LAS v4i16_t*)p)); }
__device__ __forceinline__ float rowmax(const f32x16& p0, const f32x16& p1) {
  float a = max3f(p0[0], p0[1], p1[0]), b = max3f(p0[2], p0[3], p1[1]); a = max3f(a, p1[2], p1[3]);
  #pragma unroll
  for (int r = 4; r < 16; r += 4) { a = max3f(a, p0[r], p0[r + 1]); b = max3f(b, p0[r + 2], p0[r + 3]); a = max3f(a, p1[r], p1[r + 1]); b = max3f(b, p1[r + 2], p1[r + 3]); }
  const float m = max2f(a, b);
  auto rr = __builtin_amdgcn_permlane32_swap(__float_as_uint(m), __float_as_uint(m), false, false);
  return max2f(__uint_as_float(rr[0]), __uint_as_float(rr[1]));
}
__device__ __forceinline__ void pv(f32x16* o, int vb, bf16x8 pa0, bf16x8 pa1, bf16x8 pa2, bf16x8 pa3) {
  #pragma unroll
  for (int d0 = 0; d0 < 2; ++d0) { s16x4 lo[4], hi[4];
    #pragma unroll
    for (int ks = 0; ks < 4; ++ks) {
      asm volatile("ds_read_b64_tr_b16 %0,%1 offset:%c2" : "=&v"(lo[ks]) : "v"(vb), "i"(d0 * 4096 + ks * 1024) : "memory");
      asm volatile("ds_read_b64_tr_b16 %0,%1 offset:%c2" : "=&v"(hi[ks]) : "v"(vb), "i"(d0 * 4096 + ks * 1024 + 512) : "memory"); }
    asm volatile("s_waitcnt lgkmcnt(0)" ::: "memory"); SBAR();
    #define PK(k) (bf16x8){lo[k][0], lo[k][1], lo[k][2], lo[k][3], hi[k][0], hi[k][1], hi[k][2], hi[k][3]}
    o[d0] = __builtin_amdgcn_mfma_f32_32x32x16_bf16(pa0, PK(0), o[d0], 0, 0, 0);
    o[d0] = __builtin_amdgcn_mfma_f32_32x32x16_bf16(pa1, PK(1), o[d0], 0, 0, 0);
    o[d0] = __builtin_amdgcn_mfma_f32_32x32x16_bf16(pa2, PK(2), o[d0], 0, 0, 0);
    o[d0] = __builtin_amdgcn_mfma_f32_32x32x16_bf16(pa3, PK(3), o[d0], 0, 0, 0);
    #undef PK
  }
}
#define BLD(X0, X1, bp) do { _Pragma("unroll") for (int g_ = 0; g_ < 4; ++g_) { const f32x4 b0_ = *(const LAS f32x4*)((bp) + 32 * g_), b1_ = *(const LAS f32x4*)((bp) + 128 + 32 * g_); \
    X0[4 * g_] = b0_[0]; X0[4 * g_ + 1] = b0_[1]; X0[4 * g_ + 2] = b0_[2]; X0[4 * g_ + 3] = b0_[3]; X1[4 * g_] = b1_[0]; X1[4 * g_ + 1] = b1_[1]; X1[4 * g_ + 2] = b1_[2]; X1[4 * g_ + 3] = b1_[3]; } } while (0)

template <int THRL> __device__ __forceinline__ void attn_unit(int b, int h, int qb, const bf16* Q, const bf16* __restrict__ K, const bf16* __restrict__ V, bf16* O, const float* __restrict__ CUM, float* __restrict__ SSF, char* shm, int* counter, int& nxt) {
  int tid = threadIdx.x; asm volatile("" : "+v"(tid));
  const int lane = tid & 63, r32 = lane & 31, hi = lane >> 5; const int wid = __builtin_amdgcn_readfirstlane(tid >> 6);
  const long rowbase = (long)b * SEQ; const int q0 = qb * QB;
  const bf16* Qw = Q + (rowbase + q0 + wid * QBLK) * DMP + h * D;
  const float* cbs = CUM + ((long)b * NHEAD + h) * SEQ;
  int t_start = 0;
  { const int ntile = (q0 + QB) / KVBLK; const float cq = cbs[q0]; const float ce = cbs[(lane < ntile ? lane : ntile - 1) * KVBLK + KVBLK - 1];
    const unsigned long long keep = __ballot(lane < ntile && (cq - ce >= -64.0f));
    t_start = keep ? (int)__builtin_ctzll(keep) : 0; t_start &= ~1; if (t_start > ntile - 4) t_start = ntile - 4;
    t_start = __builtin_amdgcn_readfirstlane(t_start); }
  const int skip_rows = t_start * KVBLK;
  const bf16 *Kh = K + (rowbase + skip_rows) * DMP + h * D, *Vh = V + (rowbase + skip_rows) * DMP + h * D;
  const unsigned lds0 = (unsigned)(uintptr_t)shm;
  float* wsf = (float*)(shm + LDS_WS) + wid * 64;
  const bf16* ksrc = Kh + (long)lane * DMP + wid * 8;
  const bf16* vsrc = Vh + (long)(16 * (wid & 3) + (lane >> 2)) * DMP + (wid >> 2) * 32 + (lane & 3) * 8;
  const unsigned kdst = lds0 + LDS_K + wid * 1024, vdst = lds0 + LDS_V + wid * 1024;
  #define DMA_K(t, slot) glds16(ksrc + (long)(t) * KVBLK * DMP, (unsigned)__builtin_amdgcn_readfirstlane(kdst + (slot)))
  #define DMA_V(t, slot) glds16(vsrc + (long)(t) * KVBLK * DMP, (unsigned)__builtin_amdgcn_readfirstlane(vdst + (slot)))
  const int vb0 = (int)(lds0 + LDS_V) + ((lane >> 4) & 1) * 32 + (lane & 3) * 8 + (4 * hi + ((lane & 15) >> 2)) * 64;
  const char* Kbase = shm + LDS_K; bf16x8 kf[8];
  const lds_cptr shm3 = (lds_cptr)shm; const lds_cptr kp0 = shm3 + LDS_K + hi * 1024 + r32 * 16; const lds_cptr vp0 = shm3 + LDS_V + ((lane >> 4) & 1) * 32 + (lane & 3) * 8 + (4 * hi + ((lane & 15) >> 2)) * 64;
  if (wid >= 4) __builtin_amdgcn_s_setprio(1);
  const lds_cptr bp0 = shm3 + LDS_BIAS + hi * 16;
  const int NT = (q0 + QB) / KVBLK - t_start;
  DMA_K(0, 0); DMA_V(0, 0); DMA_K(1, SLOTB);
  {
    const float* cb = cbs + skip_rows; const float cref = cbs[q0 + QB - 1]; const int nkeys = q0 + QB - skip_rows;
    LAS float* bl = (LAS float*)(shm3 + LDS_BIAS);
    float cv[SEQ / (NW * 64)];
    #pragma unroll
    for (int i = 0; i < SEQ / (NW * 64); ++i) { const int j = tid + i * NW * 64; cv[i] = cb[j < nkeys ? j : 0]; }
    #pragma unroll
    for (int i = 0; i < SEQ / (NW * 64); ++i) { const int j = tid + i * NW * 64; if (j < nkeys) bl[j] = cref - cv[i]; }
  }
  bf16x8 qr[4];
  #pragma unroll
  for (int d0 = 0; d0 < 4; ++d0) qr[d0] = *reinterpret_cast<const bf16x8*>(&Qw[(long)r32 * DMP + d0 * 16 + hi * 8]);
  float mhat = 0.f, l_reg = 0.f; f32x16 o[2]; o[0] = f32x16{}; o[1] = f32x16{};
  const int qrel = wid * QBLK + r32;
  #define CMASK(P0, P1, t) do { int jb_ = (t) - (NT - 4); if (jb_ >= 0) cmask(P0, P1, jb_, qrel, hi); } while (0)
  bool resc = false;
  #define START(P0, P1) do { const float rm = rowmax(P0, P1); resc = false; \
    { const float dl = rm; mhat = fadd_s(mhat, dl); \
      _Pragma("unroll") for (int r = 0; r < 16; ++r) { P0[r] = fsub_s(P0[r], dl); P1[r] = fsub_s(P1[r], dl); } } \
    _Pragma("unroll") for (int r = 0; r < 16; ++r) P0[r] = __builtin_amdgcn_exp2f(P0[r]); } while (0)
  #define RESC() do { if (resc) { asm volatile("s_waitcnt lgkmcnt(0)" ::: "memory"); \
      _Pragma("unroll") for (int d_ = 0; d_ < 2; ++d_) _Pragma("unroll") for (int r = 0; r < 16; ++r) o[d_][r] *= wsf[crow(r, hi)]; } } while (0)
  f32x16 pA0, pA1, pB0, pB1;
  int sl_prev = 0, sl_cur = 0, sl_next = SLOTB;
  #define ROT() do { sl_prev = sl_cur; sl_cur = sl_next; sl_next = (sl_next == (NSLOT - 1) * SLOTB) ? 0 : sl_next + SLOTB; } while (0)
  DMA_K(2, 2 * SLOTB);
  WAIT_BAR(3);
  BLD(pA0, pA1, bp0);
  qkt(pA0, pA1, Kbase, qr, r32, hi); asm volatile("s_nop 15\n\ts_nop 7" : "+v"(pA0), "+v"(pA1)); CMASK(pA0, pA1, 0);
  START(pA0, pA1);
  _Pragma("unroll") for (int r = 0; r < 16; ++r) pA1[r] = __builtin_amdgcn_exp2f(pA1[r]);
  BLD(pB0, pB1, bp0 + 256);
  _Pragma("unroll") for (int r = 0; r < 16; ++r) { pB0[r] = fsub_s(pB0[r], mhat); pB1[r] = fsub_s(pB1[r], mhat); }
  WAIT_BAR(0);
  DMA_K(3, 0); DMA_V(1, SLOTB);
  ROT();
  kload8(kf, kp0 + sl_cur);
  WAIT_BAR(2);
  s16x4 vlo[8], vhi[8]; u32x4 pw0, pw1, pw2, pw3;
  #define PKW(P, B) cvtpk_s(P[B], P[B + 1])
  #define PAF(k) __builtin_bit_cast(bf16x8, pw##k)
  #define VFR(i) (bf16x8){vlo[i][0], vlo[i][1], vlo[i][2], vlo[i][3], vhi[i][0], vhi[i][1], vhi[i][2], vhi[i][3]}
  #define PIN(x) asm volatile("" : "+v"(x))
  #define MX3(a, b, c) __builtin_fmaxf(__builtin_fmaxf((a), (b)), (c))
  #define GAPA(MF, A0, A1, A2, A3, W0, W1, PW) do { MF; sacc += A0; sacc += A1; sacc += A2; sacc += A3; PIN(sacc); W0; W1; PIN(PW); SBAR(); } while (0)
  #define EX(v) __builtin_amdgcn_exp2f(v)
  #define GAPB(MF, X, B, N, NB) do { MF; X[B] = EX(X[B]); X[B + 1] = EX(X[B + 1]); X[B + 2] = EX(X[B + 2]); X[B + 3] = EX(X[B + 3]); PIN(X); \
    N[NB] = fsub_s(N[NB], mhat); N[NB + 1] = fsub_s(N[NB + 1], mhat); N[NB + 2] = fsub_s(N[NB + 2], mhat); N[NB + 3] = fsub_s(N[NB + 3], mhat); PIN(N); SBAR(); } while (0)
  #define VRD(i) do { vlo[i] = vtr(vp_ + (((i) >> 2) * 4096 + ((i) & 3) * 1024)); vhi[i] = vtr(vp_ + (((i) >> 2) * 4096 + ((i) & 3) * 1024 + 512)); } while (0)
  #define KRD(G, j) do { if (G) { kload2(kf, kp0 + sl_next, j); SBAR(); } } while (0)
  #define STEP(C0, C1, P0, P1, t, GK, GV, GL) do { SBAR(); \
    const lds_cptr vp_ = vp0 + sl_prev; \
    VRD(0); SBAR(); float sacc = (P0[0] + P0[1]); \
    GAPA(C0 = __builtin_amdgcn_mfma_f32_32x32x16_bf16(kf[0], qr[0], C0, 0, 0, 0), P0[2], P0[3], P0[4], P0[5],     pw0[0] = PKW(P0, 0), pw0[1] = PKW(P0, 2), pw0); \
    VRD(4); SBAR(); GAPA(C1 = __builtin_amdgcn_mfma_f32_32x32x16_bf16(kf[1], qr[0], C1, 0, 0, 0), P0[6], P0[7], P0[8], P0[9],     pw0[2] = PKW(P0, 4), pw0[3] = PKW(P0, 6), pw0); \
    VRD(1); SBAR(); GAPA(C0 = __builtin_amdgcn_mfma_f32_32x32x16_bf16(kf[2], qr[1], C0, 0, 0, 0),   P0[10], P0[11], P0[12], P0[13], pw1[0] = PKW(P0, 8), pw1[1] = PKW(P0, 10), pw1); \
    VRD(5); SBAR(); GAPA(C1 = __builtin_amdgcn_mfma_f32_32x32x16_bf16(kf[3], qr[1], C1, 0, 0, 0),   P0[14], P0[15], P1[0], P1[1],   pw1[2] = PKW(P0, 12), pw1[3] = PKW(P0, 14), pw1); \
    VRD(2); SBAR(); GAPA(C0 = __builtin_amdgcn_mfma_f32_32x32x16_bf16(kf[4], qr[2], C0, 0, 0, 0),   P1[2], P1[3], P1[4], P1[5],     pw2[0] = PKW(P1, 0), pw2[1] = PKW(P1, 2), pw2); \
    VRD(6); SBAR(); GAPA(C1 = __builtin_amdgcn_mfma_f32_32x32x16_bf16(kf[5], qr[2], C1, 0, 0, 0),   P1[6], P1[7], P1[8], P1[9],     pw2[2] = PKW(P1, 4), pw2[3] = PKW(P1, 6), pw2); \
    VRD(3); SBAR(); GAPA(C0 = __builtin_amdgcn_mfma_f32_32x32x16_bf16(kf[6], qr[3], C0, 0, 0, 0),   P1[10], P1[11], P1[12], P1[13], pw3[0] = PKW(P1, 8), pw3[1] = PKW(P1, 10), pw3); \
    VRD(7); SBAR(); GAPA(C1 = __builtin_amdgcn_mfma_f32_32x32x16_bf16(kf[7], qr[3], C1, 0, 0, 0),   P1[14], P1[15], 0.f, 0.f,       pw3[2] = PKW(P1, 12), pw3[3] = PKW(P1, 14), pw3); \
    l_reg += sacc; \
    if (GK) { DMA_K((t) + 3, sl_cur); } if (GV) { DMA_V((t) + 1, sl_next); } \
    CMASK(C0, C1, t); \
    { float a = MX3(C0[0], C0[1], C1[0]), b = MX3(C0[2], C0[3], C1[1]); a = MX3(a, C1[2], C1[3]); \
      _Pragma("unroll") for (int r = 4; r < 16; r += 4) { a = MX3(a, C0[r], C0[r + 1]); b = MX3(b, C0[r + 2], C0[r + 3]); a = MX3(a, C1[r], C1[r + 1]); b = MX3(b, C1[r + 2], C1[r + 3]); } \
      float rm = __builtin_fmaxf(a, b); { auto rr = __builtin_amdgcn_permlane32_swap(__float_as_uint(rm), __float_as_uint(rm), false, false); rm = __builtin_fmaxf(__uint_as_float(rr[0]), __uint_as_float(rr[1])); } \
      resc = false; \
      if (__builtin_expect(__any(rm > (float)THRL), 0)) { const float dl = __builtin_fmaxf(rm, 0.f); mhat += dl; \
        _Pragma("unroll") for (int r = 0; r < 16; ++r) { C0[r] -= dl; C1[r] -= dl; } \
        const float f = __builtin_amdgcn_exp2f(-dl); l_reg *= f; if (hi == 0) wsf[r32] = f; resc = true; } } \
    SBAR(); \
    BLD(P0, P1, bp0 + ((t) + 1) * 256); SBAR(); \
    GAPB(o[0] = __builtin_amdgcn_mfma_f32_32x32x16_bf16(PAF(0), VFR(0), o[0], 0, 0, 0), C0, 0, P0, 0); \
    GAPB(o[1] = __builtin_amdgcn_mfma_f32_32x32x16_bf16(PAF(0), VFR(4), o[1], 0, 0, 0), C0, 4, P0, 4); \
    KRD(GL, 0); GAPB(o[0] = __builtin_amdgcn_mfma_f32_32x32x16_bf16(PAF(1), VFR(1), o[0], 0, 0, 0), C0, 8, P0, 8); \
    KRD(GL, 1); GAPB(o[1] = __builtin_amdgcn_mfma_f32_32x32x16_bf16(PAF(1), VFR(5), o[1], 0, 0, 0), C0, 12, P0, 12); \
    KRD(GL, 2); GAPB(o[0] = __builtin_amdgcn_mfma_f32_32x32x16_bf16(PAF(2), VFR(2), o[0], 0, 0, 0), C1, 0, P1, 0); \
    KRD(GL, 3); GAPB(o[1] = __builtin_amdgcn_mfma_f32_32x32x16_bf16(PAF(2), VFR(6), o[1], 0, 0, 0), C1, 4, P1, 4); \
    GAPB(o[0] = __builtin_amdgcn_mfma_f32_32x32x16_bf16(PAF(3), VFR(3), o[0], 0, 0, 0), C1, 8, P1, 8); \
    GAPB(o[1] = __builtin_amdgcn_mfma_f32_32x32x16_bf16(PAF(3), VFR(7), o[1], 0, 0, 0), C1, 12, P1, 12); \
    } while (0)
  int t = 1;
  #undef CMASK
  #define CMASK(P0, P1, t) do {} while (0)
  for (; t + 5 < NT; t += 2) {
    STEP(pB0, pB1, pA0, pA1, t, true, true, true);     WAIT_BAR(2); RESC(); ROT();
    STEP(pA0, pA1, pB0, pB1, t + 1, true, true, true);   WAIT_BAR(2); RESC(); ROT();
  }
  #undef CMASK
  #define CMASK(P0, P1, t) do { int jb_ = (t) - (NT - 4); if (jb_ >= 0) cmask(P0, P1, jb_, qrel, hi); } while (0)
  #define ENDW(tt) do { if ((tt) + 3 < NT) { WAIT_BAR(2); } else if ((tt) + 2 < NT) { WAIT_BAR(1); } else { WAIT_BAR(0); } } while (0)
  for (; t + 1 < NT; t += 2) {
    STEP(pB0, pB1, pA0, pA1, t, (t + 3 < NT), (t + 1 < NT), (t + 1 < NT));       ENDW(t);   RESC(); ROT();
    STEP(pA0, pA1, pB0, pB1, t + 1, (t + 4 < NT), (t + 2 < NT), (t + 2 < NT));     ENDW(t + 1); RESC(); ROT();
  }
  STEP(pB0, pB1, pA0, pA1, NT - 1, false, false, false); RESC();
  { float sacc = pB0[0] + pB0[1]; _Pragma("unroll") for (int r = 2; r < 16; ++r) sacc += pB0[r]; _Pragma("unroll") for (int r = 0; r < 16; ++r) sacc += pB1[r]; l_reg += sacc;
    pw0 = (u32x4){PKW(pB0, 0), PKW(pB0, 2), PKW(pB0, 4), PKW(pB0, 6)}; pw1 = (u32x4){PKW(pB0, 8), PKW(pB0, 10), PKW(pB0, 12), PKW(pB0, 14)}; pw2 = (u32x4){PKW(pB1, 0), PKW(pB1, 2), PKW(pB1, 4), PKW(pB1, 6)}; pw3 = (u32x4){PKW(pB1, 8), PKW(pB1, 10), PKW(pB1, 12), PKW(pB1, 14)};
    SBAR(); pv(o, vb0 + sl_cur, PAF(0), PAF(1), PAF(2), PAF(3)); }
  #undef PKW
  #undef PAF
  #undef VFR
  #undef PIN
  #undef MX3
  #undef GAPA
  #undef GAPB
  #undef EX
  #undef VRD
  #undef KRD
  #undef STEP
  #undef ENDW
  { auto rr = __builtin_amdgcn_permlane32_swap(__float_as_uint(l_reg), __float_as_uint(l_reg), false, false); l_reg = __uint_as_float(rr[0]) + __uint_as_float(rr[1]); }
  if (hi == 0) wsf[32 + r32] = l_reg; asm volatile("s_waitcnt lgkmcnt(0)" ::: "memory");
  float rli[16];
  #pragma unroll
  for (int r = 0; r < 16; ++r) rli[r] = __builtin_amdgcn_rcpf(wsf[32 + crow(r, hi)]);
  bf16* Ow = O + (rowbase + q0 + wid * QBLK) * DMP + h * D;
  if (threadIdx.x == 0) nxt = atomicAdd(counter, 1);
  { bf16* stg = (bf16*)(shm + LDS_OST) + wid * 2048;
    const __amdgpu_buffer_rsrc_t orsrc = wt_rsrc((const void*)O);
    #pragma unroll
    for (int r = 0; r < 16; ++r) { const int orow = crow(r, hi);
      #pragma unroll
      for (int d0 = 0; d0 < 2; ++d0) stg[orow * 64 + d0 * 32 + r32] = f2bf(o[d0][r] * rli[r]); }
    asm volatile("s_waitcnt lgkmcnt(0)" ::: "memory");
    #pragma unroll
    for (int i = 0; i < 4; ++i) { const int row = i * 8 + (lane >> 3), ch = lane & 7; const u32x4 v = *(const u32x4*)(stg + row * 64 + ch * 8); st16_wt<WTC>(orsrc, (unsigned)(((Ow - O) + (long)row * DMP + ch * 8) * 2), v);
      float ss = 0.f;
      #pragma unroll
      for (int j = 0; j < 4; ++j) { const float lo = __uint_as_float(v[j] << 16), hi_ = __uint_as_float(v[j] & 0xffff0000u); ss += lo * lo + hi_ * hi_; }
      ss += __shfl_xor(ss, 1); ss += __shfl_xor(ss, 2); ss += __shfl_xor(ss, 4);
      if (ch == 0) SSF[(rowbase + q0 + wid * QBLK + row) * 8 + h] = ss; } }
  __builtin_amdgcn_s_setprio(0);
  asm volatile("s_waitcnt lgkmcnt(0)\n\ts_barrier" ::: "memory");
  #undef DMA_K
  #undef DMA_V
  #undef CMASK
  #undef START
  #undef RESC
  #undef ROT
}
struct ConvArgs { const float *w_gate, *w_up, *w_down, *g; unsigned char *WT_GU, *WT_D; const bf16 *MEMN, *WT_KV; bf16 *KM, *VM; int* cumc; };
template <int THRL> __device__ __forceinline__ void attn_phase(char* lds, const bf16* Q, const bf16* K, const bf16* V, bf16* O, const float* CUM, float* SSF, int* counter, const ConvArgs cv) {
  LAS int* slot = (LAS int*)((LAS char*)lds + 140032);
  constexpr int NKV = 4, NENT = NKV + NHEAD * NQB / 4 * 7;
  if (threadIdx.x == 0) { unsigned sp = 0;
    while (__hip_atomic_load(cv.cumc + (blockIdx.x & 7), __ATOMIC_RELAXED, __HIP_MEMORY_SCOPE_AGENT) < NHEAD) { __builtin_amdgcn_s_sleep(4); if (++sp > (1u << 22)) break; } }
  __syncthreads();
  int nxt = 0; bool have = false;
  for (;;) {
    if (threadIdx.x == 0) { if (!have) nxt = atomicAdd(counter, 1); *slot = nxt; }
    __syncthreads();
    const int v = *slot;
    __syncthreads();
    if (v >= NENT) break;
    have = false;
    if (v < NKV) {
      const int k = (blockIdx.x & 7) * NKV + v;
      const pg8::Gemm g{cv.MEMN, cv.WT_KV, DM, DM, DM, 0, 0, 0, 0}; const pg8::OneTile S{k >> 2, k & 3};
      const pg8::EpiBf16 E{(bf16_t*)cv.KM, (bf16_t*)cv.VM, 512, 512};
      pg8::gemm_phase<pg8::EpiBf16, pg8::OneTile, true>((LAS unsigned char*)lds, g, S, E);
      continue;
    }
    constexpr int NA0 = 32, NCV = 96;
    const int w_ = v - NKV - NA0;
    const bool is_conv = (w_ >= 0) && ((w_ & 1) == 0);
    if (is_conv) {
      if (threadIdx.x == 0) nxt = atomicAdd(counter, 1);
      have = true;
      const int chunk = (blockIdx.x & 7) * NCV + (w_ >> 1);
      int tid = threadIdx.x; asm volatile("" : "+v"(tid));
      const int wave = __builtin_amdgcn_readfirstlane(tid >> 6), lane = tid & 63;
      const int it = chunk * 8 + wave, e = it / 192, q = it % 192;
      LAS unsigned char* scq = (LAS unsigned char*)lds + wave * 17408;
      if (q < 64) p0_transpose_item_q<2, true>(cv.w_gate + (size_t)e * DM * D_EXP, D_EXP, DM, D_EXP, cv.WT_GU + (size_t)e * 1024 * 1024, scq, q, lane, cv.g);
      else if (q < 128) p0_transpose_item_q<3, true>(cv.w_up + (size_t)e * DM * D_EXP, D_EXP, DM, D_EXP, cv.WT_GU + (size_t)e * 1024 * 1024, scq, q - 64, lane, cv.g);
      else p0_transpose_item_q<0, false>(cv.w_down + (size_t)e * D_EXP * DM, DM, D_EXP, DM, cv.WT_D + (size_t)e * 1024 * 512, scq, q - 128, lane, cv.g);
    } else {
      const int u = (w_ < 0) ? (v - NKV) : NA0 + (w_ >> 1);
      const int qb = NQB - 1 - (u >> 3), bh = (blockIdx.x & 7) * NHEAD + (u & 7);
      attn_unit<THRL>(bh / NHEAD, bh % NHEAD, qb, Q, K, V, O, CUM, SSF, lds, counter, nxt);
      have = true;
    }
  }
}
#undef SBAR
#undef WAIT_BAR
#undef BLD
}


namespace lru {
constexpr int CL = 128, NCH = SEQ / CL;
constexpr int WLDS = 16384;
typedef unsigned u32x4 __attribute__((ext_vector_type(4)));
template <bool PASS2>
__device__ __forceinline__ void unit(int b, int chunk, const bf16_t* __restrict__ U, const bf16_t* __restrict__ GATE, const float* __restrict__ conv_w, const float* __restrict__ conv_b,
                                     const bf16_t* __restrict__ LRUW, const float* __restrict__ ba, const float* __restrict__ bx, const float* __restrict__ a_param,
                                     float* __restrict__ SUMA, float* __restrict__ SUMH, bf16_t* __restrict__ YL, float* __restrict__ SSL, unsigned char* __restrict__ LAB, LAS unsigned char* ldsw, int w, int lane) {
    const int cl = lane & 31, hi = lane >> 5;
    LAS float* cp = (LAS float*)ldsw;
    LAS bf16_t* stg = (LAS bf16_t*)(ldsw + 2048);
    if (!PASS2) {
      const int c = 64 * w + lane;
      float pv[8];
#pragma unroll
      for (int tap = 0; tap < 4; ++tap) pv[tap] = conv_w[tap * 512 + c];
      pv[4] = conv_b[c]; pv[5] = ba[c]; pv[6] = bx[c]; pv[7] = a_param[c];
      asm volatile("" ::: "memory");
#pragma unroll
      for (int j = 0; j < 7; ++j) cp[64 * j + lane] = pv[j];
      const float ap = -pv[7]; const float sp = (ap > 20.f) ? ap : log1pf(__expf(ap)); cp[448 + lane] = -8.f * sp * LOG2E;
    }
    const u32x4* wf = (const u32x4*)LRUW + (size_t)w * 16 * 64 + lane;
    bf16x8 Bi[2];
#pragma unroll
    for (int q = 0; q < 2; ++q)
#pragma unroll
        for (int j = 0; j < 8; ++j) Bi[q][j] = (16 * q + 8 * hi + j == cl) ? (short)0x3F80 : (short)0;
    float h[2], atot[2];
#pragma unroll
    for (int n = 0; n < 2; ++n) { h[n] = 0.f; atot[n] = 1.f; }
    if (PASS2) {
#pragma unroll 1
        for (int c0 = 0; c0 < chunk; c0 += 8) {
            float sa[8][2], sh[8][2];
#pragma unroll
            for (int j = 0; j < 8; ++j)
#pragma unroll
                for (int n = 0; n < 2; ++n) { const bool ok = (c0 + j < chunk); const size_t o = ((size_t)(b * NCH + (ok ? c0 + j : 0))) * 512 + 64 * w + 32 * n + cl;
                    const float av = SUMA[o], hv = SUMH[o]; sa[j][n] = ok ? av : 1.f; sh[j][n] = ok ? hv : 0.f; }
#pragma unroll
            for (int j = 0; j < 8; ++j)
#pragma unroll
                for (int n = 0; n < 2; ++n) h[n] = sa[j][n] * h[n] + sh[j][n];
        }
    }
    asm volatile("s_waitcnt lgkmcnt(0)" ::: "memory");
    const int t0 = b * SEQ + chunk * CL;
    LAS unsigned char* ub0 = ldsw + 6144;
    const int dri = lane >> 3, dch = lane & 7;
#define LRU_DMA_U(tb_, buf_) do { _Pragma("unroll") for (int i_ = 0; i_ < 5; ++i_) { const int ri_ = 8 * i_ + dri; int gr_ = (tb_) - 3 + ri_; gr_ = gr_ < 0 ? 0 : (gr_ > T - 1 ? T - 1 : gr_); \
        __builtin_amdgcn_global_load_lds((const unsigned*)((const char*)U + (unsigned)((gr_ * 512 + 64 * w + 8 * (dch ^ (ri_ & 7))) * 2)), (LAS unsigned*)(ub0 + (buf_) * 5120 + i_ * 1024), 16, 0, 0); } } while (0)
#define LRU_DMA_G(tb_) do { _Pragma("unroll") for (int i_ = 0; i_ < 4; ++i_) \
        __builtin_amdgcn_global_load_lds((const unsigned*)((const char*)GATE + (unsigned)((((tb_) + 8 * i_ + dri) * 512 + 64 * w + 8 * dch) * 2)), (LAS unsigned*)(ldsw + 2048 + i_ * 1024), 16, 0, 0); } while (0)
    unsigned char* labw = LAB + ((size_t)((b * NCH + chunk) * 8 + w) * 16) * 2048 + lane * 32;
#define LRU_LDPK(dst, mt_) do { _Pragma("unroll") for (int q_ = 0; q_ < 8; ++q_) dst[q_] = *(const u32x4*)(labw + ((mt_) * 4 + (q_ >> 1)) * 2048 + (q_ & 1) * 16); } while (0)
    u32x4 pkc[8];
    if (PASS2) { LRU_LDPK(pkc, 0); asm volatile("" ::: "memory"); }
    if (!PASS2) LRU_DMA_U(t0, 0);
#pragma unroll 1
    for (int mt = 0; mt < CL / 32; ++mt) {
        int tb = t0 + mt * 32; asm volatile("" : "+s"(tb));
        const int srow = chunk * CL + mt * 32 + cl;
        if (!PASS2) asm volatile("s_waitcnt vmcnt(0)" ::: "memory");
        if (!PASS2 && mt + 1 < CL / 32) LRU_DMA_U(tb + 32, (mt + 1) & 1);
        u32x4 pkn[8];
        if (PASS2) { const int mn = (mt + 1 < CL / 32) ? mt + 1 : mt; LRU_LDPK(pkn, mn); asm volatile("" ::: "memory"); }
        if (PASS2) LRU_DMA_G(tb);
        const LAS unsigned char* ub = ub0 + (mt & 1) * 5120;
        bf16x8 af[4];
        if (!PASS2) {
#pragma unroll
        for (int s_ = 0; s_ < 4; ++s_) {
            const int cc = 16 * s_ + 8 * hi;
            float xv[8];
            { const f32x4 b0 = *(const LAS f32x4*)(cp + 256 + cc), b1 = *(const LAS f32x4*)(cp + 256 + cc + 4);
              xv[0] = b0[0]; xv[1] = b0[1]; xv[2] = b0[2]; xv[3] = b0[3]; xv[4] = b1[0]; xv[5] = b1[1]; xv[6] = b1[2]; xv[7] = b1[3]; }
#pragma unroll
            for (int tap = 0; tap < 4; ++tap) {
                const bool inseq = (srow - 3 + tap >= 0);
                const int ri = cl + tap;
                u32x4 uu = *(const LAS u32x4*)(ub + ri * 128 + (((2 * s_ + hi) ^ (ri & 7)) << 4));
                if (!inseq) uu = (u32x4){0u, 0u, 0u, 0u};
                const f32x4 w0 = *(const LAS f32x4*)(cp + tap * 64 + cc), w1 = *(const LAS f32x4*)(cp + tap * 64 + cc + 4);
                xv[0] += w0[0] * __uint_as_float(uu[0] << 16); xv[1] += w0[1] * __uint_as_float(uu[0] & 0xffff0000u);
                xv[2] += w0[2] * __uint_as_float(uu[1] << 16); xv[3] += w0[3] * __uint_as_float(uu[1] & 0xffff0000u);
                xv[4] += w1[0] * __uint_as_float(uu[2] << 16); xv[5] += w1[1] * __uint_as_float(uu[2] & 0xffff0000u);
                xv[6] += w1[2] * __uint_as_float(uu[3] << 16); xv[7] += w1[3] * __uint_as_float(uu[3] & 0xffff0000u);
            }
            u32x4 pk; pk[0] = pg8::cvt_pk_bf16(xv[0], xv[1]); pk[1] = pg8::cvt_pk_bf16(xv[2], xv[3]); pk[2] = pg8::cvt_pk_bf16(xv[4], xv[5]); pk[3] = pg8::cvt_pk_bf16(xv[6], xv[7]);
            af[s_] = __builtin_bit_cast(bf16x8, pk);
            asm volatile("" ::: "memory"); __builtin_amdgcn_sched_barrier(0);
        }
        }
#pragma unroll
        for (int n = 0; n < 2; ++n) {
            f32x16 rCn, iCn;
            if (!PASS2) {
            f32x16 xCn;
#pragma unroll
            for (int r = 0; r < 16; ++r) { rCn[r] = cp[320 + 32 * n + cl]; iCn[r] = cp[384 + 32 * n + cl]; xCn[r] = 0.f; }
            const float c1n = cp[448 + 32 * n + cl];
#pragma unroll
            for (int s_ = 0; s_ < 4; ++s_) {
                const bf16x8 fa = __builtin_bit_cast(bf16x8, wf[(n * 4 + s_) * 64]), fx = __builtin_bit_cast(bf16x8, wf[(8 + n * 4 + s_) * 64]);
                rCn = __builtin_amdgcn_mfma_f32_32x32x16_bf16(af[s_], fa, rCn, 0, 0, 0);
                iCn = __builtin_amdgcn_mfma_f32_32x32x16_bf16(af[s_], fx, iCn, 0, 0, 0);
                if ((s_ >> 1) == n) xCn = __builtin_amdgcn_mfma_f32_32x32x16_bf16(af[s_], Bi[s_ & 1], xCn, 0, 0, 0);
            }
            u32x4 pla[2], pbx[2];
#pragma unroll
            for (int r = 0; r < 16; r += 2) {
                const float rr0 = __builtin_amdgcn_rcpf(1.f + __builtin_amdgcn_exp2f(-LOG2E * rCn[r])), rr1 = __builtin_amdgcn_rcpf(1.f + __builtin_amdgcn_exp2f(-LOG2E * rCn[r + 1]));
                const float ii0 = __builtin_amdgcn_rcpf(1.f + __builtin_amdgcn_exp2f(-LOG2E * iCn[r])), ii1 = __builtin_amdgcn_rcpf(1.f + __builtin_amdgcn_exp2f(-LOG2E * iCn[r + 1]));
                const unsigned pl = pg8::cvt_pk_bf16(c1n * rr0, c1n * rr1);
                const float a0 = __builtin_amdgcn_exp2f(__uint_as_float(pl << 16)), a1 = __builtin_amdgcn_exp2f(__uint_as_float(pl & 0xffff0000u));
                const float m0 = __builtin_amdgcn_sqrtf(fmaxf(1.f - a0 * a0, 0.f)), m1 = __builtin_amdgcn_sqrtf(fmaxf(1.f - a1 * a1, 0.f));
                const unsigned pb = pg8::cvt_pk_bf16(m0 * (ii0 * xCn[r]), m1 * (ii1 * xCn[r + 1]));
                rCn[r] = a0; rCn[r + 1] = a1; iCn[r] = __uint_as_float(pb << 16); iCn[r + 1] = __uint_as_float(pb & 0xffff0000u);
                pla[r >> 3][(r >> 1) & 3] = pl; pbx[r >> 3][(r >> 1) & 3] = pb;
                if ((r & 3) == 2) __builtin_amdgcn_sched_barrier(0);
            }
            { unsigned char* pp = labw + (mt * 4 + n * 2) * 2048;
              const __amdgpu_buffer_rsrc_t lr = wt_rsrc(LAB); const unsigned po = (unsigned)(pp - LAB);
              st16_wt<WTC>(lr, po, pla[0]); st16_wt<WTC>(lr, po + 16, pla[1]); st16_wt<WTC>(lr, po + 2048, pbx[0]); st16_wt<WTC>(lr, po + 2064, pbx[1]); }
            } else {
#pragma unroll
                for (int j = 0; j < 8; ++j) { const unsigned pl = pkc[n * 4 + (j >> 2)][j & 3], pb = pkc[n * 4 + 2 + (j >> 2)][j & 3];
                    rCn[2 * j] = __builtin_amdgcn_exp2f(__uint_as_float(pl << 16)); rCn[2 * j + 1] = __builtin_amdgcn_exp2f(__uint_as_float(pl & 0xffff0000u));
                    iCn[2 * j] = __uint_as_float(pb << 16); iCn[2 * j + 1] = __uint_as_float(pb & 0xffff0000u); }
            }
            float Ao[4], Bo[4], Ap[4], Bp[4];
#pragma unroll
            for (int g = 0; g < 4; ++g) { float A = rCn[4 * g], B = iCn[4 * g];
#pragma unroll
                for (int k = 1; k < 4; ++k) { B = rCn[4 * g + k] * B + iCn[4 * g + k]; A *= rCn[4 * g + k]; }
                Ao[g] = A; Bo[g] = B; Ap[g] = __shfl_xor(A, 32); Bp[g] = __shfl_xor(B, 32); }
            float hh = h[n], at = atot[n];
#pragma unroll
            for (int g = 0; g < 4; ++g) {
                const float A1 = hi ? Ap[g] : Ao[g], B1 = hi ? Bp[g] : Bo[g], A2 = hi ? Ao[g] : Ap[g], B2 = hi ? Bo[g] : Bp[g];
                const float h1 = A1 * hh + B1, h2 = A2 * h1 + B2;
                float hr = hi ? h1 : hh;
                at *= A1 * A2; hh = h2;
                if (PASS2) {
#pragma unroll
                    for (int k = 0; k < 4; ++k) { hr = rCn[4 * g + k] * hr + iCn[4 * g + k]; iCn[4 * g + k] = hr; }
                }
            }
            h[n] = hh; atot[n] = at;
            if (PASS2) {
                if (n == 0) asm volatile("s_waitcnt vmcnt(0)" ::: "memory");
#pragma unroll
                for (int r = 0; r < 16; ++r) {
                    const int tok = crow(r, hi);
                    const float gx = bf2f(stg[tok * 64 + 32 * n + cl]);
                    const float uq = 0.7978845608028654f * (gx + 0.044715f * gx * gx * gx);
                    const float th = 1.f - 2.f * __builtin_amdgcn_rcpf(1.f + __builtin_amdgcn_exp2f(2.f * LOG2E * uq));
                    stg[tok * 64 + 32 * n + cl] = f2bf(iCn[r] * (0.5f * gx * (1.f + th)));
                    if ((r & 3) == 3) __builtin_amdgcn_sched_barrier(0);
                }
            }
        }
        if (PASS2) {
            asm volatile("s_waitcnt lgkmcnt(0)" ::: "memory");
#pragma unroll
            for (int i = 0; i < 4; ++i) { const int row = i * 8 + (lane >> 3), ch = lane & 7; const u32x4 v = *(const LAS u32x4*)(stg + row * 64 + ch * 8);
                st16_wt<WTC>(wt_rsrc(YL), (unsigned)(((tb + row) * 512 + 64 * w + ch * 8) * 2), v);
                float ss = 0.f;
#pragma unroll
                for (int j = 0; j < 4; ++j) { const float lo = __uint_as_float(v[j] << 16), hi_ = __uint_as_float(v[j] & 0xffff0000u); ss += lo * lo + hi_ * hi_; }
                ss += __shfl_xor(ss, 1); ss += __shfl_xor(ss, 2); ss += __shfl_xor(ss, 4);
                if (ch == 0) SSL[(size_t)(tb + row) * 8 + w] = ss; }
            asm volatile("s_waitcnt lgkmcnt(0)" ::: "memory");
#pragma unroll
            for (int q_ = 0; q_ < 8; ++q_) pkc[q_] = pkn[q_];
        }
    }
    if (!PASS2) {
        if (hi == 0) {
#pragma unroll
            for (int n = 0; n < 2; ++n) { const size_t o = ((size_t)(b * NCH + chunk)) * 512 + 64 * w + 32 * n + cl; __hip_atomic_store(&SUMA[o], atot[n], __ATOMIC_RELAXED, __HIP_MEMORY_SCOPE_AGENT); __hip_atomic_store(&SUMH[o], h[n], __ATOMIC_RELAXED, __HIP_MEMORY_SCOPE_AGENT); }
        }
    }
}
#undef LRU_DMA_U
#undef LRU_DMA_G
#undef LRU_LDPK
}


namespace xat {
constexpr int KS_BYTES = MEM_LEN * 256, VT_STRIDE = 520, VT_BYTES = MEM_D * VT_STRIDE, LDS_NEED = KS_BYTES + VT_BYTES;
typedef unsigned u32x4 __attribute__((ext_vector_type(4)));
typedef unsigned u32x2 __attribute__((ext_vector_type(2)));
__device__ __forceinline__ void item(int b, int h, int qhalf  , const bf16_t* __restrict__ QM, const bf16_t* __restrict__ KM, const bf16_t* __restrict__ VM, bf16_t* __restrict__ OM,
                                     const float* __restrict__ q_g, const float* __restrict__ k_g, LAS unsigned char* lds) {
    int tid = threadIdx.x; asm volatile("" : "+v"(tid));
    const int lane = tid & 63, wid = __builtin_amdgcn_readfirstlane(tid >> 6), r32 = lane & 31, hi = lane >> 5;
    LAS unsigned char* Ks = lds; LAS unsigned char* VT = lds + KS_BYTES;
    {
        const int ch = tid & 15, k0 = tid >> 4;
        const f32x4 g0 = *(const f32x4*)(k_g + 8 * ch), g1 = *(const f32x4*)(k_g + 8 * ch + 4);
#pragma unroll 2
        for (int p = 0; p < 8; ++p) {
            const int key = p * 32 + k0;
            const size_t goff = ((size_t)(b * MEM_LEN + key)) * 512 + h * MEM_D + 8 * ch;
            const u32x4 kk = *(const u32x4*)(KM + goff), vv = *(const u32x4*)(VM + goff);
            float f[8];
#pragma unroll
            for (int j = 0; j < 4; ++j) { f[2 * j] = __uint_as_float(kk[j] << 16); f[2 * j + 1] = __uint_as_float(kk[j] & 0xffff0000u); }
            float ss = 0.f;
#pragma unroll
            for (int j = 0; j < 8; ++j) ss += f[j] * f[j];
            ss += __shfl_xor(ss, 1); ss += __shfl_xor(ss, 2); ss += __shfl_xor(ss, 4); ss += __shfl_xor(ss, 8);
            const float rs = rsqrtf(ss * (1.f / MEM_D) + EPS);
            u32x4 o; o[0] = pg8::cvt_pk_bf16(f[0] * rs * g0[0], f[1] * rs * g0[1]); o[1] = pg8::cvt_pk_bf16(f[2] * rs * g0[2], f[3] * rs * g0[3]);
                     o[2] = pg8::cvt_pk_bf16(f[4] * rs * g1[0], f[5] * rs * g1[1]); o[3] = pg8::cvt_pk_bf16(f[6] * rs * g1[2], f[7] * rs * g1[3]);
            *(LAS u32x4*)(Ks + key * 256 + ((ch ^ (key & 15)) << 4)) = o;
#pragma unroll
            for (int j = 0; j < 4; ++j) { *(LAS bf16_t*)(VT + (8 * ch + 2 * j) * VT_STRIDE + key * 2) = (bf16_t)(vv[j] & 0xffffu); *(LAS bf16_t*)(VT + (8 * ch + 2 * j + 1) * VT_STRIDE + key * 2) = (bf16_t)(vv[j] >> 16); }
        }
    }
    __syncthreads();
#pragma unroll 1
    for (int qi = 0; qi < 2; ++qi) {
        const int q0 = qhalf * 512 + qi * 256 + wid * 32;
        const bf16_t* Qp = QM + ((size_t)(b * SEQ + q0 + r32)) * 512 + h * MEM_D + hi * 8;
        bf16x8 qf[8];
        {
            float ss = 0.f; u32x4 raw[8];
#pragma unroll
            for (int d0 = 0; d0 < 8; ++d0) { raw[d0] = *(const u32x4*)(Qp + d0 * 16);
#pragma unroll
                for (int j = 0; j < 4; ++j) { const float lo = __uint_as_float(raw[d0][j] << 16), hi_ = __uint_as_float(raw[d0][j] & 0xffff0000u); ss += lo * lo + hi_ * hi_; } }
            ss += __shfl_xor(ss, 32);
            const float rs = rsqrtf(ss * (1.f / MEM_D) + EPS) * (0.08838834764831845f * LOG2E);
#pragma unroll
            for (int d0 = 0; d0 < 8; ++d0) { const f32x4 g0 = *(const f32x4*)(q_g + 16 * d0 + 8 * hi), g1 = *(const f32x4*)(q_g + 16 * d0 + 8 * hi + 4);
                u32x4 o;
                o[0] = pg8::cvt_pk_bf16(__uint_as_float(raw[d0][0] << 16) * rs * g0[0], __uint_as_float(raw[d0][0] & 0xffff0000u) * rs * g0[1]);
                o[1] = pg8::cvt_pk_bf16(__uint_as_float(raw[d0][1] << 16) * rs * g0[2], __uint_as_float(raw[d0][1] & 0xffff0000u) * rs * g0[3]);
                o[2] = pg8::cvt_pk_bf16(__uint_as_float(raw[d0][2] << 16) * rs * g1[0], __uint_as_float(raw[d0][2] & 0xffff0000u) * rs * g1[1]);
                o[3] = pg8::cvt_pk_bf16(__uint_as_float(raw[d0][3] << 16) * rs * g1[2], __uint_as_float(raw[d0][3] & 0xffff0000u) * rs * g1[3]);
                qf[d0] = __builtin_bit_cast(bf16x8, o); }
        }
        f32x16 o[4];
#pragma unroll
        for (int i = 0; i < 4; ++i)
#pragma unroll
            for (int r = 0; r < 16; ++r) o[i][r] = 0.f;
        float m = -1e30f, l = 0.f;
#pragma unroll 1
        for (int kv0 = 0; kv0 < MEM_LEN; kv0 += 32) {
            f32x16 sc;
#pragma unroll
            for (int r = 0; r < 16; ++r) sc[r] = 0.f;
            const int key = kv0 + r32;
#pragma unroll
            for (int d0 = 0; d0 < 8; ++d0) { const bf16x8 kf = *(const LAS bf16x8*)(Ks + key * 256 + (((2 * d0 + hi) ^ (key & 15)) << 4)); sc = __builtin_amdgcn_mfma_f32_32x32x16_bf16(kf, qf[d0], sc, 0, 0, 0); }
            float tmax = sc[0];
#pragma unroll
            for (int r = 1; r < 16; ++r) tmax = fmaxf(tmax, sc[r]);
            tmax = fmaxf(tmax, __shfl_xor(tmax, 32));
            const bool grow = tmax > m + 8.f;
            if (__any(grow)) { const float mnew = grow ? tmax : m, alpha = __builtin_amdgcn_exp2f(m - mnew);
                l *= alpha; m = mnew;
#pragma unroll
                for (int i = 0; i < 4; ++i)
#pragma unroll
                    for (int r = 0; r < 16; ++r) o[i][r] *= alpha; }
            float ps = 0.f;
#pragma unroll
            for (int r = 0; r < 16; ++r) { sc[r] = __builtin_amdgcn_exp2f(sc[r] - m); ps += sc[r]; }
            l += ps;
            bf16x8 pb[2];
#pragma unroll
            for (int s2 = 0; s2 < 2; ++s2) { u32x4 w; w[0] = pg8::cvt_pk_bf16(sc[8 * s2], sc[8 * s2 + 1]); w[1] = pg8::cvt_pk_bf16(sc[8 * s2 + 2], sc[8 * s2 + 3]); w[2] = pg8::cvt_pk_bf16(sc[8 * s2 + 4], sc[8 * s2 + 5]); w[3] = pg8::cvt_pk_bf16(sc[8 * s2 + 6], sc[8 * s2 + 7]); pb[s2] = __builtin_bit_cast(bf16x8, w); }
#pragma unroll
            for (int i = 0; i < 4; ++i)
#pragma unroll
                for (int s2 = 0; s2 < 2; ++s2) {
                    const LAS unsigned char* vp = VT + (32 * i + r32) * VT_STRIDE + (kv0 + 16 * s2 + 4 * hi) * 2;
                    const u32x2 v0 = *(const LAS u32x2*)vp, v1 = *(const LAS u32x2*)(vp + 16);
                    const u32x4 vv = (u32x4){v0[0], v0[1], v1[0], v1[1]};
                    o[i] = __builtin_amdgcn_mfma_f32_32x32x16_bf16(__builtin_bit_cast(bf16x8, vv), pb[s2], o[i], 0, 0, 0);
                }
        }
        l += __shfl_xor(l, 32);
        const float rl = __builtin_amdgcn_rcpf(l);
        bf16_t* Op = OM + ((size_t)(b * SEQ + q0 + r32)) * 512 + h * MEM_D;
#pragma unroll
        for (int i = 0; i < 4; ++i)
#pragma unroll
            for (int g = 0; g < 4; ++g) { u32x2 w; w[0] = pg8::cvt_pk_bf16(o[i][4 * g] * rl, o[i][4 * g + 1] * rl); w[1] = pg8::cvt_pk_bf16(o[i][4 * g + 2] * rl, o[i][4 * g + 3] * rl);
                st8_wt<WTC>(wt_rsrc(OM), (unsigned)(((Op - OM) + 32 * i + 8 * g + 4 * hi) * 2), w); }
    }
    __syncthreads();
}
}

struct Params { const float* in[32]; float* out; unsigned char* ws; };

__global__ void __launch_bounds__(NTHREADS, 2) mega_fwd(Params p) {
    extern __shared__ __attribute__((aligned(16))) unsigned char lds[];
    const int bid = blockIdx.x, G = gridDim.x;
    const int NGW = G * NWAVES, NGT = G * NTHREADS;
#define PHASE_IDS int tid = threadIdx.x; asm volatile("" : "+v"(tid)); const int lane = tid & 63, wave = __builtin_amdgcn_readfirstlane(tid >> 6), half = tid >> 8, vt = tid & 255; \
    unsigned char* sm = lds + half * 32768; const int gw = bid * NWAVES + wave, gt = bid * NTHREADS + tid; (void)lane; (void)vt; (void)sm; (void)gw; (void)gt;

    const float* x = p.in[0];            const float* mem = p.in[1];
    const float* norm_mix_g = p.in[2];   const float* w_in = p.in[3];
    const float* b_forget = p.in[4];     const float* conv_w = p.in[5];
    const float* conv_b = p.in[6];       const float* lru_wa = p.in[7];
    const float* lru_ba = p.in[8];       const float* lru_wx = p.in[9];
    const float* lru_bx = p.in[10];      const float* lru_a_param = p.in[11];
    const float* fox_q_g = p.in[12];     const float* fox_k_g = p.in[13];
    const float* lru_out_g = p.in[14];   const float* fox_out_g = p.in[15];
    const float* w_out = p.in[16];       const float* norm_mem_x_g = p.in[17];
    const float* norm_mem_g = p.in[18];  const float* mem_wq = p.in[19];
    const float* mem_wkv = p.in[20];     const float* mem_q_g = p.in[21];
    const float* mem_k_g = p.in[22];     const float* mem_wo = p.in[23];
    const float* norm_ffn_g = p.in[24];  const float* r_gw = p.in[25];
    const float* r_gb = p.in[26];        const float* r_ew = p.in[27];
    const float* r_eb = p.in[28];        const float* w_gate = p.in[29];
    const float* w_up = p.in[30];        const float* w_down = p.in[31];
    float* out = p.out;
    unsigned char* ws = p.ws;
    int* ctl = (int*)(ws + WS_CTL) + CW_MOE;
    float* LOGF = (float*)(ws + WS_LOGF); float* CUM = (float*)(ws + WS_CUM);
    bf16_t* MEMN = (bf16_t*)(ws + WS_MEMN); bf16_t* KM = (bf16_t*)(ws + WS_KM); bf16_t* VM = (bf16_t*)(ws + WS_VM);
    int* RE = (int*)(ws + WS_RE); float* RW = (float*)(ws + WS_RW); int* ROWTOK = (int*)(ws + WS_ROWTOK); int* TILEE = (int*)(ws + WS_TILEE);
    bf16_t* H = (bf16_t*)(ws + WS_H); bf16_t* U = (bf16_t*)(ws + WS_U); bf16_t* GATE = (bf16_t*)(ws + WS_GATE);
    bf16_t* Q = (bf16_t*)(ws + WS_Q); bf16_t* K = (bf16_t*)(ws + WS_K); bf16_t* V = (bf16_t*)(ws + WS_V);
    bf16_t* YL = (bf16_t*)(ws + WS_YL); bf16_t* YF = (bf16_t*)(ws + WS_YF); bf16_t* MIXED = (bf16_t*)(ws + WS_MIXED);
    float* X1F = p.out;     float* LA = (float*)(ws + WS_LA); float* LB = (float*)(ws + WS_LB);
    bf16_t* QM = (bf16_t*)(ws + WS_QM); bf16_t* OM = (bf16_t*)(ws + WS_OM); unsigned char* HDN = ws + WS_HDN; unsigned char* YB = ws + WS_YB;

    bf16_t* WT_IN = (bf16_t*)(ws + WS_WT_IN); bf16_t* WT_KV = (bf16_t*)(ws + WS_WT_KV); bf16_t* WT_OUT = (bf16_t*)(ws + WS_WT_OUT);
    bf16_t* WT_Q = (bf16_t*)(ws + WS_WT_Q); bf16_t* WT_O = (bf16_t*)(ws + WS_WT_O); unsigned char* WT_GU = ws + WS_WT_GU; unsigned char* WT_D = ws + WS_WT_D; unsigned char* X2Q = ws + WS_X2Q;
    bf16_t* LRUW = (bf16_t*)(ws + WS_LRUW);
    bf16_t* WT_R = (bf16_t*)(ws + WS_WT_R); float* RSTD2 = (float*)(ws + WS_RSTD2); int* LIST = (int*)(ws + WS_LIST);
    bf16_t* X1B = (bf16_t*)(ws + WS_X1B); bf16_t* X2B = (bf16_t*)(ws + WS_X2B); float* SSL = (float*)(ws + WS_SSL); float* SSF = (float*)(ws + WS_SSF);
    float* SS1 = (float*)(ws + WS_SS1); float* SS2 = (float*)(ws + WS_SS2); float* RSL = (float*)(ws + WS_RSL); int* POSR = (int*)(ws + WS_POSR);
    float* SUMA = (float*)(ws + WS_SUMA); float* SUMH = (float*)(ws + WS_SUMH);
    LAS unsigned char* ldsl = (LAS unsigned char*)lds;
    volatile LAS unsigned* MISC = (volatile LAS unsigned*)((LAS unsigned char*)lds + MISC_OFF);
    if (threadIdx.x < 32) MISC[threadIdx.x] = 0u;
    __syncthreads();
    XcdBarrier bar = xcd_barrier_post((unsigned*)(ws + WS_CTL) + CW_BAR, MISC + 8);
#define GRID_BAR() xcd_barrier(bar)
#define FOR_VB(NB) for (int _vb0 = 2 * bid; _vb0 < (NB); _vb0 += 2 * G) { const int vb = (_vb0 + half < (NB)) ? (_vb0 + half) : ((NB) - 1);
#define END_VB }

    { PHASE_IDS
    {
        LAS unsigned* scr = (LAS unsigned*)(ldsl + wave * 17408);
        constexpr int I_IN = (DM / 128) * (2560 / 64), I_KV = (DM / 128) * (1024 / 64), I_OUT = (DM / 128) * (DM / 64), I_Q = (DM / 128) * (MEM_W / 64), I_O = (MEM_W / 128) * (DM / 64);
        constexpr int NITEMS = I_IN + I_KV + I_OUT + I_Q + I_O;
        for (int it = gw; it < NITEMS; it += NGW) {
            int r = it;
            if (r < I_IN) { p0_transpose_item<1, false>(w_in, IN_COLS, DM, 2560, WT_IN, scr, r, lane, nullptr, nullptr, 0); continue; } r -= I_IN;
            if (r < I_KV) { p0_transpose_item<0, false>(mem_wkv, 2 * MEM_W, DM, 2 * MEM_W, WT_KV, scr, r, lane, nullptr, nullptr, 0); continue; } r -= I_KV;
            if (r < I_OUT) { p0_transpose_item<0, true>(w_out, DM, DM, DM, WT_OUT, scr, r, lane, lru_out_g, fox_out_g, 512); continue; } r -= I_OUT;
            if (r < I_Q) { p0_transpose_item<0, true>(mem_wq, MEM_W, DM, MEM_W, WT_Q, scr, r, lane, norm_mem_x_g, norm_mem_x_g, 1 << 30); continue; } r -= I_Q;
            p0_transpose_item<0, false>(mem_wo, DM, MEM_W, DM, WT_O, scr, r, lane, nullptr, nullptr, 0);
        }
    }
    asm volatile("s_waitcnt vmcnt(0)" ::: "memory");
    __syncthreads();
    if (tid == 0) __hip_atomic_fetch_add(ctl + CW_P0A, 1, __ATOMIC_RELAXED, __HIP_MEMORY_SCOPE_AGENT);
    }
    { PHASE_IDS
    {
        LAS float* wfT = (LAS float*)ldsl;
        for (int i = tid; i < 8 * 1024; i += NTHREADS) { const int k = i >> 3, h = i & 7; wfT[h * 1024 + k] = w_in[(size_t)k * IN_COLS + 2560 + h]; }
        __syncthreads();
        b_rmsnorm_rows_f(x, norm_mix_g, H, wfT, b_forget, LOGF, (bid & 7) * SEQ + (bid >> 3) * NWAVES + wave, (G >> 3) * NWAVES, (bid & 7) * SEQ + SEQ, lane);
    }
    asm volatile("s_waitcnt vmcnt(0)" ::: "memory");
    __syncthreads();
    if (tid == 0) __hip_atomic_fetch_add(ctl + CW_P0B + (bid & 7), 1, __ATOMIC_RELAXED, __HIP_MEMORY_SCOPE_AGENT);
    }
    { PHASE_IDS
    if (bid == 0 && tid < 128) ctl[tid] = 0;
    static_assert(TM <= 256 * NWAVES && 48 * DM <= 256 * NTHREADS && 8 * 16 * 64 * 8 <= 256 * NTHREADS, "P0c: one item of each kind per wave / thread");
    const bool do_m = gw < TM, do_r = gt < 48 * DM, do_l = gt < 8 * 16 * 64 * 8;
    f32x4 mv[4]; float rv = 0.f, rg = 0.f, lv = 0.f;
    { const f32x4* xr = (const f32x4*)(mem + (size_t)(do_m ? gw : 0) * DM) + lane;
#pragma unroll
      for (int j = 0; j < 4; ++j) mv[j] = xr[64 * j]; }
    { const int i = do_r ? gt : 0, col = i >> 10, k = i & 1023;
      if (col < 4) rv = r_gw[(size_t)k * 4 + col]; else if (col < 36) rv = r_ew[(size_t)k * 32 + col - 4];
      rg = norm_ffn_g[k]; }
    { const int i = do_l ? gt : 0;
      const int j = i & 7, ln = (i >> 3) & 63, s_ = (i >> 9) & 3, n = (i >> 11) & 1, mat = (i >> 12) & 1, blk = i >> 13;
      const float* W = mat ? lru_wx : lru_wa;
      lv = W[(size_t)blk * 4096 + (16 * s_ + 8 * (ln >> 5) + j) * 64 + 32 * n + (ln & 31)]; }
    asm volatile("" ::: "memory");
    if (do_r) WT_R[gt] = f2bf(rv * rg);
    if (do_l) LRUW[gt] = f2bf(lv);
    { float ssum = 0.f;
#pragma unroll
      for (int j = 0; j < 4; ++j) ssum += mv[j].x * mv[j].x + mv[j].y * mv[j].y + mv[j].z * mv[j].z + mv[j].w * mv[j].w;
      const float rstd = rsqrtf(wave_sum(ssum) * (1.f / DM) + EPS);
      if (do_m) { const f32x4* gr = (const f32x4*)norm_mem_g + lane; uint2* o = (uint2*)(MEMN + (size_t)gw * DM) + lane;
#pragma unroll
        for (int j = 0; j < 4; ++j) { const f32x4 gg = gr[64 * j]; uint2 w;
          w.x = (unsigned)f2bf(mv[j].x * rstd * gg.x) | ((unsigned)f2bf(mv[j].y * rstd * gg.y) << 16);
          w.y = (unsigned)f2bf(mv[j].z * rstd * gg.z) | ((unsigned)f2bf(mv[j].w * rstd * gg.w) << 16);
          o[64 * j] = w; } } }
    }
    { if (threadIdx.x == 0) { unsigned sp = 0;
        while (__hip_atomic_load(ctl + CW_P0A, __ATOMIC_RELAXED, __HIP_MEMORY_SCOPE_AGENT) < (int)gridDim.x || __hip_atomic_load(ctl + CW_P0B + (blockIdx.x & 7), __ATOMIC_RELAXED, __HIP_MEMORY_SCOPE_AGENT) < (int)(gridDim.x >> 3)) { __builtin_amdgcn_s_sleep(4); if (++sp > (1u << 22)) break; } }
      __syncthreads(); }
    { PHASE_IDS
    { const pg8::Gemm g{H, WT_IN, DM, DM, DM, 0, 0, 0, 0};
      const pg8::EpiInProj E{U, fox_q_g, fox_k_g};
      static_assert(WS_GATE - WS_U == 32 * MiB && WS_Q - WS_GATE == 32 * MiB && WS_K - WS_Q == 32 * MiB && WS_V - WS_K == 32 * MiB, "EpiInProj: section stride");
      { pg8::StaticOrder S; S.init(T, 2560, G, bid); pg8::gemm_phase<pg8::EpiInProj, pg8::StaticOrder, true>(ldsl, g, S, E); } }
    }
    GRID_BAR();
    { PHASE_IDS
    { constexpr int NB = BATCH * FOX_H;
      FOR_VB(NB) b_cumsum(LOGF, CUM, vb, vt, sm, true); END_VB
      asm volatile("s_waitcnt vmcnt(0)" ::: "memory");
      __syncthreads();
      if (tid == 0 && 2 * bid < NB) __hip_atomic_fetch_add(ctl + CW_CUMC + (2 * bid) / FOX_H, 2, __ATOMIC_RELAXED, __HIP_MEMORY_SCOPE_AGENT); }
    for (int u = bid; u < BATCH * lru::NCH; u += G) lru::unit<false>(u / lru::NCH, u % lru::NCH, U, GATE, conv_w, conv_b, LRUW, lru_ba, lru_bx, lru_a_param, SUMA, SUMH, YL, SSL, ws + WS_H, ldsl + wave * lru::WLDS, wave, lane);
    asm volatile("s_waitcnt vmcnt(0)" ::: "memory");
    __syncthreads();
    if (tid == 0) { for (int u = bid; u < BATCH * lru::NCH; u += G) __hip_atomic_fetch_add(ctl + CW_LRUC + u / lru::NCH, 1, __ATOMIC_RELAXED, __HIP_MEMORY_SCOPE_AGENT);
      for (int u = bid; u < BATCH * lru::NCH; u += G) { unsigned sp = 0;
        while (__hip_atomic_load(ctl + CW_LRUC + u / lru::NCH, __ATOMIC_RELAXED, __HIP_MEMORY_SCOPE_AGENT) < lru::NCH) { __builtin_amdgcn_s_sleep(4); if (++sp > (1u << 22)) break; } } }
    __syncthreads();
    for (int u = bid; u < BATCH * lru::NCH; u += G) lru::unit<true>(u / lru::NCH, u % lru::NCH, U, GATE, conv_w, conv_b, LRUW, lru_ba, lru_bx, lru_a_param, SUMA, SUMH, YL, SSL, ws + WS_H, ldsl + wave * lru::WLDS, wave, lane);
    __syncthreads();
    fox::attn_phase<8>((char*)lds, Q, K, V, YF, CUM, SSF, ctl + 100 + (bid & 7), fox::ConvArgs{w_gate, w_up, w_down, norm_ffn_g, WT_GU, WT_D, MEMN, WT_KV, KM, VM, ctl + CW_CUMC});
    }
    GRID_BAR();
    { PHASE_IDS
    { const pg8::Gemm g{YL, WT_OUT, 512, DM, 512, (size_t)(WS_YF - WS_YL) / 2, 512, 0, 0}; pg8::PairOrder S; S.init(T, DM, G, bid);
      const pg8::EpiOutChain E{x, X1B, SSL, SSF, SS1};
      pg8::gemm_phase<pg8::EpiOutChain, pg8::PairOrder, true>(ldsl, g, S, E); }
    }
    GRID_BAR();
    { PHASE_IDS
    { const pg8::Gemm g{X1B, WT_Q, DM, DM, DM, 0, 0, 0, 0}; pg8::StaticOrder S; S.init(T, MEM_W, G, bid);
      const pg8::EpiRowScale E{QM, 512, SS1, 1.f / DM};
      pg8::gemm_phase<pg8::EpiRowScale, pg8::StaticOrder, true>(ldsl, g, S, E); }
    }
    GRID_BAR();
    { PHASE_IDS
    static_assert(xat::LDS_NEED <= MISC_OFF, "cross-attention LDS");
    for (int it = bid; it < BATCH * MEM_H * 8; it += G) { const int bh = it >> 3; xat::item(bh / MEM_H, bh % MEM_H, it & 7, QM, KM, VM, OM, mem_q_g, mem_k_g, ldsl); }
    }
    GRID_BAR();
    { PHASE_IDS
    { const pg8::Gemm g{OM, WT_O, MEM_W, MEM_W, MEM_W, 0, 0, 0, 0}; pg8::StaticOrder S; S.init(T, DM, G, bid);
      const pg8::EpiX2 E{X1B, X2B, X2Q, SS2};
      pg8::gemm_phase<pg8::EpiX2, pg8::StaticOrder, true>(ldsl, g, S, E); }
    }
    GRID_BAR();
    { PHASE_IDS
    static_assert(T / 16 == 256 * NWAVES, "router: one 16-token task per wave on a 256-workgroup grid");
    LAS int* hist = (LAS int*)(ldsl + 8 * 8448 + 36 * 2064);
    LAS unsigned char* wr = ldsl + 8 * 8448;
    if (tid < 64) hist[tid] = 0;
    { static_assert(36 * 128 == 9 * NTHREADS, "router weight fill: nine 16-byte pieces per thread");
      pg8::u32x4 wv[9];
#pragma unroll
      for (int j = 0; j < 9; ++j) { const int i = tid + j * NTHREADS, row = i >> 7, ch = i & 127; wv[j] = *(const pg8::u32x4*)(WT_R + (size_t)row * DM + ch * 8); }
      asm volatile("" ::: "memory");
#pragma unroll
      for (int j = 0; j < 9; ++j) { const int i = tid + j * NTHREADS, row = i >> 7, ch = i & 127; *(LAS pg8::u32x4*)(wr + row * 2064 + ch * 16) = wv[j]; } }
    __syncthreads();
    for (int tk = gw; tk < T / 16; tk += NGW) rtr::task(tk * 16, X2B, WT_R, SS2, r_gb, r_eb, RW, RSL, POSR, ctl, LIST, (LAS float*)(ldsl + wave * 8448), wr, hist, lane);
    }
    GRID_BAR();
    { PHASE_IDS
    LAS int* mp = (LAS int*)(ldsl + 131072);
    if (tid == 0) { int run = 0; for (int e = 0; e < N_EXP; ++e) { const int c_ = ctl[e]; mp[e] = run; mp[64 + e] = c_; run += (c_ + 255) & ~255; } mp[32] = run; }
    __syncthreads();
    if (tid < N_TILES) { const int row = tid * 256; int e = 0; for (int j = 1; j < N_EXP; ++j) if (mp[j] <= row) e = j; mp[128 + tid] = e; }
    __syncthreads();
    { const pg8::Gemm g{X2Q, WT_GU, DM, DM, DM, 0, (size_t)1024 * 1024, 0x7f7f7f7f, 0x7a7a7a7a};
      const pg8::MoeOrder<true> S{(mp[32] >> 8) * 4, G, bid, mp, LIST};
      const pg8::EpiMoe1 E{HDN, RSL};
      pg8::gemm_phase<pg8::EpiMoe1, pg8::MoeOrder<true>, true>(ldsl, g, S, E); }
    }
    GRID_BAR();
    { PHASE_IDS
    LAS int* mp = (LAS int*)(ldsl + 131072);
    { const pg8::Gemm g{HDN, WT_D, D_EXP, D_EXP, D_EXP, 0, (size_t)1024 * 512, 0x7c7c7c7c, 0x7a7a7a7a};
      const pg8::MoeOrder<false> S{(mp[32] >> 8) * 4, G, bid, mp, LIST};
      const pg8::EpiMoe2 E{YB};
      pg8::gemm_phase<pg8::EpiMoe2, pg8::MoeOrder<false>, true>(ldsl, g, S, E); }
    }
    GRID_BAR();
    { PHASE_IDS
    const LAS int* mp = (const LAS int*)(ldsl + 131072);
    static_assert((2 * T) % (4 * 256 * NWAVES) == 0, "final combine: four half-row items per wave and iteration");
#pragma unroll 1
    for (int k = 0; k < 2 * T / NGW; k += 4) {
        unsigned pa[4], pb[4]; float wa[4], wb[4];
#pragma unroll
        for (int j = 0; j < 4; ++j) { const int t = ((k + j) * NGW + gw) >> 1; pa[j] = (unsigned)POSR[2 * t]; pb[j] = (unsigned)POSR[2 * t + 1]; wa[j] = RW[2 * t]; wb[j] = RW[2 * t + 1]; }
        uint4 xv[4]; uint2 ya[4], yb[4];
#pragma unroll
        for (int j = 0; j < 4; ++j) { const int hr = (k + j) * NGW + gw; const size_t c = (size_t)(hr & 1) * 512 + lane * 8;
            const size_t ra = (size_t)(mp[pa[j] >> 20] + (int)(pa[j] & 0xfffffu)), rb = (size_t)(mp[pb[j] >> 20] + (int)(pb[j] & 0xfffffu));
            xv[j] = *(const uint4*)(X2B + (size_t)(hr >> 1) * DM + c); ya[j] = *(const uint2*)(YB + ra * DM + c); yb[j] = *(const uint2*)(YB + rb * DM + c); }
#pragma unroll
        for (int j = 0; j < 4; ++j) { const int hr = (k + j) * NGW + gw; b_final2(out + (size_t)(hr >> 1) * DM + (size_t)(hr & 1) * 512 + lane * 8, xv[j], ya[j], yb[j], 0.125f * wa[j], 0.125f * wb[j]); }
    }
    }
}

extern "C" void kernel_launch(void* const* d_in, const int* in_sizes, int n_in, void* d_out, int out_size, void* d_ws, size_t ws_size, hipStream_t stream) {
    static int grid = 0;
    if (grid == 0) {
        int dev = 0, cus = 0;
        if (hipGetDevice(&dev) != hipSuccess || hipDeviceGetAttribute(&cus, hipDeviceAttributeMultiprocessorCount, dev) != hipSuccess) { fprintf(stderr, "kernel_launch: device query failed\n"); grid = -1; return; }
        if (hipFuncSetAttribute((const void*)mega_fwd, hipFuncAttributeMaxDynamicSharedMemorySize, LDS_BYTES) != hipSuccess) { fprintf(stderr, "kernel_launch: hipFuncSetAttribute failed\n"); grid = -1; return; }
        if (n_in != 32 || ws_size < WS_END) { fprintf(stderr, "kernel_launch: unexpected inputs (n_in %d, ws %zu)\n", n_in, ws_size); grid = -1; return; }
        int per_cu = 0;
        if (hipOccupancyMaxActiveBlocksPerMultiprocessor(&per_cu, (const void*)mega_fwd, NTHREADS, LDS_BYTES) != hipSuccess || per_cu < 1 || cus < 256) {
            fprintf(stderr, "kernel_launch: needs 256 co-resident workgroups (CUs %d, workgroups per CU %d)\n", cus, per_cu); grid = -1; return; }
        grid = 256;
    }
    if (grid < 0) return;
    (void)hipMemsetAsync((char*)d_ws + WS_CTL, 0, CTL_ZERO_BYTES, stream);
    Params p{};
    for (int i = 0; i < 32; ++i) p.in[i] = (const float*)d_in[i];
    p.out = (float*)d_out; p.ws = (unsigned char*)d_ws;
    hipLaunchKernelGGL(mega_fwd, dim3(grid), dim3(NTHREADS), LDS_BYTES, stream, p);
}
```
